# Optimizing an MI355X kernel written in HIP

```python
import math
import jax, jax.numpy as jnp
from jax import lax
import numpy as np

D_MODEL = 1024
BATCH = 8
SEQ = 2048
DEPTH = 2

GRID_W = 64
CTX_LEN = 256
RMS_EPS = 1e-6
S5_WIDTH = D_MODEL // 2
SC_WIDTH = D_MODEL - S5_WIDTH
S5_GROUP = 16
S5_GROUPS = S5_WIDTH // S5_GROUP
S5_STATE = 64
A_RE_MAX = -1e-4
DT_MIN = 1e-3
DT_MAX = 1e-1
SC_KW = 3
NA_HEAD_DIM = 64
NA_HEADS = D_MODEL // NA_HEAD_DIM
WIN_H = 8
WIN_W = 16
N_EXPERTS = 64
TOP_K = 8
N_GROUPS = 8
TOPK_GROUPS = 4
EXPERT_DIM = D_MODEL // 4
SHARED_DIM = EXPERT_DIM
ROUTED_SCALE = 2.5

kernel_name = 'hybrid_s5_shortconv_natten_moe_dit'


def rms_norm(x, g):
    xf = x.astype(jnp.float32)
    y = xf * lax.rsqrt(jnp.mean(xf * xf, axis=-1, keepdims=True) + RMS_EPS)
    return (y * g.astype(jnp.float32)).astype(x.dtype)


def modulate(h, shift, scale):
    return h * (1 + scale[:, None]) + shift[:, None]


def short_conv(u, w):
    L = u.shape[1]
    pad = SC_KW // 2
    up = jnp.pad(u, ((0, 0), (pad, SC_KW - 1 - pad), (0, 0)))
    return sum(up[:, k:k + L] * w[k] for k in range(SC_KW))


def _s5_combine(left, right):
    a1, b1 = left
    a2, b2 = right
    return a1 * a2, a2 * b1 + b2


def s5_direction(u_lat, u_ctx, a_re, a_im, log_dt, b_re, b_im, c_re, c_im, reverse, want_ctx):
    f32 = jnp.float32
    lam = lax.complex(jnp.minimum(a_re.astype(f32), A_RE_MAX), a_im.astype(f32))
    dt = jnp.exp(log_dt.astype(f32))[:, None]
    a_bar = jnp.exp(lam * dt)
    b_bar = ((a_bar - 1) / lam)[..., None] * lax.complex(b_re.astype(f32), b_im.astype(f32))
    c_mat = lax.complex(c_re.astype(f32), c_im.astype(f32))
    start = -1 if reverse else 0

    def scan(u, h0):
        bu = jnp.einsum('blgc,gpc->blgp', u.astype(jnp.complex64), b_bar)
        if h0 is not None:
            bu = bu.at[:, start].add(a_bar * h0)
        _, h = lax.associative_scan(_s5_combine, (jnp.broadcast_to(a_bar, bu.shape), bu),
                                    reverse=reverse, axis=1)
        return h

    def readout(h):
        return jnp.real(jnp.einsum('blgp,gcp->blgc', h, c_mat))

    h_ctx = scan(u_ctx, None)
    h_ctx_final = h_ctx[:, 0] if reverse else h_ctx[:, -1]
    y_lat = readout(scan(u_lat, h_ctx_final))
    y_ctx = readout(h_ctx) if want_ctx else None
    return y_lat, y_ctx


def s5_mixer(u_lat, u_ctx, a_re, a_im, log_dt, b_re, b_im, c_re, c_im, d_skip, glu_w, glu_b, want_ctx):
    f32 = jnp.float32

    def groups(u):
        return u.astype(f32).reshape(u.shape[0], u.shape[1], S5_GROUPS, S5_GROUP)

    ul, uc = groups(u_lat), groups(u_ctx)
    dg = d_skip.astype(f32).reshape(S5_GROUPS, S5_GROUP)
    y_lat = dg * ul
    y_ctx = dg * uc if want_ctx else None
    for d, rev in enumerate((False, True)):
        yl, yc = s5_direction(ul, uc, a_re[d], a_im[d], log_dt[d], b_re[d], b_im[d],
                              c_re[d], c_im[d], rev, want_ctx)
        y_lat = y_lat + yl
        if want_ctx:
            y_ctx = y_ctx + yc

    def glu(y, dtype):
        g = jax.nn.gelu(y.reshape(y.shape[0], y.shape[1], S5_WIDTH))
        return (g * jax.nn.sigmoid(g @ glu_w.astype(f32) + glu_b.astype(f32))).astype(dtype)

    return glu(y_lat, u_lat.dtype), (glu(y_ctx, u_ctx.dtype) if want_ctx else None)


def hybrid_mixer(h_lat, h_ctx, w_in, a_re, a_im, log_dt, b_re, b_im, c_re, c_im, d_skip,
                 glu_w, glu_b, conv_w, w_out, want_ctx):
    split_at = (S5_WIDTH, S5_WIDTH + SC_WIDTH, S5_WIDTH + 2 * SC_WIDTH)
    u_lat, bg_lat, cg_lat, v_lat = jnp.split(h_lat @ w_in, split_at, axis=-1)
    if want_ctx:
        u_ctx, bg_ctx, cg_ctx, v_ctx = jnp.split(h_ctx @ w_in, split_at, axis=-1)
    else:
        u_ctx = h_ctx @ w_in[:, :S5_WIDTH]
    s5_lat, s5_ctx = s5_mixer(u_lat, u_ctx, a_re, a_im, log_dt, b_re, b_im, c_re, c_im,
                              d_skip, glu_w, glu_b, want_ctx)
    sc_lat = bg_lat * short_conv(cg_lat * v_lat, conv_w)
    y_lat = jnp.concatenate([s5_lat, sc_lat], axis=-1) @ w_out
    y_ctx = None
    if want_ctx:
        sc_ctx = bg_ctx * short_conv(cg_ctx * v_ctx, conv_w)
        y_ctx = jnp.concatenate([s5_ctx, sc_ctx], axis=-1) @ w_out
    return y_lat, y_ctx


def na_mixer(h_lat, h_ctx, w_qkv, q_g, k_g, rpb, w_out, want_ctx):
    B, L, D = h_lat.shape
    rows = L // GRID_W
    kh, kw = min(WIN_H, rows), min(WIN_W, GRID_W)
    scale = NA_HEAD_DIM ** -0.5

    def heads(t):
        return t.reshape(t.shape[0], t.shape[1], NA_HEADS, NA_HEAD_DIM)

    q, k, v = jnp.split(h_lat @ w_qkv, 3, axis=-1)
    q, k, v = rms_norm(heads(q), q_g), rms_norm(heads(k), k_g), heads(v)
    if want_ctx:
        qc, kc, vc = jnp.split(h_ctx @ w_qkv, 3, axis=-1)
        qc = rms_norm(heads(qc), q_g)
    else:
        kc, vc = jnp.split(h_ctx @ w_qkv[:, D:], 2, axis=-1)
    kc, vc = rms_norm(heads(kc), k_g), heads(vc)

    def grid(t):
        return t.reshape(B, rows, GRID_W, NA_HEADS, NA_HEAD_DIM).transpose(1, 0, 3, 2, 4)

    q_grid, k_grid, v_grid = grid(q), grid(k), grid(v)
    row_start = jnp.clip(jnp.arange(rows) - kh // 2, 0, rows - kh)
    cols = jnp.arange(GRID_W)
    col_idx = jnp.clip(cols - kw // 2, 0, GRID_W - kw)[:, None] + jnp.arange(kw)[None]
    col_off = col_idx - cols[:, None]

    def row_block(args):
        q_r, r, r0 = args
        k_win = lax.dynamic_slice_in_dim(k_grid, r0, kh, axis=0)[:, :, :, col_idx]
        v_win = lax.dynamic_slice_in_dim(v_grid, r0, kh, axis=0)[:, :, :, col_idx]
        row_off = r0 + jnp.arange(kh) - r
        bias = rpb[:, row_off[:, None, None] + WIN_H - 1, col_off[None] + WIN_W - 1]
        s_lat = (jnp.einsum('bhwd,ibhwjd->bhwij', q_r, k_win).astype(jnp.float32) * scale
                 + bias.transpose(0, 2, 1, 3)[None].astype(jnp.float32))
        s_ctx = jnp.einsum('bhwd,bnhd->bhwn', q_r, kc).astype(jnp.float32) * scale
        s = jnp.concatenate([s_lat.reshape(B, NA_HEADS, GRID_W, kh * kw), s_ctx], axis=-1)
        p = jax.nn.softmax(s, axis=-1).astype(v_win.dtype)
        p_lat = p[..., :kh * kw].reshape(B, NA_HEADS, GRID_W, kh, kw)
        return (jnp.einsum('bhwij,ibhwjd->bhwd', p_lat, v_win)
                + jnp.einsum('bhwn,bnhd->bhwd', p[..., kh * kw:], vc))

    o = lax.map(row_block, (q_grid, jnp.arange(rows), row_start))
    y_lat = o.transpose(1, 0, 3, 2, 4).reshape(B, L, D) @ w_out
    y_ctx = None
    if want_ctx:
        sc = jnp.einsum('bnhd,bmhd->bhnm', qc, kc).astype(jnp.float32) * scale
        pc = jax.nn.softmax(sc, axis=-1).astype(vc.dtype)
        oc = jnp.einsum('bhnm,bmhd->bnhd', pc, vc)
        y_ctx = oc.reshape(oc.shape[0], oc.shape[1], D) @ w_out
    return y_lat, y_ctx


def moe_ffn(h, router_w, router_bias, w_gate, w_up, w_down, s_gate, s_up, s_down):
    f32 = jnp.float32

    def per_sample(hs):
        scores = jax.nn.sigmoid((hs @ router_w).astype(f32))
        sel = scores + router_bias.astype(f32)
        grp = sel.reshape(sel.shape[0], N_GROUPS, N_EXPERTS // N_GROUPS)
        grp_score = lax.top_k(grp, 2)[0].sum(-1)
        _, grp_idx = lax.top_k(grp_score, TOPK_GROUPS)
        grp_mask = jax.nn.one_hot(grp_idx, N_GROUPS, dtype=f32).sum(-2)
        expert_mask = jnp.repeat(grp_mask, N_EXPERTS // N_GROUPS, axis=-1)
        sel = jnp.where(expert_mask > 0, sel, -jnp.inf)
        _, idx = lax.top_k(sel, TOP_K)
        w = jnp.take_along_axis(scores, idx, axis=-1)
        w = w / jnp.sum(w, axis=-1, keepdims=True) * ROUTED_SCALE
        gate = jnp.sum(jax.nn.one_hot(idx, N_EXPERTS, dtype=f32) * w[..., None], axis=-2)
        act = (jax.nn.silu(jnp.einsum('ld,edf->lef', hs, w_gate))
               * jnp.einsum('ld,edf->lef', hs, w_up) * gate[..., None].astype(hs.dtype))
        routed = jnp.einsum('lef,efd->ld', act, w_down)
        shared = (jax.nn.silu(hs @ s_gate) * (hs @ s_up)) @ s_down
        return routed + shared

    return lax.map(per_sample, h)


def setup_inputs(seed: int = 0) -> dict:
    key = jax.random.key(seed)
    ks = iter(jax.random.split(key, 48))
    f32 = jnp.float32

    def nrm(shape, scale):
        return scale * jax.random.normal(next(ks), shape, f32)

    ne, no = (DEPTH + 1) // 2, DEPTH // 2
    D, G, P, GC = D_MODEL, S5_GROUPS, S5_STATE, S5_GROUP
    n_idx = jnp.arange(P, dtype=f32)
    inp = {}
    inp['x'] = nrm((BATCH, SEQ, D), 1.0)
    inp['c'] = nrm((BATCH, D), 1.0)
    inp['ctx'] = nrm((BATCH, CTX_LEN, D), 1.0)
    inp['c_ctx'] = nrm((D,), 1.0)
    inp['ada_w'] = nrm((DEPTH, D, 6 * D), 0.5 * D ** -0.5)
    inp['ada_b'] = nrm((DEPTH, 6 * D), 0.02)
    inp['norm_mix_g'] = 1.0 + nrm((DEPTH, D), 0.02)
    inp['norm_ffn_g'] = 1.0 + nrm((DEPTH, D), 0.02)
    inp['hyb_w_in'] = nrm((ne, D, S5_WIDTH + 3 * SC_WIDTH), D ** -0.5)
    inp['s5_a_re'] = -0.5 + nrm((ne, 2, G, P), 0.01)
    inp['s5_a_im'] = math.pi * n_idx + nrm((ne, 2, G, P), 0.01)
    inp['s5_log_dt'] = jax.random.uniform(next(ks), (ne, 2, G), f32, math.log(DT_MIN), math.log(DT_MAX))
    inp['s5_b_re'] = nrm((ne, 2, G, P, GC), (2 * GC) ** -0.5)
    inp['s5_b_im'] = nrm((ne, 2, G, P, GC), (2 * GC) ** -0.5)
    inp['s5_c_re'] = nrm((ne, 2, G, GC, P), P ** -0.5)
    inp['s5_c_im'] = nrm((ne, 2, G, GC, P), P ** -0.5)
    inp['s5_d'] = nrm((ne, S5_WIDTH), 1.0)
    inp['s5_glu_w'] = nrm((ne, S5_WIDTH, S5_WIDTH), S5_WIDTH ** -0.5)
    inp['s5_glu_b'] = nrm((ne, S5_WIDTH), 0.02)
    inp['sc_conv_w'] = nrm((ne, SC_KW, SC_WIDTH), SC_KW ** -0.5)
    inp['hyb_w_out'] = nrm((ne, D, D), D ** -0.5)
    inp['na_w_qkv'] = nrm((no, D, 3 * D), D ** -0.5)
    inp['na_q_g'] = 1.0 + nrm((no, NA_HEAD_DIM), 0.02)
    inp['na_k_g'] = 1.0 + nrm((no, NA_HEAD_DIM), 0.02)
    inp['na_rpb'] = nrm((no, NA_HEADS, 2 * WIN_H - 1, 2 * WIN_W - 1), 0.02)
    inp['na_w_out'] = nrm((no, D, D), D ** -0.5)
    inp['moe_router_w'] = nrm((DEPTH, D, N_EXPERTS), D ** -0.5)
    inp['moe_router_bias'] = nrm((DEPTH, N_EXPERTS), 0.01)
    inp['moe_w_gate'] = nrm((DEPTH, N_EXPERTS, D, EXPERT_DIM), D ** -0.5)
    inp['moe_w_up'] = nrm((DEPTH, N_EXPERTS, D, EXPERT_DIM), D ** -0.5)
    inp['moe_w_down'] = nrm((DEPTH, N_EXPERTS, EXPERT_DIM, D), EXPERT_DIM ** -0.5)
    inp['shared_w_gate'] = nrm((DEPTH, D, SHARED_DIM), D ** -0.5)
    inp['shared_w_up'] = nrm((DEPTH, D, SHARED_DIM), D ** -0.5)
    inp['shared_w_down'] = nrm((DEPTH, SHARED_DIM, D), SHARED_DIM ** -0.5)
    return inp


def reference(x, c, ctx, c_ctx, ada_w, ada_b, norm_mix_g, norm_ffn_g, hyb_w_in, s5_a_re, s5_a_im,
              s5_log_dt, s5_b_re, s5_b_im, s5_c_re, s5_c_im, s5_d, s5_glu_w, s5_glu_b, sc_conv_w,
              hyb_w_out, na_w_qkv, na_q_g, na_k_g, na_rpb, na_w_out, moe_router_w, moe_router_bias,
              moe_w_gate, moe_w_up, moe_w_down, shared_w_gate, shared_w_up, shared_w_down):
    x_lat, x_ctx = x, ctx
    cond = jax.nn.silu(c)
    cond_ctx = jax.nn.silu(c_ctx)[None]
    for l in range(DEPTH):
        last = l == DEPTH - 1
        sh1, sc1, g1, sh2, sc2, g2 = jnp.split(cond @ ada_w[l] + ada_b[l], 6, axis=-1)
        csh1, csc1, cg1, csh2, csc2, cg2 = jnp.split(cond_ctx @ ada_w[l] + ada_b[l], 6, axis=-1)
        a_lat = modulate(rms_norm(x_lat, norm_mix_g[l]), sh1, sc1)
        a_ctx = modulate(rms_norm(x_ctx, norm_mix_g[l]), csh1, csc1)
        if l % 2 == 0:
            e = l // 2
            y_lat, y_ctx = hybrid_mixer(a_lat, a_ctx, hyb_w_in[e], s5_a_re[e], s5_a_im[e], s5_log_dt[e],
                                        s5_b_re[e], s5_b_im[e], s5_c_re[e], s5_c_im[e], s5_d[e],
                                        s5_glu_w[e], s5_glu_b[e], sc_conv_w[e], hyb_w_out[e], not last)
        else:
            o = l // 2
            y_lat, y_ctx = na_mixer(a_lat, a_ctx, na_w_qkv[o], na_q_g[o], na_k_g[o], na_rpb[o],
                                    na_w_out[o], not last)
        x_lat = x_lat + g1[:, None] * y_lat
        f_lat = moe_ffn(modulate(rms_norm(x_lat, norm_ffn_g[l]), sh2, sc2), moe_router_w[l],
                        moe_router_bias[l], moe_w_gate[l], moe_w_up[l], moe_w_down[l],
                        shared_w_gate[l], shared_w_up[l], shared_w_down[l])
        x_lat = x_lat + g2[:, None] * f_lat
        if not last:
            x_ctx = x_ctx + cg1[:, None] * y_ctx
            f_ctx = moe_ffn(modulate(rms_norm(x_ctx, norm_ffn_g[l]), csh2, csc2), moe_router_w[l],
                            moe_router_bias[l], moe_w_gate[l], moe_w_up[l], moe_w_down[l],
                            shared_w_gate[l], shared_w_up[l], shared_w_down[l])
            x_ctx = x_ctx + cg2[:, None] * f_ctx
    return x_lat
```

```cpp
#include <hip/hip_runtime.h>
#include <stdint.h>
#include <stdio.h>

#ifndef MK_ONE_LAUNCH
#define MK_ONE_LAUNCH 1
#endif

#define GAS __attribute__((address_space(1)))
#define LAS __attribute__((address_space(3)))
typedef unsigned short bf16_t;
typedef short bf16x8 __attribute__((ext_vector_type(8)));
typedef short s16x4 __attribute__((ext_vector_type(4)));
typedef float f32x4 __attribute__((ext_vector_type(4)));
typedef float f32x2 __attribute__((ext_vector_type(2)));
typedef float f32x16 __attribute__((ext_vector_type(16)));
typedef unsigned u32x4 __attribute__((ext_vector_type(4)));
typedef unsigned u32x2 __attribute__((ext_vector_type(2)));

constexpr int NLAT = 16384, NCTX = 2048, NTOK = NLAT + NCTX, DM = 1024;
constexpr int SEQ = 2048, CTXL = 256, NB = 8;
constexpr int NEXP = 64, NEXP1 = 65, EDIM = 256;
constexpr int S5T = 32;
constexpr int S5R = 576, S5RP = 768;
constexpr int S5K = 768;
constexpr int MAXTILES = 712;

constexpr size_t MiB = 1ull << 20;
constexpr size_t WS_CTL = 0;
constexpr size_t WS_MOD = 1 * MiB;
constexpr size_t WS_WIN = 2 * MiB;
constexpr size_t WS_GLU = 6 * MiB;
constexpr size_t WS_HOUT = 7 * MiB;
constexpr size_t WS_QKV = 9 * MiB;
constexpr size_t WS_NOUT = 15 * MiB;
constexpr size_t WS_ROUT = 17 * MiB;
constexpr size_t WS_GU = 18 * MiB;
constexpr size_t WS_DN = 83 * MiB;
constexpr size_t WS_GU1 = 116 * MiB;
constexpr size_t WS_XR = 181 * MiB;
constexpr size_t WS_LOGIT = 253 * MiB;
constexpr size_t WS_TOKE = 258 * MiB;
constexpr size_t WS_TOKW = 259 * MiB;
constexpr size_t WS_TOKP = 260 * MiB;
constexpr size_t WS_ROWIDX = 261 * MiB;
constexpr size_t WS_YROW = 262 * MiB;
constexpr size_t WS_CNTBLK = 263 * MiB;
constexpr size_t WS_TAB = 263 * MiB + 512 * 1024;
constexpr size_t WS_XA = 264 * MiB;
constexpr size_t WS_OVL = 300 * MiB;
constexpr size_t WS_A2 = WS_OVL;
constexpr size_t WS_BCV = WS_OVL + 36 * MiB;
constexpr size_t WS_F = WS_OVL + 90 * MiB;
constexpr size_t WS_Z = WS_OVL + 114 * MiB;
constexpr size_t WS_G = WS_OVL + 150 * MiB;
constexpr size_t WS_ME = WS_OVL + 168 * MiB;
constexpr size_t WS_WF = WS_OVL + 192 * MiB;
constexpr size_t WS_KK = WS_OVL + 200 * MiB;
constexpr size_t WS_PW = WS_OVL + 202 * MiB;
constexpr size_t WS_BB = WS_OVL + 204 * MiB;
constexpr size_t WS_ADAP = WS_OVL + 205 * MiB;
constexpr size_t WS_Q = WS_OVL;
constexpr size_t WS_K = WS_OVL + 32 * MiB;
constexpr size_t WS_VT = WS_OVL + 68 * MiB;
constexpr size_t WS_O = WS_OVL + 104 * MiB;
constexpr size_t WS_Y = WS_XA;
constexpr size_t WS_ACT = WS_XA + 178 * MiB;
constexpr size_t WS_END = WS_ACT + 89 * MiB;

constexpr int RING_BYTES = 131072;
constexpr int MISC_OFF = RING_BYTES;
constexpr int LDS_BYTES = 147456;
constexpr int M_BAR = 0, M_CNT = 64, M_BASE = 384, M_BBASE = 704, M_TILE = 1024, M_PART = 2048, M_NT = 3200;

__device__ __forceinline__ unsigned f2bf(float f) { unsigned u = __builtin_bit_cast(unsigned, f); return (u + 0x7fffu + ((u >> 16) & 1u)) >> 16; }
typedef __bf16 hbf16x2 __attribute__((ext_vector_type(2)));
__device__ __forceinline__ unsigned pk2(float lo, float hi) { const f32x2 v = {lo, hi}; const hbf16x2 b = __builtin_convertvector(v, hbf16x2); return __builtin_bit_cast(unsigned, b); }
__device__ __forceinline__ float bflo(unsigned w) { return __builtin_bit_cast(float, w << 16); }
__device__ __forceinline__ float bfhi(unsigned w) { return __builtin_bit_cast(float, w & 0xffff0000u); }
__device__ __forceinline__ float bf1(bf16_t b) { return __builtin_bit_cast(float, ((unsigned)b) << 16); }
__device__ __forceinline__ float wave_sum(float v) {
#pragma unroll
    for (int o = 1; o < 64; o <<= 1) v += __shfl_xor(v, o);
    return v;
}
__device__ __forceinline__ float sigmoidf_(float x) { return 1.f / (1.f + __expf(-x)); }
__device__ __forceinline__ float siluf_(float x) { return x / (1.f + __expf(-x)); }
__device__ __forceinline__ float gelu_tanh(float x) {
    const float u = 0.7978845608028654f * (x + 0.044715f * x * x * x);
    const float e = __expf(2.f * u);
    const float t = 1.f - 2.f / (e + 1.f);
    return 0.5f * x * (1.f + t);
}

__device__ __forceinline__ int lane_id_opaque() { int l; asm volatile("v_mbcnt_lo_u32_b32 %0, -1, 0\n\tv_mbcnt_hi_u32_b32 %0, -1, %0" : "=v"(l)); return l; }

#define XB_TMO      128
#define XB_XCNT(j)  (256  + 64 * (j))
#define XB_XSUB(j)  (1280 + 64 * (j))
#define XB_XGEN(j)  (2304 + 64 * (j))
#define XB_TOP      3328
#define XB_TOPGEN   3392
#define XCD_BAR_WORDS 3456
#define XB_SPIN_CAP (1u << 18)
__device__ __forceinline__ unsigned xb_ld(unsigned* p)              { return __hip_atomic_load(p, __ATOMIC_RELAXED, __HIP_MEMORY_SCOPE_AGENT); }
__device__ __forceinline__ unsigned xb_add(unsigned* p, unsigned v) { return __hip_atomic_fetch_add(p, v, __ATOMIC_RELAXED, __HIP_MEMORY_SCOPE_AGENT); }
__device__ __forceinline__ unsigned xb_xcc_id() { return (unsigned)__builtin_amdgcn_s_getreg((3 << 11) | 20) & 0xFu; }
#define XB_SPIN(cond, bar) do { unsigned _sp = 0; while (cond) { __builtin_amdgcn_s_sleep(1); \
    if ((++_sp & 255u) == 0u) { if (xb_ld(&(bar)[XB_TMO])) break; if (_sp > XB_SPIN_CAP) { atomicAdd(&(bar)[XB_TMO], 1u); break; } } } } while (0)
struct XcdBarrier { unsigned* bar; unsigned x; volatile LAS unsigned* st; };
__device__ __forceinline__ XcdBarrier xcd_barrier_post(unsigned* bar, volatile LAS unsigned* st) {
    XcdBarrier b; b.bar = bar; b.x = xb_xcc_id(); b.st = st;
    if (threadIdx.x == 0) (void)xb_add(&bar[XB_XCNT(b.x)], 1u);
    return b;
}
__device__ __forceinline__ void xcd_barrier_complete(unsigned* bar, unsigned x, unsigned& nloc, unsigned& nx) {
    const unsigned G = gridDim.x * gridDim.y * gridDim.z;
    unsigned sum, cnt, mine, sp = 0u;
    for (;;) {
        sum = 0u; cnt = 0u; mine = 0u;
#pragma unroll
        for (unsigned j = 0; j < 16; ++j) { const unsigned c = xb_ld(&bar[XB_XCNT(j)]); sum += c; cnt += (c > 0u) ? 1u : 0u; mine = (j == x) ? c : mine; }
        if (sum == G) break;
        __builtin_amdgcn_s_sleep(1);
        if ((++sp & 255u) == 0u) { if (xb_ld(&bar[XB_TMO])) break; if (sp > XB_SPIN_CAP) { atomicAdd(&bar[XB_TMO], 1u); break; } }
    }
    nloc = mine > 0u ? mine : 1u; nx = cnt > 0u ? cnt : 1u;
}
__device__ __forceinline__ void xcd_barrier(const XcdBarrier& b, const int wave0) {
    asm volatile("s_waitcnt vmcnt(0)" ::: "memory");
    __syncthreads();
    if (wave0 == 0 && lane_id_opaque() == 0) {
        unsigned* bar = b.bar;
        __builtin_amdgcn_s_waitcnt(0);
        unsigned nloc = b.st[0], nx = b.st[1];
        if (nloc == 0u) { xcd_barrier_complete(bar, b.x, nloc, nx); b.st[0] = nloc; b.st[1] = nx; }
        const unsigned old = xb_add(&bar[XB_XSUB(b.x)], 1u);
        const unsigned gen = old / nloc;
        if (old + 1u == (gen + 1u) * nloc) {
            __builtin_amdgcn_fence(__ATOMIC_RELEASE, "agent");
            asm volatile("s_waitcnt vmcnt(0)" ::: "memory");
            const unsigned og = xb_add(&bar[XB_TOP], 1u);
            const unsigned tg = og / nx;
            if (og + 1u == (tg + 1u) * nx) xb_add(&bar[XB_TOPGEN], 1u);
            else XB_SPIN(xb_ld(&bar[XB_TOPGEN]) == tg, bar);
            __builtin_amdgcn_fence(__ATOMIC_ACQUIRE, "agent");
            xb_add(&bar[XB_XGEN(b.x)], 1u);
            asm volatile("s_waitcnt vmcnt(0)" ::: "memory");
        } else {
            XB_SPIN(xb_ld(&bar[XB_XGEN(b.x)]) == gen, bar);
            __builtin_amdgcn_fence(__ATOMIC_ACQUIRE, "agent");
            asm volatile("s_waitcnt vmcnt(0)" ::: "memory");
        }
    }
    __syncthreads();
}

namespace g8 {
constexpr int BM = 256, BK = 64, HALF = 128, HTB = HALF * BK * 2, STAGE_BYTES = 8 * HTB, NXCD = 8, WGM = 8;
__host__ __device__ __forceinline__ int lds_byte(int r, int c) { const int st = (r >> 4) * 2 + (c >> 5), rr = r & 15, cc = c & 31, ob = rr * 64 + cc * 2; return st * 1024 + (ob ^ (((ob >> 9) & 1) << 5)); }
__host__ __device__ __forceinline__ void stage_rc(int b, int& R, int& C) { const int st = b / 1024, sb = b % 1024, swz = sb ^ (((sb >> 9) & 1) << 5); R = (st >> 1) * 16 + swz / 64; C = (st & 1) * 32 + (swz % 64) / 2; }
__host__ __device__ __forceinline__ int perm32(int rho) { const int n = rho >> 4, i = rho & 15; return 8 * (i >> 2) + 4 * n + (i & 3); }

struct Unit { unsigned a0; const char* B; int p0, p1, p2; };

__device__ __forceinline__ void static_map(int L, int nM, int nN, int& pm, int& pn) {
    const int nwg = nM * nN; int wgid = L;
    { const int q = nwg / NXCD, r = nwg % NXCD, xcd = wgid % NXCD, off = wgid / NXCD; wgid = (xcd < r ? xcd * (q + 1) : r * (q + 1) + (xcd - r) * q) + off; }
    const int nig = WGM * nN, gid = wgid / nig, fm = gid * WGM, gsz = (nM - fm) < WGM ? (nM - fm) : WGM;
    pm = fm + ((wgid % nig) % gsz); pn = (wgid % nig) / gsz;
}

template <class Epi, class Sched>
__device__ __forceinline__ void gemm_phase(LAS unsigned char* lds, const int wid, const char* Abase, const int K, const unsigned ldb, const Sched& S, const Epi& E) {
    const int lane = lane_id_opaque();
    const int tid = wid * 64 + lane, wr = wid >> 2, wc = wid & 3, fr = lane & 15, fq = lane >> 4;
    const int nt = K / BK;
    unsigned voffB0;
    { int R0, C0; stage_rc(tid * 16, R0, C0);
      const int Rb0 = Epi::GUP ? (256 * ((R0 >> 4) & 1) + 32 * (R0 >> 5) + 8 * ((R0 & 15) >> 2) + (R0 & 3)) : Epi::WIDE ? (64 * (R0 >> 5) + 16 * ((R0 & 15) >> 2) + 4 * ((R0 >> 4) & 1) + (R0 & 3)) : Epi::HEADP ? (64 * (R0 >> 5) + perm32(R0 & 31)) : (Epi::PERM ? ((R0 & ~31) + perm32(R0 & 31)) : R0);
      voffB0 = (unsigned)Rb0 * ldb + (unsigned)C0 * 2u; }
    const size_t hstepB = (size_t)(Epi::GUP ? 4 : Epi::WIDE ? 8 : (Epi::HEADP ? 32 : HALF)) * ldb;
    const size_t p1stepB = (size_t)((Epi::WIDE || Epi::HEADP) ? 128 : 64) * ldb;
    const unsigned ldsw = (unsigned)wid * 1024u;
    const int aoff = lds_byte(wr * 64 + fr, fq * 8), boff = lds_byte(wc * 32 + fr, fq * 8);
#define G8_SA(b, h) (((b) * 2 + (h)) * HTB)
#define G8_SB(b, h) ((4 + (b) * 2 + (h)) * HTB)
#define G8_GLDS(gp, lo) __builtin_amdgcn_global_load_lds((const unsigned*)(gp), (LAS unsigned*)(lds + (lo)), 16, 0, 0)
#define G8_STAGE_A(bufoff, o0, o1, kb, h) do { \
        G8_GLDS(Abase + ((long)(kb) + (Sched::GATHER ? 0l : (long)((h) * 128) * (long)S.lda)) + (size_t)(o0), (bufoff) + ldsw); \
        G8_GLDS(Abase + ((long)(kb) + (Sched::GATHER ? 0l : (long)((h) * 128 + 64) * (long)S.lda)) + (size_t)(o1), (bufoff) + ldsw + 8192); } while (0)
#define G8_STAGE_B(bufoff, bp, kb) do { G8_GLDS((bp) + (size_t)(kb) + (size_t)voffB0, (bufoff) + ldsw); G8_GLDS((bp) + ((size_t)(kb) + p1stepB) + (size_t)voffB0, (bufoff) + ldsw + 8192); } while (0)
#define G8_LDA(dst, b, h) do { _Pragma("unroll") for (int m = 0; m < 4; ++m) _Pragma("unroll") for (int k = 0; k < 2; ++k) dst[m][k] = *(const LAS bf16x8*)(lds + G8_SA(b, h) + aoff + m * 2048 + k * 1024); } while (0)
#define G8_LDB(dst, b, h) do { _Pragma("unroll") for (int n = 0; n < 2; ++n) _Pragma("unroll") for (int k = 0; k < 2; ++k) dst[n][k] = *(const LAS bf16x8*)(lds + G8_SB(b, h) + boff + n * 2048 + k * 1024); } while (0)
#define G8_MMA(ai, bj, At, Bt) do { __builtin_amdgcn_s_setprio(1); _Pragma("unroll") for (int m = 0; m < 4; ++m) _Pragma("unroll") for (int n = 0; n < 2; ++n) _Pragma("unroll") for (int k = 0; k < 2; ++k) \
        acc[ai][bj][m][n] = __builtin_amdgcn_mfma_f32_16x16x32_bf16(Bt[n][k], At[m][k], acc[ai][bj][m][n], 0, 0, 0); __builtin_amdgcn_s_setprio(0); } while (0)
#define G8_WAIT_V(n) asm volatile("s_waitcnt vmcnt(" #n ")" ::: "memory")
#define G8_WAIT_L(n) asm volatile("s_waitcnt lgkmcnt(" #n ")" ::: "memory")
#define G8_BAR __builtin_amdgcn_s_barrier()
#define G8_SCHED __builtin_amdgcn_sched_barrier(0)
    Unit cur, nxt; int ui = 0;
    if (!S.next(0, cur)) return;
    f32x4 acc[2][2][4][2];
#pragma unroll
    for (int a = 0; a < 2; ++a)
#pragma unroll
        for (int b = 0; b < 2; ++b)
#pragma unroll
            for (int m = 0; m < 4; ++m)
#pragma unroll
                for (int n = 0; n < 2; ++n) acc[a][b][m][n] = (f32x4){0.f, 0.f, 0.f, 0.f};
    bf16x8 At[4][2], B0[2][2], B1[2][2];
    unsigned cA00, cA01, cA10, cA11;
    { int R0, C0, R1, C1; stage_rc(tid * 16, R0, C0); stage_rc(tid * 16 + 8192, R1, C1);
      cA00 = S.aoff(cur, R0) + (unsigned)C0 * 2u;
      if constexpr (Sched::GATHER) { cA01 = S.aoff(cur, R1) + (unsigned)C1 * 2u; cA10 = S.aoff(cur, HALF + R0) + (unsigned)C0 * 2u; cA11 = S.aoff(cur, HALF + R1) + (unsigned)C1 * 2u; }
      else { cA01 = cA00; cA10 = cA00; cA11 = cA00; } }
    const char* cB = cur.B;
    G8_STAGE_B(G8_SB(0, 0), cB, 0); G8_SCHED; G8_STAGE_B(G8_SB(0, 1), cB + hstepB, 0); G8_SCHED; G8_STAGE_A(G8_SA(0, 0), cA00, cA01, 0, 0); G8_SCHED; G8_STAGE_A(G8_SA(0, 1), cA10, cA11, 0, 1); G8_SCHED;
    if (wr == 1) G8_BAR;
    G8_WAIT_V(2); G8_BAR;
    G8_STAGE_B(G8_SB(1, 0), cB, 128); G8_SCHED; G8_STAGE_A(G8_SA(1, 0), cA00, cA01, 128, 0); G8_SCHED; G8_STAGE_B(G8_SB(1, 1), cB + hstepB, 128); G8_SCHED;
    G8_WAIT_V(6); G8_BAR;
    for (;;) {
        const bool has_next = S.next(ui + 1, nxt);
        unsigned nA00 = cA00, nA01 = cA01, nA10 = cA10, nA11 = cA11; const char* nB = cB; long dl = 0;
        if (has_next) {
            nB = nxt.B;
            if constexpr (!Sched::GATHER) dl = ((long)nxt.a0 - (long)cur.a0) * (long)S.lda;
            else { const int t2 = wid * 64 + lane_id_opaque(); int R0, C0, R1, C1; stage_rc(t2 * 16, R0, C0); stage_rc(t2 * 16 + 8192, R1, C1);
                nA00 = S.aoff(nxt, R0) + (unsigned)C0 * 2u; nA01 = S.aoff(nxt, R1) + (unsigned)C1 * 2u; nA10 = S.aoff(nxt, HALF + R0) + (unsigned)C0 * 2u; nA11 = S.aoff(nxt, HALF + R1) + (unsigned)C1 * 2u; }
        }
        for (int t = 0; t < nt; t += 2) {
            const bool last = (t == nt - 2);
            const unsigned kb = (unsigned)t * 128u;
            const unsigned kb2 = last ? 0u : kb + 256u;
            const char* b2 = last ? nB : cB;
            unsigned s00, s01, s10, s11; long ka2;
            if constexpr (Sched::GATHER) { s00 = last ? nA00 : cA00; s01 = last ? nA01 : cA01; s10 = last ? nA10 : cA10; s11 = last ? nA11 : cA11; ka2 = (long)kb2; }
            else { s00 = cA00; s01 = cA00; s10 = cA00; s11 = cA00; ka2 = last ? dl : (long)kb2; }
            G8_LDB(B0, 0, 0); G8_LDB(B1, 0, 1); G8_SCHED; G8_LDA(At, 0, 0); G8_STAGE_A(G8_SA(1, 1), cA10, cA11, kb + 128u, 1);
            G8_WAIT_V(8); G8_WAIT_L(0); G8_BAR; G8_MMA(0, 0, At, B0); G8_MMA(0, 1, At, B1); G8_BAR; G8_SCHED;
            G8_LDA(At, 0, 1); G8_STAGE_B(G8_SB(0, 0), b2, kb2); G8_STAGE_B(G8_SB(0, 1), b2 + hstepB, kb2); G8_STAGE_A(G8_SA(0, 0), s00, s01, ka2, 0);
            G8_WAIT_V(8); G8_WAIT_L(0); G8_BAR; G8_MMA(1, 0, At, B0); G8_MMA(1, 1, At, B1); G8_BAR; G8_SCHED;
            G8_LDB(B0, 1, 0); G8_LDB(B1, 1, 1); G8_SCHED; G8_LDA(At, 1, 0); G8_STAGE_A(G8_SA(0, 1), s10, s11, ka2, 1);
            G8_WAIT_V(8); G8_WAIT_L(0); G8_BAR; G8_MMA(0, 0, At, B0); G8_MMA(0, 1, At, B1); G8_BAR; G8_SCHED;
            G8_LDA(At, 1, 1); G8_STAGE_B(G8_SB(1, 0), b2, kb2 + 128u); G8_STAGE_B(G8_SB(1, 1), b2 + hstepB, kb2 + 128u); G8_STAGE_A(G8_SA(1, 0), s00, s01, ka2 + 128, 0);
            G8_WAIT_V(8); G8_WAIT_L(0); G8_BAR; G8_MMA(1, 0, At, B0); G8_MMA(1, 1, At, B1); G8_BAR; G8_SCHED;
        }
        if (wr == 0) G8_BAR;
        { const int l2 = lane_id_opaque(); E(acc, cur, wr, wc, l2 & 15, l2 >> 4); }
        if (!has_next) break;
#pragma unroll
        for (int a = 0; a < 2; ++a)
#pragma unroll
            for (int b = 0; b < 2; ++b)
#pragma unroll
                for (int m = 0; m < 4; ++m)
#pragma unroll
                    for (int n = 0; n < 2; ++n) acc[a][b][m][n] = (f32x4){0.f, 0.f, 0.f, 0.f};
        cur = nxt; cB = nB; ++ui;
        if constexpr (Sched::GATHER) { cA00 = nA00; cA01 = nA01; cA10 = nA10; cA11 = nA11; }
        else { cA00 += (unsigned)dl; cA01 = cA00; cA10 = cA00; cA11 = cA00; }
        if (wr == 1) G8_BAR;
    }
    G8_WAIT_V(0);
    G8_BAR;
#undef G8_SA
#undef G8_SB
#undef G8_GLDS
#undef G8_STAGE_A
#undef G8_STAGE_B
#undef G8_LDA
#undef G8_LDB
#undef G8_MMA
#undef G8_WAIT_V
#undef G8_WAIT_L
#undef G8_BAR
#undef G8_SCHED
}

struct RectSched {
    static constexpr bool GATHER = false;
    int nM, nN, G, c; unsigned row0, lda; const char* Bbase; unsigned ldb;
    __device__ __forceinline__ bool next(int i, Unit& u) const {
        const int L = i * G + c; if (L >= nM * nN) return false;
        int pm, pn; static_map(L, nM, nN, pm, pn);
        u.a0 = row0 + (unsigned)pm * 256u; u.B = Bbase + (size_t)pn * 256u * ldb; u.p0 = pm; u.p1 = pn; u.p2 = 0; return true;
    }
    __device__ __forceinline__ unsigned aoff(const Unit& u, int q) const { return (u.a0 + (unsigned)q) * lda; }
};
struct QkvSched {
    static constexpr bool GATHER = false;
    int G, c; unsigned lda; const char* Bbase; unsigned ldb;
    __device__ __forceinline__ bool next(int i, Unit& u) const {
        const int L = i * G + c; int pm, pn;
        if (L < 768) static_map(L, 64, 12, pm, pn);
        else if (L < 832) { const int l2 = L - 768; pm = 64 + (l2 & 7); pn = 4 + (l2 >> 3); }
        else return false;
        u.a0 = (unsigned)pm * 256u; u.B = Bbase + (size_t)pn * 256u * ldb; u.p0 = pm; u.p1 = pn; u.p2 = 0; return true;
    }
    __device__ __forceinline__ unsigned aoff(const Unit& u, int q) const { return (u.a0 + (unsigned)q) * lda; }
};
struct BatchSched {
    static constexpr bool GATHER = false;
    int nb, nM, nN, G, c; unsigned lda; const char* Bbase; unsigned ldb; int N;
    __device__ __forceinline__ bool next(int i, Unit& u) const {
        const int per = nM * nN; int L;
        if ((G & 7) == 0 && (nb & 7) == 0) {
            const int nx = (nb >> 3) * per, li = i * (G >> 3) + (c >> 3); if (li >= nx) return false;
            L = (c & 7) * nx + li;
        } else { L = i * G + c; if (L >= nb * per) return false; }
        const int g = L / per, rem = L % per, pm = rem / nN, pn = rem % nN;
        u.a0 = (unsigned)(g * S5RP + pm * 256); u.B = Bbase + ((size_t)g * N + (size_t)pn * 256u) * ldb; u.p0 = g; u.p1 = pm; u.p2 = pn; return true;
    }
    __device__ __forceinline__ unsigned aoff(const Unit& u, int q) const { return (u.a0 + (unsigned)q) * lda; }
};
template <bool GATHER_>
struct MoeSched {
    static constexpr bool GATHER = GATHER_;
    int ntiles, nN, G, c; unsigned lda; const char* Bbase; unsigned ldb; int Ne, pn0, bstep; const LAS unsigned char* tile_e; const int* rowidx;
    __device__ __forceinline__ void xrange(int x, int& tlo, int& nx) const { const int q = ntiles >> 3, r = ntiles & 7; nx = q + (x < r ? 1 : 0); tlo = x * q + (x < r ? x : r); }
    __device__ __forceinline__ bool next(int i, Unit& u) const {
        int tile, pn;
        if ((G & 7) == 0) {
            int tlo, nx; xrange(c & 7, tlo, nx);
            const int li = i * (G >> 3) + (c >> 3); if (li >= nx * nN) return false;
            tile = tlo + li / nN; pn = li % nN;
        } else { const int L = i * G + c; if (L >= ntiles * nN) return false; tile = L / nN; pn = L % nN; }
        const int e = __builtin_amdgcn_readfirstlane((int)tile_e[tile]);
        u.a0 = (unsigned)tile * 256u; u.B = Bbase + ((size_t)e * Ne + (size_t)(pn0 + pn) * (unsigned)bstep) * ldb; u.p0 = tile; u.p1 = pn; u.p2 = e; return true;
    }
    __device__ __forceinline__ unsigned aoff(const Unit& u, int q) const {
        if (GATHER) return (unsigned)rowidx[u.a0 + (unsigned)q] * lda;
        return (u.a0 + (unsigned)q) * lda;
    }
};
}

struct Params {
    const float* in[34];
    float* out;
    unsigned char* ws;
    int ph_lo, ph_hi;
};
enum { I_X = 0, I_C, I_CTX, I_CCTX, I_ADAW, I_ADAB, I_NMG, I_NFG, I_WIN, I_ARE, I_AIM, I_LDT, I_BRE, I_BIM, I_CRE, I_CIM, I_S5D, I_GLUW, I_GLUB, I_CONVW,
       I_HOUT, I_WQKV, I_QG, I_KG, I_RPB, I_NOUT, I_RW, I_RB, I_MG, I_MU, I_MD, I_SG, I_SU, I_SD };

using g8::Unit;
typedef f32x4 Acc[2][2][4][2];

__device__ __forceinline__ u32x4 pack8(const f32x4& a, const f32x4& b) {
    u32x4 w; w.x = pk2(a[0], a[1]); w.y = pk2(a[2], a[3]); w.z = pk2(b[0], b[1]); w.w = pk2(b[2], b[3]); return w;
}

struct EpiWin {
    static constexpr bool PERM = true, HEADP = false, WIDE = false, GUP = false;
    bf16_t* A2; bf16_t* BCV;
    __device__ __forceinline__ void operator()(const Acc& acc, const Unit& u, int wr, int wc, int fr, int fq) const {
#pragma unroll
        for (int ai = 0; ai < 2; ++ai)
#pragma unroll
            for (int m = 0; m < 4; ++m) {
                const int row = u.p0 * 256 + 128 * ai + 64 * wr + 16 * m + fr;
#pragma unroll
                for (int bj = 0; bj < 2; ++bj) {
                    const int col0 = u.p1 * 256 + 128 * bj + 32 * wc + 8 * fq;
                    const u32x4 w = pack8(acc[ai][bj][m][0], acc[ai][bj][m][1]);
                    if (u.p1 < 2) {
                        const int g = col0 >> 4, ci0 = col0 & 15, r = row >> 5, s = row & 31;
                        *(u32x4*)(A2 + ((size_t)(g * S5RP + r) * S5K + s * 16 + ci0)) = w;
                    } else {
                        *(u32x4*)(BCV + ((size_t)row * 1536 + (col0 - 512))) = w;
                    }
                }
            }
    }
};
struct EpiS5F {
    static constexpr bool PERM = false, HEADP = false, WIDE = false, GUP = false;
    float* F;
    __device__ __forceinline__ void operator()(const Acc& acc, const Unit& u, int wr, int wc, int fr, int fq) const {
#pragma unroll
        for (int ai = 0; ai < 2; ++ai)
#pragma unroll
            for (int m = 0; m < 4; ++m) {
                const int row = u.p1 * 256 + 128 * ai + 64 * wr + 16 * m + fr;
                float* rp = F + ((size_t)(u.p0 * S5RP + row) * 256);
#pragma unroll
                for (int bj = 0; bj < 2; ++bj)
#pragma unroll
                    for (int n = 0; n < 2; ++n) *(f32x4*)(rp + 128 * bj + 32 * wc + 16 * n + 4 * fq) = acc[ai][bj][m][n];
            }
    }
};
struct EpiS5Y {
    static constexpr bool PERM = true, HEADP = false, WIDE = false, GUP = false;
    bf16_t* Gb;
    __device__ __forceinline__ void operator()(const Acc& acc, const Unit& u, int wr, int wc, int fr, int fq) const {
#pragma unroll
        for (int ai = 0; ai < 2; ++ai)
#pragma unroll
            for (int m = 0; m < 4; ++m) {
                const int r = u.p1 * 256 + 128 * ai + 64 * wr + 16 * m + fr;
                if (r < S5R) {
#pragma unroll
                    for (int bj = 0; bj < 2; ++bj) {
                        const int col0 = u.p2 * 256 + 128 * bj + 32 * wc + 8 * fq;
                        const int t = col0 >> 4, co0 = col0 & 15;
                        f32x4 a = acc[ai][bj][m][0], b = acc[ai][bj][m][1];
#pragma unroll
                        for (int j = 0; j < 4; ++j) { a[j] = gelu_tanh(a[j]); b[j] = gelu_tanh(b[j]); }
                        *(u32x4*)(Gb + ((size_t)(r * S5T + t) * 512 + u.p0 * 16 + co0)) = pack8(a, b);
                    }
                }
            }
    }
};
struct EpiGlu {
    static constexpr bool PERM = true, HEADP = false, WIDE = false, GUP = false;
    const bf16_t* Gb; const float* bias; bf16_t* Z;
    __device__ __forceinline__ void operator()(const Acc& acc, const Unit& u, int wr, int wc, int fr, int fq) const {
#pragma unroll
        for (int ai = 0; ai < 2; ++ai)
#pragma unroll
            for (int m = 0; m < 4; ++m) {
                const int row = u.p0 * 256 + 128 * ai + 64 * wr + 16 * m + fr;
#pragma unroll
                for (int bj = 0; bj < 2; ++bj) {
                    const int col0 = u.p1 * 256 + 128 * bj + 32 * wc + 8 * fq;
                    const u32x4 gv = *(const u32x4*)(Gb + ((size_t)row * 512 + col0));
                    const f32x4 b0 = *(const f32x4*)(bias + col0), b1 = *(const f32x4*)(bias + col0 + 4);
                    f32x4 a = acc[ai][bj][m][0] + b0, b = acc[ai][bj][m][1] + b1;
                    a[0] = bflo(gv.x) * sigmoidf_(a[0]); a[1] = bfhi(gv.x) * sigmoidf_(a[1]); a[2] = bflo(gv.y) * sigmoidf_(a[2]); a[3] = bfhi(gv.y) * sigmoidf_(a[3]);
                    b[0] = bflo(gv.z) * sigmoidf_(b[0]); b[1] = bfhi(gv.z) * sigmoidf_(b[1]); b[2] = bflo(gv.w) * sigmoidf_(b[2]); b[3] = bfhi(gv.w) * sigmoidf_(b[3]);
                    *(u32x4*)(Z + ((size_t)row * 1024 + col0)) = pack8(a, b);
                }
            }
    }
};
template <bool SRCF32>
struct EpiResid {
    static constexpr bool PERM = true, HEADP = false, WIDE = true, GUP = false;
    const float* xlat; const float* xctx;
    const float* gate;
    bf16_t* XR; float rs;
    __device__ __forceinline__ void operator()(const Acc& acc, const Unit& u, int wr, int wc, int fr, int fq) const {
#pragma unroll
        for (int ai = 0; ai < 2; ++ai)
#pragma unroll
            for (int m = 0; m < 4; ++m) {
                const int row = u.p0 * 256 + 128 * ai + 64 * wr + 16 * m + fr;
                const int b = row < NLAT ? (row >> 11) : 8;
                const int col = u.p1 * 256 + 64 * wc + 16 * fq;
                const float* gp = gate + b * 6144 + col;
                f32x4 xv[4];
                if (SRCF32) {
                    const float* src = (row < NLAT ? xlat + (size_t)row * DM : xctx + (size_t)(row - NLAT) * DM) + col;
#pragma unroll
                    for (int q = 0; q < 4; ++q) xv[q] = *(const f32x4*)(src + 4 * q);
                } else {
                    const u32x4 a = *(const u32x4*)(XR + (size_t)row * DM + col), c = *(const u32x4*)(XR + (size_t)row * DM + col + 8);
                    xv[0] = (f32x4){bflo(a.x), bfhi(a.x), bflo(a.y), bfhi(a.y)}; xv[1] = (f32x4){bflo(a.z), bfhi(a.z), bflo(a.w), bfhi(a.w)};
                    xv[2] = (f32x4){bflo(c.x), bfhi(c.x), bflo(c.y), bfhi(c.y)}; xv[3] = (f32x4){bflo(c.z), bfhi(c.z), bflo(c.w), bfhi(c.w)};
                }
                const f32x4 o0 = xv[0] + *(const f32x4*)(gp) * (acc[ai][0][m][0] * rs), o1 = xv[1] + *(const f32x4*)(gp + 4) * (acc[ai][0][m][1] * rs);
                const f32x4 o2 = xv[2] + *(const f32x4*)(gp + 8) * (acc[ai][1][m][0] * rs), o3 = xv[3] + *(const f32x4*)(gp + 12) * (acc[ai][1][m][1] * rs);
                *(u32x4*)(XR + (size_t)row * DM + col) = pack8(o0, o1); *(u32x4*)(XR + (size_t)row * DM + col + 8) = pack8(o2, o3);
            }
    }
};
struct EpiRouter {
    static constexpr bool PERM = false, HEADP = false, WIDE = false, GUP = false;
    float* logits;
    __device__ __forceinline__ void operator()(const Acc& acc, const Unit& u, int wr, int wc, int fr, int fq) const {
        if (wc < 2) {
#pragma unroll
            for (int ai = 0; ai < 2; ++ai)
#pragma unroll
                for (int m = 0; m < 4; ++m) {
                    const int row = u.p0 * 256 + 128 * ai + 64 * wr + 16 * m + fr;
#pragma unroll
                    for (int n = 0; n < 2; ++n) *(f32x4*)(logits + (size_t)row * 64 + 32 * wc + 16 * n + 4 * fq) = acc[ai][0][m][n];
                }
        }
    }
};
struct EpiGU {
    static constexpr bool PERM = false, HEADP = false, WIDE = false, GUP = true;
    bf16_t* ACT;
    __device__ __forceinline__ void operator()(const Acc& acc, const Unit& u, int wr, int wc, int fr, int fq) const {
#pragma unroll
        for (int ai = 0; ai < 2; ++ai)
#pragma unroll
            for (int m = 0; m < 4; ++m) {
                const int slot = u.p0 * 256 + 128 * ai + 64 * wr + 16 * m + fr;
                u32x4 o;
#pragma unroll
                for (int bj = 0; bj < 2; ++bj) {
                    const f32x4 g = acc[ai][bj][m][0], up = acc[ai][bj][m][1];
                    o[2 * bj] = pk2(siluf_(g[0]) * up[0], siluf_(g[1]) * up[1]); o[2 * bj + 1] = pk2(siluf_(g[2]) * up[2], siluf_(g[3]) * up[3]);
                }
                *(u32x4*)(ACT + ((size_t)slot * EDIM + u.p1 * 128 + 32 * wc + 8 * fq)) = o;
            }
    }
};
__device__ __forceinline__ float fp8c(float v) { return __builtin_amdgcn_fmed3f(v * 16.f, -440.f, 440.f); }
__device__ __forceinline__ u32x2 pack8_fp8(const f32x4& a, const f32x4& b) {
    int w0 = 0, w1 = 0;
    w0 = __builtin_amdgcn_cvt_pk_fp8_f32(fp8c(a[0]), fp8c(a[1]), w0, false); w0 = __builtin_amdgcn_cvt_pk_fp8_f32(fp8c(a[2]), fp8c(a[3]), w0, true);
    w1 = __builtin_amdgcn_cvt_pk_fp8_f32(fp8c(b[0]), fp8c(b[1]), w1, false); w1 = __builtin_amdgcn_cvt_pk_fp8_f32(fp8c(b[2]), fp8c(b[3]), w1, true);
    return (u32x2){(unsigned)w0, (unsigned)w1};
}
struct EpiDN {
    static constexpr bool PERM = true, HEADP = false, WIDE = true, GUP = false;
    unsigned char* Y;
    __device__ __forceinline__ void operator()(const Acc& acc, const Unit& u, int wr, int wc, int fr, int fq) const {
#pragma unroll
        for (int ai = 0; ai < 2; ++ai)
#pragma unroll
            for (int m = 0; m < 4; ++m) {
                const int slot = u.p0 * 256 + 128 * ai + 64 * wr + 16 * m + fr;
                const u32x2 lo = pack8_fp8(acc[ai][0][m][0], acc[ai][0][m][1]), hi = pack8_fp8(acc[ai][1][m][0], acc[ai][1][m][1]);
                *(u32x4*)(Y + ((size_t)slot * 1024 + u.p1 * 256 + 64 * wc + 16 * fq)) = (u32x4){lo.x, lo.y, hi.x, hi.y};
            }
    }
};
struct EpiQKV {
    static constexpr bool PERM = true, HEADP = true, WIDE = false, GUP = false;
    bf16_t* Q; bf16_t* Kb; bf16_t* VT; const float* qg; const float* kg;
    __device__ __forceinline__ void operator()(const Acc& acc, const Unit& u, int wr, int wc, int fr, int fq) const {
        const int region = u.p1 >> 2;
        if (region < 2) {
            const float* gp = (region == 0 ? qg : kg) + 8 * fq; const float gs = region == 0 ? 0.125f * 1.4426950408889634f : 1.f;
            f32x4 g[2][2];
#pragma unroll
            for (int bj = 0; bj < 2; ++bj)
#pragma unroll
                for (int n = 0; n < 2; ++n) g[bj][n] = *(const f32x4*)(gp + 32 * bj + 4 * n) * gs;
            bf16_t* dst = region == 0 ? Q : Kb;
#pragma unroll
            for (int ai = 0; ai < 2; ++ai)
#pragma unroll
                for (int m = 0; m < 4; ++m) {
                    const int row = u.p0 * 256 + 128 * ai + 64 * wr + 16 * m + fr;
                    float ss = 0.f;
#pragma unroll
                    for (int bj = 0; bj < 2; ++bj)
#pragma unroll
                        for (int n = 0; n < 2; ++n) { const f32x4 v = acc[ai][bj][m][n]; ss += (v[0] * v[0] + v[1] * v[1]) + (v[2] * v[2] + v[3] * v[3]); }
                    ss += __shfl_xor(ss, 16); ss += __shfl_xor(ss, 32);
                    const float rstd = rsqrtf(ss * (1.f / 64.f) + 1e-6f);
                    bf16_t* rp = dst + ((size_t)row * DM + (u.p1 & 3) * 256 + 64 * wc + 8 * fq);
#pragma unroll
                    for (int bj = 0; bj < 2; ++bj) *(u32x4*)(rp + 32 * bj) = pack8(acc[ai][bj][m][0] * rstd * g[bj][0], acc[ai][bj][m][1] * rstd * g[bj][1]);
                }
        } else {
#pragma unroll
            for (int ai = 0; ai < 2; ++ai)
#pragma unroll
                for (int m = 0; m < 4; ++m) {
                    const int row = u.p0 * 256 + 128 * ai + 64 * wr + 16 * m + fr;
                    bf16_t* rp = VT + ((size_t)row * DM + (u.p1 & 3) * 256 + 64 * wc + 8 * fq);
#pragma unroll
                    for (int bj = 0; bj < 2; ++bj) *(u32x4*)(rp + 32 * bj) = pack8(acc[ai][bj][m][0], acc[ai][bj][m][1]);
                }
        }
    }
};

struct Ctx { int tid, lane, wave, G, blk, gw, NGW; LAS unsigned char* lds; };
__device__ __forceinline__ Ctx mkctx(LAS unsigned char* lds, int wave0) {
    Ctx X; X.lane = lane_id_opaque(); X.wave = wave0; X.tid = wave0 * 64 + X.lane; X.G = gridDim.x; X.blk = blockIdx.x;
    X.gw = X.blk * 8 + X.wave; X.NGW = X.G * 8; X.lds = lds; return X;
}

template <int MODE> __device__ __forceinline__ int wrow(int n) { return MODE == 2 ? 256 + n : n; }
template <int MODE>
__device__ __forceinline__ void conv_item(const float* W, int N, bf16_t* WT, int ldk, int k0, int n0, LAS unsigned* T, int lane) {
    (void)T;
    const int nq = lane & 15, kg = lane >> 4;
    const float* wp = W + (size_t)(k0 + 16 * kg) * N + n0 + 4 * nq;
    f32x4 r[16];
#pragma unroll
    for (int i = 0; i < 16; ++i) r[i] = *(const f32x4*)(wp + (size_t)i * N);
#pragma unroll
    for (int j = 0; j < 4; ++j) {
        bf16_t* op = WT + (size_t)wrow<MODE>(n0 + 4 * nq + j) * ldk + k0 + 16 * kg;
        u32x4 lo, hi;
        lo.x = pk2(r[0][j], r[1][j]); lo.y = pk2(r[2][j], r[3][j]); lo.z = pk2(r[4][j], r[5][j]); lo.w = pk2(r[6][j], r[7][j]);
        hi.x = pk2(r[8][j], r[9][j]); hi.y = pk2(r[10][j], r[11][j]); hi.z = pk2(r[12][j], r[13][j]); hi.w = pk2(r[14][j], r[15][j]);
        *(u32x4*)op = lo; *(u32x4*)(op + 8) = hi;
    }
}
__device__ __forceinline__ void conv_mat(const Ctx& X, const float* W, int K, int N, bf16_t* WT, int& rot) {
    LAS unsigned* T = (LAS unsigned*)(X.lds + X.wave * 8192);
    const int nb = N / 64, nitems = (K / 64) * nb;
    int start = X.gw - rot; while (start < 0) start += X.NGW;
    for (int it = start; it < nitems; it += X.NGW) conv_item<0>(W, N, WT, K, (it / nb) * 64, (it % nb) * 64, T, X.lane);
    rot = (rot + nitems) % X.NGW;
}
template <int KIND>
__device__ __forceinline__ void conv_moe_items(const Ctx& X, const Params& p, int l, bf16_t* GU, bf16_t* DN, int it0, int it1, int rank, int nrank) {
    constexpr int PER = KIND == 0 ? 192 : (KIND == 1 ? 128 : 64);
    for (int it = it0 + rank * 8 + X.wave; it < it1; it += nrank * 8) {
        const int e = it / PER, r = it % PER, kind = KIND == 2 ? 2 : (r >> 6), q = r & 63;
        if (kind == 0) {
            const float* W = e < NEXP ? p.in[I_MG] + (size_t)(l * NEXP + e) * 262144 : p.in[I_SG] + (size_t)l * 262144;
            conv_item<1>(W, 256, GU + (size_t)e * 512 * 1024, 1024, (q >> 2) * 64, (q & 3) * 64, nullptr, X.lane);
        } else if (kind == 1) {
            const float* W = e < NEXP ? p.in[I_MU] + (size_t)(l * NEXP + e) * 262144 : p.in[I_SU] + (size_t)l * 262144;
            conv_item<2>(W, 256, GU + (size_t)e * 512 * 1024, 1024, (q >> 2) * 64, (q & 3) * 64, nullptr, X.lane);
        } else {
            const float* W = e < NEXP ? p.in[I_MD] + (size_t)(l * NEXP + e) * 262144 : p.in[I_SD] + (size_t)l * 262144;
            conv_item<0>(W, 1024, DN + (size_t)e * 1024 * 256, 256, (q >> 4) * 64, (q & 15) * 64, nullptr, X.lane);
        }
    }
}
__device__ __forceinline__ int moe_idle_rank(int ntiles, int nN, int G, int blk, int& nidle) {
    if ((G & 7) != 0) { const int nunits = ntiles * nN, nfull = nunits % G; if (nfull == 0) { nidle = G; return blk; } nidle = G - nfull; return blk >= nfull ? blk - nfull : -1; }
    const int B8 = G >> 3, q = ntiles >> 3, r = ntiles & 7;
    int maxc = 0;
    for (int x = 0; x < 8; ++x) { const int n = (q + (x < r ? 1 : 0)) * nN; const int cmax = (n + B8 - 1) / B8; maxc = cmax > maxc ? cmax : maxc; }
    int rank = -1, cnt = 0;
    for (int x = 0; x < 8; ++x) {
        const int n = (q + (x < r ? 1 : 0)) * nN;
        int jfull = n - (maxc - 1) * B8; jfull = jfull < 0 ? 0 : (jfull > B8 ? B8 : jfull);
        if (x == (blk & 7)) { const int j = blk >> 3; if (j >= jfull) rank = cnt + (j - jfull); }
        cnt += B8 - jfull;
    }
    if (cnt == 0) { nidle = G; return blk; }
    nidle = cnt; return rank;
}
__device__ __forceinline__ int idle_rank(int nunits, int G, int blk, int& nidle) {
    const int nfull = nunits % G;
    if (nfull == 0) { nidle = G; return blk; }
    nidle = G - nfull; return blk >= nfull ? blk - nfull : -1;
}

__device__ __forceinline__ void sincos_red(float x, float& s, float& c) {
    const float n = rintf(x * 0.15915494309189535f);
    float r = fmaf(-n, 6.28125f, x); r = fmaf(-n, 1.9353071795864769e-3f, r);
    s = __sinf(r); c = __cosf(r);
}

__device__ __forceinline__ void phase_p0a(const Ctx& X, const Params& p) {
    {
        LAS float* PWs = (LAS float*)(X.lds);
        LAS float* BBs = (LAS float*)(X.lds + 20480);
        LAS float* CCs = (LAS float*)(X.lds + 32768);
        float* KK = (float*)(p.ws + WS_KK); float* PWG = (float*)(p.ws + WS_PW); float* BBG = (float*)(p.ws + WS_BB);
        for (int item = X.blk; item < 256; item += X.G) {
            const int g = item >> 3, d = (item >> 2) & 1, lq = item & 3, gd = d * 32 + g;
            const float dt = expf(p.in[I_LDT][gd]);
            __syncthreads();
            for (int idx = X.tid; idx < 33 * 64; idx += 512) {
                const int j = idx >> 6, pp = idx & 63;
                const float lre = fminf(p.in[I_ARE][gd * 64 + pp], -1e-4f), lim = p.in[I_AIM][gd * 64 + pp];
                const float mag = expf(lre * dt * (float)j); float sn, cs; sincos_red(lim * dt * (float)j, sn, cs);
                PWs[2 * idx] = mag * cs; PWs[2 * idx + 1] = mag * sn;
            }
            for (int idx = X.tid; idx < 1024; idx += 512) {
                const int pp = idx >> 4;
                const float lre = fminf(p.in[I_ARE][gd * 64 + pp], -1e-4f), lim = p.in[I_AIM][gd * 64 + pp];
                const float mag = expf(lre * dt); float sn, cs; sincos_red(lim * dt, sn, cs);
                const float nr = mag * cs - 1.f, ni = mag * sn, den = 1.f / (lre * lre + lim * lim);
                const float cr = (nr * lre + ni * lim) * den, ci = (ni * lre - nr * lim) * den;
                const float br = p.in[I_BRE][(size_t)gd * 1024 + idx], bi = p.in[I_BIM][(size_t)gd * 1024 + idx];
                BBs[2 * idx] = cr * br - ci * bi; BBs[2 * idx + 1] = cr * bi + ci * br;
            }
            for (int idx = X.tid; idx < 1024; idx += 512) { CCs[2 * idx] = p.in[I_CRE][(size_t)gd * 1024 + idx]; CCs[2 * idx + 1] = p.in[I_CIM][(size_t)gd * 1024 + idx]; }
            __syncthreads();
#pragma unroll
            for (int i = 0; i < 4; ++i) {
                const int e = X.tid + 512 * i, lag = 8 * lq + (e >> 8), co = (e >> 4) & 15, ci = e & 15;
                float sum = 0.f;
                for (int pp = 0; pp < 64; ++pp) {
                    const float pr = PWs[2 * (lag * 64 + pp)], pi = PWs[2 * (lag * 64 + pp) + 1];
                    const float br = BBs[2 * (pp * 16 + ci)], bi = BBs[2 * (pp * 16 + ci) + 1];
                    const float tr = pr * br - pi * bi, ti = pr * bi + pi * br;
                    sum += CCs[2 * (co * 64 + pp)] * tr - CCs[2 * (co * 64 + pp) + 1] * ti;
                }
                KK[(size_t)((g * 2 + d) * 32 + lag) * 256 + co * 16 + ci] = sum;
            }
            if (lq == 0) {
                for (int idx = X.tid; idx < 33 * 64 * 2; idx += 512) PWG[(size_t)(g * 2 + d) * 33 * 64 * 2 + idx] = PWs[idx];
                for (int idx = X.tid; idx < 2048; idx += 512) BBG[(size_t)(g * 2 + d) * 2048 + idx] = BBs[idx];
            }
        }
        __syncthreads();
    }
    {
        LAS float* condS = (LAS float*)(X.lds + 65536);
        for (int i = X.tid; i < 9 * 1024; i += 512) { const int r = i >> 10, k = i & 1023; const float v = r < 8 ? p.in[I_C][r * 1024 + k] : p.in[I_CCTX][k]; condS[i] = siluf_(v); }
        __syncthreads();
        float* ADAP = (float*)(p.ws + WS_ADAP);
        for (int it = X.gw; it < 3072; it += X.NGW) {
            const int l = it / 1536, rem = it % 1536, cg = rem >> 4, kq = rem & 15, col = cg * 64 + X.lane;
            const float* wp = p.in[I_ADAW] + (size_t)l * 1024 * 6144 + (size_t)(kq * 64) * 6144 + col;
            float a0 = 0, a1 = 0, a2 = 0, a3 = 0, a4 = 0, a5 = 0, a6 = 0, a7 = 0, a8 = 0;
            float wv[64];
#pragma unroll
            for (int kk = 0; kk < 64; ++kk) wv[kk] = wp[(size_t)kk * 6144];
#pragma unroll
            for (int kk = 0; kk < 64; ++kk) {
                const float w = wv[kk]; const LAS float* cp = condS + kq * 64 + kk;
                a0 += cp[0] * w; a1 += cp[1024] * w; a2 += cp[2048] * w; a3 += cp[3072] * w; a4 += cp[4096] * w; a5 += cp[5120] * w; a6 += cp[6144] * w; a7 += cp[7168] * w; a8 += cp[8192] * w;
            }
            float* op = ADAP + (size_t)((kq * 2 + l) * 9) * 6144 + col;
            op[0] = a0; op[6144] = a1; op[2 * 6144] = a2; op[3 * 6144] = a3; op[4 * 6144] = a4; op[5 * 6144] = a5; op[6 * 6144] = a6; op[7 * 6144] = a7; op[8 * 6144] = a8;
        }
        __syncthreads();
    }
    {
        int rot = 0;
        conv_mat(X, p.in[I_WIN], 1024, 2048, (bf16_t*)(p.ws + WS_WIN), rot);
        conv_mat(X, p.in[I_GLUW], 512, 512, (bf16_t*)(p.ws + WS_GLU), rot);
        conv_mat(X, p.in[I_HOUT], 1024, 1024, (bf16_t*)(p.ws + WS_HOUT), rot);
        conv_mat(X, p.in[I_WQKV], 1024, 3072, (bf16_t*)(p.ws + WS_QKV), rot);
        conv_mat(X, p.in[I_NOUT], 1024, 1024, (bf16_t*)(p.ws + WS_NOUT), rot);
        conv_mat(X, p.in[I_RW], 1024, 64, (bf16_t*)(p.ws + WS_ROUT), rot);
        conv_mat(X, p.in[I_RW] + 65536, 1024, 64, (bf16_t*)(p.ws + WS_ROUT) + 256 * 1024, rot);
        for (int i = X.gw * 64 + X.lane; i < 2 * 192 * 128; i += X.NGW * 64) {
            const int l = i / (192 * 128), r = i % (192 * 128);
            *(u32x4*)((bf16_t*)(p.ws + WS_ROUT) + (size_t)l * 256 * 1024 + 64 * 1024 + (size_t)r * 8) = (u32x4){0u, 0u, 0u, 0u};
        }
    }
}

__device__ __forceinline__ void phase_p0b(const Ctx& X, const Params& p) {
    const int gt = X.blk * 512 + X.tid, NT = X.G * 512;
    float* MOD = (float*)(p.ws + WS_MOD); const float* ADAP = (const float*)(p.ws + WS_ADAP);
    for (int idx = gt; idx < 2 * 9 * 6144; idx += NT) {
        const int l = idx / (9 * 6144), col = idx % 6144;
        float s = p.in[I_ADAB][l * 6144 + col];
#pragma unroll
        for (int kq = 0; kq < 16; ++kq) s += ADAP[(size_t)kq * 110592 + idx];
        MOD[idx] = s;
    }
    const float* KK = (const float*)(p.ws + WS_KK); const float* PWG = (const float*)(p.ws + WS_PW); const float* BBG = (const float*)(p.ws + WS_BB);
    bf16_t* ME = (bf16_t*)(p.ws + WS_ME); bf16_t* WF = (bf16_t*)(p.ws + WS_WF);
    for (int ch = gt; ch < 32 * 512 * 96; ch += NT) {
        const int kc = ch % 96, n = (ch / 96) & 511, g = ch / (96 * 512), t = n >> 4, co = n & 15, k0 = kc * 8;
        float v[8];
        if (k0 < 512) {
            const int s_ = k0 >> 4, ci0 = k0 & 15;
            const int lf = t - s_, lb = s_ - t; const float mf = lf >= 0 ? 1.f : 0.f, mb = lb >= 0 ? 1.f : 0.f;
            const float* kf = KK + (size_t)((g * 2 + 0) * 32 + (lf >= 0 ? lf : 0)) * 256 + co * 16 + ci0;
            const float* kb = KK + (size_t)((g * 2 + 1) * 32 + (lb >= 0 ? lb : 0)) * 256 + co * 16 + ci0;
            const f32x4 f0 = *(const f32x4*)kf, f1 = *(const f32x4*)(kf + 4), b0 = *(const f32x4*)kb, b1 = *(const f32x4*)(kb + 4);
            const float dsk = p.in[I_S5D][16 * g + co];
#pragma unroll
            for (int j = 0; j < 4; ++j) {
                v[j] = f0[j] * mf + b0[j] * mb + ((s_ == t && ci0 + j == co) ? dsk : 0.f);
                v[4 + j] = f1[j] * mf + b1[j] * mb + ((s_ == t && ci0 + 4 + j == co) ? dsk : 0.f);
            }
        } else {
            const int kk = k0 - 512, d = kk >> 7, ri = (kk >> 6) & 1, p0 = kk & 63, jj = d == 0 ? t + 1 : 32 - t;
            const float* pw = PWG + ((size_t)((g * 2 + d) * 33 + jj) * 64 + p0) * 2;
            const float* crp = p.in[I_CRE] + (size_t)((d * 32 + g) * 16 + co) * 64 + p0; const float* cip = p.in[I_CIM] + (size_t)((d * 32 + g) * 16 + co) * 64 + p0;
            f32x4 pq[4];
#pragma unroll
            for (int q = 0; q < 4; ++q) pq[q] = *(const f32x4*)(pw + 4 * q);
            const f32x4 cr0 = *(const f32x4*)crp, cr1 = *(const f32x4*)(crp + 4), ci0v = *(const f32x4*)cip, ci1v = *(const f32x4*)(cip + 4);
#pragma unroll
            for (int j = 0; j < 8; ++j) {
                const float pr = pq[j >> 1][(j & 1) * 2], pi = pq[j >> 1][(j & 1) * 2 + 1];
                const float cr = j < 4 ? cr0[j & 3] : cr1[j & 3], cim = j < 4 ? ci0v[j & 3] : ci1v[j & 3];
                const float zr = cr * pr - cim * pi, zi = cr * pi + cim * pr;
                v[j] = ri == 0 ? zr : -zi;
            }
        }
        u32x4 w; w.x = pk2(v[0], v[1]); w.y = pk2(v[2], v[3]); w.z = pk2(v[4], v[5]); w.w = pk2(v[6], v[7]);
        *(u32x4*)(ME + ((size_t)(g * 512 + n)) * 768 + k0) = w;
    }
    for (int ch = gt; ch < 32 * 256 * 64; ch += NT) {
        const int kc = ch & 63, n = (ch >> 6) & 255, g = ch >> 14, d = n >> 7, ri = (n >> 6) & 1, pp = n & 63, k0 = kc * 8, s_ = k0 >> 4, ci0 = k0 & 15;
        const int jj = d == 0 ? 31 - s_ : s_;
        const float pr = PWG[((size_t)((g * 2 + d) * 33 + jj) * 64 + pp) * 2], pi = PWG[((size_t)((g * 2 + d) * 33 + jj) * 64 + pp) * 2 + 1];
        const float* bb = BBG + ((size_t)(g * 2 + d) * 1024 + pp * 16 + ci0) * 2;
        f32x4 bq[4];
#pragma unroll
        for (int q = 0; q < 4; ++q) bq[q] = *(const f32x4*)(bb + 4 * q);
        float v[8];
#pragma unroll
        for (int j = 0; j < 8; ++j) {
            const float br = bq[j >> 1][(j & 1) * 2], bi = bq[j >> 1][(j & 1) * 2 + 1];
            v[j] = ri == 0 ? (pr * br - pi * bi) : (pr * bi + pi * br);
        }
        u32x4 w; w.x = pk2(v[0], v[1]); w.y = pk2(v[2], v[3]); w.z = pk2(v[4], v[5]); w.w = pk2(v[6], v[7]);
        *(u32x4*)(WF + ((size_t)(g * 256 + n)) * 512 + k0) = w;
    }
}

template <int SRC>
__device__ __forceinline__ void norm_load(const Params& p, int row, int lane, f32x4 (&v)[4]) {
    if (SRC == 0) {
        const float* src = (row < NLAT ? p.in[I_X] + (size_t)row * DM : p.in[I_CTX] + (size_t)(row - NLAT) * DM) + 8 * lane;
        v[0] = *(const f32x4*)(src); v[1] = *(const f32x4*)(src + 4); v[2] = *(const f32x4*)(src + 512); v[3] = *(const f32x4*)(src + 516);
    } else {
        const bf16_t* src = (const bf16_t*)(p.ws + WS_XR) + (size_t)row * DM + 8 * lane;
        const u32x4 a = *(const u32x4*)(src), c = *(const u32x4*)(src + 512);
        v[0] = (f32x4){bflo(a.x), bfhi(a.x), bflo(a.y), bfhi(a.y)}; v[1] = (f32x4){bflo(a.z), bfhi(a.z), bflo(a.w), bfhi(a.w)};
        v[2] = (f32x4){bflo(c.x), bfhi(c.x), bflo(c.y), bfhi(c.y)}; v[3] = (f32x4){bflo(c.z), bfhi(c.z), bflo(c.w), bfhi(c.w)};
    }
}
template <int SRC>
__device__ __forceinline__ void phase_norm(const Ctx& X, const Params& p, int l, int ffn, int ntok) {
    const float* gain = (ffn ? p.in[I_NFG] : p.in[I_NMG]) + l * 1024;
    const float* mod = (const float*)(p.ws + WS_MOD) + (size_t)l * 9 * 6144;
    const int shi = ffn ? 3 : 0, sci = ffn ? 4 : 1;
    bf16_t* XA = (bf16_t*)(p.ws + WS_XA);
    const int rpw = (ntok + X.NGW - 1) / X.NGW, r0 = X.gw * rpw, r1 = (r0 + rpw) < ntok ? (r0 + rpw) : ntok;
    int curb = -1; f32x4 gm[4], sh[4];
    f32x4 vn[4];
    if (r0 < r1) norm_load<SRC>(p, r0, X.lane, vn);
    for (int row = r0; row < r1; ++row) {
        const int b = row < NLAT ? (row >> 11) : 8;
        if (b != curb) {
            curb = b;
#pragma unroll
            for (int j = 0; j < 4; ++j) {
                const int c = 8 * X.lane + 512 * (j >> 1) + 4 * (j & 1);
                const f32x4 g4 = *(const f32x4*)(gain + c), sc4 = *(const f32x4*)(mod + b * 6144 + sci * 1024 + c);
                sh[j] = *(const f32x4*)(mod + b * 6144 + shi * 1024 + c); gm[j] = g4 * (sc4 + 1.f);
            }
        }
        f32x4 v[4]; float ss = 0.f;
#pragma unroll
        for (int j = 0; j < 4; ++j) v[j] = vn[j];
        if (row + 1 < r1) norm_load<SRC>(p, row + 1, X.lane, vn);
#pragma unroll
        for (int j = 0; j < 4; ++j) ss += (v[j][0] * v[j][0] + v[j][1] * v[j][1]) + (v[j][2] * v[j][2] + v[j][3] * v[j][3]);
        const float rstd = rsqrtf(wave_sum(ss) * (1.f / 1024.f) + 1e-6f);
        const f32x4 o0 = v[0] * rstd * gm[0] + sh[0], o1 = v[1] * rstd * gm[1] + sh[1], o2 = v[2] * rstd * gm[2] + sh[2], o3 = v[3] * rstd * gm[3] + sh[3];
        *(u32x4*)(XA + (size_t)row * DM + 8 * X.lane) = pack8(o0, o1); *(u32x4*)(XA + (size_t)row * DM + 512 + 8 * X.lane) = pack8(o2, o3);
    }
}

__device__ __forceinline__ void phase_scan_conv(const Ctx& X, const Params& p) {
    const float* F = (const float*)(p.ws + WS_F); bf16_t* A2 = (bf16_t*)(p.ws + WS_A2); const float* PWG = (const float*)(p.ws + WS_PW);
    for (int gid = X.blk * 512 + X.tid; gid < 32768; gid += X.G * 512) {
        const int pp = gid & 63, d = (gid >> 6) & 1, g = (gid >> 7) & 31, b = gid >> 12;
        const float ar = PWG[((size_t)((g * 2 + d) * 33 + 32) * 64 + pp) * 2], ai = PWG[((size_t)((g * 2 + d) * 33 + 32) * 64 + pp) * 2 + 1];
        float sr = 0.f, si = 0.f;
        for (int s8 = 0; s8 < 72; s8 += 8) {
            float fr[8], fi[8]; size_t ro[8];
#pragma unroll
            for (int q = 0; q < 8; ++q) {
                const int step = s8 + q; int r;
                if (d == 0) r = step < 8 ? 512 + b * 8 + step : b * 64 + (step - 8);
                else        r = step < 8 ? 512 + b * 8 + (7 - step) : b * 64 + (71 - step);
                ro[q] = (size_t)(g * S5RP + r);
                fr[q] = F[ro[q] * 256 + d * 128 + pp]; fi[q] = F[ro[q] * 256 + d * 128 + 64 + pp];
            }
#pragma unroll
            for (int q = 0; q < 8; ++q) {
                A2[ro[q] * S5K + 512 + d * 128 + pp] = (bf16_t)f2bf(sr); A2[ro[q] * S5K + 512 + d * 128 + 64 + pp] = (bf16_t)f2bf(si);
                const float nr = ar * sr - ai * si + fr[q], ni = ar * si + ai * sr + fi[q];
                sr = nr; si = ni;
            }
        }
    }
    const bf16_t* BCV = (const bf16_t*)(p.ws + WS_BCV); bf16_t* Z = (bf16_t*)(p.ws + WS_Z); const float* cw = p.in[I_CONVW];
    for (int it = X.blk * 512 + X.tid; it < NTOK * 64; it += X.G * 512) {
        const int tok = it >> 6, c0 = (it & 63) * 8;
        const int pos = tok < NLAT ? (tok & 2047) : ((tok - NLAT) & 255), len = tok < NLAT ? 2048 : 256;
        const bf16_t* base = BCV + (size_t)tok * 1536;
        const u32x4 bg = *(const u32x4*)(base + c0), cg1 = *(const u32x4*)(base + 512 + c0), v1 = *(const u32x4*)(base + 1024 + c0);
        u32x4 cg0 = (u32x4){0u, 0u, 0u, 0u}, v0 = cg0, cg2 = cg0, v2 = cg0;
        if (pos > 0) { cg0 = *(const u32x4*)(base - 1536 + 512 + c0); v0 = *(const u32x4*)(base - 1536 + 1024 + c0); }
        if (pos < len - 1) { cg2 = *(const u32x4*)(base + 1536 + 512 + c0); v2 = *(const u32x4*)(base + 1536 + 1024 + c0); }
        float o[8];
#pragma unroll
        for (int j = 0; j < 4; ++j) {
            const float w0a = cw[c0 + 2 * j], w1a = cw[512 + c0 + 2 * j], w2a = cw[1024 + c0 + 2 * j];
            const float w0b = cw[c0 + 2 * j + 1], w1b = cw[512 + c0 + 2 * j + 1], w2b = cw[1024 + c0 + 2 * j + 1];
            o[2 * j] = bflo(bg[j]) * (w0a * bflo(cg0[j]) * bflo(v0[j]) + w1a * bflo(cg1[j]) * bflo(v1[j]) + w2a * bflo(cg2[j]) * bflo(v2[j]));
            o[2 * j + 1] = bfhi(bg[j]) * (w0b * bfhi(cg0[j]) * bfhi(v0[j]) + w1b * bfhi(cg1[j]) * bfhi(v1[j]) + w2b * bfhi(cg2[j]) * bfhi(v2[j]));
        }
        u32x4 w; w.x = pk2(o[0], o[1]); w.y = pk2(o[2], o[3]); w.z = pk2(o[4], o[5]); w.w = pk2(o[6], o[7]);
        *(u32x4*)(Z + (size_t)tok * 1024 + 512 + c0) = w;
    }
}

__device__ __forceinline__ void phase_qknorm(const Ctx& X, const Params& p) {
    bf16_t* Q = (bf16_t*)(p.ws + WS_Q); bf16_t* Kb = (bf16_t*)(p.ws + WS_K);
    float gq[16], gk[16];
#pragma unroll
    for (int i = 0; i < 16; ++i) { gq[i] = p.in[I_QG][((16 * X.lane) & 63) + i] * (0.125f * 1.4426950408889634f); gk[i] = p.in[I_KG][((16 * X.lane) & 63) + i]; }
    for (int it = X.gw; it < NLAT + NTOK; it += X.NGW) {
        const bool isK = it >= NLAT; const int row = isK ? it - NLAT : it;
        bf16_t* ptr = (isK ? Kb : Q) + (size_t)row * DM + 16 * X.lane;
        const u32x4 a = *(const u32x4*)ptr, b = *(const u32x4*)(ptr + 8);
        float v[16];
#pragma unroll
        for (int j = 0; j < 4; ++j) { v[2 * j] = bflo(a[j]); v[2 * j + 1] = bfhi(a[j]); v[8 + 2 * j] = bflo(b[j]); v[8 + 2 * j + 1] = bfhi(b[j]); }
        float ss = 0.f;
#pragma unroll
        for (int j = 0; j < 16; ++j) ss += v[j] * v[j];
        ss += __shfl_xor(ss, 1); ss += __shfl_xor(ss, 2);
        const float rstd = rsqrtf(ss * (1.f / 64.f) + 1e-6f);
#pragma unroll
        for (int j = 0; j < 16; ++j) v[j] = v[j] * rstd * (isK ? gk[j] : gq[j]);
        u32x4 oa, ob;
#pragma unroll
        for (int j = 0; j < 4; ++j) { oa[j] = pk2(v[2 * j], v[2 * j + 1]); ob[j] = pk2(v[8 + 2 * j], v[8 + 2 * j + 1]); }
        *(u32x4*)ptr = oa; *(u32x4*)(ptr + 8) = ob;
    }
}

constexpr int RR_MAXT = 96, RR_KC = 256, RR_PITCH = RR_KC * 2 + 16;
constexpr int RR_A = 0, RR_B = RR_MAXT * RR_PITCH, RR_LG = RR_B + 64 * RR_PITCH;
__device__ __forceinline__ void phase_route(const Ctx& X, const Params& p, int l, int ntok) {
    LAS int* cnt = (LAS int*)(X.lds + MISC_OFF + M_CNT);
    if (X.tid < NEXP1) cnt[X.tid] = 0;
    const bf16_t* XA = (const bf16_t*)(p.ws + WS_XA); const bf16_t* RT = (const bf16_t*)(p.ws + WS_ROUT) + (size_t)l * 256 * 1024;
    int* toke = (int*)(p.ws + WS_TOKE); float* tokw = (float*)(p.ws + WS_TOKW); int* tokp = (int*)(p.ws + WS_TOKP);
    const float rb = p.in[I_RB][l * 64 + X.lane];
    const int tpb = (ntok + X.G - 1) / X.G, t0 = X.blk * tpb, t1 = (t0 + tpb) < ntok ? (t0 + tpb) : ntok, nrow = t1 - t0;
    const int lane = X.lane, grp = lane >> 3, fr = lane & 15, fq = lane >> 4;
    const int nt_ = X.wave & 3, mh = X.wave >> 2;
    f32x4 acc[3];
#pragma unroll
    for (int m = 0; m < 3; ++m) acc[m] = (f32x4){0.f, 0.f, 0.f, 0.f};
    for (int kc = 0; kc < 1024; kc += RR_KC) {
        __syncthreads();
        {
            u32x4 va[6], vb[4];
#pragma unroll
            for (int q = 0; q < 6; ++q) { const int i = X.tid + 512 * q, r = i >> 5, c = i & 31; const int rr = r < nrow ? r : 0;
                va[q] = *(const u32x4*)(XA + (size_t)(t0 + rr) * DM + kc + 8 * c); if (r >= nrow) va[q] = (u32x4){0u, 0u, 0u, 0u}; }
#pragma unroll
            for (int q = 0; q < 4; ++q) { const int i = X.tid + 512 * q, r = i >> 5, c = i & 31; vb[q] = *(const u32x4*)(RT + (size_t)r * 1024 + kc + 8 * c); }
#pragma unroll
            for (int q = 0; q < 6; ++q) { const int i = X.tid + 512 * q, r = i >> 5, c = i & 31; *(LAS u32x4*)(X.lds + RR_A + r * RR_PITCH + 16 * c) = va[q]; }
#pragma unroll
            for (int q = 0; q < 4; ++q) { const int i = X.tid + 512 * q, r = i >> 5, c = i & 31; *(LAS u32x4*)(X.lds + RR_B + r * RR_PITCH + 16 * c) = vb[q]; }
        }
        __syncthreads();
#pragma unroll
        for (int ks = 0; ks < RR_KC / 32; ++ks) {
            const bf16x8 bfr = *(const LAS bf16x8*)(X.lds + RR_B + (16 * nt_ + fr) * RR_PITCH + 64 * ks + 16 * fq);
#pragma unroll
            for (int m = 0; m < 3; ++m) {
                const bf16x8 afr = *(const LAS bf16x8*)(X.lds + RR_A + (16 * (3 * mh + m) + fr) * RR_PITCH + 64 * ks + 16 * fq);
                acc[m] = __builtin_amdgcn_mfma_f32_16x16x32_bf16(afr, bfr, acc[m], 0, 0, 0);
            }
        }
    }
    LAS float* LG = (LAS float*)(X.lds + RR_LG);
#pragma unroll
    for (int m = 0; m < 3; ++m)
#pragma unroll
        for (int j = 0; j < 4; ++j) LG[(16 * (3 * mh + m) + 4 * fq + j) * 64 + 16 * nt_ + fr] = acc[m][j];
    __syncthreads();
    for (int tok = t0 + X.wave; tok < t1; tok += 8) {
        const float score = sigmoidf_(LG[(tok - t0) * 64 + lane]);
        const float sel = score + rb;
        int rk = 0;
#pragma unroll
        for (int x = 1; x < 8; ++x) { const float o = __shfl_xor(sel, x); const int ol = lane ^ x; rk += ((o > sel) || (o == sel && ol < lane)) ? 1 : 0; }
        float gs = rk < 2 ? sel : 0.f;
        gs += __shfl_xor(gs, 1); gs += __shfl_xor(gs, 2); gs += __shfl_xor(gs, 4);
        int grk = 0;
#pragma unroll
        for (int x = 1; x < 8; ++x) { const float o = __shfl_xor(gs, 8 * x); const int og = grp ^ x; grk += ((o > gs) || (o == gs && og < grp)) ? 1 : 0; }
        const float msel = grk < 4 ? sel : -__builtin_inff();
        int rank = 0;
#pragma unroll
        for (int j = 0; j < 64; ++j) { const float sj = __builtin_bit_cast(float, __builtin_amdgcn_readlane(__builtin_bit_cast(int, msel), j)); rank += ((sj > msel) || (sj == msel && j < lane)) ? 1 : 0; }
        const bool chosen = rank < 8;
        const float wsum = wave_sum(chosen ? score : 0.f);
        if (chosen) {
            const int lpos = __hip_atomic_fetch_add(cnt + lane, 1, __ATOMIC_RELAXED, __HIP_MEMORY_SCOPE_WORKGROUP);
            toke[(size_t)tok * 8 + rank] = lane; tokw[(size_t)tok * 8 + rank] = score / wsum * 2.5f; tokp[(size_t)tok * 8 + rank] = lpos;
        }
    }
    __syncthreads();
    int* cntblk = (int*)(p.ws + WS_CNTBLK);
    if (X.tid < NEXP1) cntblk[X.blk * NEXP1 + X.tid] = X.tid < NEXP ? cnt[X.tid] : 0;
}

__device__ __forceinline__ void phase_slots(const Ctx& X, const Params& p, int ntok) {
    LAS int* part = (LAS int*)(X.lds + MISC_OFF + M_PART);
    LAS int* ptot = (LAS int*)(X.lds);
    LAS int* pbb = (LAS int*)(X.lds + 4096);
    LAS int* base = (LAS int*)(X.lds + MISC_OFF + M_BASE);
    LAS int* bbase = (LAS int*)(X.lds + MISC_OFF + M_BBASE);
    LAS int* tot = (LAS int*)(X.lds + 8192);
    LAS int* ntl = (LAS int*)(X.lds + MISC_OFF + M_NT);
    (void)part;
    const int* cntblk = (const int*)(p.ws + WS_CNTBLK);
    {
        const int e = X.tid & 127, pt = X.tid >> 7; int s = 0, sb = 0;
        if (e < NEXP) { const int b0 = (X.G * pt) / 4, b1 = (X.G * (pt + 1)) / 4;
            for (int b = b0; b < b1; ++b) { const int c = cntblk[b * NEXP1 + e]; s += c; sb += (b < X.blk) ? c : 0; } }
        ptot[pt * 128 + e] = s; pbb[pt * 128 + e] = sb;
    }
    __syncthreads();
    if (X.tid < NEXP) { tot[X.tid] = ptot[X.tid] + ptot[128 + X.tid] + ptot[256 + X.tid] + ptot[384 + X.tid]; bbase[X.tid] = pbb[X.tid] + pbb[128 + X.tid] + pbb[256 + X.tid] + pbb[384 + X.tid]; }
    __syncthreads();
    if (X.tid == 0) { int acc = 0; for (int e = 0; e < NEXP; ++e) { base[e] = acc; acc += (tot[e] + 255) & ~255; } base[NEXP] = acc; base[NEXP1] = acc + ntok; ntl[0] = (acc + ntok) >> 8; }
    __syncthreads();
    int* rowidx = (int*)(p.ws + WS_ROWIDX); int* tokslot = (int*)(p.ws + WS_YROW);
    const int* toke = (const int*)(p.ws + WS_TOKE); const int* tokp = (const int*)(p.ws + WS_TOKP);
    const int tpb = (ntok + X.G - 1) / X.G, t0 = X.blk * tpb, t1 = (t0 + tpb) < ntok ? (t0 + tpb) : ntok;
    for (int i = t0 * 8 + X.tid; i < t1 * 8; i += 512) {
        const int e = toke[i]; const int slot = base[e] + bbase[e] + tokp[i];
        rowidx[slot] = i >> 3; tokslot[(i >> 3) * 9 + (i & 7)] = slot;
    }
    const int sbase = base[NEXP];
    for (int tok = X.blk * 512 + X.tid; tok < ntok; tok += X.G * 512) { rowidx[sbase + tok] = tok; tokslot[tok * 9 + 8] = sbase + tok; }
    for (int e = X.blk; e < NEXP; e += X.G)
        for (int s = base[e] + tot[e] + X.tid; s < base[e + 1]; s += 512) rowidx[s] = 0;
    if (X.blk == 0) {
        int* TAB = (int*)(p.ws + WS_TAB);
        if (X.tid == 0) TAB[128] = ntl[0];
        for (int t = X.tid; t < ntl[0]; t += 512) { int e = NEXP; const int s = t * 256; for (int k = 0; k < NEXP; ++k) if (s >= base[k] && s < base[k + 1]) e = k; TAB[256 + t] = e; }
    }
}
__device__ __forceinline__ int load_tiles(const Ctx& X, const Params& p) {
    const int* TAB = (const int*)(p.ws + WS_TAB);
    LAS unsigned char* te = X.lds + MISC_OFF + M_TILE;
    const int nt = TAB[128];
    for (int t = X.tid; t < nt; t += 512) te[t] = (unsigned char)TAB[256 + t];
    __syncthreads();
    return __builtin_amdgcn_readfirstlane(nt);
}

template <bool NEXTNORM>
__device__ __forceinline__ void phase_combine(const Ctx& X, const Params& p, int l, int ntok, bool final_out, float rs) {
    const unsigned char* Y = (const unsigned char*)(p.ws + WS_Y); bf16_t* XR = (bf16_t*)(p.ws + WS_XR);
    const int* tokslot = (const int*)(p.ws + WS_YROW); const float* tokw = (const float*)(p.ws + WS_TOKW);
    const float* gate = (const float*)(p.ws + WS_MOD) + (size_t)l * 9 * 6144 + 5 * 1024;
    const float* gain = p.in[I_NMG] + (l + 1) * 1024; const float* modn = (const float*)(p.ws + WS_MOD) + (size_t)(l + 1) * 9 * 6144;
    bf16_t* XN = (bf16_t*)(p.ws + WS_ACT);
    for (int tok = X.gw; tok < ntok; tok += X.NGW) {
        const int b = tok < NLAT ? (tok >> 11) : 8, c = 16 * X.lane;
        float s[16];
#pragma unroll
        for (int q = 0; q < 16; ++q) s[q] = 0.f;
#pragma unroll
        for (int j = 0; j < 9; ++j) {
            const int slot = __builtin_amdgcn_readfirstlane(tokslot[tok * 9 + j]);
            const float w = j < 8 ? __builtin_bit_cast(float, __builtin_amdgcn_readfirstlane(__builtin_bit_cast(int, tokw[tok * 8 + (j & 7)]))) : 1.f;
            const u32x4 y = *(const u32x4*)(Y + ((size_t)slot * 1024 + c));
#pragma unroll
            for (int q = 0; q < 4; ++q) {
                const f32x2 lo = __builtin_amdgcn_cvt_pk_f32_fp8((int)y[q], false), hi = __builtin_amdgcn_cvt_pk_f32_fp8((int)y[q], true);
                s[4 * q] += w * lo.x; s[4 * q + 1] += w * lo.y; s[4 * q + 2] += w * hi.x; s[4 * q + 3] += w * hi.y;
            }
        }
        const float* gp = gate + b * 6144 + c; bf16_t* xp = XR + (size_t)tok * DM + c;
        const float sc = rs * (1.f / 16.f);
        const u32x4 xa = *(const u32x4*)xp, xc = *(const u32x4*)(xp + 8);
        f32x4 o[4]; float ss = 0.f;
        o[0] = (f32x4){bflo(xa.x), bfhi(xa.x), bflo(xa.y), bfhi(xa.y)}; o[1] = (f32x4){bflo(xa.z), bfhi(xa.z), bflo(xa.w), bfhi(xa.w)};
        o[2] = (f32x4){bflo(xc.x), bfhi(xc.x), bflo(xc.y), bfhi(xc.y)}; o[3] = (f32x4){bflo(xc.z), bfhi(xc.z), bflo(xc.w), bfhi(xc.w)};
#pragma unroll
        for (int q = 0; q < 4; ++q) {
            const f32x4 g = *(const f32x4*)(gp + 4 * q) * sc;
            o[q] = o[q] + g * (f32x4){s[4 * q], s[4 * q + 1], s[4 * q + 2], s[4 * q + 3]};
            if (final_out) *(f32x4*)(p.out + (size_t)tok * DM + c + 4 * q) = o[q];
            ss += (o[q][0] * o[q][0] + o[q][1] * o[q][1]) + (o[q][2] * o[q][2] + o[q][3] * o[q][3]);
        }
        if (!final_out) { *(u32x4*)xp = pack8(o[0], o[1]); *(u32x4*)(xp + 8) = pack8(o[2], o[3]); }
        if (NEXTNORM) {
            const float rstd = rsqrtf(wave_sum(ss) * (1.f / 1024.f) + 1e-6f);
            u32x4 w0, w1;
#pragma unroll
            for (int q = 0; q < 4; ++q) {
                const f32x4 g4 = *(const f32x4*)(gain + c + 4 * q), sc4 = *(const f32x4*)(modn + b * 6144 + 1024 + c + 4 * q), sh4 = *(const f32x4*)(modn + b * 6144 + c + 4 * q);
                const f32x4 v = o[q] * rstd * (g4 * (sc4 + 1.f)) + sh4;
                if (q < 2) { w0[2 * q] = pk2(v[0], v[1]); w0[2 * q + 1] = pk2(v[2], v[3]); } else { w1[2 * (q - 2)] = pk2(v[0], v[1]); w1[2 * (q - 2) + 1] = pk2(v[2], v[3]); }
            }
            *(u32x4*)(XN + (size_t)tok * DM + c) = w0; *(u32x4*)(XN + (size_t)tok * DM + c + 8) = w1;
        }
    }
}

constexpr int AT_KB = 8192, AT_VB = 64 * 136, AT_K0 = 0, AT_V0 = 4 * AT_KB, AT_BIAS = 4 * AT_KB + 4 * AT_VB + 256, AT_BPAD = 48;
#define ATT_TILE(kb_, vb_, t0_, LAT_, brow4_, rpen_) do { \
    f32x16 sa; \
    _Pragma("unroll") for (int i = 0; i < 16; ++i) sa[i] = 0.f; \
    _Pragma("unroll") for (int s = 0; s < 4; ++s) { \
        const bf16x8 kf = *(const LAS bf16x8*)((kb_) + ((t0_) + l31) * 128 + (((2 * s + hh) ^ (l31 & 7)) << 4)); \
        sa = __builtin_amdgcn_mfma_f32_32x32x16_bf16(kf, qf[s], sa, 0, 0, 0); } \
    float tmax = -1e30f; \
    if (LAT_) { \
        const LAS float* bp = (const LAS float*)((const LAS unsigned char*)biasL + (brow4_)); \
        _Pragma("unroll") for (int i = 0; i < 16; ++i) { sa[i] = (sa[i] + bp[(i & 3) + 8 * (i >> 2)]) + (pen[i] + (rpen_)); tmax = fmaxf(tmax, sa[i]); } \
    } else { \
        _Pragma("unroll") for (int i = 0; i < 16; ++i) tmax = fmaxf(tmax, sa[i]); \
    } \
    tmax = fmaxf(tmax, __shfl_xor(tmax, 32)); \
    if (__any(tmax > mrun)) { \
        const float mnew = fmaxf(mrun, tmax), alpha = __builtin_amdgcn_exp2f(mrun - mnew); \
        lrun *= alpha; mrun = mnew; \
        _Pragma("unroll") for (int i = 0; i < 16; ++i) { o0[i] *= alpha; o1[i] *= alpha; } } \
    float psum = 0.f; \
    _Pragma("unroll") for (int i = 0; i < 16; ++i) { sa[i] = __builtin_amdgcn_exp2f(sa[i] - mrun); psum += sa[i]; } \
    lrun += psum; \
    bf16x8 pf0, pf1; \
    { u32x4 w0, w1; \
      _Pragma("unroll") for (int j = 0; j < 4; ++j) { w0[j] = pk2(sa[2 * j], sa[2 * j + 1]); w1[j] = pk2(sa[8 + 2 * j], sa[8 + 2 * j + 1]); } \
      pf0 = __builtin_bit_cast(bf16x8, w0); pf1 = __builtin_bit_cast(bf16x8, w1); } \
    const LAS unsigned char* v0p = (vb_) + l31 * 136 + 2 * (t0_) + 8 * hh; const LAS unsigned char* v1p = v0p + 32 * 136; \
    const s16x4 a0 = *(const LAS s16x4*)(v0p), a1 = *(const LAS s16x4*)(v0p + 16), a2 = *(const LAS s16x4*)(v0p + 32), a3 = *(const LAS s16x4*)(v0p + 48); \
    const s16x4 c0 = *(const LAS s16x4*)(v1p), c1 = *(const LAS s16x4*)(v1p + 16), c2 = *(const LAS s16x4*)(v1p + 32), c3 = *(const LAS s16x4*)(v1p + 48); \
    const bf16x8 va0 = __builtin_shufflevector(a0, a1, 0, 1, 2, 3, 4, 5, 6, 7), va1 = __builtin_shufflevector(a2, a3, 0, 1, 2, 3, 4, 5, 6, 7); \
    const bf16x8 vb0 = __builtin_shufflevector(c0, c1, 0, 1, 2, 3, 4, 5, 6, 7), vb1 = __builtin_shufflevector(c2, c3, 0, 1, 2, 3, 4, 5, 6, 7); \
    o0 = __builtin_amdgcn_mfma_f32_32x32x16_bf16(va0, pf0, o0, 0, 0, 0); o0 = __builtin_amdgcn_mfma_f32_32x32x16_bf16(va1, pf1, o0, 0, 0, 0); \
    o1 = __builtin_amdgcn_mfma_f32_32x32x16_bf16(vb0, pf0, o1, 0, 0, 0); o1 = __builtin_amdgcn_mfma_f32_32x32x16_bf16(vb1, pf1, o1, 0, 0, 0); \
    } while (0)
__device__ __forceinline__ void phase_attn(const Ctx& X, const Params& p) {
    const bf16_t* Q = (const bf16_t*)(p.ws + WS_Q); const bf16_t* Kb = (const bf16_t*)(p.ws + WS_K); const bf16_t* VT = (const bf16_t*)(p.ws + WS_VT);
    bf16_t* O = (bf16_t*)(p.ws + WS_O);
    LAS float* biasL = (LAS float*)(X.lds + AT_BIAS);
    const int lane = X.lane, l31 = lane & 31, hh = lane >> 5, tid = X.tid;
    const float LOG2E = 1.4426950408889634f;
    const int skey = tid >> 3, sch = tid & 7;
    for (int task = X.blk; task < 256; task += X.G) {
        const int b = task >> 5, h = (task >> 1) & 15, hf = task & 1;
        __syncthreads();
        for (int i = tid; i < 465 + 2 * AT_BPAD + 64; i += 512) { const int j = i - AT_BPAD; biasL[i] = (j >= 0 && j < 465) ? p.in[I_RPB][h * 465 + j] * LOG2E : 0.f; }
        const bf16_t* vcol = VT + (size_t)skey * DM + h * 64 + 8 * sch;
        const bf16_t* kcol = Kb + (size_t)skey * DM + h * 64 + 8 * sch;
        for (int gq = 0; gq < 4; ++gq) {
            const int R0 = 16 * hf + 4 * gq;
            const int rp = X.wave >> 2, cb = X.wave & 3, r = R0 + 2 * rp, c0 = 16 * cb;
            const int t0 = cb == 0 ? 0 : (cb == 1 ? 8 : (cb == 2 ? 24 : 32));
            const int rq = r + (l31 >> 4), qc = c0 + (l31 & 15);
            const int r0q = rq < 4 ? 0 : (rq > 28 ? 24 : rq - 4);
            const int r0lo = r < 4 ? 0 : (r > 28 ? 24 : r - 4), r0hi = (r + 1 < 4 ? 0 : (r + 1 > 28 ? 24 : r + 1 - 4)) + 7;
            const int rmin = R0 < 4 ? 0 : (R0 > 28 ? 24 : R0 - 4);
            const int rl = R0 + 3, rmax = (rl < 4 ? 0 : (rl > 28 ? 24 : rl - 4)) + 7;
            const int nl = rmax - rmin + 1, nsteps = 2 + ((nl + 1) >> 1);
            const size_t qtok = (size_t)b * 2048 + rq * 64 + qc;
            bf16x8 qf[4];
#pragma unroll
            for (int s = 0; s < 4; ++s) qf[s] = *(const bf16x8*)(Q + qtok * DM + h * 64 + 16 * s + 8 * hh);
            const int cs = qc < 8 ? 0 : (qc > 56 ? 48 : qc - 8);
            float pen[16];
#pragma unroll
            for (int i = 0; i < 16; ++i) { const int kc = t0 + (i & 3) + 8 * (i >> 2) + 4 * hh; pen[i] = (kc >= cs && kc < cs + 16) ? 0.f : -1e30f; }
            const int lb4 = 4 * ((7 - (l31 >> 4)) * 31 + t0 - qc + 15 + 4 * hh + AT_BPAD);
            f32x16 o0, o1;
#pragma unroll
            for (int i = 0; i < 16; ++i) { o0[i] = 0.f; o1[i] = 0.f; }
            float mrun = -1e30f, lrun = 0.f;
            u32x4 kA0, kA1, vA0, vA1, kB0, kB1, vB0, vB1;
#define ATT_ISSUE(st_, k0_, k1_, v0r_, v1r_) do { int s_ = (st_); s_ = s_ < nsteps ? s_ : nsteps - 1; \
                size_t kt0_, kt1_; \
                if (s_ < 2) { kt0_ = (size_t)NLAT + b * 256 + s_ * 128; kt1_ = kt0_ + 64; } \
                else { const int ra_ = rmin + 2 * (s_ - 2), rb_ = ra_ + 1 <= rmax ? ra_ + 1 : rmax; kt0_ = (size_t)b * 2048 + ra_ * 64; kt1_ = (size_t)b * 2048 + rb_ * 64; } \
                k0_ = *(const u32x4*)(kcol + kt0_ * DM); k1_ = *(const u32x4*)(kcol + kt1_ * DM); v0r_ = *(const u32x4*)(vcol + kt0_ * DM); v1r_ = *(const u32x4*)(vcol + kt1_ * DM); } while (0)
#define ATT_WRITE(nb_, k0_, k1_, v0r_, v1r_) do { \
                LAS unsigned char* kw_ = X.lds + AT_K0 + (nb_) * 2 * AT_KB + skey * 128 + ((sch ^ (skey & 7)) << 4); \
                *(LAS u32x4*)(kw_) = k0_; *(LAS u32x4*)(kw_ + AT_KB) = k1_; \
                LAS unsigned short* vw_ = (LAS unsigned short*)(X.lds + AT_V0 + (nb_) * 2 * AT_VB + (8 * sch) * 136 + skey * 2);        \
                _Pragma("unroll") for (int j_ = 0; j_ < 4; ++j_) { \
                    vw_[(2 * j_) * 68] = (unsigned short)(v0r_[j_] & 0xffffu); vw_[(2 * j_ + 1) * 68] = (unsigned short)(v0r_[j_] >> 16); \
                    vw_[AT_VB / 2 + (2 * j_) * 68] = (unsigned short)(v1r_[j_] & 0xffffu); vw_[AT_VB / 2 + (2 * j_ + 1) * 68] = (unsigned short)(v1r_[j_] >> 16); } } while (0)
#define ATT_KROW(kb_, vb_, kr_) do { const int kr = (kr_); \
                if (kr <= rmax && kr >= r0lo && kr <= r0hi) { \
                    const float rpen = (kr >= r0q && kr < r0q + 8) ? 0.f : -1e30f; \
                    const int brow4 = lb4 + 4 * 31 * (kr - r) + 4 * 0; \
                    ATT_TILE(kb_, vb_, t0, true, brow4, rpen); } } while (0)
#define ATT_STEP(st_, cur_) do { const int st = (st_); \
                const LAS unsigned char* kb = X.lds + AT_K0 + (cur_) * 2 * AT_KB; const LAS unsigned char* vb = X.lds + AT_V0 + (cur_) * 2 * AT_VB; \
                if (st < 2) { ATT_TILE(kb, vb, 0, false, 0, 0.f); ATT_TILE(kb, vb, 32, false, 0, 0.f); ATT_TILE(kb + AT_KB, vb + AT_VB, 0, false, 0, 0.f); ATT_TILE(kb + AT_KB, vb + AT_VB, 32, false, 0, 0.f); } \
                else { const int ka = rmin + 2 * (st - 2); ATT_KROW(kb, vb, ka); ATT_KROW(kb + AT_KB, vb + AT_VB, ka + 1); } } while (0)
            ATT_ISSUE(0, kA0, kA1, vA0, vA1);
            ATT_ISSUE(1, kB0, kB1, vB0, vB1);
            __syncthreads();
            ATT_WRITE(0, kA0, kA1, vA0, vA1);
            __syncthreads();
            for (int sp = 0; sp < nsteps; sp += 2) {
                ATT_ISSUE(sp + 2, kA0, kA1, vA0, vA1);
                ATT_STEP(sp, 0);
                ATT_WRITE(1, kB0, kB1, vB0, vB1);
                __syncthreads();
                if (sp + 1 < nsteps) {
                    ATT_ISSUE(sp + 3, kB0, kB1, vB0, vB1);
                    ATT_STEP(sp + 1, 1);
                    ATT_WRITE(0, kA0, kA1, vA0, vA1);
                    __syncthreads();
                }
            }
#undef ATT_ISSUE
#undef ATT_WRITE
#undef ATT_STEP
#undef ATT_KROW
            const float ltot = lrun + __shfl_xor(lrun, 32), inv = 1.f / ltot;
            bf16_t* op = O + qtok * DM + h * 64;
#pragma unroll
            for (int g = 0; g < 4; ++g) {
                u32x2 w; w.x = pk2(o0[4 * g] * inv, o0[4 * g + 1] * inv); w.y = pk2(o0[4 * g + 2] * inv, o0[4 * g + 3] * inv);
                *(u32x2*)(op + 8 * g + 4 * hh) = w;
                u32x2 w2; w2.x = pk2(o1[4 * g] * inv, o1[4 * g + 1] * inv); w2.y = pk2(o1[4 * g + 2] * inv, o1[4 * g + 3] * inv);
                *(u32x2*)(op + 32 + 8 * g + 4 * hh) = w2;
            }
        }
    }
}
#undef ATT_TILE


constexpr int N_PHASES = 24;
constexpr int C0A = 4800, C0B = 6400, C0C = 7600;
constexpr int C1P = 1500, C1Q = 3000, C1A = 7320;
#ifndef PROBE_LO
#define PROBE_LO 99
#define PROBE_HI (-1)
#endif
__host__ __device__ constexpr int nrep(int k) { return (k >= PROBE_LO && k <= PROBE_HI) ? 2 : 1; }
__global__ void __launch_bounds__(512, 2) fwd_kernel(Params p) {
    extern __shared__ __attribute__((aligned(16))) unsigned char lds_raw[];
    LAS unsigned char* lds = (LAS unsigned char*)lds_raw;
    const int wave0 = __builtin_amdgcn_readfirstlane((int)(threadIdx.x >> 6));
    for (int u = threadIdx.x; u < (LDS_BYTES - MISC_OFF) / 4; u += 512) ((LAS unsigned*)(lds + MISC_OFF))[u] = 0u;
    __syncthreads();
    XcdBarrier bar; bar.bar = (unsigned*)(p.ws + WS_CTL) + 4096; bar.x = 0; bar.st = (volatile LAS unsigned*)(lds + MISC_OFF + M_BAR);
    if (p.ph_hi - p.ph_lo > 1) bar = xcd_barrier_post((unsigned*)(p.ws + WS_CTL) + 4096, (volatile LAS unsigned*)(lds + MISC_OFF + M_BAR));
#define PH(k) (p.ph_lo <= (k) && (k) < p.ph_hi)
#define SEAM(k) do { if (PH(k) && PH((k) + 1)) xcd_barrier(bar, wave0); } while (0)
#define RUN(k, ...) do { if (PH(k)) { _Pragma("unroll") for (int rep_ = 0; rep_ < nrep(k); ++rep_) { const float rs_ = rep_ == 0 ? 1.f : 0.f; (void)rs_; { __VA_ARGS__ } if (rep_ + 1 < nrep(k)) xcd_barrier(bar, wave0); } } SEAM(k); } while (0)
    unsigned char* ws = p.ws;
    const float* MOD = (const float*)(ws + WS_MOD);

    RUN(0, const Ctx X = mkctx(lds, wave0); phase_p0a(X, p););
    RUN(1, const Ctx X = mkctx(lds, wave0); phase_p0b(X, p););
    RUN(2, const Ctx X = mkctx(lds, wave0); phase_norm<0>(X, p, 0, 0, NTOK););
    RUN(3,
        g8::RectSched S{72, 8, (int)gridDim.x, (int)blockIdx.x, 0u, 2048u, (const char*)(ws + WS_WIN), 2048u};
        EpiWin E{(bf16_t*)(ws + WS_A2), (bf16_t*)(ws + WS_BCV)};
        g8::gemm_phase(lds, wave0, (const char*)(ws + WS_XA), 1024, 2048u, S, E);
        { const Ctx X = mkctx(lds, wave0); int nidle; const int rk = idle_rank(576, X.G, X.blk, nidle);
          if (rk >= 0) { conv_moe_items<0>(X, p, 0, (bf16_t*)(ws + WS_GU), (bf16_t*)(ws + WS_DN), 0, C0A, rk, nidle);
                         conv_moe_items<1>(X, p, 1, (bf16_t*)(ws + WS_GU1), nullptr, 0, C1P, rk, nidle); } });
    RUN(4,
        g8::BatchSched S{32, 3, 1, (int)gridDim.x, (int)blockIdx.x, 1536u, (const char*)(ws + WS_WF), 1024u, 256};
        EpiS5F E{(float*)(ws + WS_F)};
        g8::gemm_phase(lds, wave0, (const char*)(ws + WS_A2), 512, 1024u, S, E);
        { const Ctx X = mkctx(lds, wave0); int nidle; const int rk = moe_idle_rank(96, 1, X.G, X.blk, nidle);
          if (rk >= 0) conv_moe_items<0>(X, p, 0, (bf16_t*)(ws + WS_GU), (bf16_t*)(ws + WS_DN), C0A, C0B, rk, nidle); });
    RUN(5, const Ctx X = mkctx(lds, wave0); phase_scan_conv(X, p););
    RUN(6,
        g8::BatchSched S{32, 3, 2, (int)gridDim.x, (int)blockIdx.x, 1536u, (const char*)(ws + WS_ME), 1536u, 512};
        EpiS5Y E{(bf16_t*)(ws + WS_G)};
        g8::gemm_phase(lds, wave0, (const char*)(ws + WS_A2), 768, 1536u, S, E););
    RUN(7,
        g8::RectSched S{72, 2, (int)gridDim.x, (int)blockIdx.x, 0u, 1024u, (const char*)(ws + WS_GLU), 1024u};
        EpiGlu E{(const bf16_t*)(ws + WS_G), p.in[I_GLUB], (bf16_t*)(ws + WS_Z)};
        g8::gemm_phase(lds, wave0, (const char*)(ws + WS_G), 512, 1024u, S, E);
        { const Ctx X = mkctx(lds, wave0); int nidle; const int rk = idle_rank(144, X.G, X.blk, nidle);
          if (rk >= 0) conv_moe_items<0>(X, p, 0, (bf16_t*)(ws + WS_GU), (bf16_t*)(ws + WS_DN), C0B, C0C, rk, nidle); });
    RUN(8,
        g8::RectSched S{72, 4, (int)gridDim.x, (int)blockIdx.x, 0u, 2048u, (const char*)(ws + WS_HOUT), 2048u};
        EpiResid<true> E{p.in[I_X], p.in[I_CTX], MOD + 2 * 1024, (bf16_t*)(ws + WS_XR), 1.f};
        g8::gemm_phase(lds, wave0, (const char*)(ws + WS_Z), 1024, 2048u, S, E);
        { const Ctx X = mkctx(lds, wave0); int nidle; const int rk = idle_rank(288, X.G, X.blk, nidle);
          if (rk >= 0) { conv_moe_items<0>(X, p, 0, (bf16_t*)(ws + WS_GU), (bf16_t*)(ws + WS_DN), C0C, 12480, rk, nidle);
                         conv_moe_items<1>(X, p, 1, (bf16_t*)(ws + WS_GU1), nullptr, C1P, C1Q, rk, nidle); } });
#define MOE_PHASES(P0, L, NTOKL, FINAL) \
    RUN(P0, const Ctx X = mkctx(lds, wave0); phase_norm<1>(X, p, L, 1, NTOKL);); \
    RUN(P0 + 1, const Ctx X = mkctx(lds, wave0); phase_route(X, p, L, NTOKL);); \
    RUN(P0 + 2, const Ctx X = mkctx(lds, wave0); phase_slots(X, p, NTOKL);); \
    RUN(P0 + 3, \
        const Ctx X = mkctx(lds, wave0); const int ntiles = load_tiles(X, p); \
        g8::MoeSched<true> S{ntiles, 2, (int)gridDim.x, (int)blockIdx.x, 2048u, (const char*)(ws + (L == 0 ? WS_GU : WS_GU1)), 2048u, 512, 0, 128, lds + MISC_OFF + M_TILE, (const int*)(ws + WS_ROWIDX)}; \
        EpiGU E{(bf16_t*)(ws + WS_ACT)}; \
        g8::gemm_phase(lds, wave0, (const char*)(ws + WS_XA), 1024, 2048u, S, E); \
        { const Ctx X2 = mkctx(lds, wave0); int nidle; const int rk = moe_idle_rank(ntiles, 2, X2.G, X2.blk, nidle);        \
          if (rk >= 0 && L == 0) conv_moe_items<1>(X2, p, 1, (bf16_t*)(ws + WS_GU1), nullptr, C1Q, C1A, rk, nidle); }); \
    RUN(P0 + 4, \
        const Ctx X = mkctx(lds, wave0); const int ntiles = load_tiles(X, p); \
        g8::MoeSched<false> S{ntiles, 4, (int)gridDim.x, (int)blockIdx.x, 512u, (const char*)(ws + WS_DN), 512u, 1024, 0, 256, lds + MISC_OFF + M_TILE, nullptr}; \
        EpiDN E{(unsigned char*)(ws + WS_Y)}; \
        g8::gemm_phase(lds, wave0, (const char*)(ws + WS_ACT), 256, 512u, S, E); \
        { const Ctx X2 = mkctx(lds, wave0); int nidle; const int rk = moe_idle_rank(ntiles, 4, X2.G, X2.blk, nidle); \
          if (rk >= 0 && L == 0) conv_moe_items<1>(X2, p, 1, (bf16_t*)(ws + WS_GU1), nullptr, C1A, 8320, rk, nidle); }); \
    RUN(P0 + 5, const Ctx X = mkctx(lds, wave0); phase_combine<!FINAL>(X, p, L, NTOKL, FINAL, 1.f););

    MOE_PHASES(9, 0, NTOK, false)
    RUN(15,
        g8::QkvSched S{(int)gridDim.x, (int)blockIdx.x, 2048u, (const char*)(ws + WS_QKV), 2048u};
        EpiQKV E{(bf16_t*)(ws + WS_Q), (bf16_t*)(ws + WS_K), (bf16_t*)(ws + WS_VT), p.in[I_QG], p.in[I_KG]};
        g8::gemm_phase(lds, wave0, (const char*)(ws + WS_ACT), 1024, 2048u, S, E);
        { const Ctx X = mkctx(lds, wave0); int nidle; const int rk = idle_rank(832, X.G, X.blk, nidle);
          if (rk >= 0) conv_moe_items<2>(X, p, 1, nullptr, (bf16_t*)(ws + WS_DN), 0, 4160, rk, nidle); });
    RUN(16, const Ctx X = mkctx(lds, wave0); phase_attn(X, p););
    RUN(17,
        g8::RectSched S{64, 4, (int)gridDim.x, (int)blockIdx.x, 0u, 2048u, (const char*)(ws + WS_NOUT), 2048u};
        EpiResid<false> E{nullptr, nullptr, MOD + 9 * 6144 + 2 * 1024, (bf16_t*)(ws + WS_XR), rs_};
        g8::gemm_phase(lds, wave0, (const char*)(ws + WS_O), 1024, 2048u, S, E););
    MOE_PHASES(18, 1, NLAT, true)
#undef PH
#undef SEAM
#undef RUN
}

extern "C" void kernel_launch(void* const* d_in, const int* in_sizes, int n_in, void* d_out, int out_size, void* d_ws, size_t ws_size, hipStream_t stream) {
    static int grid = 0;
    if (grid == 0) {
        int dev = 0, cus = 0, per_cu = 0;
        if (n_in != 34 || ws_size < WS_END) { fprintf(stderr, "kernel_launch: unexpected inputs (n_in %d, ws %zu, need %zu)\n", n_in, ws_size, (size_t)WS_END); grid = -1; return; }
        if (hipGetDevice(&dev) != hipSuccess || hipDeviceGetAttribute(&cus, hipDeviceAttributeMultiprocessorCount, dev) != hipSuccess) { grid = -1; return; }
        if (hipFuncSetAttribute((const void*)fwd_kernel, hipFuncAttributeMaxDynamicSharedMemorySize, LDS_BYTES) != hipSuccess) { fprintf(stderr, "kernel_launch: hipFuncSetAttribute failed\n"); grid = -1; return; }
        if (hipOccupancyMaxActiveBlocksPerMultiprocessor(&per_cu, (const void*)fwd_kernel, 512, LDS_BYTES) != hipSuccess || per_cu < 1) { fprintf(stderr, "kernel_launch: occupancy query says %d\n", per_cu); }
        (void)hipGetLastError();
        grid = cus;
    }
    if (grid < 0) return;
    (void)hipMemsetAsync((char*)d_ws + WS_CTL, 0, 64 * 1024, stream);
    Params p{};
    for (int i = 0; i < 34; ++i) p.in[i] = (const float*)d_in[i];
    p.out = (float*)d_out; p.ws = (unsigned char*)d_ws;
#if MK_ONE_LAUNCH
    p.ph_lo = 0; p.ph_hi = N_PHASES;
    hipLaunchKernelGGL(fwd_kernel, dim3(grid), dim3(512), LDS_BYTES, stream, p);
#else
    for (int k = 0; k < N_PHASES; ++k) { p.ph_lo = k; p.ph_hi = k + 1; hipLaunchKernelGGL(fwd_kernel, dim3(grid), dim3(512), LDS_BYTES, stream, p); }
#endif
}
```

```cpp
#include <hip/hip_runtime.h>
#include <stdint.h>
#include <stdio.h>

#ifndef MK_ONE_LAUNCH
#define MK_ONE_LAUNCH 1
#endif

#define GAS __attribute__((address_space(1)))
#define LAS __attribute__((address_space(3)))
typedef unsigned short bf16_t;
typedef short bf16x8 __attribute__((ext_vector_type(8)));
typedef short s16x4 __attribute__((ext_vector_type(4)));
typedef float f32x4 __attribute__((ext_vector_type(4)));
typedef float f32x2 __attribute__((ext_vector_type(2)));
typedef float f32x16 __attribute__((ext_vector_type(16)));
typedef unsigned u32x4 __attribute__((ext_vector_type(4)));
typedef unsigned u32x2 __attribute__((ext_vector_type(2)));

constexpr int NLAT = 16384, NCTX = 2048, NTOK = NLAT + NCTX, DM = 1024;
constexpr int SEQ = 2048, CTXL = 256, NB = 8;
constexpr int NEXP = 64, NEXP1 = 65, EDIM = 256;
constexpr int S5T = 32;
constexpr int S5R = 576, S5RP = 768;
constexpr int S5K = 768;
constexpr int MAXTILES = 712;

constexpr size_t MiB = 1ull << 20;
constexpr size_t WS_CTL = 0;
constexpr size_t WS_MOD = 1 * MiB;
constexpr size_t WS_WIN = 2 * MiB;
constexpr size_t WS_GLU = 6 * MiB;
constexpr size_t WS_HOUT = 7 * MiB;
constexpr size_t WS_QKV = 9 * MiB;
constexpr size_t WS_NOUT = 15 * MiB;
constexpr size_t WS_ROUT = 17 * MiB;
constexpr size_t WS_GU = 18 * MiB;
constexpr size_t WS_DN = 83 * MiB;
constexpr size_t WS_GU1 = 116 * MiB;
constexpr size_t WS_XR = 181 * MiB;
constexpr size_t WS_LOGIT = 253 * MiB;
constexpr size_t WS_TOKE = 258 * MiB;
constexpr size_t WS_TOKW = 259 * MiB;
constexpr size_t WS_TOKP = 260 * MiB;
constexpr size_t WS_ROWIDX = 261 * MiB;
constexpr size_t WS_YROW = 262 * MiB;
constexpr size_t WS_CNTBLK = 263 * MiB;
constexpr size_t WS_TAB = 263 * MiB + 512 * 1024;
constexpr size_t WS_XA = 264 * MiB;
constexpr size_t WS_OVL = 300 * MiB;
constexpr size_t WS_A2 = WS_OVL;
constexpr size_t WS_BCV = WS_OVL + 36 * MiB;
constexpr size_t WS_F = WS_OVL + 90 * MiB;
constexpr size_t WS_Z = WS_OVL + 114 * MiB;
constexpr size_t WS_G = WS_OVL + 150 * MiB;
constexpr size_t WS_ME = WS_OVL + 168 * MiB;
constexpr size_t WS_WF = WS_OVL + 192 * MiB;
constexpr size_t WS_KK = WS_OVL + 200 * MiB;
constexpr size_t WS_PW = WS_OVL + 202 * MiB;
constexpr size_t WS_BB = WS_OVL + 204 * MiB;
constexpr size_t WS_ADAP = WS_OVL + 205 * MiB;
constexpr size_t WS_Q = WS_OVL;
constexpr size_t WS_K = WS_OVL + 32 * MiB;
constexpr size_t WS_VT = WS_OVL + 68 * MiB;
constexpr size_t WS_O = WS_OVL + 104 * MiB;
constexpr size_t WS_Y = WS_XA;
constexpr size_t WS_ACT = WS_XA + 178 * MiB;
constexpr size_t WS_END = WS_ACT + 89 * MiB;

constexpr int RING_BYTES = 131072;
constexpr int MISC_OFF = RING_BYTES;
constexpr int LDS_BYTES = 147456;
constexpr int M_BAR = 0, M_CNT = 64, M_BASE = 384, M_BBASE = 704, M_TILE = 1024, M_PART = 2048, M_NT = 3200;

__device__ __forceinline__ unsigned f2bf(float f) { unsigned u = __builtin_bit_cast(unsigned, f); return (u + 0x7fffu + ((u >> 16) & 1u)) >> 16; }
typedef __bf16 hbf16x2 __attribute__((ext_vector_type(2)));
__device__ __forceinline__ unsigned pk2(float lo, float hi) { const f32x2 v = {lo, hi}; const hbf16x2 b = __builtin_convertvector(v, hbf16x2); return __builtin_bit_cast(unsigned, b); }
__device__ __forceinline__ float bflo(unsigned w) { return __builtin_bit_cast(float, w << 16); }
__device__ __forceinline__ float bfhi(unsigned w) { return __builtin_bit_cast(float, w & 0xffff0000u); }
__device__ __forceinline__ float bf1(bf16_t b) { return __builtin_bit_cast(float, ((unsigned)b) << 16); }
__device__ __forceinline__ float wave_sum(float v) {
#pragma unroll
    for (int o = 1; o < 64; o <<= 1) v += __shfl_xor(v, o);
    return v;
}
__device__ __forceinline__ float sigmoidf_(float x) { return 1.f / (1.f + __expf(-x)); }
__device__ __forceinline__ float siluf_(float x) { return x / (1.f + __expf(-x)); }
__device__ __forceinline__ float gelu_tanh(float x) {
    const float u = 0.7978845608028654f * (x + 0.044715f * x * x * x);
    const float e = __expf(2.f * u);
    const float t = 1.f - 2.f / (e + 1.f);
    return 0.5f * x * (1.f + t);
}

__device__ __forceinline__ int lane_id_opaque() { int l; asm volatile("v_mbcnt_lo_u32_b32 %0, -1, 0\n\tv_mbcnt_hi_u32_b32 %0, -1, %0" : "=v"(l)); return l; }

#define XB_TMO      128
#define XB_XCNT(j)  (256  + 64 * (j))
#define XB_XSUB(j)  (1280 + 64 * (j))
#define XB_XGEN(j)  (2304 + 64 * (j))
#define XB_TOP      3328
#define XB_TOPGEN   3392
#define XCD_BAR_WORDS 3456
#define XB_SPIN_CAP (1u << 18)
__device__ __forceinline__ unsigned xb_ld(unsigned* p)              { return __hip_atomic_load(p, __ATOMIC_RELAXED, __HIP_MEMORY_SCOPE_AGENT); }
__device__ __forceinline__ unsigned xb_add(unsigned* p, unsigned v) { return __hip_atomic_fetch_add(p, v, __ATOMIC_RELAXED, __HIP_MEMORY_SCOPE_AGENT); }
__device__ __forceinline__ unsigned xb_xcc_id() { return (unsigned)__builtin_amdgcn_s_getreg((3 << 11) | 20) & 0xFu; }
#define XB_SPIN(cond, bar) do { unsigned _sp = 0; while (cond) { __builtin_amdgcn_s_sleep(1); \
    if ((++_sp & 255u) == 0u) { if (xb_ld(&(bar)[XB_TMO])) break; if (_sp > XB_SPIN_CAP) { atomicAdd(&(bar)[XB_TMO], 1u); break; } } } } while (0)
struct XcdBarrier { unsigned* bar; unsigned x; volatile LAS unsigned* st; };
__device__ __forceinline__ XcdBarrier xcd_barrier_post(unsigned* bar, volatile LAS unsigned* st) {
    XcdBarrier b; b.bar = bar; b.x = xb_xcc_id(); b.st = st;
    if (threadIdx.x == 0) (void)xb_add(&bar[XB_XCNT(b.x)], 1u);
    return b;
}
__device__ __forceinline__ void xcd_barrier_complete(unsigned* bar, unsigned x, unsigned& nloc, unsigned& nx) {
    const unsigned G = gridDim.x * gridDim.y * gridDim.z;
    unsigned sum, cnt, mine, sp = 0u;
    for (;;) {
        sum = 0u; cnt = 0u; mine = 0u;
#pragma unroll
        for (unsigned j = 0; j < 16; ++j) { const unsigned c = xb_ld(&bar[XB_XCNT(j)]); sum += c; cnt += (c > 0u) ? 1u : 0u; mine = (j == x) ? c : mine; }
        if (sum == G) break;
        __builtin_amdgcn_s_sleep(1);
        if ((++sp & 255u) == 0u) { if (xb_ld(&bar[XB_TMO])) break; if (sp > XB_SPIN_CAP) { atomicAdd(&bar[XB_TMO], 1u); break; } }
    }
    nloc = mine > 0u ? mine : 1u; nx = cnt > 0u ? cnt : 1u;
}
__device__ __forceinline__ void xcd_barrier(const XcdBarrier& b, const int wave0) {
    asm volatile("s_waitcnt vmcnt(0)" ::: "memory");
    __syncthreads();
    if (wave0 == 0 && lane_id_opaque() == 0) {
        unsigned* bar = b.bar;
        __builtin_amdgcn_s_waitcnt(0);
        unsigned nloc = b.st[0], nx = b.st[1];
        if (nloc == 0u) { xcd_barrier_complete(bar, b.x, nloc, nx); b.st[0] = nloc; b.st[1] = nx; }
        const unsigned old = xb_add(&bar[XB_XSUB(b.x)], 1u);
        const unsigned gen = old / nloc;
        if (old + 1u == (gen + 1u) * nloc) {
            __builtin_amdgcn_fence(__ATOMIC_RELEASE, "agent");
            asm volatile("s_waitcnt vmcnt(0)" ::: "memory");
            const unsigned og = xb_add(&bar[XB_TOP], 1u);
            const unsigned tg = og / nx;
            if (og + 1u == (tg + 1u) * nx) xb_add(&bar[XB_TOPGEN], 1u);
            else XB_SPIN(xb_ld(&bar[XB_TOPGEN]) == tg, bar);
            __builtin_amdgcn_fence(__ATOMIC_ACQUIRE, "agent");
            xb_add(&bar[XB_XGEN(b.x)], 1u);
            asm volatile("s_waitcnt vmcnt(0)" ::: "memory");
        } else {
            XB_SPIN(xb_ld(&bar[XB_XGEN(b.x)]) == gen, bar);
            __builtin_amdgcn_fence(__ATOMIC_ACQUIRE, "agent");
            asm volatile("s_waitcnt vmcnt(0)" ::: "memory");
        }
    }
    __syncthreads();
}

namespace g8 {
constexpr int BM = 256, BK = 64, HALF = 128, HTB = HALF * BK * 2, STAGE_BYTES = 8 * HTB, NXCD = 8, WGM = 8;
__host__ __device__ __forceinline__ int lds_byte(int r, int c) { const int st = (r >> 4) * 2 + (c >> 5), rr = r & 15, cc = c & 31, ob = rr * 64 + cc * 2; return st * 1024 + (ob ^ (((ob >> 9) & 1) << 5)); }
__host__ __device__ __forceinline__ void stage_rc(int b, int& R, int& C) { const int st = b / 1024, sb = b % 1024, swz = sb ^ (((sb >> 9) & 1) << 5); R = (st >> 1) * 16 + swz / 64; C = (st & 1) * 32 + (swz % 64) / 2; }
__host__ __device__ __forceinline__ int perm32(int rho) { const int n = rho >> 4, i = rho & 15; return 8 * (i >> 2) + 4 * n + (i & 3); }

struct Unit { unsigned a0; const char* B; int p0, p1, p2; };

__device__ __forceinline__ void static_map(int L, int nM, int nN, int& pm, int& pn) {
    const int nwg = nM * nN; int wgid = L;
    { const int q = nwg / NXCD, r = nwg % NXCD, xcd = wgid % NXCD, off = wgid / NXCD; wgid = (xcd < r ? xcd * (q + 1) : r * (q + 1) + (xcd - r) * q) + off; }
    const int nig = WGM * nN, gid = wgid / nig, fm = gid * WGM, gsz = (nM - fm) < WGM ? (nM - fm) : WGM;
    pm = fm + ((wgid % nig) % gsz); pn = (wgid % nig) / gsz;
}

template <class Epi, class Sched>
__device__ __forceinline__ void gemm_phase(LAS unsigned char* lds, const int wid, const char* Abase, const int K, const unsigned ldb, const Sched& S, const Epi& E) {
    const int lane = lane_id_opaque();
    const int tid = wid * 64 + lane, wr = wid >> 2, wc = wid & 3, fr = lane & 15, fq = lane >> 4;
    const int nt = K / BK;
    unsigned voffB0;
    { int R0, C0; stage_rc(tid * 16, R0, C0);
      const int Rb0 = Epi::GUP ? (256 * ((R0 >> 4) & 1) + 32 * (R0 >> 5) + 8 * ((R0 & 15) >> 2) + (R0 & 3)) : Epi::WIDE ? (64 * (R0 >> 5) + 16 * ((R0 & 15) >> 2) + 4 * ((R0 >> 4) & 1) + (R0 & 3)) : Epi::HEADP ? (64 * (R0 >> 5) + perm32(R0 & 31)) : (Epi::PERM ? ((R0 & ~31) + perm32(R0 & 31)) : R0);
      voffB0 = (unsigned)Rb0 * ldb + (unsigned)C0 * 2u; }
    const size_t hstepB = (size_t)(Epi::GUP ? 4 : Epi::WIDE ? 8 : (Epi::HEADP ? 32 : HALF)) * ldb;
    const size_t p1stepB = (size_t)((Epi::WIDE || Epi::HEADP) ? 128 : 64) * ldb;
    const unsigned ldsw = (unsigned)wid * 1024u;
    const int aoff = lds_byte(wr * 64 + fr, fq * 8), boff = lds_byte(wc * 32 + fr, fq * 8);
#define G8_SA(b, h) (((b) * 2 + (h)) * HTB)
#define G8_SB(b, h) ((4 + (b) * 2 + (h)) * HTB)
#define G8_GLDS(gp, lo) __builtin_amdgcn_global_load_lds((const unsigned*)(gp), (LAS unsigned*)(lds + (lo)), 16, 0, 0)
#define G8_STAGE_A(bufoff, o0, o1, kb, h) do { \
        G8_GLDS(Abase + ((long)(kb) + (Sched::GATHER ? 0l : (long)((h) * 128) * (long)S.lda)) + (size_t)(o0), (bufoff) + ldsw); \
        G8_GLDS(Abase + ((long)(kb) + (Sched::GATHER ? 0l : (long)((h) * 128 + 64) * (long)S.lda)) + (size_t)(o1), (bufoff) + ldsw + 8192); } while (0)
#define G8_STAGE_B(bufoff, bp, kb) do { G8_GLDS((bp) + (size_t)(kb) + (size_t)voffB0, (bufoff) + ldsw); G8_GLDS((bp) + ((size_t)(kb) + p1stepB) + (size_t)voffB0, (bufoff) + ldsw + 8192); } while (0)
#define G8_LDA(dst, b, h) do { _Pragma("unroll") for (int m = 0; m < 4; ++m) _Pragma("unroll") for (int k = 0; k < 2; ++k) dst[m][k] = *(const LAS bf16x8*)(lds + G8_SA(b, h) + aoff + m * 2048 + k * 1024); } while (0)
#define G8_LDB(dst, b, h) do { _Pragma("unroll") for (int n = 0; n < 2; ++n) _Pragma("unroll") for (int k = 0; k < 2; ++k) dst[n][k] = *(const LAS bf16x8*)(lds + G8_SB(b, h) + boff + n * 2048 + k * 1024); } while (0)
#define G8_MMA(ai, bj, At, Bt) do { __builtin_amdgcn_s_setprio(1); _Pragma("unroll") for (int m = 0; m < 4; ++m) _Pragma("unroll") for (int n = 0; n < 2; ++n) _Pragma("unroll") for (int k = 0; k < 2; ++k) \
        acc[ai][bj][m][n] = __builtin_amdgcn_mfma_f32_16x16x32_bf16(Bt[n][k], At[m][k], acc[ai][bj][m][n], 0, 0, 0); __builtin_amdgcn_s_setprio(0); } while (0)
#define G8_WAIT_V(n) asm volatile("s_waitcnt vmcnt(" #n ")" ::: "memory")
#define G8_WAIT_L(n) asm volatile("s_waitcnt lgkmcnt(" #n ")" ::: "memory")
#define G8_BAR __builtin_amdgcn_s_barrier()
#define G8_SCHED __builtin_amdgcn_sched_barrier(0)
    Unit cur, nxt; int ui = 0;
    if (!S.next(0, cur)) return;
    f32x4 acc[2][2][4][2];
#pragma unroll
    for (int a = 0; a < 2; ++a)
#pragma unroll
        for (int b = 0; b < 2; ++b)
#pragma unroll
            for (int m = 0; m < 4; ++m)
#pragma unroll
                for (int n = 0; n < 2; ++n) acc[a][b][m][n] = (f32x4){0.f, 0.f, 0.f, 0.f};
    bf16x8 At[4][2], B0[2][2], B1[2][2];
    unsigned cA00, cA01, cA10, cA11;
    { int R0, C0, R1, C1; stage_rc(tid * 16, R0, C0); stage_rc(tid * 16 + 8192, R1, C1);
      cA00 = S.aoff(cur, R0) + (unsigned)C0 * 2u;
      if constexpr (Sched::GATHER) { cA01 = S.aoff(cur, R1) + (unsigned)C1 * 2u; cA10 = S.aoff(cur, HALF + R0) + (unsigned)C0 * 2u; cA11 = S.aoff(cur, HALF + R1) + (unsigned)C1 * 2u; }
      else { cA01 = cA00; cA10 = cA00; cA11 = cA00; } }
    const char* cB = cur.B;
    G8_STAGE_B(G8_SB(0, 0), cB, 0); G8_SCHED; G8_STAGE_B(G8_SB(0, 1), cB + hstepB, 0); G8_SCHED; G8_STAGE_A(G8_SA(0, 0), cA00, cA01, 0, 0); G8_SCHED; G8_STAGE_A(G8_SA(0, 1), cA10, cA11, 0, 1); G8_SCHED;
    if (wr == 1) G8_BAR;
    G8_WAIT_V(2); G8_BAR;
    G8_STAGE_B(G8_SB(1, 0), cB, 128); G8_SCHED; G8_STAGE_A(G8_SA(1, 0), cA00, cA01, 128, 0); G8_SCHED; G8_STAGE_B(G8_SB(1, 1), cB + hstepB, 128); G8_SCHED;
    G8_WAIT_V(6); G8_BAR;
    for (;;) {
        const bool has_next = S.next(ui + 1, nxt);
        unsigned nA00 = cA00, nA01 = cA01, nA10 = cA10, nA11 = cA11; const char* nB = cB; long dl = 0;
        if (has_next) {
            nB = nxt.B;
            if constexpr (!Sched::GATHER) dl = ((long)nxt.a0 - (long)cur.a0) * (long)S.lda;
            else { const int t2 = wid * 64 + lane_id_opaque(); int R0, C0, R1, C1; stage_rc(t2 * 16, R0, C0); stage_rc(t2 * 16 + 8192, R1, C1);
                nA00 = S.aoff(nxt, R0) + (unsigned)C0 * 2u; nA01 = S.aoff(nxt, R1) + (unsigned)C1 * 2u; nA10 = S.aoff(nxt, HALF + R0) + (unsigned)C0 * 2u; nA11 = S.aoff(nxt, HALF + R1) + (unsigned)C1 * 2u; }
        }
        for (int t = 0; t < nt; t += 2) {
            const bool last = (t == nt - 2);
            const unsigned kb = (unsigned)t * 128u;
            const unsigned kb2 = last ? 0u : kb + 256u;
            const char* b2 = last ? nB : cB;
            unsigned s00, s01, s10, s11; long ka2;
            if constexpr (Sched::GATHER) { s00 = last ? nA00 : cA00; s01 = last ? nA01 : cA01; s10 = last ? nA10 : cA10; s11 = last ? nA11 : cA11; ka2 = (long)kb2; }
            else { s00 = cA00; s01 = cA00; s10 = cA00; s11 = cA00; ka2 = last ? dl : (long)kb2; }
            G8_LDB(B0, 0, 0); G8_LDB(B1, 0, 1); G8_SCHED; G8_LDA(At, 0, 0); G8_STAGE_A(G8_SA(1, 1), cA10, cA11, kb + 128u, 1);
            G8_WAIT_V(8); G8_WAIT_L(0); G8_BAR; G8_MMA(0, 0, At, B0); G8_MMA(0, 1, At, B1); G8_BAR; G8_SCHED;
            G8_LDA(At, 0, 1); G8_STAGE_B(G8_SB(0, 0), b2, kb2); G8_STAGE_B(G8_SB(0, 1), b2 + hstepB, kb2); G8_STAGE_A(G8_SA(0, 0), s00, s01, ka2, 0);
            G8_WAIT_V(8); G8_WAIT_L(0); G8_BAR; G8_MMA(1, 0, At, B0); G8_MMA(1, 1, At, B1); G8_BAR; G8_SCHED;
            G8_LDB(B0, 1, 0); G8_LDB(B1, 1, 1); G8_SCHED; G8_LDA(At, 1, 0); G8_STAGE_A(G8_SA(0, 1), s10, s11, ka2, 1);
            G8_WAIT_V(8); G8_WAIT_L(0); G8_BAR; G8_MMA(0, 0, At, B0); G8_MMA(0, 1, At, B1); G8_BAR; G8_SCHED;
            G8_LDA(At, 1, 1); G8_STAGE_B(G8_SB(1, 0), b2, kb2 + 128u); G8_STAGE_B(G8_SB(1, 1), b2 + hstepB, kb2 + 128u); G8_STAGE_A(G8_SA(1, 0), s00, s01, ka2 + 128, 0);
            G8_WAIT_V(8); G8_WAIT_L(0); G8_BAR; G8_MMA(1, 0, At, B0); G8_MMA(1, 1, At, B1); G8_BAR; G8_SCHED;
        }
        if (wr == 0) G8_BAR;
        { const int l2 = lane_id_opaque(); E(acc, cur, wr, wc, l2 & 15, l2 >> 4); }
        if (!has_next) break;
#pragma unroll
        for (int a = 0; a < 2; ++a)
#pragma unroll
            for (int b = 0; b < 2; ++b)
#pragma unroll
                for (int m = 0; m < 4; ++m)
#pragma unroll
                    for (int n = 0; n < 2; ++n) acc[a][b][m][n] = (f32x4){0.f, 0.f, 0.f, 0.f};
        cur = nxt; cB = nB; ++ui;
        if constexpr (Sched::GATHER) { cA00 = nA00; cA01 = nA01; cA10 = nA10; cA11 = nA11; }
        else { cA00 += (unsigned)dl; cA01 = cA00; cA10 = cA00; cA11 = cA00; }
        if (wr == 1) G8_BAR;
    }
    G8_WAIT_V(0);
    G8_BAR;
#undef G8_SA
#undef G8_SB
#undef G8_GLDS
#undef G8_STAGE_A
#undef G8_STAGE_B
#undef G8_LDA
#undef G8_LDB
#undef G8_MMA
#undef G8_WAIT_V
#undef G8_WAIT_L
#undef G8_BAR
#undef G8_SCHED
}

struct RectSched {
    static constexpr bool GATHER = false;
    int nM, nN, G, c; unsigned row0, lda; const char* Bbase; unsigned ldb;
    __device__ __forceinline__ bool next(int i, Unit& u) const {
        const int L = i * G + c; if (L >= nM * nN) return false;
        int pm, pn; static_map(L, nM, nN, pm, pn);
        u.a0 = row0 + (unsigned)pm * 256u; u.B = Bbase + (size_t)pn * 256u * ldb; u.p0 = pm; u.p1 = pn; u.p2 = 0; return true;
    }
    __device__ __forceinline__ unsigned aoff(const Unit& u, int q) const { return (u.a0 + (unsigned)q) * lda; }
};
struct QkvSched {
    static constexpr bool GATHER = false;
    int G, c; unsigned lda; const char* Bbase; unsigned ldb;
    __device__ __forceinline__ bool next(int i, Unit& u) const {
        const int L = i * G + c; int pm, pn;
        if (L < 768) static_map(L, 64, 12, pm, pn);
        else if (L < 832) { const int l2 = L - 768; pm = 64 + (l2 & 7); pn = 4 + (l2 >> 3); }
        else return false;
        u.a0 = (unsigned)pm * 256u; u.B = Bbase + (size_t)pn * 256u * ldb; u.p0 = pm; u.p1 = pn; u.p2 = 0; return true;
    }
    __device__ __forceinline__ unsigned aoff(const Unit& u, int q) const { return (u.a0 + (unsigned)q) * lda; }
};
struct BatchSched {
    static constexpr bool GATHER = false;
    int nb, nM, nN, G, c; unsigned lda; const char* Bbase; unsigned ldb; int N;
    __device__ __forceinline__ bool next(int i, Unit& u) const {
        const int per = nM * nN; int L;
        if ((G & 7) == 0 && (nb & 7) == 0) {
            const int nx = (nb >> 3) * per, li = i * (G >> 3) + (c >> 3); if (li >= nx) return false;
            L = (c & 7) * nx + li;
        } else { L = i * G + c; if (L >= nb * per) return false; }
        const int g = L / per, rem = L % per, pm = rem / nN, pn = rem % nN;
        u.a0 = (unsigned)(g * S5RP + pm * 256); u.B = Bbase + ((size_t)g * N + (size_t)pn * 256u) * ldb; u.p0 = g; u.p1 = pm; u.p2 = pn; return true;
    }
    __device__ __forceinline__ unsigned aoff(const Unit& u, int q) const { return (u.a0 + (unsigned)q) * lda; }
};
template <bool GATHER_>
struct MoeSched {
    static constexpr bool GATHER = GATHER_;
    int ntiles, nN, G, c; unsigned lda; const char* Bbase; unsigned ldb; int Ne, pn0, bstep; const LAS unsigned char* tile_e; const int* rowidx;
    __device__ __forceinline__ void xrange(int x, int& tlo, int& nx) const { const int q = ntiles >> 3, r = ntiles & 7; nx = q + (x < r ? 1 : 0); tlo = x * q + (x < r ? x : r); }
    __device__ __forceinline__ bool next(int i, Unit& u) const {
        int tile, pn;
        if ((G & 7) == 0) {
            int tlo, nx; xrange(c & 7, tlo, nx);
            const int li = i * (G >> 3) + (c >> 3); if (li >= nx * nN) return false;
            tile = tlo + li / nN; pn = li % nN;
        } else { const int L = i * G + c; if (L >= ntiles * nN) return false; tile = L / nN; pn = L % nN; }
        const int e = __builtin_amdgcn_readfirstlane((int)tile_e[tile]);
        u.a0 = (unsigned)tile * 256u; u.B = Bbase + ((size_t)e * Ne + (size_t)(pn0 + pn) * (unsigned)bstep) * ldb; u.p0 = tile; u.p1 = pn; u.p2 = e; return true;
    }
    __device__ __forceinline__ unsigned aoff(const Unit& u, int q) const {
        if (GATHER) return (unsigned)rowidx[u.a0 + (unsigned)q] * lda;
        return (u.a0 + (unsigned)q) * lda;
    }
};
}

struct Params {
    const float* in[34];
    float* out;
    unsigned char* ws;
    int ph_lo, ph_hi;
};
enum { I_X = 0, I_C, I_CTX, I_CCTX, I_ADAW, I_ADAB, I_NMG, I_NFG, I_WIN, I_ARE, I_AIM, I_LDT, I_BRE, I_BIM, I_CRE, I_CIM, I_S5D, I_GLUW, I_GLUB, I_CONVW,
       I_HOUT, I_WQKV, I_QG, I_KG, I_RPB, I_NOUT, I_RW, I_RB, I_MG, I_MU, I_MD, I_SG, I_SU, I_SD };

using g8::Unit;
typedef f32x4 Acc[2][2][4][2];

__device__ __forceinline__ u32x4 pack8(const f32x4& a, const f32x4& b) {
    u32x4 w; w.x = pk2(a[0], a[1]); w.y = pk2(a[2], a[3]); w.z = pk2(b[0], b[1]); w.w = pk2(b[2], b[3]); return w;
}

struct EpiWin {
    static constexpr bool PERM = true, HEADP = false, WIDE = false, GUP = false;
    bf16_t* A2; bf16_t* BCV;
    __device__ __forceinline__ void operator()(const Acc& acc, const Unit& u, int wr, int wc, int fr, int fq) const {
#pragma unroll
        for (int ai = 0; ai < 2; ++ai)
#pragma unroll
            for (int m = 0; m < 4; ++m) {
                const int row = u.p0 * 256 + 128 * ai + 64 * wr + 16 * m + fr;
#pragma unroll
                for (int bj = 0; bj < 2; ++bj) {
                    const int col0 = u.p1 * 256 + 128 * bj + 32 * wc + 8 * fq;
                    const u32x4 w = pack8(acc[ai][bj][m][0], acc[ai][bj][m][1]);
                    if (u.p1 < 2) {
                        const int g = col0 >> 4, ci0 = col0 & 15, r = row >> 5, s = row & 31;
                        *(u32x4*)(A2 + ((size_t)(g * S5RP + r) * S5K + s * 16 + ci0)) = w;
                    } else {
                        *(u32x4*)(BCV + ((size_t)row * 1536 + (col0 - 512))) = w;
                    }
                }
            }
    }
};
struct EpiS5F {
    static constexpr bool PERM = false, HEADP = false, WIDE = false, GUP = false;
    float* F;
    __device__ __forceinline__ void operator()(const Acc& acc, const Unit& u, int wr, int wc, int fr, int fq) const {
#pragma unroll
        for (int ai = 0; ai < 2; ++ai)
#pragma unroll
            for (int m = 0; m < 4; ++m) {
                const int row = u.p1 * 256 + 128 * ai + 64 * wr + 16 * m + fr;
                float* rp = F + ((size_t)(u.p0 * S5RP + row) * 256);
#pragma unroll
                for (int bj = 0; bj < 2; ++bj)
#pragma unroll
                    for (int n = 0; n < 2; ++n) *(f32x4*)(rp + 128 * bj + 32 * wc + 16 * n + 4 * fq) = acc[ai][bj][m][n];
            }
    }
};
struct EpiS5Y {
    static constexpr bool PERM = true, HEADP = false, WIDE = false, GUP = false;
    bf16_t* Gb;
    __device__ __forceinline__ void operator()(const Acc& acc, const Unit& u, int wr, int wc, int fr, int fq) const {
#pragma unroll
        for (int ai = 0; ai < 2; ++ai)
#pragma unroll
            for (int m = 0; m < 4; ++m) {
                const int r = u.p1 * 256 + 128 * ai + 64 * wr + 16 * m + fr;
                if (r < S5R) {
#pragma unroll
                    for (int bj = 0; bj < 2; ++bj) {
                        const int col0 = u.p2 * 256 + 128 * bj + 32 * wc + 8 * fq;
                        const int t = col0 >> 4, co0 = col0 & 15;
                        f32x4 a = acc[ai][bj][m][0], b = acc[ai][bj][m][1];
#pragma unroll
                        for (int j = 0; j < 4; ++j) { a[j] = gelu_tanh(a[j]); b[j] = gelu_tanh(b[j]); }
                        *(u32x4*)(Gb + ((size_t)(r * S5T + t) * 512 + u.p0 * 16 + co0)) = pack8(a, b);
                    }
                }
            }
    }
};
struct EpiGlu {
    static constexpr bool PERM = true, HEADP = false, WIDE = false, GUP = false;
    const bf16_t* Gb; const float* bias; bf16_t* Z;
    __device__ __forceinline__ void operator()(const Acc& acc, const Unit& u, int wr, int wc, int fr, int fq) const {
#pragma unroll
        for (int ai = 0; ai < 2; ++ai)
#pragma unroll
            for (int m = 0; m < 4; ++m) {
                const int row = u.p0 * 256 + 128 * ai + 64 * wr + 16 * m + fr;
#pragma unroll
                for (int bj = 0; bj < 2; ++bj) {
                    const int col0 = u.p1 * 256 + 128 * bj + 32 * wc + 8 * fq;
                    const u32x4 gv = *(const u32x4*)(Gb + ((size_t)row * 512 + col0));
                    const f32x4 b0 = *(const f32x4*)(bias + col0), b1 = *(const f32x4*)(bias + col0 + 4);
                    f32x4 a = acc[ai][bj][m][0] + b0, b = acc[ai][bj][m][1] + b1;
                    a[0] = bflo(gv.x) * sigmoidf_(a[0]); a[1] = bfhi(gv.x) * sigmoidf_(a[1]); a[2] = bflo(gv.y) * sigmoidf_(a[2]); a[3] = bfhi(gv.y) * sigmoidf_(a[3]);
                    b[0] = bflo(gv.z) * sigmoidf_(b[0]); b[1] = bfhi(gv.z) * sigmoidf_(b[1]); b[2] = bflo(gv.w) * sigmoidf_(b[2]); b[3] = bfhi(gv.w) * sigmoidf_(b[3]);
                    *(u32x4*)(Z + ((size_t)row * 1024 + col0)) = pack8(a, b);
                }
            }
    }
};
template <bool SRCF32>
struct EpiResid {
    static constexpr bool PERM = true, HEADP = false, WIDE = true, GUP = false;
    const float* xlat; const float* xctx;
    const float* gate;
    bf16_t* XR; float rs;
    __device__ __forceinline__ void operator()(const Acc& acc, const Unit& u, int wr, int wc, int fr, int fq) const {
#pragma unroll
        for (int ai = 0; ai < 2; ++ai)
#pragma unroll
            for (int m = 0; m < 4; ++m) {
                const int row = u.p0 * 256 + 128 * ai + 64 * wr + 16 * m + fr;
                const int b = row < NLAT ? (row >> 11) : 8;
                const int col = u.p1 * 256 + 64 * wc + 16 * fq;
                const float* gp = gate + b * 6144 + col;
                f32x4 xv[4];
                if (SRCF32) {
                    const float* src = (row < NLAT ? xlat + (size_t)row * DM : xctx + (size_t)(row - NLAT) * DM) + col;
#pragma unroll
                    for (int q = 0; q < 4; ++q) xv[q] = *(const f32x4*)(src + 4 * q);
                } else {
                    const u32x4 a = *(const u32x4*)(XR + (size_t)row * DM + col), c = *(const u32x4*)(XR + (size_t)row * DM + col + 8);
                    xv[0] = (f32x4){bflo(a.x), bfhi(a.x), bflo(a.y), bfhi(a.y)}; xv[1] = (f32x4){bflo(a.z), bfhi(a.z), bflo(a.w), bfhi(a.w)};
                    xv[2] = (f32x4){bflo(c.x), bfhi(c.x), bflo(c.y), bfhi(c.y)}; xv[3] = (f32x4){bflo(c.z), bfhi(c.z), bflo(c.w), bfhi(c.w)};
                }
                const f32x4 o0 = xv[0] + *(const f32x4*)(gp) * (acc[ai][0][m][0] * rs), o1 = xv[1] + *(const f32x4*)(gp + 4) * (acc[ai][0][m][1] * rs);
                const f32x4 o2 = xv[2] + *(const f32x4*)(gp + 8) * (acc[ai][1][m][0] * rs), o3 = xv[3] + *(const f32x4*)(gp + 12) * (acc[ai][1][m][1] * rs);
                *(u32x4*)(XR + (size_t)row * DM + col) = pack8(o0, o1); *(u32x4*)(XR + (size_t)row * DM + col + 8) = pack8(o2, o3);
            }
    }
};
struct EpiGU {
    static constexpr bool PERM = false, HEADP = false, WIDE = false, GUP = true;
    bf16_t* ACT;
    __device__ __forceinline__ void operator()(const Acc& acc, const Unit& u, int wr, int wc, int fr, int fq) const {
#pragma unroll
        for (int ai = 0; ai < 2; ++ai)
#pragma unroll
            for (int m = 0; m < 4; ++m) {
                const int slot = u.p0 * 256 + 128 * ai + 64 * wr + 16 * m + fr;
                u32x4 o;
#pragma unroll
                for (int bj = 0; bj < 2; ++bj) {
                    const f32x4 g = acc[ai][bj][m][0], up = acc[ai][bj][m][1];
                    o[2 * bj] = pk2(siluf_(g[0]) * up[0], siluf_(g[1]) * up[1]); o[2 * bj + 1] = pk2(siluf_(g[2]) * up[2], siluf_(g[3]) * up[3]);
                }
                *(u32x4*)(ACT + ((size_t)slot * EDIM + u.p1 * 128 + 32 * wc + 8 * fq)) = o;
            }
    }
};
__device__ __forceinline__ float fp8c(float v) { return __builtin_amdgcn_fmed3f(v * 16.f, -440.f, 440.f); }
__device__ __forceinline__ u32x2 pack8_fp8(const f32x4& a, const f32x4& b) {
    int w0 = 0, w1 = 0;
    w0 = __builtin_amdgcn_cvt_pk_fp8_f32(fp8c(a[0]), fp8c(a[1]), w0, false); w0 = __builtin_amdgcn_cvt_pk_fp8_f32(fp8c(a[2]), fp8c(a[3]), w0, true);
    w1 = __builtin_amdgcn_cvt_pk_fp8_f32(fp8c(b[0]), fp8c(b[1]), w1, false); w1 = __builtin_amdgcn_cvt_pk_fp8_f32(fp8c(b[2]), fp8c(b[3]), w1, true);
    return (u32x2){(unsigned)w0, (unsigned)w1};
}
struct EpiDN {
    static constexpr bool PERM = true, HEADP = false, WIDE = true, GUP = false;
    unsigned char* Y;
    __device__ __forceinline__ void operator()(const Acc& acc, const Unit& u, int wr, int wc, int fr, int fq) const {
#pragma unroll
        for (int ai = 0; ai < 2; ++ai)
#pragma unroll
            for (int m = 0; m < 4; ++m) {
                const int slot = u.p0 * 256 + 128 * ai + 64 * wr + 16 * m + fr;
                const u32x2 lo = pack8_fp8(acc[ai][0][m][0], acc[ai][0][m][1]), hi = pack8_fp8(acc[ai][1][m][0], acc[ai][1][m][1]);
                *(u32x4*)(Y + ((size_t)slot * 1024 + u.p1 * 256 + 64 * wc + 16 * fq)) = (u32x4){lo.x, lo.y, hi.x, hi.y};
            }
    }
};
struct EpiQKV {
    static constexpr bool PERM = true, HEADP = true, WIDE = false, GUP = false;
    bf16_t* Q; bf16_t* Kb; bf16_t* VT; const float* qg; const float* kg;
    __device__ __forceinline__ void operator()(const Acc& acc, const Unit& u, int wr, int wc, int fr, int fq) const {
        const int region = u.p1 >> 2;
        if (region < 2) {
            const float* gp = (region == 0 ? qg : kg) + 8 * fq; const float gs = region == 0 ? 0.125f * 1.4426950408889634f : 1.f;
            f32x4 g[2][2];
#pragma unroll
            for (int bj = 0; bj < 2; ++bj)
#pragma unroll
                for (int n = 0; n < 2; ++n) g[bj][n] = *(const f32x4*)(gp + 32 * bj + 4 * n) * gs;
            bf16_t* dst = region == 0 ? Q : Kb;
#pragma unroll
            for (int ai = 0; ai < 2; ++ai)
#pragma unroll
                for (int m = 0; m < 4; ++m) {
                    const int row = u.p0 * 256 + 128 * ai + 64 * wr + 16 * m + fr;
                    float ss = 0.f;
#pragma unroll
                    for (int bj = 0; bj < 2; ++bj)
#pragma unroll
                        for (int n = 0; n < 2; ++n) { const f32x4 v = acc[ai][bj][m][n]; ss += (v[0] * v[0] + v[1] * v[1]) + (v[2] * v[2] + v[3] * v[3]); }
                    ss += __shfl_xor(ss, 16); ss += __shfl_xor(ss, 32);
                    const float rstd = rsqrtf(ss * (1.f / 64.f) + 1e-6f);
                    bf16_t* rp = dst + ((size_t)row * DM + (u.p1 & 3) * 256 + 64 * wc + 8 * fq);
#pragma unroll
                    for (int bj = 0; bj < 2; ++bj) *(u32x4*)(rp + 32 * bj) = pack8(acc[ai][bj][m][0] * rstd * g[bj][0], acc[ai][bj][m][1] * rstd * g[bj][1]);
                }
        } else {
#pragma unroll
            for (int ai = 0; ai < 2; ++ai)
#pragma unroll
                for (int m = 0; m < 4; ++m) {
                    const int row = u.p0 * 256 + 128 * ai + 64 * wr + 16 * m + fr;
                    bf16_t* rp = VT + ((size_t)row * DM + (u.p1 & 3) * 256 + 64 * wc + 8 * fq);
#pragma unroll
                    for (int bj = 0; bj < 2; ++bj) *(u32x4*)(rp + 32 * bj) = pack8(acc[ai][bj][m][0], acc[ai][bj][m][1]);
                }
        }
    }
};

struct Ctx { int tid, lane, wave, G, blk, gw, NGW; LAS unsigned char* lds; };
__device__ __forceinline__ Ctx mkctx(LAS unsigned char* lds, int wave0) {
    Ctx X; X.lane = lane_id_opaque(); X.wave = wave0; X.tid = wave0 * 64 + X.lane; X.G = gridDim.x; X.blk = blockIdx.x;
    X.gw = X.blk * 8 + X.wave; X.NGW = X.G * 8; X.lds = lds; return X;
}

template <int MODE> __device__ __forceinline__ int wrow(int n) { return MODE == 2 ? 256 + n : n; }
template <int MODE>
__device__ __forceinline__ void conv_item(const float* W, int N, bf16_t* WT, int ldk, int k0, int n0, LAS unsigned* T, int lane) {
    (void)T;
    const int nq = lane & 15, kg = lane >> 4;
    const float* wp = W + (size_t)(k0 + 16 * kg) * N + n0 + 4 * nq;
    f32x4 r[16];
#pragma unroll
    for (int i = 0; i < 16; ++i) r[i] = *(const f32x4*)(wp + (size_t)i * N);
#pragma unroll
    for (int j = 0; j < 4; ++j) {
        bf16_t* op = WT + (size_t)wrow<MODE>(n0 + 4 * nq + j) * ldk + k0 + 16 * kg;
        u32x4 lo, hi;
        lo.x = pk2(r[0][j], r[1][j]); lo.y = pk2(r[2][j], r[3][j]); lo.z = pk2(r[4][j], r[5][j]); lo.w = pk2(r[6][j], r[7][j]);
        hi.x = pk2(r[8][j], r[9][j]); hi.y = pk2(r[10][j], r[11][j]); hi.z = pk2(r[12][j], r[13][j]); hi.w = pk2(r[14][j], r[15][j]);
        *(u32x4*)op = lo; *(u32x4*)(op + 8) = hi;
    }
}
__device__ __forceinline__ void conv_mat(const Ctx& X, const float* W, int K, int N, bf16_t* WT, int& rot) {
    LAS unsigned* T = (LAS unsigned*)(X.lds + X.wave * 8192);
    const int nb = N / 64, nitems = (K / 64) * nb;
    int start = X.gw - rot; while (start < 0) start += X.NGW;
    for (int it = start; it < nitems; it += X.NGW) conv_item<0>(W, N, WT, K, (it / nb) * 64, (it % nb) * 64, T, X.lane);
    rot = (rot + nitems) % X.NGW;
}
template <int KIND>
__device__ __forceinline__ void conv_moe_items(const Ctx& X, const Params& p, int l, bf16_t* GU, bf16_t* DN, int it0, int it1, int rank, int nrank) {
    constexpr int PER = KIND == 0 ? 192 : (KIND == 1 ? 128 : 64);
    for (int it = it0 + rank * 8 + X.wave; it < it1; it += nrank * 8) {
        const int e = it / PER, r = it % PER, kind = KIND == 2 ? 2 : (r >> 6), q = r & 63;
        if (kind == 0) {
            const float* W = e < NEXP ? p.in[I_MG] + (size_t)(l * NEXP + e) * 262144 : p.in[I_SG] + (size_t)l * 262144;
            conv_item<1>(W, 256, GU + (size_t)e * 512 * 1024, 1024, (q >> 2) * 64, (q & 3) * 64, nullptr, X.lane);
        } else if (kind == 1) {
            const float* W = e < NEXP ? p.in[I_MU] + (size_t)(l * NEXP + e) * 262144 : p.in[I_SU] + (size_t)l * 262144;
            conv_item<2>(W, 256, GU + (size_t)e * 512 * 1024, 1024, (q >> 2) * 64, (q & 3) * 64, nullptr, X.lane);
        } else {
            const float* W = e < NEXP ? p.in[I_MD] + (size_t)(l * NEXP + e) * 262144 : p.in[I_SD] + (size_t)l * 262144;
            conv_item<0>(W, 1024, DN + (size_t)e * 1024 * 256, 256, (q >> 4) * 64, (q & 15) * 64, nullptr, X.lane);
        }
    }
}
__device__ __forceinline__ int moe_idle_rank(int ntiles, int nN, int G, int blk, int& nidle) {
    if ((G & 7) != 0) { const int nunits = ntiles * nN, nfull = nunits % G; if (nfull == 0) { nidle = G; return blk; } nidle = G - nfull; return blk >= nfull ? blk - nfull : -1; }
    const int B8 = G >> 3, q = ntiles >> 3, r = ntiles & 7;
    int maxc = 0;
    for (int x = 0; x < 8; ++x) { const int n = (q + (x < r ? 1 : 0)) * nN; const int cmax = (n + B8 - 1) / B8; maxc = cmax > maxc ? cmax : maxc; }
    int rank = -1, cnt = 0;
    for (int x = 0; x < 8; ++x) {
        const int n = (q + (x < r ? 1 : 0)) * nN;
        int jfull = n - (maxc - 1) * B8; jfull = jfull < 0 ? 0 : (jfull > B8 ? B8 : jfull);
        if (x == (blk & 7)) { const int j = blk >> 3; if (j >= jfull) rank = cnt + (j - jfull); }
        cnt += B8 - jfull;
    }
    if (cnt == 0) { nidle = G; return blk; }
    nidle = cnt; return rank;
}
__device__ __forceinline__ int idle_rank(int nunits, int G, int blk, int& nidle) {
    const int nfull = nunits % G;
    if (nfull == 0) { nidle = G; return blk; }
    nidle = G - nfull; return blk >= nfull ? blk - nfull : -1;
}

__device__ __forceinline__ void sincos_red(float x, float& s, float& c) {
    const float n = rintf(x * 0.15915494309189535f);
    float r = fmaf(-n, 6.28125f, x); r = fmaf(-n, 1.9353071795864769e-3f, r);
    s = __sinf(r); c = __cosf(r);
}

__device__ __forceinline__ void phase_p0a(const Ctx& X, const Params& p) {
    {
        LAS float* PWs = (LAS float*)(X.lds);
        LAS float* BBs = (LAS float*)(X.lds + 20480);
        LAS float* CCs = (LAS float*)(X.lds + 32768);
        float* KK = (float*)(p.ws + WS_KK); float* PWG = (float*)(p.ws + WS_PW); float* BBG = (float*)(p.ws + WS_BB);
        for (int item = X.blk; item < 256; item += X.G) {
            const int g = item >> 3, d = (item >> 2) & 1, lq = item & 3, gd = d * 32 + g;
            const float dt = expf(p.in[I_LDT][gd]);
            __syncthreads();
            for (int idx = X.tid; idx < 33 * 64; idx += 512) {
                const int j = idx >> 6, pp = idx & 63;
                const float lre = fminf(p.in[I_ARE][gd * 64 + pp], -1e-4f), lim = p.in[I_AIM][gd * 64 + pp];
                const float mag = expf(lre * dt * (float)j); float sn, cs; sincos_red(lim * dt * (float)j, sn, cs);
                PWs[2 * idx] = mag * cs; PWs[2 * idx + 1] = mag * sn;
            }
            for (int idx = X.tid; idx < 1024; idx += 512) {
                const int pp = idx >> 4;
                const float lre = fminf(p.in[I_ARE][gd * 64 + pp], -1e-4f), lim = p.in[I_AIM][gd * 64 + pp];
                const float mag = expf(lre * dt); float sn, cs; sincos_red(lim * dt, sn, cs);
                const float nr = mag * cs - 1.f, ni = mag * sn, den = 1.f / (lre * lre + lim * lim);
                const float cr = (nr * lre + ni * lim) * den, ci = (ni * lre - nr * lim) * den;
                const float br = p.in[I_BRE][(size_t)gd * 1024 + idx], bi = p.in[I_BIM][(size_t)gd * 1024 + idx];
                BBs[2 * idx] = cr * br - ci * bi; BBs[2 * idx + 1] = cr * bi + ci * br;
            }
            for (int idx = X.tid; idx < 1024; idx += 512) { CCs[2 * idx] = p.in[I_CRE][(size_t)gd * 1024 + idx]; CCs[2 * idx + 1] = p.in[I_CIM][(size_t)gd * 1024 + idx]; }
            __syncthreads();
#pragma unroll
            for (int i = 0; i < 4; ++i) {
                const int e = X.tid + 512 * i, lag = 8 * lq + (e >> 8), co = (e >> 4) & 15, ci = e & 15;
                float sum = 0.f;
                for (int pp = 0; pp < 64; ++pp) {
                    const float pr = PWs[2 * (lag * 64 + pp)], pi = PWs[2 * (lag * 64 + pp) + 1];
                    const float br = BBs[2 * (pp * 16 + ci)], bi = BBs[2 * (pp * 16 + ci) + 1];
                    const float tr = pr * br - pi * bi, ti = pr * bi + pi * br;
                    sum += CCs[2 * (co * 64 + pp)] * tr - CCs[2 * (co * 64 + pp) + 1] * ti;
                }
                KK[(size_t)((g * 2 + d) * 32 + lag) * 256 + co * 16 + ci] = sum;
            }
            if (lq == 0) {
                for (int idx = X.tid; idx < 33 * 64 * 2; idx += 512) PWG[(size_t)(g * 2 + d) * 33 * 64 * 2 + idx] = PWs[idx];
                for (int idx = X.tid; idx < 2048; idx += 512) BBG[(size_t)(g * 2 + d) * 2048 + idx] = BBs[idx];
            }
        }
        __syncthreads();
    }
    {
        LAS float* condS = (LAS float*)(X.lds + 65536);
        for (int i = X.tid; i < 9 * 1024; i += 512) { const int r = i >> 10, k = i & 1023; const float v = r < 8 ? p.in[I_C][r * 1024 + k] : p.in[I_CCTX][k]; condS[i] = siluf_(v); }
        __syncthreads();
        float* ADAP = (float*)(p.ws + WS_ADAP);
        for (int it = X.gw; it < 3072; it += X.NGW) {
            const int l = it / 1536, rem = it % 1536, cg = rem >> 4, kq = rem & 15, col = cg * 64 + X.lane;
            const float* wp = p.in[I_ADAW] + (size_t)l * 1024 * 6144 + (size_t)(kq * 64) * 6144 + col;
            float a0 = 0, a1 = 0, a2 = 0, a3 = 0, a4 = 0, a5 = 0, a6 = 0, a7 = 0, a8 = 0;
            float wv[64];
#pragma unroll
            for (int kk = 0; kk < 64; ++kk) wv[kk] = wp[(size_t)kk * 6144];
#pragma unroll
            for (int kk = 0; kk < 64; ++kk) {
                const float w = wv[kk]; const LAS float* cp = condS + kq * 64 + kk;
                a0 += cp[0] * w; a1 += cp[1024] * w; a2 += cp[2048] * w; a3 += cp[3072] * w; a4 += cp[4096] * w; a5 += cp[5120] * w; a6 += cp[6144] * w; a7 += cp[7168] * w; a8 += cp[8192] * w;
            }
            float* op = ADAP + (size_t)((kq * 2 + l) * 9) * 6144 + col;
            op[0] = a0; op[6144] = a1; op[2 * 6144] = a2; op[3 * 6144] = a3; op[4 * 6144] = a4; op[5 * 6144] = a5; op[6 * 6144] = a6; op[7 * 6144] = a7; op[8 * 6144] = a8;
        }
        __syncthreads();
    }
    {
        int rot = 0;
        conv_mat(X, p.in[I_WIN], 1024, 2048, (bf16_t*)(p.ws + WS_WIN), rot);
        conv_mat(X, p.in[I_GLUW], 512, 512, (bf16_t*)(p.ws + WS_GLU), rot);
        conv_mat(X, p.in[I_HOUT], 1024, 1024, (bf16_t*)(p.ws + WS_HOUT), rot);
        conv_mat(X, p.in[I_WQKV], 1024, 3072, (bf16_t*)(p.ws + WS_QKV), rot);
        conv_mat(X, p.in[I_NOUT], 1024, 1024, (bf16_t*)(p.ws + WS_NOUT), rot);
        conv_mat(X, p.in[I_RW], 1024, 64, (bf16_t*)(p.ws + WS_ROUT), rot);
        conv_mat(X, p.in[I_RW] + 65536, 1024, 64, (bf16_t*)(p.ws + WS_ROUT) + 256 * 1024, rot);
        for (int i = X.gw * 64 + X.lane; i < 2 * 192 * 128; i += X.NGW * 64) {
            const int l = i / (192 * 128), r = i % (192 * 128);
            *(u32x4*)((bf16_t*)(p.ws + WS_ROUT) + (size_t)l * 256 * 1024 + 64 * 1024 + (size_t)r * 8) = (u32x4){0u, 0u, 0u, 0u};
        }
    }
}

__device__ __forceinline__ void phase_p0b(const Ctx& X, const Params& p) {
    const int gt = X.blk * 512 + X.tid, NT = X.G * 512;
    float* MOD = (float*)(p.ws + WS_MOD); const float* ADAP = (const float*)(p.ws + WS_ADAP);
    for (int idx = gt; idx < 2 * 9 * 6144; idx += NT) {
        const int l = idx / (9 * 6144), col = idx % 6144;
        float s = p.in[I_ADAB][l * 6144 + col];
#pragma unroll
        for (int kq = 0; kq < 16; ++kq) s += ADAP[(size_t)kq * 110592 + idx];
        MOD[idx] = s;
    }
    const float* KK = (const float*)(p.ws + WS_KK); const float* PWG = (const float*)(p.ws + WS_PW); const float* BBG = (const float*)(p.ws + WS_BB);
    bf16_t* ME = (bf16_t*)(p.ws + WS_ME); bf16_t* WF = (bf16_t*)(p.ws + WS_WF);
    for (int ch = gt; ch < 32 * 512 * 96; ch += NT) {
        const int kc = ch % 96, n = (ch / 96) & 511, g = ch / (96 * 512), t = n >> 4, co = n & 15, k0 = kc * 8;
        float v[8];
        if (k0 < 512) {
            const int s_ = k0 >> 4, ci0 = k0 & 15;
            const int lf = t - s_, lb = s_ - t; const float mf = lf >= 0 ? 1.f : 0.f, mb = lb >= 0 ? 1.f : 0.f;
            const float* kf = KK + (size_t)((g * 2 + 0) * 32 + (lf >= 0 ? lf : 0)) * 256 + co * 16 + ci0;
            const float* kb = KK + (size_t)((g * 2 + 1) * 32 + (lb >= 0 ? lb : 0)) * 256 + co * 16 + ci0;
            const f32x4 f0 = *(const f32x4*)kf, f1 = *(const f32x4*)(kf + 4), b0 = *(const f32x4*)kb, b1 = *(const f32x4*)(kb + 4);
            const float dsk = p.in[I_S5D][16 * g + co];
#pragma unroll
            for (int j = 0; j < 4; ++j) {
                v[j] = f0[j] * mf + b0[j] * mb + ((s_ == t && ci0 + j == co) ? dsk : 0.f);
                v[4 + j] = f1[j] * mf + b1[j] * mb + ((s_ == t && ci0 + 4 + j == co) ? dsk : 0.f);
            }
        } else {
            const int kk = k0 - 512, d = kk >> 7, ri = (kk >> 6) & 1, p0 = kk & 63, jj = d == 0 ? t + 1 : 32 - t;
            const float* pw = PWG + ((size_t)((g * 2 + d) * 33 + jj) * 64 + p0) * 2;
            const float* crp = p.in[I_CRE] + (size_t)((d * 32 + g) * 16 + co) * 64 + p0; const float* cip = p.in[I_CIM] + (size_t)((d * 32 + g) * 16 + co) * 64 + p0;
            f32x4 pq[4];
#pragma unroll
            for (int q = 0; q < 4; ++q) pq[q] = *(const f32x4*)(pw + 4 * q);
            const f32x4 cr0 = *(const f32x4*)crp, cr1 = *(const f32x4*)(crp + 4), ci0v = *(const f32x4*)cip, ci1v = *(const f32x4*)(cip + 4);
#pragma unroll
            for (int j = 0; j < 8; ++j) {
                const float pr = pq[j >> 1][(j & 1) * 2], pi = pq[j >> 1][(j & 1) * 2 + 1];
                const float cr = j < 4 ? cr0[j & 3] : cr1[j & 3], cim = j < 4 ? ci0v[j & 3] : ci1v[j & 3];
                const float zr = cr * pr - cim * pi, zi = cr * pi + cim * pr;
                v[j] = ri == 0 ? zr : -zi;
            }
        }
        u32x4 w; w.x = pk2(v[0], v[1]); w.y = pk2(v[2], v[3]); w.z = pk2(v[4], v[5]); w.w = pk2(v[6], v[7]);
        *(u32x4*)(ME + ((size_t)(g * 512 + n)) * 768 + k0) = w;
    }
    for (int ch = gt; ch < 32 * 256 * 64; ch += NT) {
        const int kc = ch & 63, n = (ch >> 6) & 255, g = ch >> 14, d = n >> 7, ri = (n >> 6) & 1, pp = n & 63, k0 = kc * 8, s_ = k0 >> 4, ci0 = k0 & 15;
        const int jj = d == 0 ? 31 - s_ : s_;
        const float pr = PWG[((size_t)((g * 2 + d) * 33 + jj) * 64 + pp) * 2], pi = PWG[((size_t)((g * 2 + d) * 33 + jj) * 64 + pp) * 2 + 1];
        const float* bb = BBG + ((size_t)(g * 2 + d) * 1024 + pp * 16 + ci0) * 2;
        f32x4 bq[4];
#pragma unroll
        for (int q = 0; q < 4; ++q) bq[q] = *(const f32x4*)(bb + 4 * q);
        float v[8];
#pragma unroll
        for (int j = 0; j < 8; ++j) {
            const float br = bq[j >> 1][(j & 1) * 2], bi = bq[j >> 1][(j & 1) * 2 + 1];
            v[j] = ri == 0 ? (pr * br - pi * bi) : (pr * bi + pi * br);
        }
        u32x4 w; w.x = pk2(v[0], v[1]); w.y = pk2(v[2], v[3]); w.z = pk2(v[4], v[5]); w.w = pk2(v[6], v[7]);
        *(u32x4*)(WF + ((size_t)(g * 256 + n)) * 512 + k0) = w;
    }
}

template <int SRC>
__device__ __forceinline__ void norm_load(const Params& p, int row, int lane, f32x4 (&v)[4]) {
    if (SRC == 0) {
        const float* src = (row < NLAT ? p.in[I_X] + (size_t)row * DM : p.in[I_CTX] + (size_t)(row - NLAT) * DM) + 8 * lane;
        v[0] = *(const f32x4*)(src); v[1] = *(const f32x4*)(src + 4); v[2] = *(const f32x4*)(src + 512); v[3] = *(const f32x4*)(src + 516);
    } else {
        const bf16_t* src = (const bf16_t*)(p.ws + WS_XR) + (size_t)row * DM + 8 * lane;
        const u32x4 a = *(const u32x4*)(src), c = *(const u32x4*)(src + 512);
        v[0] = (f32x4){bflo(a.x), bfhi(a.x), bflo(a.y), bfhi(a.y)}; v[1] = (f32x4){bflo(a.z), bfhi(a.z), bflo(a.w), bfhi(a.w)};
        v[2] = (f32x4){bflo(c.x), bfhi(c.x), bflo(c.y), bfhi(c.y)}; v[3] = (f32x4){bflo(c.z), bfhi(c.z), bflo(c.w), bfhi(c.w)};
    }
}
template <int SRC>
__device__ __forceinline__ void phase_norm(const Ctx& X, const Params& p, int l, int ffn, int ntok) {
    const float* gain = (ffn ? p.in[I_NFG] : p.in[I_NMG]) + l * 1024;
    const float* mod = (const float*)(p.ws + WS_MOD) + (size_t)l * 9 * 6144;
    const int shi = ffn ? 3 : 0, sci = ffn ? 4 : 1;
    bf16_t* XA = (bf16_t*)(p.ws + WS_XA);
    const int rpw = (ntok + X.NGW - 1) / X.NGW, r0 = X.gw * rpw, r1 = (r0 + rpw) < ntok ? (r0 + rpw) : ntok;
    int curb = -1; f32x4 gm[4], sh[4];
    f32x4 vn[4];
    if (r0 < r1) norm_load<SRC>(p, r0, X.lane, vn);
    for (int row = r0; row < r1; ++row) {
        const int b = row < NLAT ? (row >> 11) : 8;
        if (b != curb) {
            curb = b;
#pragma unroll
            for (int j = 0; j < 4; ++j) {
                const int c = 8 * X.lane + 512 * (j >> 1) + 4 * (j & 1);
                const f32x4 g4 = *(const f32x4*)(gain + c), sc4 = *(const f32x4*)(mod + b * 6144 + sci * 1024 + c);
                sh[j] = *(const f32x4*)(mod + b * 6144 + shi * 1024 + c); gm[j] = g4 * (sc4 + 1.f);
            }
        }
        f32x4 v[4]; float ss = 0.f;
#pragma unroll
        for (int j = 0; j < 4; ++j) v[j] = vn[j];
        if (row + 1 < r1) norm_load<SRC>(p, row + 1, X.lane, vn);
#pragma unroll
        for (int j = 0; j < 4; ++j) ss += (v[j][0] * v[j][0] + v[j][1] * v[j][1]) + (v[j][2] * v[j][2] + v[j][3] * v[j][3]);
        const float rstd = rsqrtf(wave_sum(ss) * (1.f / 1024.f) + 1e-6f);
        const f32x4 o0 = v[0] * rstd * gm[0] + sh[0], o1 = v[1] * rstd * gm[1] + sh[1], o2 = v[2] * rstd * gm[2] + sh[2], o3 = v[3] * rstd * gm[3] + sh[3];
        *(u32x4*)(XA + (size_t)row * DM + 8 * X.lane) = pack8(o0, o1); *(u32x4*)(XA + (size_t)row * DM + 512 + 8 * X.lane) = pack8(o2, o3);
    }
}

__device__ __forceinline__ void phase_scan_conv(const Ctx& X, const Params& p) {
    const float* F = (const float*)(p.ws + WS_F); bf16_t* A2 = (bf16_t*)(p.ws + WS_A2); const float* PWG = (const float*)(p.ws + WS_PW);
    for (int gid = X.blk * 512 + X.tid; gid < 32768; gid += X.G * 512) {
        const int pp = gid & 63, d = (gid >> 6) & 1, g = (gid >> 7) & 31, b = gid >> 12;
        const float ar = PWG[((size_t)((g * 2 + d) * 33 + 32) * 64 + pp) * 2], ai = PWG[((size_t)((g * 2 + d) * 33 + 32) * 64 + pp) * 2 + 1];
        float sr = 0.f, si = 0.f;
        for (int s8 = 0; s8 < 72; s8 += 8) {
            float fr[8], fi[8]; size_t ro[8];
#pragma unroll
            for (int q = 0; q < 8; ++q) {
                const int step = s8 + q; int r;
                if (d == 0) r = step < 8 ? 512 + b * 8 + step : b * 64 + (step - 8);
                else        r = step < 8 ? 512 + b * 8 + (7 - step) : b * 64 + (71 - step);
                ro[q] = (size_t)(g * S5RP + r);
                fr[q] = F[ro[q] * 256 + d * 128 + pp]; fi[q] = F[ro[q] * 256 + d * 128 + 64 + pp];
            }
#pragma unroll
            for (int q = 0; q < 8; ++q) {
                A2[ro[q] * S5K + 512 + d * 128 + pp] = (bf16_t)f2bf(sr); A2[ro[q] * S5K + 512 + d * 128 + 64 + pp] = (bf16_t)f2bf(si);
                const float nr = ar * sr - ai * si + fr[q], ni = ar * si + ai * sr + fi[q];
                sr = nr; si = ni;
            }
        }
    }
    const bf16_t* BCV = (const bf16_t*)(p.ws + WS_BCV); bf16_t* Z = (bf16_t*)(p.ws + WS_Z); const float* cw = p.in[I_CONVW];
    for (int it = X.blk * 512 + X.tid; it < NTOK * 64; it += X.G * 512) {
        const int tok = it >> 6, c0 = (it & 63) * 8;
        const int pos = tok < NLAT ? (tok & 2047) : ((tok - NLAT) & 255), len = tok < NLAT ? 2048 : 256;
        const bf16_t* base = BCV + (size_t)tok * 1536;
        const u32x4 bg = *(const u32x4*)(base + c0), cg1 = *(const u32x4*)(base + 512 + c0), v1 = *(const u32x4*)(base + 1024 + c0);
        u32x4 cg0 = (u32x4){0u, 0u, 0u, 0u}, v0 = cg0, cg2 = cg0, v2 = cg0;
        if (pos > 0) { cg0 = *(const u32x4*)(base - 1536 + 512 + c0); v0 = *(const u32x4*)(base - 1536 + 1024 + c0); }
        if (pos < len - 1) { cg2 = *(const u32x4*)(base + 1536 + 512 + c0); v2 = *(const u32x4*)(base + 1536 + 1024 + c0); }
        float o[8];
#pragma unroll
        for (int j = 0; j < 4; ++j) {
            const float w0a = cw[c0 + 2 * j], w1a = cw[512 + c0 + 2 * j], w2a = cw[1024 + c0 + 2 * j];
            const float w0b = cw[c0 + 2 * j + 1], w1b = cw[512 + c0 + 2 * j + 1], w2b = cw[1024 + c0 + 2 * j + 1];
            o[2 * j] = bflo(bg[j]) * (w0a * bflo(cg0[j]) * bflo(v0[j]) + w1a * bflo(cg1[j]) * bflo(v1[j]) + w2a * bflo(cg2[j]) * bflo(v2[j]));
            o[2 * j + 1] = bfhi(bg[j]) * (w0b * bfhi(cg0[j]) * bfhi(v0[j]) + w1b * bfhi(cg1[j]) * bfhi(v1[j]) + w2b * bfhi(cg2[j]) * bfhi(v2[j]));
        }
        u32x4 w; w.x = pk2(o[0], o[1]); w.y = pk2(o[2], o[3]); w.z = pk2(o[4], o[5]); w.w = pk2(o[6], o[7]);
        *(u32x4*)(Z + (size_t)tok * 1024 + 512 + c0) = w;
    }
}

constexpr int RR_MAXT = 96, RR_KC = 256, RR_PITCH = RR_KC * 2 + 16;
constexpr int RR_A = 0, RR_B = RR_MAXT * RR_PITCH, RR_LG = RR_B + 64 * RR_PITCH;
__device__ __forceinline__ void phase_route(const Ctx& X, const Params& p, int l, int ntok) {
    LAS int* cnt = (LAS int*)(X.lds + MISC_OFF + M_CNT);
    if (X.tid < NEXP1) cnt[X.tid] = 0;
    const bf16_t* XA = (const bf16_t*)(p.ws + WS_XA); const bf16_t* RT = (const bf16_t*)(p.ws + WS_ROUT) + (size_t)l * 256 * 1024;
    int* toke = (int*)(p.ws + WS_TOKE); float* tokw = (float*)(p.ws + WS_TOKW); int* tokp = (int*)(p.ws + WS_TOKP);
    const float rb = p.in[I_RB][l * 64 + X.lane];
    const int tpb = (ntok + X.G - 1) / X.G, t0 = X.blk * tpb, t1 = (t0 + tpb) < ntok ? (t0 + tpb) : ntok, nrow = t1 - t0;
    const int lane = X.lane, grp = lane >> 3, fr = lane & 15, fq = lane >> 4;
    const int nt_ = X.wave & 3, mh = X.wave >> 2;
    f32x4 acc[3];
#pragma unroll
    for (int m = 0; m < 3; ++m) acc[m] = (f32x4){0.f, 0.f, 0.f, 0.f};
    for (int kc = 0; kc < 1024; kc += RR_KC) {
        __syncthreads();
        {
            u32x4 va[6], vb[4];
#pragma unroll
            for (int q = 0; q < 6; ++q) { const int i = X.tid + 512 * q, r = i >> 5, c = i & 31; const int rr = r < nrow ? r : 0;
                va[q] = *(const u32x4*)(XA + (size_t)(t0 + rr) * DM + kc + 8 * c); if (r >= nrow) va[q] = (u32x4){0u, 0u, 0u, 0u}; }
#pragma unroll
            for (int q = 0; q < 4; ++q) { const int i = X.tid + 512 * q, r = i >> 5, c = i & 31; vb[q] = *(const u32x4*)(RT + (size_t)r * 1024 + kc + 8 * c); }
#pragma unroll
            for (int q = 0; q < 6; ++q) { const int i = X.tid + 512 * q, r = i >> 5, c = i & 31; *(LAS u32x4*)(X.lds + RR_A + r * RR_PITCH + 16 * c) = va[q]; }
#pragma unroll
            for (int q = 0; q < 4; ++q) { const int i = X.tid + 512 * q, r = i >> 5, c = i & 31; *(LAS u32x4*)(X.lds + RR_B + r * RR_PITCH + 16 * c) = vb[q]; }
        }
        __syncthreads();
#pragma unroll
        for (int ks = 0; ks < RR_KC / 32; ++ks) {
            const bf16x8 bfr = *(const LAS bf16x8*)(X.lds + RR_B + (16 * nt_ + fr) * RR_PITCH + 64 * ks + 16 * fq);
#pragma unroll
            for (int m = 0; m < 3; ++m) {
                const bf16x8 afr = *(const LAS bf16x8*)(X.lds + RR_A + (16 * (3 * mh + m) + fr) * RR_PITCH + 64 * ks + 16 * fq);
                acc[m] = __builtin_amdgcn_mfma_f32_16x16x32_bf16(afr, bfr, acc[m], 0, 0, 0);
            }
        }
    }
    LAS float* LG = (LAS float*)(X.lds + RR_LG);
#pragma unroll
    for (int m = 0; m < 3; ++m)
#pragma unroll
        for (int j = 0; j < 4; ++j) LG[(16 * (3 * mh + m) + 4 * fq + j) * 64 + 16 * nt_ + fr] = acc[m][j];
    __syncthreads();
    for (int tok = t0 + X.wave; tok < t1; tok += 8) {
        const float score = sigmoidf_(LG[(tok - t0) * 64 + lane]);
        const float sel = score + rb;
        int rk = 0;
#pragma unroll
        for (int x = 1; x < 8; ++x) { const float o = __shfl_xor(sel, x); const int ol = lane ^ x; rk += ((o > sel) || (o == sel && ol < lane)) ? 1 : 0; }
        float gs = rk < 2 ? sel : 0.f;
        gs += __shfl_xor(gs, 1); gs += __shfl_xor(gs, 2); gs += __shfl_xor(gs, 4);
        int grk = 0;
#pragma unroll
        for (int x = 1; x < 8; ++x) { const float o = __shfl_xor(gs, 8 * x); const int og = grp ^ x; grk += ((o > gs) || (o == gs && og < grp)) ? 1 : 0; }
        const float msel = grk < 4 ? sel : -__builtin_inff();
        int rank = 0;
#pragma unroll
        for (int j = 0; j < 64; ++j) { const float sj = __builtin_bit_cast(float, __builtin_amdgcn_readlane(__builtin_bit_cast(int, msel), j)); rank += ((sj > msel) || (sj == msel && j < lane)) ? 1 : 0; }
        const bool chosen = rank < 8;
        const float wsum = wave_sum(chosen ? score : 0.f);
        if (chosen) {
            const int lpos = __hip_atomic_fetch_add(cnt + lane, 1, __ATOMIC_RELAXED, __HIP_MEMORY_SCOPE_WORKGROUP);
            toke[(size_t)tok * 8 + rank] = lane; tokw[(size_t)tok * 8 + rank] = score / wsum * 2.5f; tokp[(size_t)tok * 8 + rank] = lpos;
        }
    }
    __syncthreads();
    int* cntblk = (int*)(p.ws + WS_CNTBLK);
    if (X.tid < NEXP1) cntblk[X.blk * NEXP1 + X.tid] = X.tid < NEXP ? cnt[X.tid] : 0;
}

__device__ __forceinline__ void phase_slots(const Ctx& X, const Params& p, int ntok) {
    LAS int* part = (LAS int*)(X.lds + MISC_OFF + M_PART);
    LAS int* ptot = (LAS int*)(X.lds);
    LAS int* pbb = (LAS int*)(X.lds + 4096);
    LAS int* base = (LAS int*)(X.lds + MISC_OFF + M_BASE);
    LAS int* bbase = (LAS int*)(X.lds + MISC_OFF + M_BBASE);
    LAS int* tot = (LAS int*)(X.lds + 8192);
    LAS int* ntl = (LAS int*)(X.lds + MISC_OFF + M_NT);
    (void)part;
    const int* cntblk = (const int*)(p.ws + WS_CNTBLK);
    {
        const int e = X.tid & 127, pt = X.tid >> 7; int s = 0, sb = 0;
        if (e < NEXP) { const int b0 = (X.G * pt) / 4, b1 = (X.G * (pt + 1)) / 4;
            for (int b = b0; b < b1; ++b) { const int c = cntblk[b * NEXP1 + e]; s += c; sb += (b < X.blk) ? c : 0; } }
        ptot[pt * 128 + e] = s; pbb[pt * 128 + e] = sb;
    }
    __syncthreads();
    if (X.tid < NEXP) { tot[X.tid] = ptot[X.tid] + ptot[128 + X.tid] + ptot[256 + X.tid] + ptot[384 + X.tid]; bbase[X.tid] = pbb[X.tid] + pbb[128 + X.tid] + pbb[256 + X.tid] + pbb[384 + X.tid]; }
    __syncthreads();
    if (X.tid == 0) { int acc = 0; for (int e = 0; e < NEXP; ++e) { base[e] = acc; acc += (tot[e] + 255) & ~255; } base[NEXP] = acc; base[NEXP1] = acc + ntok; ntl[0] = (acc + ntok) >> 8; }
    __syncthreads();
    int* rowidx = (int*)(p.ws + WS_ROWIDX); int* tokslot = (int*)(p.ws + WS_YROW);
    const int* toke = (const int*)(p.ws + WS_TOKE); const int* tokp = (const int*)(p.ws + WS_TOKP);
    const int tpb = (ntok + X.G - 1) / X.G, t0 = X.blk * tpb, t1 = (t0 + tpb) < ntok ? (t0 + tpb) : ntok;
    for (int i = t0 * 8 + X.tid; i < t1 * 8; i += 512) {
        const int e = toke[i]; const int slot = base[e] + bbase[e] + tokp[i];
        rowidx[slot] = i >> 3; tokslot[(i >> 3) * 9 + (i & 7)] = slot;
    }
    const int sbase = base[NEXP];
    for (int tok = X.blk * 512 + X.tid; tok < ntok; tok += X.G * 512) { rowidx[sbase + tok] = tok; tokslot[tok * 9 + 8] = sbase + tok; }
    for (int e = X.blk; e < NEXP; e += X.G)
        for (int s = base[e] + tot[e] + X.tid; s < base[e + 1]; s += 512) rowidx[s] = 0;
    if (X.blk == 0) {
        int* TAB = (int*)(p.ws + WS_TAB);
        if (X.tid == 0) TAB[128] = ntl[0];
        for (int t = X.tid; t < ntl[0]; t += 512) { int e = NEXP; const int s = t * 256; for (int k = 0; k < NEXP; ++k) if (s >= base[k] && s < base[k + 1]) e = k; TAB[256 + t] = e; }
    }
}
__device__ __forceinline__ int load_tiles(const Ctx& X, const Params& p) {
    const int* TAB = (const int*)(p.ws + WS_TAB);
    LAS unsigned char* te = X.lds + MISC_OFF + M_TILE;
    const int nt = TAB[128];
    for (int t = X.tid; t < nt; t += 512) te[t] = (unsigned char)TAB[256 + t];
    __syncthreads();
    return __builtin_amdgcn_readfirstlane(nt);
}

template <bool NEXTNORM>
__device__ __forceinline__ void phase_combine(const Ctx& X, const Params& p, int l, int ntok, bool final_out, float rs) {
    const unsigned char* Y = (const unsigned char*)(p.ws + WS_Y); bf16_t* XR = (bf16_t*)(p.ws + WS_XR);
    const int* tokslot = (const int*)(p.ws + WS_YROW); const float* tokw = (const float*)(p.ws + WS_TOKW);
    const float* gate = (const float*)(p.ws + WS_MOD) + (size_t)l * 9 * 6144 + 5 * 1024;
    const float* gain = p.in[I_NMG] + (l + 1) * 1024; const float* modn = (const float*)(p.ws + WS_MOD) + (size_t)(l + 1) * 9 * 6144;
    bf16_t* XN = (bf16_t*)(p.ws + WS_ACT);
    for (int tok = X.gw; tok < ntok; tok += X.NGW) {
        const int b = tok < NLAT ? (tok >> 11) : 8, c = 16 * X.lane;
        float s[16];
#pragma unroll
        for (int q = 0; q < 16; ++q) s[q] = 0.f;
#pragma unroll
        for (int j = 0; j < 9; ++j) {
            const int slot = __builtin_amdgcn_readfirstlane(tokslot[tok * 9 + j]);
            const float w = j < 8 ? __builtin_bit_cast(float, __builtin_amdgcn_readfirstlane(__builtin_bit_cast(int, tokw[tok * 8 + (j & 7)]))) : 1.f;
            const u32x4 y = *(const u32x4*)(Y + ((size_t)slot * 1024 + c));
#pragma unroll
            for (int q = 0; q < 4; ++q) {
                const f32x2 lo = __builtin_amdgcn_cvt_pk_f32_fp8((int)y[q], false), hi = __builtin_amdgcn_cvt_pk_f32_fp8((int)y[q], true);
                s[4 * q] += w * lo.x; s[4 * q + 1] += w * lo.y; s[4 * q + 2] += w * hi.x; s[4 * q + 3] += w * hi.y;
            }
        }
        const float* gp = gate + b * 6144 + c; bf16_t* xp = XR + (size_t)tok * DM + c;
        const float sc = rs * (1.f / 16.f);
        const u32x4 xa = *(const u32x4*)xp, xc = *(const u32x4*)(xp + 8);
        f32x4 o[4]; float ss = 0.f;
        o[0] = (f32x4){bflo(xa.x), bfhi(xa.x), bflo(xa.y), bfhi(xa.y)}; o[1] = (f32x4){bflo(xa.z), bfhi(xa.z), bflo(xa.w), bfhi(xa.w)};
        o[2] = (f32x4){bflo(xc.x), bfhi(xc.x), bflo(xc.y), bfhi(xc.y)}; o[3] = (f32x4){bflo(xc.z), bfhi(xc.z), bflo(xc.w), bfhi(xc.w)};
#pragma unroll
        for (int q = 0; q < 4; ++q) {
            const f32x4 g = *(const f32x4*)(gp + 4 * q) * sc;
            o[q] = o[q] + g * (f32x4){s[4 * q], s[4 * q + 1], s[4 * q + 2], s[4 * q + 3]};
            if (final_out) *(f32x4*)(p.out + (size_t)tok * DM + c + 4 * q) = o[q];
            ss += (o[q][0] * o[q][0] + o[q][1] * o[q][1]) + (o[q][2] * o[q][2] + o[q][3] * o[q][3]);
        }
        if (!final_out) { *(u32x4*)xp = pack8(o[0], o[1]); *(u32x4*)(xp + 8) = pack8(o[2], o[3]); }
        if (NEXTNORM) {
            const float rstd = rsqrtf(wave_sum(ss) * (1.f / 1024.f) + 1e-6f);
            u32x4 w0, w1;
#pragma unroll
            for (int q = 0; q < 4; ++q) {
                const f32x4 g4 = *(const f32x4*)(gain + c + 4 * q), sc4 = *(const f32x4*)(modn + b * 6144 + 1024 + c + 4 * q), sh4 = *(const f32x4*)(modn + b * 6144 + c + 4 * q);
                const f32x4 v = o[q] * rstd * (g4 * (sc4 + 1.f)) + sh4;
                if (q < 2) { w0[2 * q] = pk2(v[0], v[1]); w0[2 * q + 1] = pk2(v[2], v[3]); } else { w1[2 * (q - 2)] = pk2(v[0], v[1]); w1[2 * (q - 2) + 1] = pk2(v[2], v[3]); }
            }
            *(u32x4*)(XN + (size_t)tok * DM + c) = w0; *(u32x4*)(XN + (size_t)tok * DM + c + 8) = w1;
        }
    }
}

constexpr int AT_KB = 8192, AT_VB = 64 * 136, AT_K0 = 0, AT_V0 = 4 * AT_KB, AT_BIAS = 4 * AT_KB + 4 * AT_VB + 256, AT_BPAD = 48;
#define ATT_TILE(kb_, vb_, t0_, LAT_, brow4_, rpen_) do { \
    f32x16 sa; \
    _Pragma("unroll") for (int i = 0; i < 16; ++i) sa[i] = 0.f; \
    _Pragma("unroll") for (int s = 0; s < 4; ++s) { \
        const bf16x8 kf = *(const LAS bf16x8*)((kb_) + ((t0_) + l31) * 128 + (((2 * s + hh) ^ (l31 & 7)) << 4)); \
        sa = __builtin_amdgcn_mfma_f32_32x32x16_bf16(kf, qf[s], sa, 0, 0, 0); } \
    float tmax = -1e30f; \
    if (LAT_) { \
        const LAS float* bp = (const LAS float*)((const LAS unsigned char*)biasL + (brow4_)); \
        _Pragma("unroll") for (int i = 0; i < 16; ++i) { sa[i] = (sa[i] + bp[(i & 3) + 8 * (i >> 2)]) + (pen[i] + (rpen_)); tmax = fmaxf(tmax, sa[i]); } \
    } else { \
        _Pragma("unroll") for (int i = 0; i < 16; ++i) tmax = fmaxf(tmax, sa[i]); \
    } \
    tmax = fmaxf(tmax, __shfl_xor(tmax, 32)); \
    if (__any(tmax > mrun)) { \
        const float mnew = fmaxf(mrun, tmax), alpha = __builtin_amdgcn_exp2f(mrun - mnew); \
        lrun *= alpha; mrun = mnew; \
        _Pragma("unroll") for (int i = 0; i < 16; ++i) { o0[i] *= alpha; o1[i] *= alpha; } } \
    float psum = 0.f; \
    _Pragma("unroll") for (int i = 0; i < 16; ++i) { sa[i] = __builtin_amdgcn_exp2f(sa[i] - mrun); psum += sa[i]; } \
    lrun += psum; \
    bf16x8 pf0, pf1; \
    { u32x4 w0, w1; \
      _Pragma("unroll") for (int j = 0; j < 4; ++j) { w0[j] = pk2(sa[2 * j], sa[2 * j + 1]); w1[j] = pk2(sa[8 + 2 * j], sa[8 + 2 * j + 1]); } \
      pf0 = __builtin_bit_cast(bf16x8, w0); pf1 = __builtin_bit_cast(bf16x8, w1); } \
    const LAS unsigned char* v0p = (vb_) + l31 * 136 + 2 * (t0_) + 8 * hh; const LAS unsigned char* v1p = v0p + 32 * 136; \
    const s16x4 a0 = *(const LAS s16x4*)(v0p), a1 = *(const LAS s16x4*)(v0p + 16), a2 = *(const LAS s16x4*)(v0p + 32), a3 = *(const LAS s16x4*)(v0p + 48); \
    const s16x4 c0 = *(const LAS s16x4*)(v1p), c1 = *(const LAS s16x4*)(v1p + 16), c2 = *(const LAS s16x4*)(v1p + 32), c3 = *(const LAS s16x4*)(v1p + 48); \
    const bf16x8 va0 = __builtin_shufflevector(a0, a1, 0, 1, 2, 3, 4, 5, 6, 7), va1 = __builtin_shufflevector(a2, a3, 0, 1, 2, 3, 4, 5, 6, 7); \
    const bf16x8 vb0 = __builtin_shufflevector(c0, c1, 0, 1, 2, 3, 4, 5, 6, 7), vb1 = __builtin_shufflevector(c2, c3, 0, 1, 2, 3, 4, 5, 6, 7); \
    o0 = __builtin_amdgcn_mfma_f32_32x32x16_bf16(va0, pf0, o0, 0, 0, 0); o0 = __builtin_amdgcn_mfma_f32_32x32x16_bf16(va1, pf1, o0, 0, 0, 0); \
    o1 = __builtin_amdgcn_mfma_f32_32x32x16_bf16(vb0, pf0, o1, 0, 0, 0); o1 = __builtin_amdgcn_mfma_f32_32x32x16_bf16(vb1, pf1, o1, 0, 0, 0); \
    } while (0)
__device__ __forceinline__ void phase_attn(const Ctx& X, const Params& p) {
    const bf16_t* Q = (const bf16_t*)(p.ws + WS_Q); const bf16_t* Kb = (const bf16_t*)(p.ws + WS_K); const bf16_t* VT = (const bf16_t*)(p.ws + WS_VT);
    bf16_t* O = (bf16_t*)(p.ws + WS_O);
    LAS float* biasL = (LAS float*)(X.lds + AT_BIAS);
    const int lane = X.lane, l31 = lane & 31, hh = lane >> 5, tid = X.tid;
    const float LOG2E = 1.4426950408889634f;
    const int skey = tid >> 3, sch = tid & 7;
    for (int task = X.blk; task < 256; task += X.G) {
        const int b = task >> 5, h = (task >> 1) & 15, hf = task & 1;
        __syncthreads();
        for (int i = tid; i < 465 + 2 * AT_BPAD + 64; i += 512) { const int j = i - AT_BPAD; biasL[i] = (j >= 0 && j < 465) ? p.in[I_RPB][h * 465 + j] * LOG2E : 0.f; }
        const bf16_t* vcol = VT + (size_t)skey * DM + h * 64 + 8 * sch;
        const bf16_t* kcol = Kb + (size_t)skey * DM + h * 64 + 8 * sch;
        for (int gq = 0; gq < 4; ++gq) {
            const int R0 = 16 * hf + 4 * gq;
            const int rp = X.wave >> 2, cb = X.wave & 3, r = R0 + 2 * rp, c0 = 16 * cb;
            const int t0 = cb == 0 ? 0 : (cb == 1 ? 8 : (cb == 2 ? 24 : 32));
            const int rq = r + (l31 >> 4), qc = c0 + (l31 & 15);
            const int r0q = rq < 4 ? 0 : (rq > 28 ? 24 : rq - 4);
            const int r0lo = r < 4 ? 0 : (r > 28 ? 24 : r - 4), r0hi = (r + 1 < 4 ? 0 : (r + 1 > 28 ? 24 : r + 1 - 4)) + 7;
            const int rmin = R0 < 4 ? 0 : (R0 > 28 ? 24 : R0 - 4);
            const int rl = R0 + 3, rmax = (rl < 4 ? 0 : (rl > 28 ? 24 : rl - 4)) + 7;
            const int nl = rmax - rmin + 1, nsteps = 2 + ((nl + 1) >> 1);
            const size_t qtok = (size_t)b * 2048 + rq * 64 + qc;
            bf16x8 qf[4];
#pragma unroll
            for (int s = 0; s < 4; ++s) qf[s] = *(const bf16x8*)(Q + qtok * DM + h * 64 + 16 * s + 8 * hh);
            const int cs = qc < 8 ? 0 : (qc > 56 ? 48 : qc - 8);
            float pen[16];
#pragma unroll
            for (int i = 0; i < 16; ++i) { const int kc = t0 + (i & 3) + 8 * (i >> 2) + 4 * hh; pen[i] = (kc >= cs && kc < cs + 16) ? 0.f : -1e30f; }
            const int lb4 = 4 * ((7 - (l31 >> 4)) * 31 + t0 - qc + 15 + 4 * hh + AT_BPAD);
            f32x16 o0, o1;
#pragma unroll
            for (int i = 0; i < 16; ++i) { o0[i] = 0.f; o1[i] = 0.f; }
            float mrun = -1e30f, lrun = 0.f;
            u32x4 kA0, kA1, vA0, vA1, kB0, kB1, vB0, vB1;
#define ATT_ISSUE(st_, k0_, k1_, v0r_, v1r_) do { int s_ = (st_); s_ = s_ < nsteps ? s_ : nsteps - 1; \
                size_t kt0_, kt1_; \
                if (s_ < 2) { kt0_ = (size_t)NLAT + b * 256 + s_ * 128; kt1_ = kt0_ + 64; } \
                else { const int ra_ = rmin + 2 * (s_ - 2), rb_ = ra_ + 1 <= rmax ? ra_ + 1 : rmax; kt0_ = (size_t)b * 2048 + ra_ * 64; kt1_ = (size_t)b * 2048 + rb_ * 64; } \
                k0_ = *(const u32x4*)(kcol + kt0_ * DM); k1_ = *(const u32x4*)(kcol + kt1_ * DM); v0r_ = *(const u32x4*)(vcol + kt0_ * DM); v1r_ = *(const u32x4*)(vcol + kt1_ * DM); } while (0)
#define ATT_WRITE(nb_, k0_, k1_, v0r_, v1r_) do { \
                LAS unsigned char* kw_ = X.lds + AT_K0 + (nb_) * 2 * AT_KB + skey * 128 + ((sch ^ (skey & 7)) << 4); \
                *(LAS u32x4*)(kw_) = k0_; *(LAS u32x4*)(kw_ + AT_KB) = k1_; \
                LAS unsigned short* vw_ = (LAS unsigned short*)(X.lds + AT_V0 + (nb_) * 2 * AT_VB + (8 * sch) * 136 + skey * 2);        \
                _Pragma("unroll") for (int j_ = 0; j_ < 4; ++j_) { \
                    vw_[(2 * j_) * 68] = (unsigned short)(v0r_[j_] & 0xffffu); vw_[(2 * j_ + 1) * 68] = (unsigned short)(v0r_[j_] >> 16); \
                    vw_[AT_VB / 2 + (2 * j_) * 68] = (unsigned short)(v1r_[j_] & 0xffffu); vw_[AT_VB / 2 + (2 * j_ + 1) * 68] = (unsigned short)(v1r_[j_] >> 16); } } while (0)
#define ATT_KROW(kb_, vb_, kr_) do { const int kr = (kr_); \
                if (kr <= rmax && kr >= r0lo && kr <= r0hi) { \
                    const float rpen = (kr >= r0q && kr < r0q + 8) ? 0.f : -1e30f; \
                    const int brow4 = lb4 + 4 * 31 * (kr - r) + 4 * 0; \
                    ATT_TILE(kb_, vb_, t0, true, brow4, rpen); } } while (0)
#define ATT_STEP(st_, cur_) do { const int st = (st_); \
                const LAS unsigned char* kb = X.lds + AT_K0 + (cur_) * 2 * AT_KB; const LAS unsigned char* vb = X.lds + AT_V0 + (cur_) * 2 * AT_VB; \
                if (st < 2) { ATT_TILE(kb, vb, 0, false, 0, 0.f); ATT_TILE(kb, vb, 32, false, 0, 0.f); ATT_TILE(kb + AT_KB, vb + AT_VB, 0, false, 0, 0.f); ATT_TILE(kb + AT_KB, vb + AT_VB, 32, false, 0, 0.f); } \
                else { const int ka = rmin + 2 * (st - 2); ATT_KROW(kb, vb, ka); ATT_KROW(kb + AT_KB, vb + AT_VB, ka + 1); } } while (0)
            ATT_ISSUE(0, kA0, kA1, vA0, vA1);
            ATT_ISSUE(1, kB0, kB1, vB0, vB1);
            __syncthreads();
            ATT_WRITE(0, kA0, kA1, vA0, vA1);
            __syncthreads();
            for (int sp = 0; sp < nsteps; sp += 2) {
                ATT_ISSUE(sp + 2, kA0, kA1, vA0, vA1);
                ATT_STEP(sp, 0);
                ATT_WRITE(1, kB0, kB1, vB0, vB1);
                __syncthreads();
                if (sp + 1 < nsteps) {
                    ATT_ISSUE(sp + 3, kB0, kB1, vB0, vB1);
                    ATT_STEP(sp + 1, 1);
                    ATT_WRITE(0, kA0, kA1, vA0, vA1);
                    __syncthreads();
                }
            }
#undef ATT_ISSUE
#undef ATT_WRITE
#undef ATT_STEP
#undef ATT_KROW
            const float ltot = lrun + __shfl_xor(lrun, 32), inv = 1.f / ltot;
            bf16_t* op = O + qtok * DM + h * 64;
#pragma unroll
            for (int g = 0; g < 4; ++g) {
                u32x2 w; w.x = pk2(o0[4 * g] * inv, o0[4 * g + 1] * inv); w.y = pk2(o0[4 * g + 2] * inv, o0[4 * g + 3] * inv);
                *(u32x2*)(op + 8 * g + 4 * hh) = w;
                u32x2 w2; w2.x = pk2(o1[4 * g] * inv, o1[4 * g + 1] * inv); w2.y = pk2(o1[4 * g + 2] * inv, o1[4 * g + 3] * inv);
                *(u32x2*)(op + 32 + 8 * g + 4 * hh) = w2;
            }
        }
    }
}
#undef ATT_TILE


constexpr int N_PHASES = 24;
constexpr int C0A = 4800, C0B = 6400, C0C = 7600;
constexpr int C1A = 6000, C1B = 7000;
#ifndef PROBE_LO
#define PROBE_LO 99
#define PROBE_HI (-1)
#endif
__host__ __device__ constexpr int nrep(int k) { return (k >= PROBE_LO && k <= PROBE_HI) ? 2 : 1; }
__global__ void __launch_bounds__(512, 2) fwd_kernel(Params p) {
    extern __shared__ __attribute__((aligned(16))) unsigned char lds_raw[];
    LAS unsigned char* lds = (LAS unsigned char*)lds_raw;
    const int wave0 = __builtin_amdgcn_readfirstlane((int)(threadIdx.x >> 6));
    for (int u = threadIdx.x; u < (LDS_BYTES - MISC_OFF) / 4; u += 512) ((LAS unsigned*)(lds + MISC_OFF))[u] = 0u;
    __syncthreads();
    XcdBarrier bar; bar.bar = (unsigned*)(p.ws + WS_CTL) + 4096; bar.x = 0; bar.st = (volatile LAS unsigned*)(lds + MISC_OFF + M_BAR);
    if (p.ph_hi - p.ph_lo > 1) bar = xcd_barrier_post((unsigned*)(p.ws + WS_CTL) + 4096, (volatile LAS unsigned*)(lds + MISC_OFF + M_BAR));
#define PH(k) (p.ph_lo <= (k) && (k) < p.ph_hi)
#define SEAM(k) do { if (PH(k) && PH((k) + 1)) xcd_barrier(bar, wave0); } while (0)
#define RUN(k, ...) do { if (PH(k)) { _Pragma("unroll") for (int rep_ = 0; rep_ < nrep(k); ++rep_) { const float rs_ = rep_ == 0 ? 1.f : 0.f; (void)rs_; { __VA_ARGS__ } if (rep_ + 1 < nrep(k)) xcd_barrier(bar, wave0); } } SEAM(k); } while (0)
    unsigned char* ws = p.ws;
    const float* MOD = (const float*)(ws + WS_MOD);

    RUN(0, const Ctx X = mkctx(lds, wave0); phase_p0a(X, p););
    RUN(1, const Ctx X = mkctx(lds, wave0); phase_p0b(X, p););
    RUN(2, const Ctx X = mkctx(lds, wave0); phase_norm<0>(X, p, 0, 0, NTOK););
    RUN(3,
        g8::RectSched S{72, 8, (int)gridDim.x, (int)blockIdx.x, 0u, 2048u, (const char*)(ws + WS_WIN), 2048u};
        EpiWin E{(bf16_t*)(ws + WS_A2), (bf16_t*)(ws + WS_BCV)};
        g8::gemm_phase(lds, wave0, (const char*)(ws + WS_XA), 1024, 2048u, S, E);
        { const Ctx X = mkctx(lds, wave0); int nidle; const int rk = idle_rank(576, X.G, X.blk, nidle);
          if (rk >= 0) conv_moe_items<0>(X, p, 0, (bf16_t*)(ws + WS_GU), (bf16_t*)(ws + WS_DN), 0, C0A, rk, nidle); });
    RUN(4,
        g8::BatchSched S{32, 3, 1, (int)gridDim.x, (int)blockIdx.x, 1536u, (const char*)(ws + WS_WF), 1024u, 256};
        EpiS5F E{(float*)(ws + WS_F)};
        g8::gemm_phase(lds, wave0, (const char*)(ws + WS_A2), 512, 1024u, S, E);
        { const Ctx X = mkctx(lds, wave0); int nidle; const int rk = moe_idle_rank(96, 1, X.G, X.blk, nidle);
          if (rk >= 0) conv_moe_items<0>(X, p, 0, (bf16_t*)(ws + WS_GU), (bf16_t*)(ws + WS_DN), C0A, C0B, rk, nidle); });
    RUN(5, const Ctx X = mkctx(lds, wave0); phase_scan_conv(X, p););
    RUN(6,
        g8::BatchSched S{32, 3, 2, (int)gridDim.x, (int)blockIdx.x, 1536u, (const char*)(ws + WS_ME), 1536u, 512};
        EpiS5Y E{(bf16_t*)(ws + WS_G)};
        g8::gemm_phase(lds, wave0, (const char*)(ws + WS_A2), 768, 1536u, S, E););
    RUN(7,
        g8::RectSched S{72, 2, (int)gridDim.x, (int)blockIdx.x, 0u, 1024u, (const char*)(ws + WS_GLU), 1024u};
        EpiGlu E{(const bf16_t*)(ws + WS_G), p.in[I_GLUB], (bf16_t*)(ws + WS_Z)};
        g8::gemm_phase(lds, wave0, (const char*)(ws + WS_G), 512, 1024u, S, E);
        { const Ctx X = mkctx(lds, wave0); int nidle; const int rk = idle_rank(144, X.G, X.blk, nidle);
          if (rk >= 0) conv_moe_items<0>(X, p, 0, (bf16_t*)(ws + WS_GU), (bf16_t*)(ws + WS_DN), C0B, C0C, rk, nidle); });
    RUN(8,
        g8::RectSched S{72, 4, (int)gridDim.x, (int)blockIdx.x, 0u, 2048u, (const char*)(ws + WS_HOUT), 2048u};
        EpiResid<true> E{p.in[I_X], p.in[I_CTX], MOD + 2 * 1024, (bf16_t*)(ws + WS_XR), 1.f};
        g8::gemm_phase(lds, wave0, (const char*)(ws + WS_Z), 1024, 2048u, S, E);
        { const Ctx X = mkctx(lds, wave0); int nidle; const int rk = idle_rank(288, X.G, X.blk, nidle);
          if (rk >= 0) conv_moe_items<0>(X, p, 0, (bf16_t*)(ws + WS_GU), (bf16_t*)(ws + WS_DN), C0C, 12480, rk, nidle); });
#define MOE_PHASES(P0, L, NTOKL, FINAL) \
    RUN(P0, const Ctx X = mkctx(lds, wave0); phase_norm<1>(X, p, L, 1, NTOKL);); \
    RUN(P0 + 1, const Ctx X = mkctx(lds, wave0); phase_route(X, p, L, NTOKL);); \
    RUN(P0 + 2, const Ctx X = mkctx(lds, wave0); phase_slots(X, p, NTOKL);); \
    RUN(P0 + 3, \
        const Ctx X = mkctx(lds, wave0); const int ntiles = load_tiles(X, p); \
        g8::MoeSched<true> S{ntiles, 2, (int)gridDim.x, (int)blockIdx.x, 2048u, (const char*)(ws + (L == 0 ? WS_GU : WS_GU1)), 2048u, 512, 0, 128, lds + MISC_OFF + M_TILE, (const int*)(ws + WS_ROWIDX)}; \
        EpiGU E{(bf16_t*)(ws + WS_ACT)}; \
        g8::gemm_phase(lds, wave0, (const char*)(ws + WS_XA), 1024, 2048u, S, E); \
        { const Ctx X2 = mkctx(lds, wave0); int nidle; const int rk = moe_idle_rank(ntiles, 2, X2.G, X2.blk, nidle);        \
          if (rk >= 0 && L == 0) conv_moe_items<1>(X2, p, 1, (bf16_t*)(ws + WS_GU1), nullptr, 0, C1A, rk, nidle); }); \
    RUN(P0 + 4, \
        const Ctx X = mkctx(lds, wave0); const int ntiles = load_tiles(X, p); \
        g8::MoeSched<false> S{ntiles, 4, (int)gridDim.x, (int)blockIdx.x, 512u, (const char*)(ws + WS_DN), 512u, 1024, 0, 256, lds + MISC_OFF + M_TILE, nullptr}; \
        EpiDN E{(unsigned char*)(ws + WS_Y)}; \
        g8::gemm_phase(lds, wave0, (const char*)(ws + WS_ACT), 256, 512u, S, E); \
        { const Ctx X2 = mkctx(lds, wave0); int nidle; const int rk = moe_idle_rank(ntiles, 4, X2.G, X2.blk, nidle); \
          if (rk >= 0 && L == 0) conv_moe_items<1>(X2, p, 1, (bf16_t*)(ws + WS_GU1), nullptr, C1A, C1B, rk, nidle); }); \
    RUN(P0 + 5, const Ctx X = mkctx(lds, wave0); phase_combine<!FINAL>(X, p, L, NTOKL, FINAL, 1.f););

    MOE_PHASES(9, 0, NTOK, false)
    RUN(15,
        g8::QkvSched S{(int)gridDim.x, (int)blockIdx.x, 2048u, (const char*)(ws + WS_QKV), 2048u};
        EpiQKV E{(bf16_t*)(ws + WS_Q), (bf16_t*)(ws + WS_K), (bf16_t*)(ws + WS_VT), p.in[I_QG], p.in[I_KG]};
        g8::gemm_phase(lds, wave0, (const char*)(ws + WS_ACT), 1024, 2048u, S, E);
        { const Ctx X = mkctx(lds, wave0); int nidle; const int rk = idle_rank(832, X.G, X.blk, nidle);
          if (rk >= 0) { conv_moe_items<1>(X, p, 1, (bf16_t*)(ws + WS_GU1), nullptr, C1B, 8320, rk, nidle);
                         conv_moe_items<2>(X, p, 1, nullptr, (bf16_t*)(ws + WS_DN), 0, 4160, rk, nidle); } });
    RUN(16, const Ctx X = mkctx(lds, wave0); phase_attn(X, p););
    RUN(17,
        g8::RectSched S{64, 4, (int)gridDim.x, (int)blockIdx.x, 0u, 2048u, (const char*)(ws + WS_NOUT), 2048u};
        EpiResid<false> E{nullptr, nullptr, MOD + 9 * 6144 + 2 * 1024, (bf16_t*)(ws + WS_XR), rs_};
        g8::gemm_phase(lds, wave0, (const char*)(ws + WS_O), 1024, 2048u, S, E););
    MOE_PHASES(18, 1, NLAT, true)
#undef PH
#undef SEAM
#undef RUN
}

extern "C" void kernel_launch(void* const* d_in, const int* in_sizes, int n_in, void* d_out, int out_size, void* d_ws, size_t ws_size, hipStream_t stream) {
    static int grid = 0;
    if (grid == 0) {
        int dev = 0, cus = 0, per_cu = 0;
        if (n_in != 34 || ws_size < WS_END) { fprintf(stderr, "kernel_launch: unexpected inputs (n_in %d, ws %zu, need %zu)\n", n_in, ws_size, (size_t)WS_END); grid = -1; return; }
        if (hipGetDevice(&dev) != hipSuccess || hipDeviceGetAttribute(&cus, hipDeviceAttributeMultiprocessorCount, dev) != hipSuccess) { grid = -1; return; }
        if (hipFuncSetAttribute((const void*)fwd_kernel, hipFuncAttributeMaxDynamicSharedMemorySize, LDS_BYTES) != hipSuccess) { fprintf(stderr, "kernel_launch: hipFuncSetAttribute failed\n"); grid = -1; return; }
        if (hipOccupancyMaxActiveBlocksPerMultiprocessor(&per_cu, (const void*)fwd_kernel, 512, LDS_BYTES) != hipSuccess || per_cu < 1) { fprintf(stderr, "kernel_launch: occupancy query says %d\n", per_cu); }
        (void)hipGetLastError();
        grid = cus;
    }
    if (grid < 0) return;
    (void)hipMemsetAsync((char*)d_ws + WS_CTL, 0, 64 * 1024, stream);
    Params p{};
    for (int i = 0; i < 34; ++i) p.in[i] = (const float*)d_in[i];
    p.out = (float*)d_out; p.ws = (unsigned char*)d_ws;
#if MK_ONE_LAUNCH
    p.ph_lo = 0; p.ph_hi = N_PHASES;
    hipLaunchKernelGGL(fwd_kernel, dim3(grid), dim3(512), LDS_BYTES, stream, p);
#else
    for (int k = 0; k < N_PHASES; ++k) { p.ph_lo = k; p.ph_hi = k + 1; hipLaunchKernelGGL(fwd_kernel, dim3(grid), dim3(512), LDS_BYTES, stream, p); }
#endif
}
```

```cpp
#include <hip/hip_runtime.h>
#include <stdint.h>
#include <stdio.h>

#ifndef MK_ONE_LAUNCH
#define MK_ONE_LAUNCH 1
#endif

#define GAS __attribute__((address_space(1)))
#define LAS __attribute__((address_space(3)))
typedef unsigned short bf16_t;
typedef short bf16x8 __attribute__((ext_vector_type(8)));
typedef short s16x4 __attribute__((ext_vector_type(4)));
typedef float f32x4 __attribute__((ext_vector_type(4)));
typedef float f32x2 __attribute__((ext_vector_type(2)));
typedef float f32x16 __attribute__((ext_vector_type(16)));
typedef unsigned u32x4 __attribute__((ext_vector_type(4)));
typedef unsigned u32x2 __attribute__((ext_vector_type(2)));

constexpr int NLAT = 16384, NCTX = 2048, NTOK = NLAT + NCTX, DM = 1024;
constexpr int SEQ = 2048, CTXL = 256, NB = 8;
constexpr int NEXP = 64, NEXP1 = 65, EDIM = 256;
constexpr int S5T = 32;
constexpr int S5R = 576, S5RP = 768;
constexpr int S5K = 768;
constexpr int MAXTILES = 712;

constexpr size_t MiB = 1ull << 20;
constexpr size_t WS_CTL = 0;
constexpr size_t WS_MOD = 1 * MiB;
constexpr size_t WS_WIN = 2 * MiB;
constexpr size_t WS_GLU = 6 * MiB;
constexpr size_t WS_HOUT = 7 * MiB;
constexpr size_t WS_QKV = 9 * MiB;
constexpr size_t WS_NOUT = 15 * MiB;
constexpr size_t WS_ROUT = 17 * MiB;
constexpr size_t WS_GU = 18 * MiB;
constexpr size_t WS_DN = 83 * MiB;
constexpr size_t WS_GU1 = 116 * MiB;
constexpr size_t WS_XR = 181 * MiB;
constexpr size_t WS_LOGIT = 253 * MiB;
constexpr size_t WS_TOKE = 258 * MiB;
constexpr size_t WS_TOKW = 259 * MiB;
constexpr size_t WS_TOKP = 260 * MiB;
constexpr size_t WS_ROWIDX = 261 * MiB;
constexpr size_t WS_YROW = 262 * MiB;
constexpr size_t WS_CNTBLK = 263 * MiB;
constexpr size_t WS_TAB = 263 * MiB + 512 * 1024;
constexpr size_t WS_XA = 264 * MiB;
constexpr size_t WS_OVL = 300 * MiB;
constexpr size_t WS_A2 = WS_OVL;
constexpr size_t WS_BCV = WS_OVL + 36 * MiB;
constexpr size_t WS_F = WS_OVL + 90 * MiB;
constexpr size_t WS_Z = WS_OVL + 114 * MiB;
constexpr size_t WS_G = WS_OVL + 150 * MiB;
constexpr size_t WS_ME = WS_OVL + 168 * MiB;
constexpr size_t WS_WF = WS_OVL + 192 * MiB;
constexpr size_t WS_KK = WS_OVL + 200 * MiB;
constexpr size_t WS_PW = WS_OVL + 202 * MiB;
constexpr size_t WS_BB = WS_OVL + 204 * MiB;
constexpr size_t WS_ADAP = WS_OVL + 205 * MiB;
constexpr size_t WS_Q = WS_OVL;
constexpr size_t WS_K = WS_OVL + 32 * MiB;
constexpr size_t WS_VT = WS_OVL + 68 * MiB;
constexpr size_t WS_O = WS_OVL + 104 * MiB;
constexpr size_t WS_Y = WS_XA;
constexpr size_t WS_ACT = WS_XA + 178 * MiB;
constexpr size_t WS_END = WS_ACT + 89 * MiB;

constexpr int RING_BYTES = 131072;
constexpr int MISC_OFF = RING_BYTES;
constexpr int LDS_BYTES = 147456;
constexpr int M_BAR = 0, M_CNT = 64, M_BASE = 384, M_BBASE = 704, M_TILE = 1024, M_PART = 2048, M_NT = 3200;

__device__ __forceinline__ unsigned f2bf(float f) { unsigned u = __builtin_bit_cast(unsigned, f); return (u + 0x7fffu + ((u >> 16) & 1u)) >> 16; }
typedef __bf16 hbf16x2 __attribute__((ext_vector_type(2)));
__device__ __forceinline__ unsigned pk2(float lo, float hi) { const f32x2 v = {lo, hi}; const hbf16x2 b = __builtin_convertvector(v, hbf16x2); return __builtin_bit_cast(unsigned, b); }
__device__ __forceinline__ float bflo(unsigned w) { return __builtin_bit_cast(float, w << 16); }
__device__ __forceinline__ float bfhi(unsigned w) { return __builtin_bit_cast(float, w & 0xffff0000u); }
__device__ __forceinline__ float bf1(bf16_t b) { return __builtin_bit_cast(float, ((unsigned)b) << 16); }
__device__ __forceinline__ float wave_sum(float v) {
#pragma unroll
    for (int o = 1; o < 64; o <<= 1) v += __shfl_xor(v, o);
    return v;
}
__device__ __forceinline__ float sigmoidf_(float x) { return 1.f / (1.f + __expf(-x)); }
__device__ __forceinline__ float siluf_(float x) { return x / (1.f + __expf(-x)); }
__device__ __forceinline__ float gelu_tanh(float x) {
    const float u = 0.7978845608028654f * (x + 0.044715f * x * x * x);
    const float e = __expf(2.f * u);
    const float t = 1.f - 2.f / (e + 1.f);
    return 0.5f * x * (1.f + t);
}

__device__ __forceinline__ int lane_id_opaque() { int l; asm volatile("v_mbcnt_lo_u32_b32 %0, -1, 0\n\tv_mbcnt_hi_u32_b32 %0, -1, %0" : "=v"(l)); return l; }

#define XB_TMO      128
#define XB_XCNT(j)  (256  + 64 * (j))
#define XB_XSUB(j)  (1280 + 64 * (j))
#define XB_XGEN(j)  (2304 + 64 * (j))
#define XB_TOP      3328
#define XB_TOPGEN   3392
#define XCD_BAR_WORDS 3456
#define XB_SPIN_CAP (1u << 18)
__device__ __forceinline__ unsigned xb_ld(unsigned* p)              { return __hip_atomic_load(p, __ATOMIC_RELAXED, __HIP_MEMORY_SCOPE_AGENT); }
__device__ __forceinline__ unsigned xb_add(unsigned* p, unsigned v) { return __hip_atomic_fetch_add(p, v, __ATOMIC_RELAXED, __HIP_MEMORY_SCOPE_AGENT); }
__device__ __forceinline__ unsigned xb_xcc_id() { return (unsigned)__builtin_amdgcn_s_getreg((3 << 11) | 20) & 0xFu; }
#define XB_SPIN(cond, bar) do { unsigned _sp = 0; while (cond) { __builtin_amdgcn_s_sleep(1); \
    if ((++_sp & 255u) == 0u) { if (xb_ld(&(bar)[XB_TMO])) break; if (_sp > XB_SPIN_CAP) { atomicAdd(&(bar)[XB_TMO], 1u); break; } } } } while (0)
struct XcdBarrier { unsigned* bar; unsigned x; volatile LAS unsigned* st; };
__device__ __forceinline__ XcdBarrier xcd_barrier_post(unsigned* bar, volatile LAS unsigned* st) {
    XcdBarrier b; b.bar = bar; b.x = xb_xcc_id(); b.st = st;
    if (threadIdx.x == 0) (void)xb_add(&bar[XB_XCNT(b.x)], 1u);
    return b;
}
__device__ __forceinline__ void xcd_barrier_complete(unsigned* bar, unsigned x, unsigned& nloc, unsigned& nx) {
    const unsigned G = gridDim.x * gridDim.y * gridDim.z;
    unsigned sum, cnt, mine, sp = 0u;
    for (;;) {
        sum = 0u; cnt = 0u; mine = 0u;
#pragma unroll
        for (unsigned j = 0; j < 16; ++j) { const unsigned c = xb_ld(&bar[XB_XCNT(j)]); sum += c; cnt += (c > 0u) ? 1u : 0u; mine = (j == x) ? c : mine; }
        if (sum == G) break;
        __builtin_amdgcn_s_sleep(1);
        if ((++sp & 255u) == 0u) { if (xb_ld(&bar[XB_TMO])) break; if (sp > XB_SPIN_CAP) { atomicAdd(&bar[XB_TMO], 1u); break; } }
    }
    nloc = mine > 0u ? mine : 1u; nx = cnt > 0u ? cnt : 1u;
}
__device__ __forceinline__ void xcd_barrier(const XcdBarrier& b, const int wave0) {
    asm volatile("s_waitcnt vmcnt(0)" ::: "memory");
    __syncthreads();
    if (wave0 == 0 && lane_id_opaque() == 0) {
        unsigned* bar = b.bar;
        __builtin_amdgcn_s_waitcnt(0);
        unsigned nloc = b.st[0], nx = b.st[1];
        if (nloc == 0u) { xcd_barrier_complete(bar, b.x, nloc, nx); b.st[0] = nloc; b.st[1] = nx; }
        const unsigned old = xb_add(&bar[XB_XSUB(b.x)], 1u);
        const unsigned gen = old / nloc;
        if (old + 1u == (gen + 1u) * nloc) {
            __builtin_amdgcn_fence(__ATOMIC_RELEASE, "agent");
            asm volatile("s_waitcnt vmcnt(0)" ::: "memory");
            const unsigned og = xb_add(&bar[XB_TOP], 1u);
            const unsigned tg = og / nx;
            if (og + 1u == (tg + 1u) * nx) xb_add(&bar[XB_TOPGEN], 1u);
            else XB_SPIN(xb_ld(&bar[XB_TOPGEN]) == tg, bar);
            __builtin_amdgcn_fence(__ATOMIC_ACQUIRE, "agent");
            xb_add(&bar[XB_XGEN(b.x)], 1u);
            asm volatile("s_waitcnt vmcnt(0)" ::: "memory");
        } else {
            XB_SPIN(xb_ld(&bar[XB_XGEN(b.x)]) == gen, bar);
            __builtin_amdgcn_fence(__ATOMIC_ACQUIRE, "agent");
            asm volatile("s_waitcnt vmcnt(0)" ::: "memory");
        }
    }
    __syncthreads();
}

namespace g8 {
constexpr int BM = 256, BK = 64, HALF = 128, HTB = HALF * BK * 2, STAGE_BYTES = 8 * HTB, NXCD = 8, WGM = 8;
__host__ __device__ __forceinline__ int lds_byte(int r, int c) { const int st = (r >> 4) * 2 + (c >> 5), rr = r & 15, cc = c & 31, ob = rr * 64 + cc * 2; return st * 1024 + (ob ^ (((ob >> 9) & 1) << 5)); }
__host__ __device__ __forceinline__ void stage_rc(int b, int& R, int& C) { const int st = b / 1024, sb = b % 1024, swz = sb ^ (((sb >> 9) & 1) << 5); R = (st >> 1) * 16 + swz / 64; C = (st & 1) * 32 + (swz % 64) / 2; }
__host__ __device__ __forceinline__ int perm32(int rho) { const int n = rho >> 4, i = rho & 15; return 8 * (i >> 2) + 4 * n + (i & 3); }

struct Unit { unsigned a0; const char* B; int p0, p1, p2; };

__device__ __forceinline__ void static_map(int L, int nM, int nN, int& pm, int& pn) {
    const int nwg = nM * nN; int wgid = L;
    { const int q = nwg / NXCD, r = nwg % NXCD, xcd = wgid % NXCD, off = wgid / NXCD; wgid = (xcd < r ? xcd * (q + 1) : r * (q + 1) + (xcd - r) * q) + off; }
    const int nig = WGM * nN, gid = wgid / nig, fm = gid * WGM, gsz = (nM - fm) < WGM ? (nM - fm) : WGM;
    pm = fm + ((wgid % nig) % gsz); pn = (wgid % nig) / gsz;
}

template <class Epi, class Sched>
__device__ __forceinline__ void gemm_phase(LAS unsigned char* lds, const int wid, const char* Abase, const int K, const unsigned ldb, const Sched& S, const Epi& E) {
    const int lane = lane_id_opaque();
    const int tid = wid * 64 + lane, wr = wid >> 2, wc = wid & 3, fr = lane & 15, fq = lane >> 4;
    const int nt = K / BK;
    unsigned voffB0;
    { int R0, C0; stage_rc(tid * 16, R0, C0);
      const int Rb0 = Epi::GUP ? (256 * ((R0 >> 4) & 1) + 32 * (R0 >> 5) + 8 * ((R0 & 15) >> 2) + (R0 & 3)) : Epi::WIDE ? (64 * (R0 >> 5) + 16 * ((R0 & 15) >> 2) + 4 * ((R0 >> 4) & 1) + (R0 & 3)) : Epi::HEADP ? (64 * (R0 >> 5) + perm32(R0 & 31)) : (Epi::PERM ? ((R0 & ~31) + perm32(R0 & 31)) : R0);
      voffB0 = (unsigned)Rb0 * ldb + (unsigned)C0 * 2u; }
    const size_t hstepB = (size_t)(Epi::GUP ? 4 : Epi::WIDE ? 8 : (Epi::HEADP ? 32 : HALF)) * ldb;
    const size_t p1stepB = (size_t)((Epi::WIDE || Epi::HEADP) ? 128 : 64) * ldb;
    const unsigned ldsw = (unsigned)wid * 1024u;
    const int aoff = lds_byte(wr * 64 + fr, fq * 8), boff = lds_byte(wc * 32 + fr, fq * 8);
#define G8_SA(b, h) (((b) * 2 + (h)) * HTB)
#define G8_SB(b, h) ((4 + (b) * 2 + (h)) * HTB)
#define G8_GLDS(gp, lo) __builtin_amdgcn_global_load_lds((const unsigned*)(gp), (LAS unsigned*)(lds + (lo)), 16, 0, 0)
#define G8_STAGE_A(bufoff, o0, o1, kb, h) do { \
        G8_GLDS(Abase + ((long)(kb) + (Sched::GATHER ? 0l : (long)((h) * 128) * (long)S.lda)) + (size_t)(o0), (bufoff) + ldsw); \
        G8_GLDS(Abase + ((long)(kb) + (Sched::GATHER ? 0l : (long)((h) * 128 + 64) * (long)S.lda)) + (size_t)(o1), (bufoff) + ldsw + 8192); } while (0)
#define G8_STAGE_B(bufoff, bp, kb) do { G8_GLDS((bp) + (size_t)(kb) + (size_t)voffB0, (bufoff) + ldsw); G8_GLDS((bp) + ((size_t)(kb) + p1stepB) + (size_t)voffB0, (bufoff) + ldsw + 8192); } while (0)
#define G8_LDA(dst, b, h) do { _Pragma("unroll") for (int m = 0; m < 4; ++m) _Pragma("unroll") for (int k = 0; k < 2; ++k) dst[m][k] = *(const LAS bf16x8*)(lds + G8_SA(b, h) + aoff + m * 2048 + k * 1024); } while (0)
#define G8_LDB(dst, b, h) do { _Pragma("unroll") for (int n = 0; n < 2; ++n) _Pragma("unroll") for (int k = 0; k < 2; ++k) dst[n][k] = *(const LAS bf16x8*)(lds + G8_SB(b, h) + boff + n * 2048 + k * 1024); } while (0)
#define G8_MMA(ai, bj, At, Bt) do { __builtin_amdgcn_s_setprio(1); _Pragma("unroll") for (int m = 0; m < 4; ++m) _Pragma("unroll") for (int n = 0; n < 2; ++n) _Pragma("unroll") for (int k = 0; k < 2; ++k) \
        acc[ai][bj][m][n] = __builtin_amdgcn_mfma_f32_16x16x32_bf16(Bt[n][k], At[m][k], acc[ai][bj][m][n], 0, 0, 0); __builtin_amdgcn_s_setprio(0); } while (0)
#define G8_WAIT_V(n) asm volatile("s_waitcnt vmcnt(" #n ")" ::: "memory")
#define G8_WAIT_L(n) asm volatile("s_waitcnt lgkmcnt(" #n ")" ::: "memory")
#define G8_BAR __builtin_amdgcn_s_barrier()
#define G8_SCHED __builtin_amdgcn_sched_barrier(0)
    Unit cur, nxt; int ui = 0;
    if (!S.next(0, cur)) return;
    f32x4 acc[2][2][4][2];
#pragma unroll
    for (int a = 0; a < 2; ++a)
#pragma unroll
        for (int b = 0; b < 2; ++b)
#pragma unroll
            for (int m = 0; m < 4; ++m)
#pragma unroll
                for (int n = 0; n < 2; ++n) acc[a][b][m][n] = (f32x4){0.f, 0.f, 0.f, 0.f};
    bf16x8 At[4][2], B0[2][2], B1[2][2];
    unsigned cA00, cA01, cA10, cA11;
    { int R0, C0, R1, C1; stage_rc(tid * 16, R0, C0); stage_rc(tid * 16 + 8192, R1, C1);
      cA00 = S.aoff(cur, R0) + (unsigned)C0 * 2u;
      if constexpr (Sched::GATHER) { cA01 = S.aoff(cur, R1) + (unsigned)C1 * 2u; cA10 = S.aoff(cur, HALF + R0) + (unsigned)C0 * 2u; cA11 = S.aoff(cur, HALF + R1) + (unsigned)C1 * 2u; }
      else { cA01 = cA00; cA10 = cA00; cA11 = cA00; } }
    const char* cB = cur.B;
    G8_STAGE_B(G8_SB(0, 0), cB, 0); G8_SCHED; G8_STAGE_B(G8_SB(0, 1), cB + hstepB, 0); G8_SCHED; G8_STAGE_A(G8_SA(0, 0), cA00, cA01, 0, 0); G8_SCHED; G8_STAGE_A(G8_SA(0, 1), cA10, cA11, 0, 1); G8_SCHED;
    if (wr == 1) G8_BAR;
    G8_WAIT_V(2); G8_BAR;
    G8_STAGE_B(G8_SB(1, 0), cB, 128); G8_SCHED; G8_STAGE_A(G8_SA(1, 0), cA00, cA01, 128, 0); G8_SCHED; G8_STAGE_B(G8_SB(1, 1), cB + hstepB, 128); G8_SCHED;
    G8_WAIT_V(6); G8_BAR;
    for (;;) {
        const bool has_next = S.next(ui + 1, nxt);
        unsigned nA00 = cA00, nA01 = cA01, nA10 = cA10, nA11 = cA11; const char* nB = cB; long dl = 0;
        if (has_next) {
            nB = nxt.B;
            if constexpr (!Sched::GATHER) dl = ((long)nxt.a0 - (long)cur.a0) * (long)S.lda;
            else { const int t2 = wid * 64 + lane_id_opaque(); int R0, C0, R1, C1; stage_rc(t2 * 16, R0, C0); stage_rc(t2 * 16 + 8192, R1, C1);
                nA00 = S.aoff(nxt, R0) + (unsigned)C0 * 2u; nA01 = S.aoff(nxt, R1) + (unsigned)C1 * 2u; nA10 = S.aoff(nxt, HALF + R0) + (unsigned)C0 * 2u; nA11 = S.aoff(nxt, HALF + R1) + (unsigned)C1 * 2u; }
        }
        for (int t = 0; t < nt; t += 2) {
            const bool last = (t == nt - 2);
            const unsigned kb = (unsigned)t * 128u;
            const unsigned kb2 = last ? 0u : kb + 256u;
            const char* b2 = last ? nB : cB;
            unsigned s00, s01, s10, s11; long ka2;
            if constexpr (Sched::GATHER) { s00 = last ? nA00 : cA00; s01 = last ? nA01 : cA01; s10 = last ? nA10 : cA10; s11 = last ? nA11 : cA11; ka2 = (long)kb2; }
            else { s00 = cA00; s01 = cA00; s10 = cA00; s11 = cA00; ka2 = last ? dl : (long)kb2; }
            G8_LDB(B0, 0, 0); G8_LDB(B1, 0, 1); G8_SCHED; G8_LDA(At, 0, 0); G8_STAGE_A(G8_SA(1, 1), cA10, cA11, kb + 128u, 1);
            G8_WAIT_V(8); G8_WAIT_L(0); G8_BAR; G8_MMA(0, 0, At, B0); G8_MMA(0, 1, At, B1); G8_BAR; G8_SCHED;
            G8_LDA(At, 0, 1); G8_STAGE_B(G8_SB(0, 0), b2, kb2); G8_STAGE_B(G8_SB(0, 1), b2 + hstepB, kb2); G8_STAGE_A(G8_SA(0, 0), s00, s01, ka2, 0);
            G8_WAIT_V(8); G8_WAIT_L(0); G8_BAR; G8_MMA(1, 0, At, B0); G8_MMA(1, 1, At, B1); G8_BAR; G8_SCHED;
            G8_LDB(B0, 1, 0); G8_LDB(B1, 1, 1); G8_SCHED; G8_LDA(At, 1, 0); G8_STAGE_A(G8_SA(0, 1), s10, s11, ka2, 1);
            G8_WAIT_V(8); G8_WAIT_L(0); G8_BAR; G8_MMA(0, 0, At, B0); G8_MMA(0, 1, At, B1); G8_BAR; G8_SCHED;
            G8_LDA(At, 1, 1); G8_STAGE_B(G8_SB(1, 0), b2, kb2 + 128u); G8_STAGE_B(G8_SB(1, 1), b2 + hstepB, kb2 + 128u); G8_STAGE_A(G8_SA(1, 0), s00, s01, ka2 + 128, 0);
            G8_WAIT_V(8); G8_WAIT_L(0); G8_BAR; G8_MMA(1, 0, At, B0); G8_MMA(1, 1, At, B1); G8_BAR; G8_SCHED;
        }
        if (wr == 0) G8_BAR;
        { const int l2 = lane_id_opaque(); E(acc, cur, wr, wc, l2 & 15, l2 >> 4); }
        if (!has_next) break;
#pragma unroll
        for (int a = 0; a < 2; ++a)
#pragma unroll
            for (int b = 0; b < 2; ++b)
#pragma unroll
                for (int m = 0; m < 4; ++m)
#pragma unroll
                    for (int n = 0; n < 2; ++n) acc[a][b][m][n] = (f32x4){0.f, 0.f, 0.f, 0.f};
        cur = nxt; cB = nB; ++ui;
        if constexpr (Sched::GATHER) { cA00 = nA00; cA01 = nA01; cA10 = nA10; cA11 = nA11; }
        else { cA00 += (unsigned)dl; cA01 = cA00; cA10 = cA00; cA11 = cA00; }
        if (wr == 1) G8_BAR;
    }
    G8_WAIT_V(0);
    G8_BAR;
#undef G8_SA
#undef G8_SB
#undef G8_GLDS
#undef G8_STAGE_A
#undef G8_STAGE_B
#undef G8_LDA
#undef G8_LDB
#undef G8_MMA
#undef G8_WAIT_V
#undef G8_WAIT_L
#undef G8_BAR
#undef G8_SCHED
}

struct RectSched {
    static constexpr bool GATHER = false;
    int nM, nN, G, c; unsigned row0, lda; const char* Bbase; unsigned ldb;
    __device__ __forceinline__ bool next(int i, Unit& u) const {
        const int L = i * G + c; if (L >= nM * nN) return false;
        int pm, pn; static_map(L, nM, nN, pm, pn);
        u.a0 = row0 + (unsigned)pm * 256u; u.B = Bbase + (size_t)pn * 256u * ldb; u.p0 = pm; u.p1 = pn; u.p2 = 0; return true;
    }
    __device__ __forceinline__ unsigned aoff(const Unit& u, int q) const { return (u.a0 + (unsigned)q) * lda; }
};
struct QkvSched {
    static constexpr bool GATHER = false;
    int G, c; unsigned lda; const char* Bbase; unsigned ldb;
    __device__ __forceinline__ bool next(int i, Unit& u) const {
        const int L = i * G + c; int pm, pn;
        if (L < 768) static_map(L, 64, 12, pm, pn);
        else if (L < 832) { const int l2 = L - 768; pm = 64 + (l2 & 7); pn = 4 + (l2 >> 3); }
        else return false;
        u.a0 = (unsigned)pm * 256u; u.B = Bbase + (size_t)pn * 256u * ldb; u.p0 = pm; u.p1 = pn; u.p2 = 0; return true;
    }
    __device__ __forceinline__ unsigned aoff(const Unit& u, int q) const { return (u.a0 + (unsigned)q) * lda; }
};
struct BatchSched {
    static constexpr bool GATHER = false;
    int nb, nM, nN, G, c; unsigned lda; const char* Bbase; unsigned ldb; int N;
    __device__ __forceinline__ bool next(int i, Unit& u) const {
        const int per = nM * nN; int L;
        if ((G & 7) == 0 && (nb & 7) == 0) {
            const int nx = (nb >> 3) * per, li = i * (G >> 3) + (c >> 3); if (li >= nx) return false;
            L = (c & 7) * nx + li;
        } else { L = i * G + c; if (L >= nb * per) return false; }
        const int g = L / per, rem = L % per, pm = rem / nN, pn = rem % nN;
        u.a0 = (unsigned)(g * S5RP + pm * 256); u.B = Bbase + ((size_t)g * N + (size_t)pn * 256u) * ldb; u.p0 = g; u.p1 = pm; u.p2 = pn; return true;
    }
    __device__ __forceinline__ unsigned aoff(const Unit& u, int q) const { return (u.a0 + (unsigned)q) * lda; }
};
template <bool GATHER_>
struct MoeSched {
    static constexpr bool GATHER = GATHER_;
    int ntiles, nN, G, c; unsigned lda; const char* Bbase; unsigned ldb; int Ne, pn0, bstep; const LAS unsigned char* tile_e; const int* rowidx;
    __device__ __forceinline__ void xrange(int x, int& tlo, int& nx) const { const int q = ntiles >> 3, r = ntiles & 7; nx = q + (x < r ? 1 : 0); tlo = x * q + (x < r ? x : r); }
    __device__ __forceinline__ bool next(int i, Unit& u) const {
        int tile, pn;
        if ((G & 7) == 0) {
            int tlo, nx; xrange(c & 7, tlo, nx);
            const int li = i * (G >> 3) + (c >> 3); if (li >= nx * nN) return false;
            tile = tlo + li / nN; pn = li % nN;
        } else { const int L = i * G + c; if (L >= ntiles * nN) return false; tile = L / nN; pn = L % nN; }
        const int e = __builtin_amdgcn_readfirstlane((int)tile_e[tile]);
        u.a0 = (unsigned)tile * 256u; u.B = Bbase + ((size_t)e * Ne + (size_t)(pn0 + pn) * (unsigned)bstep) * ldb; u.p0 = tile; u.p1 = pn; u.p2 = e; return true;
    }
    __device__ __forceinline__ unsigned aoff(const Unit& u, int q) const {
        if (GATHER) return (unsigned)rowidx[u.a0 + (unsigned)q] * lda;
        return (u.a0 + (unsigned)q) * lda;
    }
};
}

struct Params {
    const float* in[34];
    float* out;
    unsigned char* ws;
    int ph_lo, ph_hi;
};
enum { I_X = 0, I_C, I_CTX, I_CCTX, I_ADAW, I_ADAB, I_NMG, I_NFG, I_WIN, I_ARE, I_AIM, I_LDT, I_BRE, I_BIM, I_CRE, I_CIM, I_S5D, I_GLUW, I_GLUB, I_CONVW,
       I_HOUT, I_WQKV, I_QG, I_KG, I_RPB, I_NOUT, I_RW, I_RB, I_MG, I_MU, I_MD, I_SG, I_SU, I_SD };

using g8::Unit;
typedef f32x4 Acc[2][2][4][2];

__device__ __forceinline__ u32x4 pack8(const f32x4& a, const f32x4& b) {
    u32x4 w; w.x = pk2(a[0], a[1]); w.y = pk2(a[2], a[3]); w.z = pk2(b[0], b[1]); w.w = pk2(b[2], b[3]); return w;
}

struct EpiWin {
    static constexpr bool PERM = true, HEADP = false, WIDE = false, GUP = false;
    bf16_t* A2; bf16_t* BCV;
    __device__ __forceinline__ void operator()(const Acc& acc, const Unit& u, int wr, int wc, int fr, int fq) const {
#pragma unroll
        for (int ai = 0; ai < 2; ++ai)
#pragma unroll
            for (int m = 0; m < 4; ++m) {
                const int row = u.p0 * 256 + 128 * ai + 64 * wr + 16 * m + fr;
#pragma unroll
                for (int bj = 0; bj < 2; ++bj) {
                    const int col0 = u.p1 * 256 + 128 * bj + 32 * wc + 8 * fq;
                    const u32x4 w = pack8(acc[ai][bj][m][0], acc[ai][bj][m][1]);
                    if (u.p1 < 2) {
                        const int g = col0 >> 4, ci0 = col0 & 15, r = row >> 5, s = row & 31;
                        *(u32x4*)(A2 + ((size_t)(g * S5RP + r) * S5K + s * 16 + ci0)) = w;
                    } else {
                        *(u32x4*)(BCV + ((size_t)row * 1536 + (col0 - 512))) = w;
                    }
                }
            }
    }
};
struct EpiS5F {
    static constexpr bool PERM = false, HEADP = false, WIDE = false, GUP = false;
    float* F;
    __device__ __forceinline__ void operator()(const Acc& acc, const Unit& u, int wr, int wc, int fr, int fq) const {
#pragma unroll
        for (int ai = 0; ai < 2; ++ai)
#pragma unroll
            for (int m = 0; m < 4; ++m) {
                const int row = u.p1 * 256 + 128 * ai + 64 * wr + 16 * m + fr;
                float* rp = F + ((size_t)(u.p0 * S5RP + row) * 256);
#pragma unroll
                for (int bj = 0; bj < 2; ++bj)
#pragma unroll
                    for (int n = 0; n < 2; ++n) *(f32x4*)(rp + 128 * bj + 32 * wc + 16 * n + 4 * fq) = acc[ai][bj][m][n];
            }
    }
};
struct EpiS5Y {
    static constexpr bool PERM = true, HEADP = false, WIDE = false, GUP = false;
    bf16_t* Gb;
    __device__ __forceinline__ void operator()(const Acc& acc, const Unit& u, int wr, int wc, int fr, int fq) const {
#pragma unroll
        for (int ai = 0; ai < 2; ++ai)
#pragma unroll
            for (int m = 0; m < 4; ++m) {
                const int r = u.p1 * 256 + 128 * ai + 64 * wr + 16 * m + fr;
                if (r < S5R) {
#pragma unroll
                    for (int bj = 0; bj < 2; ++bj) {
                        const int col0 = u.p2 * 256 + 128 * bj + 32 * wc + 8 * fq;
                        const int t = col0 >> 4, co0 = col0 & 15;
                        f32x4 a = acc[ai][bj][m][0], b = acc[ai][bj][m][1];
#pragma unroll
                        for (int j = 0; j < 4; ++j) { a[j] = gelu_tanh(a[j]); b[j] = gelu_tanh(b[j]); }
                        *(u32x4*)(Gb + ((size_t)(r * S5T + t) * 512 + u.p0 * 16 + co0)) = pack8(a, b);
                    }
                }
            }
    }
};
struct EpiGlu {
    static constexpr bool PERM = true, HEADP = false, WIDE = false, GUP = false;
    const bf16_t* Gb; const float* bias; bf16_t* Z;
    __device__ __forceinline__ void operator()(const Acc& acc, const Unit& u, int wr, int wc, int fr, int fq) const {
#pragma unroll
        for (int ai = 0; ai < 2; ++ai)
#pragma unroll
            for (int m = 0; m < 4; ++m) {
                const int row = u.p0 * 256 + 128 * ai + 64 * wr + 16 * m + fr;
#pragma unroll
                for (int bj = 0; bj < 2; ++bj) {
                    const int col0 = u.p1 * 256 + 128 * bj + 32 * wc + 8 * fq;
                    const u32x4 gv = *(const u32x4*)(Gb + ((size_t)row * 512 + col0));
                    const f32x4 b0 = *(const f32x4*)(bias + col0), b1 = *(const f32x4*)(bias + col0 + 4);
                    f32x4 a = acc[ai][bj][m][0] + b0, b = acc[ai][bj][m][1] + b1;
                    a[0] = bflo(gv.x) * sigmoidf_(a[0]); a[1] = bfhi(gv.x) * sigmoidf_(a[1]); a[2] = bflo(gv.y) * sigmoidf_(a[2]); a[3] = bfhi(gv.y) * sigmoidf_(a[3]);
                    b[0] = bflo(gv.z) * sigmoidf_(b[0]); b[1] = bfhi(gv.z) * sigmoidf_(b[1]); b[2] = bflo(gv.w) * sigmoidf_(b[2]); b[3] = bfhi(gv.w) * sigmoidf_(b[3]);
                    *(u32x4*)(Z + ((size_t)row * 1024 + col0)) = pack8(a, b);
                }
            }
    }
};
template <bool SRCF32>
struct EpiResid {
    static constexpr bool PERM = true, HEADP = false, WIDE = true, GUP = false;
    const float* xlat; const float* xctx;
    const float* gate;
    bf16_t* XR; float rs;
    __device__ __forceinline__ void operator()(const Acc& acc, const Unit& u, int wr, int wc, int fr, int fq) const {
#pragma unroll
        for (int ai = 0; ai < 2; ++ai)
#pragma unroll
            for (int m = 0; m < 4; ++m) {
                const int row = u.p0 * 256 + 128 * ai + 64 * wr + 16 * m + fr;
                const int b = row < NLAT ? (row >> 11) : 8;
                const int col = u.p1 * 256 + 64 * wc + 16 * fq;
                const float* gp = gate + b * 6144 + col;
                f32x4 xv[4];
                if (SRCF32) {
                    const float* src = (row < NLAT ? xlat + (size_t)row * DM : xctx + (size_t)(row - NLAT) * DM) + col;
#pragma unroll
                    for (int q = 0; q < 4; ++q) xv[q] = *(const f32x4*)(src + 4 * q);
                } else {
                    const u32x4 a = *(const u32x4*)(XR + (size_t)row * DM + col), c = *(const u32x4*)(XR + (size_t)row * DM + col + 8);
                    xv[0] = (f32x4){bflo(a.x), bfhi(a.x), bflo(a.y), bfhi(a.y)}; xv[1] = (f32x4){bflo(a.z), bfhi(a.z), bflo(a.w), bfhi(a.w)};
                    xv[2] = (f32x4){bflo(c.x), bfhi(c.x), bflo(c.y), bfhi(c.y)}; xv[3] = (f32x4){bflo(c.z), bfhi(c.z), bflo(c.w), bfhi(c.w)};
                }
                const f32x4 o0 = xv[0] + *(const f32x4*)(gp) * (acc[ai][0][m][0] * rs), o1 = xv[1] + *(const f32x4*)(gp + 4) * (acc[ai][0][m][1] * rs);
                const f32x4 o2 = xv[2] + *(const f32x4*)(gp + 8) * (acc[ai][1][m][0] * rs), o3 = xv[3] + *(const f32x4*)(gp + 12) * (acc[ai][1][m][1] * rs);
                *(u32x4*)(XR + (size_t)row * DM + col) = pack8(o0, o1); *(u32x4*)(XR + (size_t)row * DM + col + 8) = pack8(o2, o3);
            }
    }
};
struct EpiGU {
    static constexpr bool PERM = false, HEADP = false, WIDE = false, GUP = true;
    bf16_t* ACT;
    __device__ __forceinline__ void operator()(const Acc& acc, const Unit& u, int wr, int wc, int fr, int fq) const {
#pragma unroll
        for (int ai = 0; ai < 2; ++ai)
#pragma unroll
            for (int m = 0; m < 4; ++m) {
                const int slot = u.p0 * 256 + 128 * ai + 64 * wr + 16 * m + fr;
                u32x4 o;
#pragma unroll
                for (int bj = 0; bj < 2; ++bj) {
                    const f32x4 g = acc[ai][bj][m][0], up = acc[ai][bj][m][1];
                    o[2 * bj] = pk2(siluf_(g[0]) * up[0], siluf_(g[1]) * up[1]); o[2 * bj + 1] = pk2(siluf_(g[2]) * up[2], siluf_(g[3]) * up[3]);
                }
                *(u32x4*)(ACT + ((size_t)slot * EDIM + u.p1 * 128 + 32 * wc + 8 * fq)) = o;
            }
    }
};
__device__ __forceinline__ float fp8c(float v) { return __builtin_amdgcn_fmed3f(v * 16.f, -440.f, 440.f); }
__device__ __forceinline__ u32x2 pack8_fp8(const f32x4& a, const f32x4& b) {
    int w0 = 0, w1 = 0;
    w0 = __builtin_amdgcn_cvt_pk_fp8_f32(fp8c(a[0]), fp8c(a[1]), w0, false); w0 = __builtin_amdgcn_cvt_pk_fp8_f32(fp8c(a[2]), fp8c(a[3]), w0, true);
    w1 = __builtin_amdgcn_cvt_pk_fp8_f32(fp8c(b[0]), fp8c(b[1]), w1, false); w1 = __builtin_amdgcn_cvt_pk_fp8_f32(fp8c(b[2]), fp8c(b[3]), w1, true);
    return (u32x2){(unsigned)w0, (unsigned)w1};
}
struct EpiDN {
    static constexpr bool PERM = true, HEADP = false, WIDE = true, GUP = false;
    unsigned char* Y;
    __device__ __forceinline__ void operator()(const Acc& acc, const Unit& u, int wr, int wc, int fr, int fq) const {
#pragma unroll
        for (int ai = 0; ai < 2; ++ai)
#pragma unroll
            for (int m = 0; m < 4; ++m) {
                const int slot = u.p0 * 256 + 128 * ai + 64 * wr + 16 * m + fr;
                const u32x2 lo = pack8_fp8(acc[ai][0][m][0], acc[ai][0][m][1]), hi = pack8_fp8(acc[ai][1][m][0], acc[ai][1][m][1]);
                *(u32x4*)(Y + ((size_t)slot * 1024 + u.p1 * 256 + 64 * wc + 16 * fq)) = (u32x4){lo.x, lo.y, hi.x, hi.y};
            }
    }
};
struct EpiQKV {
    static constexpr bool PERM = true, HEADP = true, WIDE = false, GUP = false;
    bf16_t* Q; bf16_t* Kb; bf16_t* VT; const float* qg; const float* kg;
    __device__ __forceinline__ void operator()(const Acc& acc, const Unit& u, int wr, int wc, int fr, int fq) const {
        const int region = u.p1 >> 2;
        if (region < 2) {
            const float* gp = (region == 0 ? qg : kg) + 8 * fq; const float gs = region == 0 ? 0.125f * 1.4426950408889634f : 1.f;
            f32x4 g[2][2];
#pragma unroll
            for (int bj = 0; bj < 2; ++bj)
#pragma unroll
                for (int n = 0; n < 2; ++n) g[bj][n] = *(const f32x4*)(gp + 32 * bj + 4 * n) * gs;
            bf16_t* dst = region == 0 ? Q : Kb;
#pragma unroll
            for (int ai = 0; ai < 2; ++ai)
#pragma unroll
                for (int m = 0; m < 4; ++m) {
                    const int row = u.p0 * 256 + 128 * ai + 64 * wr + 16 * m + fr;
                    float ss = 0.f;
#pragma unroll
                    for (int bj = 0; bj < 2; ++bj)
#pragma unroll
                        for (int n = 0; n < 2; ++n) { const f32x4 v = acc[ai][bj][m][n]; ss += (v[0] * v[0] + v[1] * v[1]) + (v[2] * v[2] + v[3] * v[3]); }
                    ss += __shfl_xor(ss, 16); ss += __shfl_xor(ss, 32);
                    const float rstd = rsqrtf(ss * (1.f / 64.f) + 1e-6f);
                    bf16_t* rp = dst + ((size_t)row * DM + (u.p1 & 3) * 256 + 64 * wc + 8 * fq);
#pragma unroll
                    for (int bj = 0; bj < 2; ++bj) *(u32x4*)(rp + 32 * bj) = pack8(acc[ai][bj][m][0] * rstd * g[bj][0], acc[ai][bj][m][1] * rstd * g[bj][1]);
                }
        } else {
#pragma unroll
            for (int ai = 0; ai < 2; ++ai)
#pragma unroll
                for (int m = 0; m < 4; ++m) {
                    const int row = u.p0 * 256 + 128 * ai + 64 * wr + 16 * m + fr;
                    bf16_t* rp = VT + ((size_t)row * DM + (u.p1 & 3) * 256 + 64 * wc + 8 * fq);
#pragma unroll
                    for (int bj = 0; bj < 2; ++bj) *(u32x4*)(rp + 32 * bj) = pack8(acc[ai][bj][m][0], acc[ai][bj][m][1]);
                }
        }
    }
};

struct Ctx { int tid, lane, wave, G, blk, gw, NGW; LAS unsigned char* lds; };
__device__ __forceinline__ Ctx mkctx(LAS unsigned char* lds, int wave0) {
    Ctx X; X.lane = lane_id_opaque(); X.wave = wave0; X.tid = wave0 * 64 + X.lane; X.G = gridDim.x; X.blk = blockIdx.x;
    X.gw = X.blk * 8 + X.wave; X.NGW = X.G * 8; X.lds = lds; return X;
}

template <int MODE> __device__ __forceinline__ int wrow(int n) { return MODE == 2 ? 256 + n : n; }
template <int MODE>
__device__ __forceinline__ void conv_item(const float* W, int N, bf16_t* WT, int ldk, int k0, int n0, LAS unsigned* T, int lane) {
    (void)T;
    const int nq = lane & 15, kg = lane >> 4;
    const float* wp = W + (size_t)(k0 + 16 * kg) * N + n0 + 4 * nq;
    f32x4 r[16];
#pragma unroll
    for (int i = 0; i < 16; ++i) r[i] = *(const f32x4*)(wp + (size_t)i * N);
#pragma unroll
    for (int j = 0; j < 4; ++j) {
        bf16_t* op = WT + (size_t)wrow<MODE>(n0 + 4 * nq + j) * ldk + k0 + 16 * kg;
        u32x4 lo, hi;
        lo.x = pk2(r[0][j], r[1][j]); lo.y = pk2(r[2][j], r[3][j]); lo.z = pk2(r[4][j], r[5][j]); lo.w = pk2(r[6][j], r[7][j]);
        hi.x = pk2(r[8][j], r[9][j]); hi.y = pk2(r[10][j], r[11][j]); hi.z = pk2(r[12][j], r[13][j]); hi.w = pk2(r[14][j], r[15][j]);
        *(u32x4*)op = lo; *(u32x4*)(op + 8) = hi;
    }
}
__device__ __forceinline__ void conv_mat(const Ctx& X, const float* W, int K, int N, bf16_t* WT, int& rot) {
    LAS unsigned* T = (LAS unsigned*)(X.lds + X.wave * 8192);
    const int nb = N / 64, nitems = (K / 64) * nb;
    int start = X.gw - rot; while (start < 0) start += X.NGW;
    for (int it = start; it < nitems; it += X.NGW) conv_item<0>(W, N, WT, K, (it / nb) * 64, (it % nb) * 64, T, X.lane);
    rot = (rot + nitems) % X.NGW;
}
template <int KIND>
__device__ __forceinline__ void conv_moe_items(const Ctx& X, const Params& p, int l, bf16_t* GU, bf16_t* DN, int it0, int it1, int rank, int nrank) {
    constexpr int PER = KIND == 0 ? 192 : (KIND == 1 ? 128 : 64);
    for (int it = it0 + rank * 8 + X.wave; it < it1; it += nrank * 8) {
        const int e = it / PER, r = it % PER, kind = KIND == 2 ? 2 : (r >> 6), q = r & 63;
        if (kind == 0) {
            const float* W = e < NEXP ? p.in[I_MG] + (size_t)(l * NEXP + e) * 262144 : p.in[I_SG] + (size_t)l * 262144;
            conv_item<1>(W, 256, GU + (size_t)e * 512 * 1024, 1024, (q >> 2) * 64, (q & 3) * 64, nullptr, X.lane);
        } else if (kind == 1) {
            const float* W = e < NEXP ? p.in[I_MU] + (size_t)(l * NEXP + e) * 262144 : p.in[I_SU] + (size_t)l * 262144;
            conv_item<2>(W, 256, GU + (size_t)e * 512 * 1024, 1024, (q >> 2) * 64, (q & 3) * 64, nullptr, X.lane);
        } else {
            const float* W = e < NEXP ? p.in[I_MD] + (size_t)(l * NEXP + e) * 262144 : p.in[I_SD] + (size_t)l * 262144;
            conv_item<0>(W, 1024, DN + (size_t)e * 1024 * 256, 256, (q >> 4) * 64, (q & 15) * 64, nullptr, X.lane);
        }
    }
}
__device__ __forceinline__ int moe_idle_rank(int ntiles, int nN, int G, int blk, int& nidle) {
    if ((G & 7) != 0) { const int nunits = ntiles * nN, nfull = nunits % G; if (nfull == 0) { nidle = G; return blk; } nidle = G - nfull; return blk >= nfull ? blk - nfull : -1; }
    const int B8 = G >> 3, q = ntiles >> 3, r = ntiles & 7;
    int maxc = 0;
    for (int x = 0; x < 8; ++x) { const int n = (q + (x < r ? 1 : 0)) * nN; const int cmax = (n + B8 - 1) / B8; maxc = cmax > maxc ? cmax : maxc; }
    int rank = -1, cnt = 0;
    for (int x = 0; x < 8; ++x) {
        const int n = (q + (x < r ? 1 : 0)) * nN;
        int jfull = n - (maxc - 1) * B8; jfull = jfull < 0 ? 0 : (jfull > B8 ? B8 : jfull);
        if (x == (blk & 7)) { const int j = blk >> 3; if (j >= jfull) rank = cnt + (j - jfull); }
        cnt += B8 - jfull;
    }
    if (cnt == 0) { nidle = G; return blk; }
    nidle = cnt; return rank;
}
__device__ __forceinline__ int idle_rank(int nunits, int G, int blk, int& nidle) {
    const int nfull = nunits % G;
    if (nfull == 0) { nidle = G; return blk; }
    nidle = G - nfull; return blk >= nfull ? blk - nfull : -1;
}

__device__ __forceinline__ void sincos_red(float x, float& s, float& c) {
    const float n = rintf(x * 0.15915494309189535f);
    float r = fmaf(-n, 6.28125f, x); r = fmaf(-n, 1.9353071795864769e-3f, r);
    s = __sinf(r); c = __cosf(r);
}

__device__ __forceinline__ void phase_p0a(const Ctx& X, const Params& p) {
    {
        LAS float* PWs = (LAS float*)(X.lds);
        LAS float* BBs = (LAS float*)(X.lds + 20480);
        LAS float* CCs = (LAS float*)(X.lds + 32768);
        float* KK = (float*)(p.ws + WS_KK); float* PWG = (float*)(p.ws + WS_PW); float* BBG = (float*)(p.ws + WS_BB);
        for (int item = X.blk; item < 256; item += X.G) {
            const int g = item >> 3, d = (item >> 2) & 1, lq = item & 3, gd = d * 32 + g;
            const float dt = expf(p.in[I_LDT][gd]);
            __syncthreads();
            for (int idx = X.tid; idx < 33 * 64; idx += 512) {
                const int j = idx >> 6, pp = idx & 63;
                const float lre = fminf(p.in[I_ARE][gd * 64 + pp], -1e-4f), lim = p.in[I_AIM][gd * 64 + pp];
                const float mag = expf(lre * dt * (float)j); float sn, cs; sincos_red(lim * dt * (float)j, sn, cs);
                PWs[2 * idx] = mag * cs; PWs[2 * idx + 1] = mag * sn;
            }
            for (int idx = X.tid; idx < 1024; idx += 512) {
                const int pp = idx >> 4;
                const float lre = fminf(p.in[I_ARE][gd * 64 + pp], -1e-4f), lim = p.in[I_AIM][gd * 64 + pp];
                const float mag = expf(lre * dt); float sn, cs; sincos_red(lim * dt, sn, cs);
                const float nr = mag * cs - 1.f, ni = mag * sn, den = 1.f / (lre * lre + lim * lim);
                const float cr = (nr * lre + ni * lim) * den, ci = (ni * lre - nr * lim) * den;
                const float br = p.in[I_BRE][(size_t)gd * 1024 + idx], bi = p.in[I_BIM][(size_t)gd * 1024 + idx];
                BBs[2 * idx] = cr * br - ci * bi; BBs[2 * idx + 1] = cr * bi + ci * br;
            }
            for (int idx = X.tid; idx < 1024; idx += 512) { CCs[2 * idx] = p.in[I_CRE][(size_t)gd * 1024 + idx]; CCs[2 * idx + 1] = p.in[I_CIM][(size_t)gd * 1024 + idx]; }
            __syncthreads();
#pragma unroll
            for (int i = 0; i < 4; ++i) {
                const int e = X.tid + 512 * i, lag = 8 * lq + (e >> 8), co = (e >> 4) & 15, ci = e & 15;
                float sum = 0.f;
                for (int pp = 0; pp < 64; ++pp) {
                    const float pr = PWs[2 * (lag * 64 + pp)], pi = PWs[2 * (lag * 64 + pp) + 1];
                    const float br = BBs[2 * (pp * 16 + ci)], bi = BBs[2 * (pp * 16 + ci) + 1];
                    const float tr = pr * br - pi * bi, ti = pr * bi + pi * br;
                    sum += CCs[2 * (co * 64 + pp)] * tr - CCs[2 * (co * 64 + pp) + 1] * ti;
                }
                KK[(size_t)((g * 2 + d) * 32 + lag) * 256 + co * 16 + ci] = sum;
            }
            if (lq == 0) {
                for (int idx = X.tid; idx < 33 * 64 * 2; idx += 512) PWG[(size_t)(g * 2 + d) * 33 * 64 * 2 + idx] = PWs[idx];
                for (int idx = X.tid; idx < 2048; idx += 512) BBG[(size_t)(g * 2 + d) * 2048 + idx] = BBs[idx];
            }
        }
        __syncthreads();
    }
    {
        LAS float* condS = (LAS float*)(X.lds + 65536);
        for (int i = X.tid; i < 9 * 1024; i += 512) { const int r = i >> 10, k = i & 1023; const float v = r < 8 ? p.in[I_C][r * 1024 + k] : p.in[I_CCTX][k]; condS[i] = siluf_(v); }
        __syncthreads();
        float* ADAP = (float*)(p.ws + WS_ADAP);
        for (int it = X.gw; it < 3072; it += X.NGW) {
            const int l = it / 1536, rem = it % 1536, cg = rem >> 4, kq = rem & 15, col = cg * 64 + X.lane;
            const float* wp = p.in[I_ADAW] + (size_t)l * 1024 * 6144 + (size_t)(kq * 64) * 6144 + col;
            float a0 = 0, a1 = 0, a2 = 0, a3 = 0, a4 = 0, a5 = 0, a6 = 0, a7 = 0, a8 = 0;
            float wv[64];
#pragma unroll
            for (int kk = 0; kk < 64; ++kk) wv[kk] = wp[(size_t)kk * 6144];
#pragma unroll
            for (int kk = 0; kk < 64; ++kk) {
                const float w = wv[kk]; const LAS float* cp = condS + kq * 64 + kk;
                a0 += cp[0] * w; a1 += cp[1024] * w; a2 += cp[2048] * w; a3 += cp[3072] * w; a4 += cp[4096] * w; a5 += cp[5120] * w; a6 += cp[6144] * w; a7 += cp[7168] * w; a8 += cp[8192] * w;
            }
            float* op = ADAP + (size_t)((kq * 2 + l) * 9) * 6144 + col;
            op[0] = a0; op[6144] = a1; op[2 * 6144] = a2; op[3 * 6144] = a3; op[4 * 6144] = a4; op[5 * 6144] = a5; op[6 * 6144] = a6; op[7 * 6144] = a7; op[8 * 6144] = a8;
        }
        __syncthreads();
    }
    {
        int rot = 0;
        conv_mat(X, p.in[I_WIN], 1024, 2048, (bf16_t*)(p.ws + WS_WIN), rot);
        conv_mat(X, p.in[I_GLUW], 512, 512, (bf16_t*)(p.ws + WS_GLU), rot);
        conv_mat(X, p.in[I_HOUT], 1024, 1024, (bf16_t*)(p.ws + WS_HOUT), rot);
        conv_mat(X, p.in[I_WQKV], 1024, 3072, (bf16_t*)(p.ws + WS_QKV), rot);
        conv_mat(X, p.in[I_NOUT], 1024, 1024, (bf16_t*)(p.ws + WS_NOUT), rot);
        conv_mat(X, p.in[I_RW], 1024, 64, (bf16_t*)(p.ws + WS_ROUT), rot);
        conv_mat(X, p.in[I_RW] + 65536, 1024, 64, (bf16_t*)(p.ws + WS_ROUT) + 256 * 1024, rot);
        for (int i = X.gw * 64 + X.lane; i < 2 * 192 * 128; i += X.NGW * 64) {
            const int l = i / (192 * 128), r = i % (192 * 128);
            *(u32x4*)((bf16_t*)(p.ws + WS_ROUT) + (size_t)l * 256 * 1024 + 64 * 1024 + (size_t)r * 8) = (u32x4){0u, 0u, 0u, 0u};
        }
    }
}

__device__ __forceinline__ void phase_p0b(const Ctx& X, const Params& p) {
    const int gt = X.blk * 512 + X.tid, NT = X.G * 512;
    float* MOD = (float*)(p.ws + WS_MOD); const float* ADAP = (const float*)(p.ws + WS_ADAP);
    for (int idx = gt; idx < 2 * 9 * 6144; idx += NT) {
        const int l = idx / (9 * 6144), col = idx % 6144;
        float s = p.in[I_ADAB][l * 6144 + col];
#pragma unroll
        for (int kq = 0; kq < 16; ++kq) s += ADAP[(size_t)kq * 110592 + idx];
        MOD[idx] = s;
    }
    const float* KK = (const float*)(p.ws + WS_KK); const float* PWG = (const float*)(p.ws + WS_PW); const float* BBG = (const float*)(p.ws + WS_BB);
    bf16_t* ME = (bf16_t*)(p.ws + WS_ME); bf16_t* WF = (bf16_t*)(p.ws + WS_WF);
    for (int ch = gt; ch < 32 * 512 * 96; ch += NT) {
        const int kc = ch % 96, n = (ch / 96) & 511, g = ch / (96 * 512), t = n >> 4, co = n & 15, k0 = kc * 8;
        float v[8];
        if (k0 < 512) {
            const int s_ = k0 >> 4, ci0 = k0 & 15;
            const int lf = t - s_, lb = s_ - t; const float mf = lf >= 0 ? 1.f : 0.f, mb = lb >= 0 ? 1.f : 0.f;
            const float* kf = KK + (size_t)((g * 2 + 0) * 32 + (lf >= 0 ? lf : 0)) * 256 + co * 16 + ci0;
            const float* kb = KK + (size_t)((g * 2 + 1) * 32 + (lb >= 0 ? lb : 0)) * 256 + co * 16 + ci0;
            const f32x4 f0 = *(const f32x4*)kf, f1 = *(const f32x4*)(kf + 4), b0 = *(const f32x4*)kb, b1 = *(const f32x4*)(kb + 4);
            const float dsk = p.in[I_S5D][16 * g + co];
#pragma unroll
            for (int j = 0; j < 4; ++j) {
                v[j] = f0[j] * mf + b0[j] * mb + ((s_ == t && ci0 + j == co) ? dsk : 0.f);
                v[4 + j] = f1[j] * mf + b1[j] * mb + ((s_ == t && ci0 + 4 + j == co) ? dsk : 0.f);
            }
        } else {
            const int kk = k0 - 512, d = kk >> 7, ri = (kk >> 6) & 1, p0 = kk & 63, jj = d == 0 ? t + 1 : 32 - t;
            const float* pw = PWG + ((size_t)((g * 2 + d) * 33 + jj) * 64 + p0) * 2;
            const float* crp = p.in[I_CRE] + (size_t)((d * 32 + g) * 16 + co) * 64 + p0; const float* cip = p.in[I_CIM] + (size_t)((d * 32 + g) * 16 + co) * 64 + p0;
            f32x4 pq[4];
#pragma unroll
            for (int q = 0; q < 4; ++q) pq[q] = *(const f32x4*)(pw + 4 * q);
            const f32x4 cr0 = *(const f32x4*)crp, cr1 = *(const f32x4*)(crp + 4), ci0v = *(const f32x4*)cip, ci1v = *(const f32x4*)(cip + 4);
#pragma unroll
            for (int j = 0; j < 8; ++j) {
                const float pr = pq[j >> 1][(j & 1) * 2], pi = pq[j >> 1][(j & 1) * 2 + 1];
                const float cr = j < 4 ? cr0[j & 3] : cr1[j & 3], cim = j < 4 ? ci0v[j & 3] : ci1v[j & 3];
                const float zr = cr * pr - cim * pi, zi = cr * pi + cim * pr;
                v[j] = ri == 0 ? zr : -zi;
            }
        }
        u32x4 w; w.x = pk2(v[0], v[1]); w.y = pk2(v[2], v[3]); w.z = pk2(v[4], v[5]); w.w = pk2(v[6], v[7]);
        *(u32x4*)(ME + ((size_t)(g * 512 + n)) * 768 + k0) = w;
    }
    for (int ch = gt; ch < 32 * 256 * 64; ch += NT) {
        const int kc = ch & 63, n = (ch >> 6) & 255, g = ch >> 14, d = n >> 7, ri = (n >> 6) & 1, pp = n & 63, k0 = kc * 8, s_ = k0 >> 4, ci0 = k0 & 15;
        const int jj = d == 0 ? 31 - s_ : s_;
        const float pr = PWG[((size_t)((g * 2 + d) * 33 + jj) * 64 + pp) * 2], pi = PWG[((size_t)((g * 2 + d) * 33 + jj) * 64 + pp) * 2 + 1];
        const float* bb = BBG + ((size_t)(g * 2 + d) * 1024 + pp * 16 + ci0) * 2;
        f32x4 bq[4];
#pragma unroll
        for (int q = 0; q < 4; ++q) bq[q] = *(const f32x4*)(bb + 4 * q);
        float v[8];
#pragma unroll
        for (int j = 0; j < 8; ++j) {
            const float br = bq[j >> 1][(j & 1) * 2], bi = bq[j >> 1][(j & 1) * 2 + 1];
            v[j] = ri == 0 ? (pr * br - pi * bi) : (pr * bi + pi * br);
        }
        u32x4 w; w.x = pk2(v[0], v[1]); w.y = pk2(v[2], v[3]); w.z = pk2(v[4], v[5]); w.w = pk2(v[6], v[7]);
        *(u32x4*)(WF + ((size_t)(g * 256 + n)) * 512 + k0) = w;
    }
}

template <int SRC>
__device__ __forceinline__ void norm_load(const Params& p, int row, int lane, f32x4 (&v)[4]) {
    if (SRC == 0) {
        const float* src = (row < NLAT ? p.in[I_X] + (size_t)row * DM : p.in[I_CTX] + (size_t)(row - NLAT) * DM) + 8 * lane;
        v[0] = *(const f32x4*)(src); v[1] = *(const f32x4*)(src + 4); v[2] = *(const f32x4*)(src + 512); v[3] = *(const f32x4*)(src + 516);
    } else {
        const bf16_t* src = (const bf16_t*)(p.ws + WS_XR) + (size_t)row * DM + 8 * lane;
        const u32x4 a = *(const u32x4*)(src), c = *(const u32x4*)(src + 512);
        v[0] = (f32x4){bflo(a.x), bfhi(a.x), bflo(a.y), bfhi(a.y)}; v[1] = (f32x4){bflo(a.z), bfhi(a.z), bflo(a.w), bfhi(a.w)};
        v[2] = (f32x4){bflo(c.x), bfhi(c.x), bflo(c.y), bfhi(c.y)}; v[3] = (f32x4){bflo(c.z), bfhi(c.z), bflo(c.w), bfhi(c.w)};
    }
}
template <int SRC>
__device__ __forceinline__ void phase_norm(const Ctx& X, const Params& p, int l, int ffn, int ntok) {
    const float* gain = (ffn ? p.in[I_NFG] : p.in[I_NMG]) + l * 1024;
    const float* mod = (const float*)(p.ws + WS_MOD) + (size_t)l * 9 * 6144;
    const int shi = ffn ? 3 : 0, sci = ffn ? 4 : 1;
    bf16_t* XA = (bf16_t*)(p.ws + WS_XA);
    const int rpw = (ntok + X.NGW - 1) / X.NGW, r0 = X.gw * rpw, r1 = (r0 + rpw) < ntok ? (r0 + rpw) : ntok;
    int curb = -1; f32x4 gm[4], sh[4];
    f32x4 vn[4];
    if (r0 < r1) norm_load<SRC>(p, r0, X.lane, vn);
    for (int row = r0; row < r1; ++row) {
        const int b = row < NLAT ? (row >> 11) : 8;
        if (b != curb) {
            curb = b;
#pragma unroll
            for (int j = 0; j < 4; ++j) {
                const int c = 8 * X.lane + 512 * (j >> 1) + 4 * (j & 1);
                const f32x4 g4 = *(const f32x4*)(gain + c), sc4 = *(const f32x4*)(mod + b * 6144 + sci * 1024 + c);
                sh[j] = *(const f32x4*)(mod + b * 6144 + shi * 1024 + c); gm[j] = g4 * (sc4 + 1.f);
            }
        }
        f32x4 v[4]; float ss = 0.f;
#pragma unroll
        for (int j = 0; j < 4; ++j) v[j] = vn[j];
        if (row + 1 < r1) norm_load<SRC>(p, row + 1, X.lane, vn);
#pragma unroll
        for (int j = 0; j < 4; ++j) ss += (v[j][0] * v[j][0] + v[j][1] * v[j][1]) + (v[j][2] * v[j][2] + v[j][3] * v[j][3]);
        const float rstd = rsqrtf(wave_sum(ss) * (1.f / 1024.f) + 1e-6f);
        const f32x4 o0 = v[0] * rstd * gm[0] + sh[0], o1 = v[1] * rstd * gm[1] + sh[1], o2 = v[2] * rstd * gm[2] + sh[2], o3 = v[3] * rstd * gm[3] + sh[3];
        *(u32x4*)(XA + (size_t)row * DM + 8 * X.lane) = pack8(o0, o1); *(u32x4*)(XA + (size_t)row * DM + 512 + 8 * X.lane) = pack8(o2, o3);
    }
}

__device__ __forceinline__ void phase_scan_conv(const Ctx& X, const Params& p) {
    const float* F = (const float*)(p.ws + WS_F); bf16_t* A2 = (bf16_t*)(p.ws + WS_A2); const float* PWG = (const float*)(p.ws + WS_PW);
    for (int gid = X.blk * 512 + X.tid; gid < 32768; gid += X.G * 512) {
        const int pp = gid & 63, d = (gid >> 6) & 1, g = (gid >> 7) & 31, b = gid >> 12;
        const float ar = PWG[((size_t)((g * 2 + d) * 33 + 32) * 64 + pp) * 2], ai = PWG[((size_t)((g * 2 + d) * 33 + 32) * 64 + pp) * 2 + 1];
        float sr = 0.f, si = 0.f;
        for (int s8 = 0; s8 < 72; s8 += 8) {
            float fr[8], fi[8]; size_t ro[8];
#pragma unroll
            for (int q = 0; q < 8; ++q) {
                const int step = s8 + q; int r;
                if (d == 0) r = step < 8 ? 512 + b * 8 + step : b * 64 + (step - 8);
                else        r = step < 8 ? 512 + b * 8 + (7 - step) : b * 64 + (71 - step);
                ro[q] = (size_t)(g * S5RP + r);
                fr[q] = F[ro[q] * 256 + d * 128 + pp]; fi[q] = F[ro[q] * 256 + d * 128 + 64 + pp];
            }
#pragma unroll
            for (int q = 0; q < 8; ++q) {
                A2[ro[q] * S5K + 512 + d * 128 + pp] = (bf16_t)f2bf(sr); A2[ro[q] * S5K + 512 + d * 128 + 64 + pp] = (bf16_t)f2bf(si);
                const float nr = ar * sr - ai * si + fr[q], ni = ar * si + ai * sr + fi[q];
                sr = nr; si = ni;
            }
        }
    }
    const bf16_t* BCV = (const bf16_t*)(p.ws + WS_BCV); bf16_t* Z = (bf16_t*)(p.ws + WS_Z); const float* cw = p.in[I_CONVW];
    for (int it = X.blk * 512 + X.tid; it < NTOK * 64; it += X.G * 512) {
        const int tok = it >> 6, c0 = (it & 63) * 8;
        const int pos = tok < NLAT ? (tok & 2047) : ((tok - NLAT) & 255), len = tok < NLAT ? 2048 : 256;
        const bf16_t* base = BCV + (size_t)tok * 1536;
        const u32x4 bg = *(const u32x4*)(base + c0), cg1 = *(const u32x4*)(base + 512 + c0), v1 = *(const u32x4*)(base + 1024 + c0);
        u32x4 cg0 = (u32x4){0u, 0u, 0u, 0u}, v0 = cg0, cg2 = cg0, v2 = cg0;
        if (pos > 0) { cg0 = *(const u32x4*)(base - 1536 + 512 + c0); v0 = *(const u32x4*)(base - 1536 + 1024 + c0); }
        if (pos < len - 1) { cg2 = *(const u32x4*)(base + 1536 + 512 + c0); v2 = *(const u32x4*)(base + 1536 + 1024 + c0); }
        float o[8];
#pragma unroll
        for (int j = 0; j < 4; ++j) {
            const float w0a = cw[c0 + 2 * j], w1a = cw[512 + c0 + 2 * j], w2a = cw[1024 + c0 + 2 * j];
            const float w0b = cw[c0 + 2 * j + 1], w1b = cw[512 + c0 + 2 * j + 1], w2b = cw[1024 + c0 + 2 * j + 1];
            o[2 * j] = bflo(bg[j]) * (w0a * bflo(cg0[j]) * bflo(v0[j]) + w1a * bflo(cg1[j]) * bflo(v1[j]) + w2a * bflo(cg2[j]) * bflo(v2[j]));
            o[2 * j + 1] = bfhi(bg[j]) * (w0b * bfhi(cg0[j]) * bfhi(v0[j]) + w1b * bfhi(cg1[j]) * bfhi(v1[j]) + w2b * bfhi(cg2[j]) * bfhi(v2[j]));
        }
        u32x4 w; w.x = pk2(o[0], o[1]); w.y = pk2(o[2], o[3]); w.z = pk2(o[4], o[5]); w.w = pk2(o[6], o[7]);
        *(u32x4*)(Z + (size_t)tok * 1024 + 512 + c0) = w;
    }
}

constexpr int RR_MAXT = 96, RR_KC = 256, RR_PITCH = RR_KC * 2 + 16;
constexpr int RR_A = 0, RR_B = RR_MAXT * RR_PITCH, RR_LG = RR_B + 64 * RR_PITCH;
__device__ __forceinline__ void phase_route(const Ctx& X, const Params& p, int l, int ntok) {
    LAS int* cnt = (LAS int*)(X.lds + MISC_OFF + M_CNT);
    if (X.tid < NEXP1) cnt[X.tid] = 0;
    const bf16_t* XA = (const bf16_t*)(p.ws + WS_XA); const bf16_t* RT = (const bf16_t*)(p.ws + WS_ROUT) + (size_t)l * 256 * 1024;
    int* toke = (int*)(p.ws + WS_TOKE); float* tokw = (float*)(p.ws + WS_TOKW); int* tokp = (int*)(p.ws + WS_TOKP);
    const float rb = p.in[I_RB][l * 64 + X.lane];
    const int tpb = (ntok + X.G - 1) / X.G, t0 = X.blk * tpb, t1 = (t0 + tpb) < ntok ? (t0 + tpb) : ntok, nrow = t1 - t0;
    const int lane = X.lane, grp = lane >> 3, fr = lane & 15, fq = lane >> 4;
    const int nt_ = X.wave & 3, mh = X.wave >> 2;
    f32x4 acc[3];
#pragma unroll
    for (int m = 0; m < 3; ++m) acc[m] = (f32x4){0.f, 0.f, 0.f, 0.f};
    u32x4 va[6], vb[4];
#define RR_LOAD(kc_) do { \
        _Pragma("unroll") for (int q = 0; q < 6; ++q) { const int i = X.tid + 512 * q, r = i >> 5, c = i & 31; const int rr = r < nrow ? r : 0; \
            va[q] = *(const u32x4*)(XA + (size_t)(t0 + rr) * DM + (kc_) + 8 * c); if (r >= nrow) va[q] = (u32x4){0u, 0u, 0u, 0u}; } \
        _Pragma("unroll") for (int q = 0; q < 4; ++q) { const int i = X.tid + 512 * q, r = i >> 5, c = i & 31; vb[q] = *(const u32x4*)(RT + (size_t)r * 1024 + (kc_) + 8 * c); } } while (0)
    RR_LOAD(0);
    for (int kc = 0; kc < 1024; kc += RR_KC) {
        __syncthreads();
#pragma unroll
        for (int q = 0; q < 6; ++q) { const int i = X.tid + 512 * q, r = i >> 5, c = i & 31; *(LAS u32x4*)(X.lds + RR_A + r * RR_PITCH + 16 * c) = va[q]; }
#pragma unroll
        for (int q = 0; q < 4; ++q) { const int i = X.tid + 512 * q, r = i >> 5, c = i & 31; *(LAS u32x4*)(X.lds + RR_B + r * RR_PITCH + 16 * c) = vb[q]; }
        __syncthreads();
        if (kc + RR_KC < 1024) RR_LOAD(kc + RR_KC);
#pragma unroll
        for (int ks = 0; ks < RR_KC / 32; ++ks) {
            const bf16x8 bfr = *(const LAS bf16x8*)(X.lds + RR_B + (16 * nt_ + fr) * RR_PITCH + 64 * ks + 16 * fq);
#pragma unroll
            for (int m = 0; m < 3; ++m) {
                const bf16x8 afr = *(const LAS bf16x8*)(X.lds + RR_A + (16 * (3 * mh + m) + fr) * RR_PITCH + 64 * ks + 16 * fq);
                acc[m] = __builtin_amdgcn_mfma_f32_16x16x32_bf16(afr, bfr, acc[m], 0, 0, 0);
            }
        }
    }
#undef RR_LOAD
    LAS float* LG = (LAS float*)(X.lds + RR_LG);
#pragma unroll
    for (int m = 0; m < 3; ++m)
#pragma unroll
        for (int j = 0; j < 4; ++j) LG[(16 * (3 * mh + m) + 4 * fq + j) * 64 + 16 * nt_ + fr] = acc[m][j];
    __syncthreads();
    for (int tok = t0 + X.wave; tok < t1; tok += 8) {
        const float score = sigmoidf_(LG[(tok - t0) * 64 + lane]);
        const float sel = score + rb;
        int rk = 0;
#pragma unroll
        for (int x = 1; x < 8; ++x) { const float o = __shfl_xor(sel, x); const int ol = lane ^ x; rk += ((o > sel) || (o == sel && ol < lane)) ? 1 : 0; }
        float gs = rk < 2 ? sel : 0.f;
        gs += __shfl_xor(gs, 1); gs += __shfl_xor(gs, 2); gs += __shfl_xor(gs, 4);
        int grk = 0;
#pragma unroll
        for (int x = 1; x < 8; ++x) { const float o = __shfl_xor(gs, 8 * x); const int og = grp ^ x; grk += ((o > gs) || (o == gs && og < grp)) ? 1 : 0; }
        const float msel = grk < 4 ? sel : -__builtin_inff();
        int rank = 0;
#pragma unroll
        for (int j = 0; j < 64; ++j) { const float sj = __builtin_bit_cast(float, __builtin_amdgcn_readlane(__builtin_bit_cast(int, msel), j)); rank += ((sj > msel) || (sj == msel && j < lane)) ? 1 : 0; }
        const bool chosen = rank < 8;
        const float wsum = wave_sum(chosen ? score : 0.f);
        if (chosen) {
            const int lpos = __hip_atomic_fetch_add(cnt + lane, 1, __ATOMIC_RELAXED, __HIP_MEMORY_SCOPE_WORKGROUP);
            toke[(size_t)tok * 8 + rank] = lane; tokw[(size_t)tok * 8 + rank] = score / wsum * 2.5f; tokp[(size_t)tok * 8 + rank] = lpos;
        }
    }
    __syncthreads();
    int* cntblk = (int*)(p.ws + WS_CNTBLK);
    if (X.tid < NEXP1) cntblk[X.blk * NEXP1 + X.tid] = X.tid < NEXP ? cnt[X.tid] : 0;
}

__device__ __forceinline__ void phase_slots(const Ctx& X, const Params& p, int ntok) {
    LAS int* part = (LAS int*)(X.lds + MISC_OFF + M_PART);
    LAS int* ptot = (LAS int*)(X.lds);
    LAS int* pbb = (LAS int*)(X.lds + 4096);
    LAS int* base = (LAS int*)(X.lds + MISC_OFF + M_BASE);
    LAS int* bbase = (LAS int*)(X.lds + MISC_OFF + M_BBASE);
    LAS int* tot = (LAS int*)(X.lds + 8192);
    LAS int* ntl = (LAS int*)(X.lds + MISC_OFF + M_NT);
    (void)part;
    const int* cntblk = (const int*)(p.ws + WS_CNTBLK);
    {
        const int e = X.tid & 127, pt = X.tid >> 7; int s = 0, sb = 0;
        if (e < NEXP) { const int b0 = (X.G * pt) / 4, b1 = (X.G * (pt + 1)) / 4;
            for (int b = b0; b < b1; ++b) { const int c = cntblk[b * NEXP1 + e]; s += c; sb += (b < X.blk) ? c : 0; } }
        ptot[pt * 128 + e] = s; pbb[pt * 128 + e] = sb;
    }
    __syncthreads();
    if (X.tid < NEXP) { tot[X.tid] = ptot[X.tid] + ptot[128 + X.tid] + ptot[256 + X.tid] + ptot[384 + X.tid]; bbase[X.tid] = pbb[X.tid] + pbb[128 + X.tid] + pbb[256 + X.tid] + pbb[384 + X.tid]; }
    __syncthreads();
    if (X.tid == 0) { int acc = 0; for (int e = 0; e < NEXP; ++e) { base[e] = acc; acc += (tot[e] + 255) & ~255; } base[NEXP] = acc; base[NEXP1] = acc + ntok; ntl[0] = (acc + ntok) >> 8; }
    __syncthreads();
    int* rowidx = (int*)(p.ws + WS_ROWIDX); int* tokslot = (int*)(p.ws + WS_YROW);
    const int* toke = (const int*)(p.ws + WS_TOKE); const int* tokp = (const int*)(p.ws + WS_TOKP);
    const int tpb = (ntok + X.G - 1) / X.G, t0 = X.blk * tpb, t1 = (t0 + tpb) < ntok ? (t0 + tpb) : ntok;
    for (int i = t0 * 8 + X.tid; i < t1 * 8; i += 512) {
        const int e = toke[i]; const int slot = base[e] + bbase[e] + tokp[i];
        rowidx[slot] = i >> 3; tokslot[(i >> 3) * 9 + (i & 7)] = slot;
    }
    const int sbase = base[NEXP];
    for (int tok = X.blk * 512 + X.tid; tok < ntok; tok += X.G * 512) { rowidx[sbase + tok] = tok; tokslot[tok * 9 + 8] = sbase + tok; }
    for (int e = X.blk; e < NEXP; e += X.G)
        for (int s = base[e] + tot[e] + X.tid; s < base[e + 1]; s += 512) rowidx[s] = 0;
    if (X.blk == 0) {
        int* TAB = (int*)(p.ws + WS_TAB);
        if (X.tid == 0) TAB[128] = ntl[0];
        for (int t = X.tid; t < ntl[0]; t += 512) { int e = NEXP; const int s = t * 256; for (int k = 0; k < NEXP; ++k) if (s >= base[k] && s < base[k + 1]) e = k; TAB[256 + t] = e; }
    }
}
__device__ __forceinline__ int load_tiles(const Ctx& X, const Params& p) {
    const int* TAB = (const int*)(p.ws + WS_TAB);
    LAS unsigned char* te = X.lds + MISC_OFF + M_TILE;
    const int nt = TAB[128];
    for (int t = X.tid; t < nt; t += 512) te[t] = (unsigned char)TAB[256 + t];
    __syncthreads();
    return __builtin_amdgcn_readfirstlane(nt);
}

template <bool NEXTNORM>
__device__ __forceinline__ void phase_combine(const Ctx& X, const Params& p, int l, int ntok, bool final_out, float rs) {
    const unsigned char* Y = (const unsigned char*)(p.ws + WS_Y); bf16_t* XR = (bf16_t*)(p.ws + WS_XR);
    const int* tokslot = (const int*)(p.ws + WS_YROW); const float* tokw = (const float*)(p.ws + WS_TOKW);
    const float* gate = (const float*)(p.ws + WS_MOD) + (size_t)l * 9 * 6144 + 5 * 1024;
    const float* gain = p.in[I_NMG] + (l + 1) * 1024; const float* modn = (const float*)(p.ws + WS_MOD) + (size_t)(l + 1) * 9 * 6144;
    bf16_t* XN = (bf16_t*)(p.ws + WS_ACT);
    for (int tok = X.gw; tok < ntok; tok += X.NGW) {
        const int b = tok < NLAT ? (tok >> 11) : 8, c = 16 * X.lane;
        float s[16];
#pragma unroll
        for (int q = 0; q < 16; ++q) s[q] = 0.f;
#pragma unroll
        for (int j = 0; j < 9; ++j) {
            const int slot = __builtin_amdgcn_readfirstlane(tokslot[tok * 9 + j]);
            const float w = j < 8 ? __builtin_bit_cast(float, __builtin_amdgcn_readfirstlane(__builtin_bit_cast(int, tokw[tok * 8 + (j & 7)]))) : 1.f;
            const u32x4 y = *(const u32x4*)(Y + ((size_t)slot * 1024 + c));
#pragma unroll
            for (int q = 0; q < 4; ++q) {
                const f32x2 lo = __builtin_amdgcn_cvt_pk_f32_fp8((int)y[q], false), hi = __builtin_amdgcn_cvt_pk_f32_fp8((int)y[q], true);
                s[4 * q] += w * lo.x; s[4 * q + 1] += w * lo.y; s[4 * q + 2] += w * hi.x; s[4 * q + 3] += w * hi.y;
            }
        }
        const float* gp = gate + b * 6144 + c; bf16_t* xp = XR + (size_t)tok * DM + c;
        const float sc = rs * (1.f / 16.f);
        const u32x4 xa = *(const u32x4*)xp, xc = *(const u32x4*)(xp + 8);
        f32x4 o[4]; float ss = 0.f;
        o[0] = (f32x4){bflo(xa.x), bfhi(xa.x), bflo(xa.y), bfhi(xa.y)}; o[1] = (f32x4){bflo(xa.z), bfhi(xa.z), bflo(xa.w), bfhi(xa.w)};
        o[2] = (f32x4){bflo(xc.x), bfhi(xc.x), bflo(xc.y), bfhi(xc.y)}; o[3] = (f32x4){bflo(xc.z), bfhi(xc.z), bflo(xc.w), bfhi(xc.w)};
#pragma unroll
        for (int q = 0; q < 4; ++q) {
            const f32x4 g = *(const f32x4*)(gp + 4 * q) * sc;
            o[q] = o[q] + g * (f32x4){s[4 * q], s[4 * q + 1], s[4 * q + 2], s[4 * q + 3]};
            if (final_out) *(f32x4*)(p.out + (size_t)tok * DM + c + 4 * q) = o[q];
            ss += (o[q][0] * o[q][0] + o[q][1] * o[q][1]) + (o[q][2] * o[q][2] + o[q][3] * o[q][3]);
        }
        if (!final_out) { *(u32x4*)xp = pack8(o[0], o[1]); *(u32x4*)(xp + 8) = pack8(o[2], o[3]); }
        if (NEXTNORM) {
            const float rstd = rsqrtf(wave_sum(ss) * (1.f / 1024.f) + 1e-6f);
            u32x4 w0, w1;
#pragma unroll
            for (int q = 0; q < 4; ++q) {
                const f32x4 g4 = *(const f32x4*)(gain + c + 4 * q), sc4 = *(const f32x4*)(modn + b * 6144 + 1024 + c + 4 * q), sh4 = *(const f32x4*)(modn + b * 6144 + c + 4 * q);
                const f32x4 v = o[q] * rstd * (g4 * (sc4 + 1.f)) + sh4;
                if (q < 2) { w0[2 * q] = pk2(v[0], v[1]); w0[2 * q + 1] = pk2(v[2], v[3]); } else { w1[2 * (q - 2)] = pk2(v[0], v[1]); w1[2 * (q - 2) + 1] = pk2(v[2], v[3]); }
            }
            *(u32x4*)(XN + (size_t)tok * DM + c) = w0; *(u32x4*)(XN + (size_t)tok * DM + c + 8) = w1;
        }
    }
}

constexpr int AT_KB = 8192, AT_VB = 64 * 136, AT_K0 = 0, AT_V0 = 4 * AT_KB, AT_BIAS = 4 * AT_KB + 4 * AT_VB + 256, AT_BPAD = 48;
#define ATT_TILE(kb_, vb_, t0_, LAT_, brow4_, rpen_) do { \
    f32x16 sa; \
    _Pragma("unroll") for (int i = 0; i < 16; ++i) sa[i] = 0.f; \
    _Pragma("unroll") for (int s = 0; s < 4; ++s) { \
        const bf16x8 kf = *(const LAS bf16x8*)((kb_) + ((t0_) + l31) * 128 + (((2 * s + hh) ^ (l31 & 7)) << 4)); \
        sa = __builtin_amdgcn_mfma_f32_32x32x16_bf16(kf, qf[s], sa, 0, 0, 0); } \
    float tmax = -1e30f; \
    if (LAT_) { \
        const LAS float* bp = (const LAS float*)((const LAS unsigned char*)biasL + (brow4_)); \
        _Pragma("unroll") for (int i = 0; i < 16; ++i) { sa[i] = (sa[i] + bp[(i & 3) + 8 * (i >> 2)]) + (pen[i] + (rpen_)); tmax = fmaxf(tmax, sa[i]); } \
    } else { \
        _Pragma("unroll") for (int i = 0; i < 16; ++i) tmax = fmaxf(tmax, sa[i]); \
    } \
    tmax = fmaxf(tmax, __shfl_xor(tmax, 32)); \
    if (__any(tmax > mrun)) { \
        const float mnew = fmaxf(mrun, tmax), alpha = __builtin_amdgcn_exp2f(mrun - mnew); \
        lrun *= alpha; mrun = mnew; \
        _Pragma("unroll") for (int i = 0; i < 16; ++i) { o0[i] *= alpha; o1[i] *= alpha; } } \
    float psum = 0.f; \
    _Pragma("unroll") for (int i = 0; i < 16; ++i) { sa[i] = __builtin_amdgcn_exp2f(sa[i] - mrun); psum += sa[i]; } \
    lrun += psum; \
    bf16x8 pf0, pf1; \
    { u32x4 w0, w1; \
      _Pragma("unroll") for (int j = 0; j < 4; ++j) { w0[j] = pk2(sa[2 * j], sa[2 * j + 1]); w1[j] = pk2(sa[8 + 2 * j], sa[8 + 2 * j + 1]); } \
      pf0 = __builtin_bit_cast(bf16x8, w0); pf1 = __builtin_bit_cast(bf16x8, w1); } \
    const LAS unsigned char* v0p = (vb_) + l31 * 136 + 2 * (t0_) + 8 * hh; const LAS unsigned char* v1p = v0p + 32 * 136; \
    const s16x4 a0 = *(const LAS s16x4*)(v0p), a1 = *(const LAS s16x4*)(v0p + 16), a2 = *(const LAS s16x4*)(v0p + 32), a3 = *(const LAS s16x4*)(v0p + 48); \
    const s16x4 c0 = *(const LAS s16x4*)(v1p), c1 = *(const LAS s16x4*)(v1p + 16), c2 = *(const LAS s16x4*)(v1p + 32), c3 = *(const LAS s16x4*)(v1p + 48); \
    const bf16x8 va0 = __builtin_shufflevector(a0, a1, 0, 1, 2, 3, 4, 5, 6, 7), va1 = __builtin_shufflevector(a2, a3, 0, 1, 2, 3, 4, 5, 6, 7); \
    const bf16x8 vb0 = __builtin_shufflevector(c0, c1, 0, 1, 2, 3, 4, 5, 6, 7), vb1 = __builtin_shufflevector(c2, c3, 0, 1, 2, 3, 4, 5, 6, 7); \
    o0 = __builtin_amdgcn_mfma_f32_32x32x16_bf16(va0, pf0, o0, 0, 0, 0); o0 = __builtin_amdgcn_mfma_f32_32x32x16_bf16(va1, pf1, o0, 0, 0, 0); \
    o1 = __builtin_amdgcn_mfma_f32_32x32x16_bf16(vb0, pf0, o1, 0, 0, 0); o1 = __builtin_amdgcn_mfma_f32_32x32x16_bf16(vb1, pf1, o1, 0, 0, 0); \
    } while (0)
__device__ __forceinline__ void phase_attn(const Ctx& X, const Params& p) {
    const bf16_t* Q = (const bf16_t*)(p.ws + WS_Q); const bf16_t* Kb = (const bf16_t*)(p.ws + WS_K); const bf16_t* VT = (const bf16_t*)(p.ws + WS_VT);
    bf16_t* O = (bf16_t*)(p.ws + WS_O);
    LAS float* biasL = (LAS float*)(X.lds + AT_BIAS);
    const int lane = X.lane, l31 = lane & 31, hh = lane >> 5, tid = X.tid;
    const float LOG2E = 1.4426950408889634f;
    const int skey = tid >> 3, sch = tid & 7;
    for (int task = X.blk; task < 256; task += X.G) {
        const int b = task >> 5, h = (task >> 1) & 15, hf = task & 1;
        __syncthreads();
        for (int i = tid; i < 465 + 2 * AT_BPAD + 64; i += 512) { const int j = i - AT_BPAD; biasL[i] = (j >= 0 && j < 465) ? p.in[I_RPB][h * 465 + j] * LOG2E : 0.f; }
        const bf16_t* vcol = VT + (size_t)skey * DM + h * 64 + 8 * sch;
        const bf16_t* kcol = Kb + (size_t)skey * DM + h * 64 + 8 * sch;
        for (int gq = 0; gq < 4; ++gq) {
            const int R0 = 16 * hf + 4 * gq;
            const int rp = X.wave >> 2, cb = X.wave & 3, r = R0 + 2 * rp, c0 = 16 * cb;
            const int t0 = cb == 0 ? 0 : (cb == 1 ? 8 : (cb == 2 ? 24 : 32));
            const int rq = r + (l31 >> 4), qc = c0 + (l31 & 15);
            const int r0q = rq < 4 ? 0 : (rq > 28 ? 24 : rq - 4);
            const int r0lo = r < 4 ? 0 : (r > 28 ? 24 : r - 4), r0hi = (r + 1 < 4 ? 0 : (r + 1 > 28 ? 24 : r + 1 - 4)) + 7;
            const int rmin = R0 < 4 ? 0 : (R0 > 28 ? 24 : R0 - 4);
            const int rl = R0 + 3, rmax = (rl < 4 ? 0 : (rl > 28 ? 24 : rl - 4)) + 7;
            const int nl = rmax - rmin + 1, nsteps = 2 + ((nl + 1) >> 1);
            const size_t qtok = (size_t)b * 2048 + rq * 64 + qc;
            bf16x8 qf[4];
#pragma unroll
            for (int s = 0; s < 4; ++s) qf[s] = *(const bf16x8*)(Q + qtok * DM + h * 64 + 16 * s + 8 * hh);
            const int cs = qc < 8 ? 0 : (qc > 56 ? 48 : qc - 8);
            float pen[16];
#pragma unroll
            for (int i = 0; i < 16; ++i) { const int kc = t0 + (i & 3) + 8 * (i >> 2) + 4 * hh; pen[i] = (kc >= cs && kc < cs + 16) ? 0.f : -1e30f; }
            const int lb4 = 4 * ((7 - (l31 >> 4)) * 31 + t0 - qc + 15 + 4 * hh + AT_BPAD);
            f32x16 o0, o1;
#pragma unroll
            for (int i = 0; i < 16; ++i) { o0[i] = 0.f; o1[i] = 0.f; }
            float mrun = -1e30f, lrun = 0.f;
            u32x4 kA0, kA1, vA0, vA1, kB0, kB1, vB0, vB1;
#define ATT_ISSUE(st_, k0_, k1_, v0r_, v1r_) do { int s_ = (st_); s_ = s_ < nsteps ? s_ : nsteps - 1; \
                size_t kt0_, kt1_; \
                if (s_ < 2) { kt0_ = (size_t)NLAT + b * 256 + s_ * 128; kt1_ = kt0_ + 64; } \
                else { const int ra_ = rmin + 2 * (s_ - 2), rb_ = ra_ + 1 <= rmax ? ra_ + 1 : rmax; kt0_ = (size_t)b * 2048 + ra_ * 64; kt1_ = (size_t)b * 2048 + rb_ * 64; } \
                k0_ = *(const u32x4*)(kcol + kt0_ * DM); k1_ = *(const u32x4*)(kcol + kt1_ * DM); v0r_ = *(const u32x4*)(vcol + kt0_ * DM); v1r_ = *(const u32x4*)(vcol + kt1_ * DM); } while (0)
#define ATT_WRITE(nb_, k0_, k1_, v0r_, v1r_) do { \
                LAS unsigned char* kw_ = X.lds + AT_K0 + (nb_) * 2 * AT_KB + skey * 128 + ((sch ^ (skey & 7)) << 4); \
                *(LAS u32x4*)(kw_) = k0_; *(LAS u32x4*)(kw_ + AT_KB) = k1_; \
                LAS unsigned short* vw_ = (LAS unsigned short*)(X.lds + AT_V0 + (nb_) * 2 * AT_VB + (8 * sch) * 136 + skey * 2);        \
                _Pragma("unroll") for (int j_ = 0; j_ < 4; ++j_) { \
                    vw_[(2 * j_) * 68] = (unsigned short)(v0r_[j_] & 0xffffu); vw_[(2 * j_ + 1) * 68] = (unsigned short)(v0r_[j_] >> 16); \
                    vw_[AT_VB / 2 + (2 * j_) * 68] = (unsigned short)(v1r_[j_] & 0xffffu); vw_[AT_VB / 2 + (2 * j_ + 1) * 68] = (unsigned short)(v1r_[j_] >> 16); } } while (0)
#define ATT_KROW(kb_, vb_, kr_) do { const int kr = (kr_); \
                if (kr <= rmax && kr >= r0lo && kr <= r0hi) { \
                    const float rpen = (kr >= r0q && kr < r0q + 8) ? 0.f : -1e30f; \
                    const int brow4 = lb4 + 4 * 31 * (kr - r) + 4 * 0; \
                    ATT_TILE(kb_, vb_, t0, true, brow4, rpen); } } while (0)
#define ATT_STEP(st_, cur_) do { const int st = (st_); \
                const LAS unsigned char* kb = X.lds + AT_K0 + (cur_) * 2 * AT_KB; const LAS unsigned char* vb = X.lds + AT_V0 + (cur_) * 2 * AT_VB; \
                if (st < 2) { ATT_TILE(kb, vb, 0, false, 0, 0.f); ATT_TILE(kb, vb, 32, false, 0, 0.f); ATT_TILE(kb + AT_KB, vb + AT_VB, 0, false, 0, 0.f); ATT_TILE(kb + AT_KB, vb + AT_VB, 32, false, 0, 0.f); } \
                else { const int ka = rmin + 2 * (st - 2); ATT_KROW(kb, vb, ka); ATT_KROW(kb + AT_KB, vb + AT_VB, ka + 1); } } while (0)
            ATT_ISSUE(0, kA0, kA1, vA0, vA1);
            ATT_ISSUE(1, kB0, kB1, vB0, vB1);
            __syncthreads();
            ATT_WRITE(0, kA0, kA1, vA0, vA1);
            __syncthreads();
            for (int sp = 0; sp < nsteps; sp += 2) {
                ATT_ISSUE(sp + 2, kA0, kA1, vA0, vA1);
                ATT_STEP(sp, 0);
                ATT_WRITE(1, kB0, kB1, vB0, vB1);
                __syncthreads();
                if (sp + 1 < nsteps) {
                    ATT_ISSUE(sp + 3, kB0, kB1, vB0, vB1);
                    ATT_STEP(sp + 1, 1);
                    ATT_WRITE(0, kA0, kA1, vA0, vA1);
                    __syncthreads();
                }
            }
#undef ATT_ISSUE
#undef ATT_WRITE
#undef ATT_STEP
#undef ATT_KROW
            const float ltot = lrun + __shfl_xor(lrun, 32), inv = 1.f / ltot;
            bf16_t* op = O + qtok * DM + h * 64;
#pragma unroll
            for (int g = 0; g < 4; ++g) {
                u32x2 w; w.x = pk2(o0[4 * g] * inv, o0[4 * g + 1] * inv); w.y = pk2(o0[4 * g + 2] * inv, o0[4 * g + 3] * inv);
                *(u32x2*)(op + 8 * g + 4 * hh) = w;
                u32x2 w2; w2.x = pk2(o1[4 * g] * inv, o1[4 * g + 1] * inv); w2.y = pk2(o1[4 * g + 2] * inv, o1[4 * g + 3] * inv);
                *(u32x2*)(op + 32 + 8 * g + 4 * hh) = w2;
            }
        }
    }
}
#undef ATT_TILE


constexpr int N_PHASES = 24;
constexpr int C0A = 4800, C0B = 6400, C0C = 7600;
constexpr int C1A = 6000, C1B = 7000;
#ifndef PROBE_LO
#define PROBE_LO 99
#define PROBE_HI (-1)
#endif
__host__ __device__ constexpr int nrep(int k) { return (k >= PROBE_LO && k <= PROBE_HI) ? 2 : 1; }
__global__ void __launch_bounds__(512, 2) fwd_kernel(Params p) {
    extern __shared__ __attribute__((aligned(16))) unsigned char lds_raw[];
    LAS unsigned char* lds = (LAS unsigned char*)lds_raw;
    const int wave0 = __builtin_amdgcn_readfirstlane((int)(threadIdx.x >> 6));
    for (int u = threadIdx.x; u < (LDS_BYTES - MISC_OFF) / 4; u += 512) ((LAS unsigned*)(lds + MISC_OFF))[u] = 0u;
    __syncthreads();
    XcdBarrier bar; bar.bar = (unsigned*)(p.ws + WS_CTL) + 4096; bar.x = 0; bar.st = (volatile LAS unsigned*)(lds + MISC_OFF + M_BAR);
    if (p.ph_hi - p.ph_lo > 1) bar = xcd_barrier_post((unsigned*)(p.ws + WS_CTL) + 4096, (volatile LAS unsigned*)(lds + MISC_OFF + M_BAR));
#define PH(k) (p.ph_lo <= (k) && (k) < p.ph_hi)
#define SEAM(k) do { if (PH(k) && PH((k) + 1)) xcd_barrier(bar, wave0); } while (0)
#define RUN(k, ...) do { if (PH(k)) { _Pragma("unroll") for (int rep_ = 0; rep_ < nrep(k); ++rep_) { const float rs_ = rep_ == 0 ? 1.f : 0.f; (void)rs_; { __VA_ARGS__ } if (rep_ + 1 < nrep(k)) xcd_barrier(bar, wave0); } } SEAM(k); } while (0)
    unsigned char* ws = p.ws;
    const float* MOD = (const float*)(ws + WS_MOD);

    RUN(0, const Ctx X = mkctx(lds, wave0); phase_p0a(X, p););
    RUN(1, const Ctx X = mkctx(lds, wave0); phase_p0b(X, p););
    RUN(2, const Ctx X = mkctx(lds, wave0); phase_norm<0>(X, p, 0, 0, NTOK););
    RUN(3,
        g8::RectSched S{72, 8, (int)gridDim.x, (int)blockIdx.x, 0u, 2048u, (const char*)(ws + WS_WIN), 2048u};
        EpiWin E{(bf16_t*)(ws + WS_A2), (bf16_t*)(ws + WS_BCV)};
        g8::gemm_phase(lds, wave0, (const char*)(ws + WS_XA), 1024, 2048u, S, E);
        { const Ctx X = mkctx(lds, wave0); int nidle; const int rk = idle_rank(576, X.G, X.blk, nidle);
          if (rk >= 0) conv_moe_items<0>(X, p, 0, (bf16_t*)(ws + WS_GU), (bf16_t*)(ws + WS_DN), 0, C0A, rk, nidle); });
    RUN(4,
        g8::BatchSched S{32, 3, 1, (int)gridDim.x, (int)blockIdx.x, 1536u, (const char*)(ws + WS_WF), 1024u, 256};
        EpiS5F E{(float*)(ws + WS_F)};
        g8::gemm_phase(lds, wave0, (const char*)(ws + WS_A2), 512, 1024u, S, E);
        { const Ctx X = mkctx(lds, wave0); int nidle; const int rk = moe_idle_rank(96, 1, X.G, X.blk, nidle);
          if (rk >= 0) conv_moe_items<0>(X, p, 0, (bf16_t*)(ws + WS_GU), (bf16_t*)(ws + WS_DN), C0A, C0B, rk, nidle); });
    RUN(5, const Ctx X = mkctx(lds, wave0); phase_scan_conv(X, p););
    RUN(6,
        g8::BatchSched S{32, 3, 2, (int)gridDim.x, (int)blockIdx.x, 1536u, (const char*)(ws + WS_ME), 1536u, 512};
        EpiS5Y E{(bf16_t*)(ws + WS_G)};
        g8::gemm_phase(lds, wave0, (const char*)(ws + WS_A2), 768, 1536u, S, E););
    RUN(7,
        g8::RectSched S{72, 2, (int)gridDim.x, (int)blockIdx.x, 0u, 1024u, (const char*)(ws + WS_GLU), 1024u};
        EpiGlu E{(const bf16_t*)(ws + WS_G), p.in[I_GLUB], (bf16_t*)(ws + WS_Z)};
        g8::gemm_phase(lds, wave0, (const char*)(ws + WS_G), 512, 1024u, S, E);
        { const Ctx X = mkctx(lds, wave0); int nidle; const int rk = idle_rank(144, X.G, X.blk, nidle);
          if (rk >= 0) conv_moe_items<0>(X, p, 0, (bf16_t*)(ws + WS_GU), (bf16_t*)(ws + WS_DN), C0B, C0C, rk, nidle); });
    RUN(8,
        g8::RectSched S{72, 4, (int)gridDim.x, (int)blockIdx.x, 0u, 2048u, (const char*)(ws + WS_HOUT), 2048u};
        EpiResid<true> E{p.in[I_X], p.in[I_CTX], MOD + 2 * 1024, (bf16_t*)(ws + WS_XR), 1.f};
        g8::gemm_phase(lds, wave0, (const char*)(ws + WS_Z), 1024, 2048u, S, E);
        { const Ctx X = mkctx(lds, wave0); int nidle; const int rk = idle_rank(288, X.G, X.blk, nidle);
          if (rk >= 0) conv_moe_items<0>(X, p, 0, (bf16_t*)(ws + WS_GU), (bf16_t*)(ws + WS_DN), C0C, 12480, rk, nidle); });
#define MOE_PHASES(P0, L, NTOKL, FINAL) \
    RUN(P0, const Ctx X = mkctx(lds, wave0); phase_norm<1>(X, p, L, 1, NTOKL);); \
    RUN(P0 + 1, const Ctx X = mkctx(lds, wave0); phase_route(X, p, L, NTOKL);); \
    RUN(P0 + 2, const Ctx X = mkctx(lds, wave0); phase_slots(X, p, NTOKL);); \
    RUN(P0 + 3, \
        const Ctx X = mkctx(lds, wave0); const int ntiles = load_tiles(X, p); \
        g8::MoeSched<true> S{ntiles, 2, (int)gridDim.x, (int)blockIdx.x, 2048u, (const char*)(ws + (L == 0 ? WS_GU : WS_GU1)), 2048u, 512, 0, 128, lds + MISC_OFF + M_TILE, (const int*)(ws + WS_ROWIDX)}; \
        EpiGU E{(bf16_t*)(ws + WS_ACT)}; \
        g8::gemm_phase(lds, wave0, (const char*)(ws + WS_XA), 1024, 2048u, S, E); \
        { const Ctx X2 = mkctx(lds, wave0); int nidle; const int rk = moe_idle_rank(ntiles, 2, X2.G, X2.blk, nidle);        \
          if (rk >= 0 && L == 0) conv_moe_items<1>(X2, p, 1, (bf16_t*)(ws + WS_GU1), nullptr, 0, C1A, rk, nidle); }); \
    RUN(P0 + 4, \
        const Ctx X = mkctx(lds, wave0); const int ntiles = load_tiles(X, p); \
        g8::MoeSched<false> S{ntiles, 4, (int)gridDim.x, (int)blockIdx.x, 512u, (const char*)(ws + WS_DN), 512u, 1024, 0, 256, lds + MISC_OFF + M_TILE, nullptr}; \
        EpiDN E{(unsigned char*)(ws + WS_Y)}; \
        g8::gemm_phase(lds, wave0, (const char*)(ws + WS_ACT), 256, 512u, S, E); \
        { const Ctx X2 = mkctx(lds, wave0); int nidle; const int rk = moe_idle_rank(ntiles, 4, X2.G, X2.blk, nidle); \
          if (rk >= 0 && L == 0) conv_moe_items<1>(X2, p, 1, (bf16_t*)(ws + WS_GU1), nullptr, C1A, C1B, rk, nidle); }); \
    RUN(P0 + 5, const Ctx X = mkctx(lds, wave0); phase_combine<!FINAL>(X, p, L, NTOKL, FINAL, 1.f););

    MOE_PHASES(9, 0, NTOK, false)
    RUN(15,
        g8::QkvSched S{(int)gridDim.x, (int)blockIdx.x, 2048u, (const char*)(ws + WS_QKV), 2048u};
        EpiQKV E{(bf16_t*)(ws + WS_Q), (bf16_t*)(ws + WS_K), (bf16_t*)(ws + WS_VT), p.in[I_QG], p.in[I_KG]};
        g8::gemm_phase(lds, wave0, (const char*)(ws + WS_ACT), 1024, 2048u, S, E);
        { const Ctx X = mkctx(lds, wave0); int nidle; const int rk = idle_rank(832, X.G, X.blk, nidle);
          if (rk >= 0) { conv_moe_items<1>(X, p, 1, (bf16_t*)(ws + WS_GU1), nullptr, C1B, 8320, rk, nidle);
                         conv_moe_items<2>(X, p, 1, nullptr, (bf16_t*)(ws + WS_DN), 0, 4160, rk, nidle); } });
    RUN(16, const Ctx X = mkctx(lds, wave0); phase_attn(X, p););
    RUN(17,
        g8::RectSched S{64, 4, (int)gridDim.x, (int)blockIdx.x, 0u, 2048u, (const char*)(ws + WS_NOUT), 2048u};
        EpiResid<false> E{nullptr, nullptr, MOD + 9 * 6144 + 2 * 1024, (bf16_t*)(ws + WS_XR), rs_};
        g8::gemm_phase(lds, wave0, (const char*)(ws + WS_O), 1024, 2048u, S, E););
    MOE_PHASES(18, 1, NLAT, true)
#undef PH
#undef SEAM
#undef RUN
}

extern "C" void kernel_launch(void* const* d_in, const int* in_sizes, int n_in, void* d_out, int out_size, void* d_ws, size_t ws_size, hipStream_t stream) {
    static int grid = 0;
    if (grid == 0) {
        int dev = 0, cus = 0, per_cu = 0;
        if (n_in != 34 || ws_size < WS_END) { fprintf(stderr, "kernel_launch: unexpected inputs (n_in %d, ws %zu, need %zu)\n", n_in, ws_size, (size_t)WS_END); grid = -1; return; }
        if (hipGetDevice(&dev) != hipSuccess || hipDeviceGetAttribute(&cus, hipDeviceAttributeMultiprocessorCount, dev) != hipSuccess) { grid = -1; return; }
        if (hipFuncSetAttribute((const void*)fwd_kernel, hipFuncAttributeMaxDynamicSharedMemorySize, LDS_BYTES) != hipSuccess) { fprintf(stderr, "kernel_launch: hipFuncSetAttribute failed\n"); grid = -1; return; }
        if (hipOccupancyMaxActiveBlocksPerMultiprocessor(&per_cu, (const void*)fwd_kernel, 512, LDS_BYTES) != hipSuccess || per_cu < 1) { fprintf(stderr, "kernel_launch: occupancy query says %d\n", per_cu); }
        (void)hipGetLastError();
        grid = cus;
    }
    if (grid < 0) return;
    (void)hipMemsetAsync((char*)d_ws + WS_CTL, 0, 64 * 1024, stream);
    Params p{};
    for (int i = 0; i < 34; ++i) p.in[i] = (const float*)d_in[i];
    p.out = (float*)d_out; p.ws = (unsigned char*)d_ws;
#if MK_ONE_LAUNCH
    p.ph_lo = 0; p.ph_hi = N_PHASES;
    hipLaunchKernelGGL(fwd_kernel, dim3(grid), dim3(512), LDS_BYTES, stream, p);
#else
    for (int k = 0; k < N_PHASES; ++k) { p.ph_lo = k; p.ph_hi = k + 1; hipLaunchKernelGGL(fwd_kernel, dim3(grid), dim3(512), LDS_BYTES, stream, p); }
#endif
}
```

```cpp
#include <hip/hip_runtime.h>
#include <stdint.h>
#include <stdio.h>

#ifndef MK_ONE_LAUNCH
#define MK_ONE_LAUNCH 1
#endif

#define GAS __attribute__((address_space(1)))
#define LAS __attribute__((address_space(3)))
typedef unsigned short bf16_t;
typedef short bf16x8 __attribute__((ext_vector_type(8)));
typedef short s16x4 __attribute__((ext_vector_type(4)));
typedef float f32x4 __attribute__((ext_vector_type(4)));
typedef float f32x2 __attribute__((ext_vector_type(2)));
typedef float f32x16 __attribute__((ext_vector_type(16)));
typedef unsigned u32x4 __attribute__((ext_vector_type(4)));
typedef unsigned u32x2 __attribute__((ext_vector_type(2)));

constexpr int NLAT = 16384, NCTX = 2048, NTOK = NLAT + NCTX, DM = 1024;
constexpr int SEQ = 2048, CTXL = 256, NB = 8;
constexpr int NEXP = 64, NEXP1 = 65, EDIM = 256;
constexpr int S5T = 32;
constexpr int S5R = 576, S5RP = 768;
constexpr int S5K = 768;
constexpr int MAXTILES = 712;

constexpr size_t MiB = 1ull << 20;
constexpr size_t WS_CTL = 0;
constexpr size_t WS_MOD = 1 * MiB;
constexpr size_t WS_WIN = 2 * MiB;
constexpr size_t WS_GLU = 6 * MiB;
constexpr size_t WS_HOUT = 7 * MiB;
constexpr size_t WS_QKV = 9 * MiB;
constexpr size_t WS_NOUT = 15 * MiB;
constexpr size_t WS_ROUT = 17 * MiB;
constexpr size_t WS_GU = 18 * MiB;
constexpr size_t WS_DN = 83 * MiB;
constexpr size_t WS_GU1 = 116 * MiB;
constexpr size_t WS_XR = 181 * MiB;
constexpr size_t WS_LOGIT = 253 * MiB;
constexpr size_t WS_TOKE = 258 * MiB;
constexpr size_t WS_TOKW = 259 * MiB;
constexpr size_t WS_TOKP = 260 * MiB;
constexpr size_t WS_ROWIDX = 261 * MiB;
constexpr size_t WS_YROW = 262 * MiB;
constexpr size_t WS_CNTBLK = 263 * MiB;
constexpr size_t WS_TAB = 263 * MiB + 512 * 1024;
constexpr size_t WS_XA = 264 * MiB;
constexpr size_t WS_OVL = 300 * MiB;
constexpr size_t WS_A2 = WS_OVL;
constexpr size_t WS_BCV = WS_OVL + 36 * MiB;
constexpr size_t WS_F = WS_OVL + 90 * MiB;
constexpr size_t WS_Z = WS_OVL + 114 * MiB;
constexpr size_t WS_G = WS_OVL + 150 * MiB;
constexpr size_t WS_ME = WS_OVL + 168 * MiB;
constexpr size_t WS_WF = WS_OVL + 192 * MiB;
constexpr size_t WS_KK = WS_OVL + 200 * MiB;
constexpr size_t WS_PW = WS_OVL + 202 * MiB;
constexpr size_t WS_BB = WS_OVL + 204 * MiB;
constexpr size_t WS_ADAP = WS_OVL + 205 * MiB;
constexpr size_t WS_Q = WS_OVL;
constexpr size_t WS_K = WS_OVL + 32 * MiB;
constexpr size_t WS_VT = WS_OVL + 68 * MiB;
constexpr size_t WS_O = WS_OVL + 104 * MiB;
constexpr size_t WS_Y = WS_XA;
constexpr size_t WS_ACT = WS_XA + 178 * MiB;
constexpr size_t WS_END = WS_ACT + 89 * MiB;

constexpr int RING_BYTES = 131072;
constexpr int MISC_OFF = RING_BYTES;
constexpr int LDS_BYTES = 147456;
constexpr int M_BAR = 0, M_CNT = 64, M_BASE = 384, M_BBASE = 704, M_TILE = 1024, M_PART = 2048, M_NT = 3200;

__device__ __forceinline__ unsigned f2bf(float f) { unsigned u = __builtin_bit_cast(unsigned, f); return (u + 0x7fffu + ((u >> 16) & 1u)) >> 16; }
typedef __bf16 hbf16x2 __attribute__((ext_vector_type(2)));
__device__ __forceinline__ unsigned pk2(float lo, float hi) { const f32x2 v = {lo, hi}; const hbf16x2 b = __builtin_convertvector(v, hbf16x2); return __builtin_bit_cast(unsigned, b); }
__device__ __forceinline__ float bflo(unsigned w) { return __builtin_bit_cast(float, w << 16); }
__device__ __forceinline__ float bfhi(unsigned w) { return __builtin_bit_cast(float, w & 0xffff0000u); }
__device__ __forceinline__ float bf1(bf16_t b) { return __builtin_bit_cast(float, ((unsigned)b) << 16); }
__device__ __forceinline__ float wave_sum(float v) {
#pragma unroll
    for (int o = 1; o < 64; o <<= 1) v += __shfl_xor(v, o);
    return v;
}
__device__ __forceinline__ float sigmoidf_(float x) { return 1.f / (1.f + __expf(-x)); }
__device__ __forceinline__ float siluf_(float x) { return x / (1.f + __expf(-x)); }
__device__ __forceinline__ float gelu_tanh(float x) {
    const float u = 0.7978845608028654f * (x + 0.044715f * x * x * x);
    const float e = __expf(2.f * u);
    const float t = 1.f - 2.f / (e + 1.f);
    return 0.5f * x * (1.f + t);
}

__device__ __forceinline__ int lane_id_opaque() { int l; asm volatile("v_mbcnt_lo_u32_b32 %0, -1, 0\n\tv_mbcnt_hi_u32_b32 %0, -1, %0" : "=v"(l)); return l; }

#define XB_TMO      128
#define XB_XCNT(j)  (256  + 64 * (j))
#define XB_XSUB(j)  (1280 + 64 * (j))
#define XB_XGEN(j)  (2304 + 64 * (j))
#define XB_TOP      3328
#define XB_TOPGEN   3392
#define XCD_BAR_WORDS 3456
#define XB_SPIN_CAP (1u << 18)
__device__ __forceinline__ unsigned xb_ld(unsigned* p)              { return __hip_atomic_load(p, __ATOMIC_RELAXED, __HIP_MEMORY_SCOPE_AGENT); }
__device__ __forceinline__ unsigned xb_add(unsigned* p, unsigned v) { return __hip_atomic_fetch_add(p, v, __ATOMIC_RELAXED, __HIP_MEMORY_SCOPE_AGENT); }
__device__ __forceinline__ unsigned xb_xcc_id() { return (unsigned)__builtin_amdgcn_s_getreg((3 << 11) | 20) & 0xFu; }
#define XB_SPIN(cond, bar) do { unsigned _sp = 0; while (cond) { __builtin_amdgcn_s_sleep(1); \
    if ((++_sp & 255u) == 0u) { if (xb_ld(&(bar)[XB_TMO])) break; if (_sp > XB_SPIN_CAP) { atomicAdd(&(bar)[XB_TMO], 1u); break; } } } } while (0)
struct XcdBarrier { unsigned* bar; unsigned x; volatile LAS unsigned* st; };
__device__ __forceinline__ XcdBarrier xcd_barrier_post(unsigned* bar, volatile LAS unsigned* st) {
    XcdBarrier b; b.bar = bar; b.x = xb_xcc_id(); b.st = st;
    if (threadIdx.x == 0) (void)xb_add(&bar[XB_XCNT(b.x)], 1u);
    return b;
}
__device__ __forceinline__ void xcd_barrier_complete(unsigned* bar, unsigned x, unsigned& nloc, unsigned& nx) {
    const unsigned G = gridDim.x * gridDim.y * gridDim.z;
    unsigned sum, cnt, mine, sp = 0u;
    for (;;) {
        sum = 0u; cnt = 0u; mine = 0u;
#pragma unroll
        for (unsigned j = 0; j < 16; ++j) { const unsigned c = xb_ld(&bar[XB_XCNT(j)]); sum += c; cnt += (c > 0u) ? 1u : 0u; mine = (j == x) ? c : mine; }
        if (sum == G) break;
        __builtin_amdgcn_s_sleep(1);
        if ((++sp & 255u) == 0u) { if (xb_ld(&bar[XB_TMO])) break; if (sp > XB_SPIN_CAP) { atomicAdd(&bar[XB_TMO], 1u); break; } }
    }
    nloc = mine > 0u ? mine : 1u; nx = cnt > 0u ? cnt : 1u;
}
__device__ __forceinline__ void xcd_barrier(const XcdBarrier& b, const int wave0) {
    asm volatile("s_waitcnt vmcnt(0)" ::: "memory");
    __syncthreads();
    if (wave0 == 0 && lane_id_opaque() == 0) {
        unsigned* bar = b.bar;
        __builtin_amdgcn_s_waitcnt(0);
        unsigned nloc = b.st[0], nx = b.st[1];
        if (nloc == 0u) { xcd_barrier_complete(bar, b.x, nloc, nx); b.st[0] = nloc; b.st[1] = nx; }
        const unsigned old = xb_add(&bar[XB_XSUB(b.x)], 1u);
        const unsigned gen = old / nloc;
        if (old + 1u == (gen + 1u) * nloc) {
            __builtin_amdgcn_fence(__ATOMIC_RELEASE, "agent");
            asm volatile("s_waitcnt vmcnt(0)" ::: "memory");
            const unsigned og = xb_add(&bar[XB_TOP], 1u);
            const unsigned tg = og / nx;
            if (og + 1u == (tg + 1u) * nx) xb_add(&bar[XB_TOPGEN], 1u);
            else XB_SPIN(xb_ld(&bar[XB_TOPGEN]) == tg, bar);
            __builtin_amdgcn_fence(__ATOMIC_ACQUIRE, "agent");
            xb_add(&bar[XB_XGEN(b.x)], 1u);
            asm volatile("s_waitcnt vmcnt(0)" ::: "memory");
        } else {
            XB_SPIN(xb_ld(&bar[XB_XGEN(b.x)]) == gen, bar);
            __builtin_amdgcn_fence(__ATOMIC_ACQUIRE, "agent");
            asm volatile("s_waitcnt vmcnt(0)" ::: "memory");
        }
    }
    __syncthreads();
}

namespace g8 {
constexpr int BM = 256, BK = 64, HALF = 128, HTB = HALF * BK * 2, STAGE_BYTES = 8 * HTB, NXCD = 8, WGM = 8;
__host__ __device__ __forceinline__ int lds_byte(int r, int c) { const int st = (r >> 4) * 2 + (c >> 5), rr = r & 15, cc = c & 31, ob = rr * 64 + cc * 2; return st * 1024 + (ob ^ (((ob >> 9) & 1) << 5)); }
__host__ __device__ __forceinline__ void stage_rc(int b, int& R, int& C) { const int st = b / 1024, sb = b % 1024, swz = sb ^ (((sb >> 9) & 1) << 5); R = (st >> 1) * 16 + swz / 64; C = (st & 1) * 32 + (swz % 64) / 2; }
__host__ __device__ __forceinline__ int perm32(int rho) { const int n = rho >> 4, i = rho & 15; return 8 * (i >> 2) + 4 * n + (i & 3); }

struct Unit { unsigned a0; const char* B; int p0, p1, p2; };

__device__ __forceinline__ void static_map(int L, int nM, int nN, int& pm, int& pn) {
    const int nwg = nM * nN; int wgid = L;
    { const int q = nwg / NXCD, r = nwg % NXCD, xcd = wgid % NXCD, off = wgid / NXCD; wgid = (xcd < r ? xcd * (q + 1) : r * (q + 1) + (xcd - r) * q) + off; }
    const int nig = WGM * nN, gid = wgid / nig, fm = gid * WGM, gsz = (nM - fm) < WGM ? (nM - fm) : WGM;
    pm = fm + ((wgid % nig) % gsz); pn = (wgid % nig) / gsz;
}

template <class Epi, class Sched>
__device__ __forceinline__ void gemm_phase(LAS unsigned char* lds, const int wid, const char* Abase, const int K, const unsigned ldb, const Sched& S, const Epi& E) {
    const int lane = lane_id_opaque();
    const int tid = wid * 64 + lane, wr = wid >> 2, wc = wid & 3, fr = lane & 15, fq = lane >> 4;
    const int nt = K / BK;
    unsigned voffB0;
    { int R0, C0; stage_rc(tid * 16, R0, C0);
      const int Rb0 = Epi::GUP ? (256 * ((R0 >> 4) & 1) + 32 * (R0 >> 5) + 8 * ((R0 & 15) >> 2) + (R0 & 3)) : Epi::WIDE ? (64 * (R0 >> 5) + 16 * ((R0 & 15) >> 2) + 4 * ((R0 >> 4) & 1) + (R0 & 3)) : Epi::HEADP ? (64 * (R0 >> 5) + perm32(R0 & 31)) : (Epi::PERM ? ((R0 & ~31) + perm32(R0 & 31)) : R0);
      voffB0 = (unsigned)Rb0 * ldb + (unsigned)C0 * 2u; }
    const size_t hstepB = (size_t)(Epi::GUP ? 4 : Epi::WIDE ? 8 : (Epi::HEADP ? 32 : HALF)) * ldb;
    const size_t p1stepB = (size_t)((Epi::WIDE || Epi::HEADP) ? 128 : 64) * ldb;
    const unsigned ldsw = (unsigned)wid * 1024u;
    const int aoff = lds_byte(wr * 64 + fr, fq * 8), boff = lds_byte(wc * 32 + fr, fq * 8);
#define G8_SA(b, h) (((b) * 2 + (h)) * HTB)
#define G8_SB(b, h) ((4 + (b) * 2 + (h)) * HTB)
#define G8_GLDS(gp, lo) __builtin_amdgcn_global_load_lds((const unsigned*)(gp), (LAS unsigned*)(lds + (lo)), 16, 0, 0)
#define G8_STAGE_A(bufoff, o0, o1, kb, h) do { \
        G8_GLDS(Abase + ((long)(kb) + (Sched::GATHER ? 0l : (long)((h) * 128) * (long)S.lda)) + (size_t)(o0), (bufoff) + ldsw); \
        G8_GLDS(Abase + ((long)(kb) + (Sched::GATHER ? 0l : (long)((h) * 128 + 64) * (long)S.lda)) + (size_t)(o1), (bufoff) + ldsw + 8192); } while (0)
#define G8_STAGE_B(bufoff, bp, kb) do { G8_GLDS((bp) + (size_t)(kb) + (size_t)voffB0, (bufoff) + ldsw); G8_GLDS((bp) + ((size_t)(kb) + p1stepB) + (size_t)voffB0, (bufoff) + ldsw + 8192); } while (0)
#define G8_LDA(dst, b, h) do { _Pragma("unroll") for (int m = 0; m < 4; ++m) _Pragma("unroll") for (int k = 0; k < 2; ++k) dst[m][k] = *(const LAS bf16x8*)(lds + G8_SA(b, h) + aoff + m * 2048 + k * 1024); } while (0)
#define G8_LDB(dst, b, h) do { _Pragma("unroll") for (int n = 0; n < 2; ++n) _Pragma("unroll") for (int k = 0; k < 2; ++k) dst[n][k] = *(const LAS bf16x8*)(lds + G8_SB(b, h) + boff + n * 2048 + k * 1024); } while (0)
#define G8_MMA(ai, bj, At, Bt) do { __builtin_amdgcn_s_setprio(1); _Pragma("unroll") for (int m = 0; m < 4; ++m) _Pragma("unroll") for (int n = 0; n < 2; ++n) _Pragma("unroll") for (int k = 0; k < 2; ++k) \
        acc[ai][bj][m][n] = __builtin_amdgcn_mfma_f32_16x16x32_bf16(Bt[n][k], At[m][k], acc[ai][bj][m][n], 0, 0, 0); __builtin_amdgcn_s_setprio(0); } while (0)
#define G8_WAIT_V(n) asm volatile("s_waitcnt vmcnt(" #n ")" ::: "memory")
#define G8_WAIT_L(n) asm volatile("s_waitcnt lgkmcnt(" #n ")" ::: "memory")
#define G8_BAR __builtin_amdgcn_s_barrier()
#define G8_SCHED __builtin_amdgcn_sched_barrier(0)
    Unit cur, nxt; int ui = 0;
    if (!S.next(0, cur)) return;
    f32x4 acc[2][2][4][2];
#pragma unroll
    for (int a = 0; a < 2; ++a)
#pragma unroll
        for (int b = 0; b < 2; ++b)
#pragma unroll
            for (int m = 0; m < 4; ++m)
#pragma unroll
                for (int n = 0; n < 2; ++n) acc[a][b][m][n] = (f32x4){0.f, 0.f, 0.f, 0.f};
    bf16x8 At[4][2], B0[2][2], B1[2][2];
    unsigned cA00, cA01, cA10, cA11;
    { int R0, C0, R1, C1; stage_rc(tid * 16, R0, C0); stage_rc(tid * 16 + 8192, R1, C1);
      cA00 = S.aoff(cur, R0) + (unsigned)C0 * 2u;
      if constexpr (Sched::GATHER) { cA01 = S.aoff(cur, R1) + (unsigned)C1 * 2u; cA10 = S.aoff(cur, HALF + R0) + (unsigned)C0 * 2u; cA11 = S.aoff(cur, HALF + R1) + (unsigned)C1 * 2u; }
      else { cA01 = cA00; cA10 = cA00; cA11 = cA00; } }
    const char* cB = cur.B;
    G8_STAGE_B(G8_SB(0, 0), cB, 0); G8_SCHED; G8_STAGE_B(G8_SB(0, 1), cB + hstepB, 0); G8_SCHED; G8_STAGE_A(G8_SA(0, 0), cA00, cA01, 0, 0); G8_SCHED; G8_STAGE_A(G8_SA(0, 1), cA10, cA11, 0, 1); G8_SCHED;
    if (wr == 1) G8_BAR;
    G8_WAIT_V(2); G8_BAR;
    G8_STAGE_B(G8_SB(1, 0), cB, 128); G8_SCHED; G8_STAGE_A(G8_SA(1, 0), cA00, cA01, 128, 0); G8_SCHED; G8_STAGE_B(G8_SB(1, 1), cB + hstepB, 128); G8_SCHED;
    G8_WAIT_V(6); G8_BAR;
    for (;;) {
        const bool has_next = S.next(ui + 1, nxt);
        unsigned nA00 = cA00, nA01 = cA01, nA10 = cA10, nA11 = cA11; const char* nB = cB; long dl = 0;
        if (has_next) {
            nB = nxt.B;
            if constexpr (!Sched::GATHER) dl = ((long)nxt.a0 - (long)cur.a0) * (long)S.lda;
            else { const int t2 = wid * 64 + lane_id_opaque(); int R0, C0, R1, C1; stage_rc(t2 * 16, R0, C0); stage_rc(t2 * 16 + 8192, R1, C1);
                nA00 = S.aoff(nxt, R0) + (unsigned)C0 * 2u; nA01 = S.aoff(nxt, R1) + (unsigned)C1 * 2u; nA10 = S.aoff(nxt, HALF + R0) + (unsigned)C0 * 2u; nA11 = S.aoff(nxt, HALF + R1) + (unsigned)C1 * 2u; }
        }
        for (int t = 0; t < nt; t += 2) {
            const bool last = (t == nt - 2);
            const unsigned kb = (unsigned)t * 128u;
            const unsigned kb2 = last ? 0u : kb + 256u;
            const char* b2 = last ? nB : cB;
            unsigned s00, s01, s10, s11; long ka2;
            if constexpr (Sched::GATHER) { s00 = last ? nA00 : cA00; s01 = last ? nA01 : cA01; s10 = last ? nA10 : cA10; s11 = last ? nA11 : cA11; ka2 = (long)kb2; }
            else { s00 = cA00; s01 = cA00; s10 = cA00; s11 = cA00; ka2 = last ? dl : (long)kb2; }
            G8_LDB(B0, 0, 0); G8_LDB(B1, 0, 1); G8_SCHED; G8_LDA(At, 0, 0); G8_STAGE_A(G8_SA(1, 1), cA10, cA11, kb + 128u, 1);
            G8_WAIT_V(8); G8_WAIT_L(0); G8_BAR; G8_MMA(0, 0, At, B0); G8_MMA(0, 1, At, B1); G8_BAR; G8_SCHED;
            G8_LDA(At, 0, 1); G8_STAGE_B(G8_SB(0, 0), b2, kb2); G8_STAGE_B(G8_SB(0, 1), b2 + hstepB, kb2); G8_STAGE_A(G8_SA(0, 0), s00, s01, ka2, 0);
            G8_WAIT_V(8); G8_WAIT_L(0); G8_BAR; G8_MMA(1, 0, At, B0); G8_MMA(1, 1, At, B1); G8_BAR; G8_SCHED;
            G8_LDB(B0, 1, 0); G8_LDB(B1, 1, 1); G8_SCHED; G8_LDA(At, 1, 0); G8_STAGE_A(G8_SA(0, 1), s10, s11, ka2, 1);
            G8_WAIT_V(8); G8_WAIT_L(0); G8_BAR; G8_MMA(0, 0, At, B0); G8_MMA(0, 1, At, B1); G8_BAR; G8_SCHED;
            G8_LDA(At, 1, 1); G8_STAGE_B(G8_SB(1, 0), b2, kb2 + 128u); G8_STAGE_B(G8_SB(1, 1), b2 + hstepB, kb2 + 128u); G8_STAGE_A(G8_SA(1, 0), s00, s01, ka2 + 128, 0);
            G8_WAIT_V(8); G8_WAIT_L(0); G8_BAR; G8_MMA(1, 0, At, B0); G8_MMA(1, 1, At, B1); G8_BAR; G8_SCHED;
        }
        if (wr == 0) G8_BAR;
        { const int l2 = lane_id_opaque(); E(acc, cur, wr, wc, l2 & 15, l2 >> 4); }
        if (!has_next) break;
#pragma unroll
        for (int a = 0; a < 2; ++a)
#pragma unroll
            for (int b = 0; b < 2; ++b)
#pragma unroll
                for (int m = 0; m < 4; ++m)
#pragma unroll
                    for (int n = 0; n < 2; ++n) acc[a][b][m][n] = (f32x4){0.f, 0.f, 0.f, 0.f};
        cur = nxt; cB = nB; ++ui;
        if constexpr (Sched::GATHER) { cA00 = nA00; cA01 = nA01; cA10 = nA10; cA11 = nA11; }
        else { cA00 += (unsigned)dl; cA01 = cA00; cA10 = cA00; cA11 = cA00; }
        if (wr == 1) G8_BAR;
    }
    G8_WAIT_V(0);
    G8_BAR;
#undef G8_SA
#undef G8_SB
#undef G8_GLDS
#undef G8_STAGE_A
#undef G8_STAGE_B
#undef G8_LDA
#undef G8_LDB
#undef G8_MMA
#undef G8_WAIT_V
#undef G8_WAIT_L
#undef G8_BAR
#undef G8_SCHED
}

struct RectSched {
    static constexpr bool GATHER = false;
    int nM, nN, G, c; unsigned row0, lda; const char* Bbase; unsigned ldb;
    __device__ __forceinline__ bool next(int i, Unit& u) const {
        const int L = i * G + c; if (L >= nM * nN) return false;
        int pm, pn; static_map(L, nM, nN, pm, pn);
        u.a0 = row0 + (unsigned)pm * 256u; u.B = Bbase + (size_t)pn * 256u * ldb; u.p0 = pm; u.p1 = pn; u.p2 = 0; return true;
    }
    __device__ __forceinline__ unsigned aoff(const Unit& u, int q) const { return (u.a0 + (unsigned)q) * lda; }
};
struct QkvSched {
    static constexpr bool GATHER = false;
    int G, c; unsigned lda; const char* Bbase; unsigned ldb;
    __device__ __forceinline__ bool next(int i, Unit& u) const {
        const int L = i * G + c; int pm, pn;
        if (L < 768) static_map(L, 64, 12, pm, pn);
        else if (L < 832) { const int l2 = L - 768; pm = 64 + (l2 & 7); pn = 4 + (l2 >> 3); }
        else return false;
        u.a0 = (unsigned)pm * 256u; u.B = Bbase + (size_t)pn * 256u * ldb; u.p0 = pm; u.p1 = pn; u.p2 = 0; return true;
    }
    __device__ __forceinline__ unsigned aoff(const Unit& u, int q) const { return (u.a0 + (unsigned)q) * lda; }
};
struct BatchSched {
    static constexpr bool GATHER = false;
    int nb, nM, nN, G, c; unsigned lda; const char* Bbase; unsigned ldb; int N;
    __device__ __forceinline__ bool next(int i, Unit& u) const {
        const int per = nM * nN; int L;
        if ((G & 7) == 0 && (nb & 7) == 0) {
            const int nx = (nb >> 3) * per, li = i * (G >> 3) + (c >> 3); if (li >= nx) return false;
            L = (c & 7) * nx + li;
        } else { L = i * G + c; if (L >= nb * per) return false; }
        const int g = L / per, rem = L % per, pm = rem / nN, pn = rem % nN;
        u.a0 = (unsigned)(g * S5RP + pm * 256); u.B = Bbase + ((size_t)g * N + (size_t)pn * 256u) * ldb; u.p0 = g; u.p1 = pm; u.p2 = pn; return true;
    }
    __device__ __forceinline__ unsigned aoff(const Unit& u, int q) const { return (u.a0 + (unsigned)q) * lda; }
};
template <bool GATHER_>
struct MoeSched {
    static constexpr bool GATHER = GATHER_;
    int ntiles, nN, G, c; unsigned lda; const char* Bbase; unsigned ldb; int Ne, pn0, bstep; const LAS unsigned char* tile_e; const int* rowidx;
    __device__ __forceinline__ void xrange(int x, int& tlo, int& nx) const { const int q = ntiles >> 3, r = ntiles & 7; nx = q + (x < r ? 1 : 0); tlo = x * q + (x < r ? x : r); }
    __device__ __forceinline__ bool next(int i, Unit& u) const {
        int tile, pn;
        if ((G & 7) == 0) {
            int tlo, nx; xrange(c & 7, tlo, nx);
            const int li = i * (G >> 3) + (c >> 3); if (li >= nx * nN) return false;
            tile = tlo + li / nN; pn = li % nN;
        } else { const int L = i * G + c; if (L >= ntiles * nN) return false; tile = L / nN; pn = L % nN; }
        const int e = __builtin_amdgcn_readfirstlane((int)tile_e[tile]);
        u.a0 = (unsigned)tile * 256u; u.B = Bbase + ((size_t)e * Ne + (size_t)(pn0 + pn) * (unsigned)bstep) * ldb; u.p0 = tile; u.p1 = pn; u.p2 = e; return true;
    }
    __device__ __forceinline__ unsigned aoff(const Unit& u, int q) const {
        if (GATHER) return (unsigned)rowidx[u.a0 + (unsigned)q] * lda;
        return (u.a0 + (unsigned)q) * lda;
    }
};
}

struct Params {
    const float* in[34];
    float* out;
    unsigned char* ws;
    int ph_lo, ph_hi;
};
enum { I_X = 0, I_C, I_CTX, I_CCTX, I_ADAW, I_ADAB, I_NMG, I_NFG, I_WIN, I_ARE, I_AIM, I_LDT, I_BRE, I_BIM, I_CRE, I_CIM, I_S5D, I_GLUW, I_GLUB, I_CONVW,
       I_HOUT, I_WQKV, I_QG, I_KG, I_RPB, I_NOUT, I_RW, I_RB, I_MG, I_MU, I_MD, I_SG, I_SU, I_SD };

using g8::Unit;
typedef f32x4 Acc[2][2][4][2];

__device__ __forceinline__ u32x4 pack8(const f32x4& a, const f32x4& b) {
    u32x4 w; w.x = pk2(a[0], a[1]); w.y = pk2(a[2], a[3]); w.z = pk2(b[0], b[1]); w.w = pk2(b[2], b[3]); return w;
}

struct EpiWin {
    static constexpr bool PERM = true, HEADP = false, WIDE = false, GUP = false;
    bf16_t* A2; bf16_t* BCV;
    __device__ __forceinline__ void operator()(const Acc& acc, const Unit& u, int wr, int wc, int fr, int fq) const {
#pragma unroll
        for (int ai = 0; ai < 2; ++ai)
#pragma unroll
            for (int m = 0; m < 4; ++m) {
                const int row = u.p0 * 256 + 128 * ai + 64 * wr + 16 * m + fr;
#pragma unroll
                for (int bj = 0; bj < 2; ++bj) {
                    const int col0 = u.p1 * 256 + 128 * bj + 32 * wc + 8 * fq;
                    const u32x4 w = pack8(acc[ai][bj][m][0], acc[ai][bj][m][1]);
                    if (u.p1 < 2) {
                        const int g = col0 >> 4, ci0 = col0 & 15, r = row >> 5, s = row & 31;
                        *(u32x4*)(A2 + ((size_t)(g * S5RP + r) * S5K + s * 16 + ci0)) = w;
                    } else {
                        *(u32x4*)(BCV + ((size_t)row * 1536 + (col0 - 512))) = w;
                    }
                }
            }
    }
};
struct EpiS5F {
    static constexpr bool PERM = false, HEADP = false, WIDE = false, GUP = false;
    float* F;
    __device__ __forceinline__ void operator()(const Acc& acc, const Unit& u, int wr, int wc, int fr, int fq) const {
#pragma unroll
        for (int ai = 0; ai < 2; ++ai)
#pragma unroll
            for (int m = 0; m < 4; ++m) {
                const int row = u.p1 * 256 + 128 * ai + 64 * wr + 16 * m + fr;
                float* rp = F + ((size_t)(u.p0 * S5RP + row) * 256);
#pragma unroll
                for (int bj = 0; bj < 2; ++bj)
#pragma unroll
                    for (int n = 0; n < 2; ++n) *(f32x4*)(rp + 128 * bj + 32 * wc + 16 * n + 4 * fq) = acc[ai][bj][m][n];
            }
    }
};
struct EpiS5Y {
    static constexpr bool PERM = true, HEADP = false, WIDE = false, GUP = false;
    bf16_t* Gb;
    __device__ __forceinline__ void operator()(const Acc& acc, const Unit& u, int wr, int wc, int fr, int fq) const {
#pragma unroll
        for (int ai = 0; ai < 2; ++ai)
#pragma unroll
            for (int m = 0; m < 4; ++m) {
                const int r = u.p1 * 256 + 128 * ai + 64 * wr + 16 * m + fr;
                if (r < S5R) {
#pragma unroll
                    for (int bj = 0; bj < 2; ++bj) {
                        const int col0 = u.p2 * 256 + 128 * bj + 32 * wc + 8 * fq;
                        const int t = col0 >> 4, co0 = col0 & 15;
                        f32x4 a = acc[ai][bj][m][0], b = acc[ai][bj][m][1];
#pragma unroll
                        for (int j = 0; j < 4; ++j) { a[j] = gelu_tanh(a[j]); b[j] = gelu_tanh(b[j]); }
                        *(u32x4*)(Gb + ((size_t)(r * S5T + t) * 512 + u.p0 * 16 + co0)) = pack8(a, b);
                    }
                }
            }
    }
};
struct EpiGlu {
    static constexpr bool PERM = true, HEADP = false, WIDE = false, GUP = false;
    const bf16_t* Gb; const float* bias; bf16_t* Z;
    __device__ __forceinline__ void operator()(const Acc& acc, const Unit& u, int wr, int wc, int fr, int fq) const {
#pragma unroll
        for (int ai = 0; ai < 2; ++ai)
#pragma unroll
            for (int m = 0; m < 4; ++m) {
                const int row = u.p0 * 256 + 128 * ai + 64 * wr + 16 * m + fr;
#pragma unroll
                for (int bj = 0; bj < 2; ++bj) {
                    const int col0 = u.p1 * 256 + 128 * bj + 32 * wc + 8 * fq;
                    const u32x4 gv = *(const u32x4*)(Gb + ((size_t)row * 512 + col0));
                    const f32x4 b0 = *(const f32x4*)(bias + col0), b1 = *(const f32x4*)(bias + col0 + 4);
                    f32x4 a = acc[ai][bj][m][0] + b0, b = acc[ai][bj][m][1] + b1;
                    a[0] = bflo(gv.x) * sigmoidf_(a[0]); a[1] = bfhi(gv.x) * sigmoidf_(a[1]); a[2] = bflo(gv.y) * sigmoidf_(a[2]); a[3] = bfhi(gv.y) * sigmoidf_(a[3]);
                    b[0] = bflo(gv.z) * sigmoidf_(b[0]); b[1] = bfhi(gv.z) * sigmoidf_(b[1]); b[2] = bflo(gv.w) * sigmoidf_(b[2]); b[3] = bfhi(gv.w) * sigmoidf_(b[3]);
                    *(u32x4*)(Z + ((size_t)row * 1024 + col0)) = pack8(a, b);
                }
            }
    }
};
template <bool SRCF32>
struct EpiResid {
    static constexpr bool PERM = true, HEADP = false, WIDE = true, GUP = false;
    const float* xlat; const float* xctx;
    const float* gate;
    bf16_t* XR; float rs;
    __device__ __forceinline__ void operator()(const Acc& acc, const Unit& u, int wr, int wc, int fr, int fq) const {
#pragma unroll
        for (int ai = 0; ai < 2; ++ai)
#pragma unroll
            for (int m = 0; m < 4; ++m) {
                const int row = u.p0 * 256 + 128 * ai + 64 * wr + 16 * m + fr;
                const int b = row < NLAT ? (row >> 11) : 8;
                const int col = u.p1 * 256 + 64 * wc + 16 * fq;
                const float* gp = gate + b * 6144 + col;
                f32x4 xv[4];
                if (SRCF32) {
                    const float* src = (row < NLAT ? xlat + (size_t)row * DM : xctx + (size_t)(row - NLAT) * DM) + col;
#pragma unroll
                    for (int q = 0; q < 4; ++q) xv[q] = *(const f32x4*)(src + 4 * q);
                } else {
                    const u32x4 a = *(const u32x4*)(XR + (size_t)row * DM + col), c = *(const u32x4*)(XR + (size_t)row * DM + col + 8);
                    xv[0] = (f32x4){bflo(a.x), bfhi(a.x), bflo(a.y), bfhi(a.y)}; xv[1] = (f32x4){bflo(a.z), bfhi(a.z), bflo(a.w), bfhi(a.w)};
                    xv[2] = (f32x4){bflo(c.x), bfhi(c.x), bflo(c.y), bfhi(c.y)}; xv[3] = (f32x4){bflo(c.z), bfhi(c.z), bflo(c.w), bfhi(c.w)};
                }
                const f32x4 o0 = xv[0] + *(const f32x4*)(gp) * (acc[ai][0][m][0] * rs), o1 = xv[1] + *(const f32x4*)(gp + 4) * (acc[ai][0][m][1] * rs);
                const f32x4 o2 = xv[2] + *(const f32x4*)(gp + 8) * (acc[ai][1][m][0] * rs), o3 = xv[3] + *(const f32x4*)(gp + 12) * (acc[ai][1][m][1] * rs);
                *(u32x4*)(XR + (size_t)row * DM + col) = pack8(o0, o1); *(u32x4*)(XR + (size_t)row * DM + col + 8) = pack8(o2, o3);
            }
    }
};
struct EpiGU {
    static constexpr bool PERM = false, HEADP = false, WIDE = false, GUP = true;
    bf16_t* ACT;
    __device__ __forceinline__ void operator()(const Acc& acc, const Unit& u, int wr, int wc, int fr, int fq) const {
#pragma unroll
        for (int ai = 0; ai < 2; ++ai)
#pragma unroll
            for (int m = 0; m < 4; ++m) {
                const int slot = u.p0 * 256 + 128 * ai + 64 * wr + 16 * m + fr;
                u32x4 o;
#pragma unroll
                for (int bj = 0; bj < 2; ++bj) {
                    const f32x4 g = acc[ai][bj][m][0], up = acc[ai][bj][m][1];
                    o[2 * bj] = pk2(siluf_(g[0]) * up[0], siluf_(g[1]) * up[1]); o[2 * bj + 1] = pk2(siluf_(g[2]) * up[2], siluf_(g[3]) * up[3]);
                }
                *(u32x4*)(ACT + ((size_t)slot * EDIM + u.p1 * 128 + 32 * wc + 8 * fq)) = o;
            }
    }
};
__device__ __forceinline__ float fp8c(float v) { return __builtin_amdgcn_fmed3f(v * 16.f, -440.f, 440.f); }
__device__ __forceinline__ u32x2 pack8_fp8(const f32x4& a, const f32x4& b) {
    int w0 = 0, w1 = 0;
    w0 = __builtin_amdgcn_cvt_pk_fp8_f32(fp8c(a[0]), fp8c(a[1]), w0, false); w0 = __builtin_amdgcn_cvt_pk_fp8_f32(fp8c(a[2]), fp8c(a[3]), w0, true);
    w1 = __builtin_amdgcn_cvt_pk_fp8_f32(fp8c(b[0]), fp8c(b[1]), w1, false); w1 = __builtin_amdgcn_cvt_pk_fp8_f32(fp8c(b[2]), fp8c(b[3]), w1, true);
    return (u32x2){(unsigned)w0, (unsigned)w1};
}
struct EpiDN {
    static constexpr bool PERM = true, HEADP = false, WIDE = true, GUP = false;
    unsigned char* Y;
    __device__ __forceinline__ void operator()(const Acc& acc, const Unit& u, int wr, int wc, int fr, int fq) const {
#pragma unroll
        for (int ai = 0; ai < 2; ++ai)
#pragma unroll
            for (int m = 0; m < 4; ++m) {
                const int slot = u.p0 * 256 + 128 * ai + 64 * wr + 16 * m + fr;
                const u32x2 lo = pack8_fp8(acc[ai][0][m][0], acc[ai][0][m][1]), hi = pack8_fp8(acc[ai][1][m][0], acc[ai][1][m][1]);
                *(u32x4*)(Y + ((size_t)slot * 1024 + u.p1 * 256 + 64 * wc + 16 * fq)) = (u32x4){lo.x, lo.y, hi.x, hi.y};
            }
    }
};
struct EpiQKV {
    static constexpr bool PERM = true, HEADP = true, WIDE = false, GUP = false;
    bf16_t* Q; bf16_t* Kb; bf16_t* VT; const float* qg; const float* kg;
    __device__ __forceinline__ void operator()(const Acc& acc, const Unit& u, int wr, int wc, int fr, int fq) const {
        const int region = u.p1 >> 2;
        if (region < 2) {
            const float* gp = (region == 0 ? qg : kg) + 8 * fq; const float gs = region == 0 ? 0.125f * 1.4426950408889634f : 1.f;
            f32x4 g[2][2];
#pragma unroll
            for (int bj = 0; bj < 2; ++bj)
#pragma unroll
                for (int n = 0; n < 2; ++n) g[bj][n] = *(const f32x4*)(gp + 32 * bj + 4 * n) * gs;
            bf16_t* dst = region == 0 ? Q : Kb;
#pragma unroll
            for (int ai = 0; ai < 2; ++ai)
#pragma unroll
                for (int m = 0; m < 4; ++m) {
                    const int row = u.p0 * 256 + 128 * ai + 64 * wr + 16 * m + fr;
                    float ss = 0.f;
#pragma unroll
                    for (int bj = 0; bj < 2; ++bj)
#pragma unroll
                        for (int n = 0; n < 2; ++n) { const f32x4 v = acc[ai][bj][m][n]; ss += (v[0] * v[0] + v[1] * v[1]) + (v[2] * v[2] + v[3] * v[3]); }
                    ss += __shfl_xor(ss, 16); ss += __shfl_xor(ss, 32);
                    const float rstd = rsqrtf(ss * (1.f / 64.f) + 1e-6f);
                    bf16_t* rp = dst + ((size_t)row * DM + (u.p1 & 3) * 256 + 64 * wc + 8 * fq);
#pragma unroll
                    for (int bj = 0; bj < 2; ++bj) *(u32x4*)(rp + 32 * bj) = pack8(acc[ai][bj][m][0] * rstd * g[bj][0], acc[ai][bj][m][1] * rstd * g[bj][1]);
                }
        } else {
#pragma unroll
            for (int ai = 0; ai < 2; ++ai)
#pragma unroll
                for (int m = 0; m < 4; ++m) {
                    const int row = u.p0 * 256 + 128 * ai + 64 * wr + 16 * m + fr;
                    bf16_t* rp = VT + ((size_t)row * DM + (u.p1 & 3) * 256 + 64 * wc + 8 * fq);
#pragma unroll
                    for (int bj = 0; bj < 2; ++bj) *(u32x4*)(rp + 32 * bj) = pack8(acc[ai][bj][m][0], acc[ai][bj][m][1]);
                }
        }
    }
};

struct Ctx { int tid, lane, wave, G, blk, gw, NGW; LAS unsigned char* lds; };
__device__ __forceinline__ Ctx mkctx(LAS unsigned char* lds, int wave0) {
    Ctx X; X.lane = lane_id_opaque(); X.wave = wave0; X.tid = wave0 * 64 + X.lane; X.G = gridDim.x; X.blk = blockIdx.x;
    X.gw = X.blk * 8 + X.wave; X.NGW = X.G * 8; X.lds = lds; return X;
}

template <int MODE> __device__ __forceinline__ int wrow(int n) { return MODE == 2 ? 256 + n : n; }
template <int MODE>
__device__ __forceinline__ void conv_item(const float* W, int N, bf16_t* WT, int ldk, int k0, int n0, LAS unsigned* T, int lane) {
    (void)T;
    const int nq = lane & 15, kg = lane >> 4;
    const float* wp = W + (size_t)(k0 + 16 * kg) * N + n0 + 4 * nq;
    f32x4 r[16];
#pragma unroll
    for (int i = 0; i < 16; ++i) r[i] = *(const f32x4*)(wp + (size_t)i * N);
#pragma unroll
    for (int j = 0; j < 4; ++j) {
        bf16_t* op = WT + (size_t)wrow<MODE>(n0 + 4 * nq + j) * ldk + k0 + 16 * kg;
        u32x4 lo, hi;
        lo.x = pk2(r[0][j], r[1][j]); lo.y = pk2(r[2][j], r[3][j]); lo.z = pk2(r[4][j], r[5][j]); lo.w = pk2(r[6][j], r[7][j]);
        hi.x = pk2(r[8][j], r[9][j]); hi.y = pk2(r[10][j], r[11][j]); hi.z = pk2(r[12][j], r[13][j]); hi.w = pk2(r[14][j], r[15][j]);
        *(u32x4*)op = lo; *(u32x4*)(op + 8) = hi;
    }
}
__device__ __forceinline__ void conv_mat(const Ctx& X, const float* W, int K, int N, bf16_t* WT, int& rot) {
    LAS unsigned* T = (LAS unsigned*)(X.lds + X.wave * 8192);
    const int nb = N / 64, nitems = (K / 64) * nb;
    int start = X.gw - rot; while (start < 0) start += X.NGW;
    for (int it = start; it < nitems; it += X.NGW) conv_item<0>(W, N, WT, K, (it / nb) * 64, (it % nb) * 64, T, X.lane);
    rot = (rot + nitems) % X.NGW;
}
template <int KIND>
__device__ __forceinline__ void conv_moe_items(const Ctx& X, const Params& p, int l, bf16_t* GU, bf16_t* DN, int it0, int it1, int rank, int nrank) {
    constexpr int PER = KIND == 0 ? 192 : (KIND == 1 ? 128 : 64);
    for (int it = it0 + rank * 8 + X.wave; it < it1; it += nrank * 8) {
        const int e = it / PER, r = it % PER, kind = KIND == 2 ? 2 : (r >> 6), q = r & 63;
        if (kind == 0) {
            const float* W = e < NEXP ? p.in[I_MG] + (size_t)(l * NEXP + e) * 262144 : p.in[I_SG] + (size_t)l * 262144;
            conv_item<1>(W, 256, GU + (size_t)e * 512 * 1024, 1024, (q >> 2) * 64, (q & 3) * 64, nullptr, X.lane);
        } else if (kind == 1) {
            const float* W = e < NEXP ? p.in[I_MU] + (size_t)(l * NEXP + e) * 262144 : p.in[I_SU] + (size_t)l * 262144;
            conv_item<2>(W, 256, GU + (size_t)e * 512 * 1024, 1024, (q >> 2) * 64, (q & 3) * 64, nullptr, X.lane);
        } else {
            const float* W = e < NEXP ? p.in[I_MD] + (size_t)(l * NEXP + e) * 262144 : p.in[I_SD] + (size_t)l * 262144;
            conv_item<0>(W, 1024, DN + (size_t)e * 1024 * 256, 256, (q >> 4) * 64, (q & 15) * 64, nullptr, X.lane);
        }
    }
}
__device__ __forceinline__ int moe_idle_rank(int ntiles, int nN, int G, int blk, int& nidle) {
    if ((G & 7) != 0) { const int nunits = ntiles * nN, nfull = nunits % G; if (nfull == 0) { nidle = G; return blk; } nidle = G - nfull; return blk >= nfull ? blk - nfull : -1; }
    const int B8 = G >> 3, q = ntiles >> 3, r = ntiles & 7;
    int maxc = 0;
    for (int x = 0; x < 8; ++x) { const int n = (q + (x < r ? 1 : 0)) * nN; const int cmax = (n + B8 - 1) / B8; maxc = cmax > maxc ? cmax : maxc; }
    int rank = -1, cnt = 0;
    for (int x = 0; x < 8; ++x) {
        const int n = (q + (x < r ? 1 : 0)) * nN;
        int jfull = n - (maxc - 1) * B8; jfull = jfull < 0 ? 0 : (jfull > B8 ? B8 : jfull);
        if (x == (blk & 7)) { const int j = blk >> 3; if (j >= jfull) rank = cnt + (j - jfull); }
        cnt += B8 - jfull;
    }
    if (cnt == 0) { nidle = G; return blk; }
    nidle = cnt; return rank;
}
__device__ __forceinline__ int idle_rank(int nunits, int G, int blk, int& nidle) {
    const int nfull = nunits % G;
    if (nfull == 0) { nidle = G; return blk; }
    nidle = G - nfull; return blk >= nfull ? blk - nfull : -1;
}

__device__ __forceinline__ void sincos_red(float x, float& s, float& c) {
    const float n = rintf(x * 0.15915494309189535f);
    float r = fmaf(-n, 6.28125f, x); r = fmaf(-n, 1.9353071795864769e-3f, r);
    s = __sinf(r); c = __cosf(r);
}

__device__ __forceinline__ void phase_p0a(const Ctx& X, const Params& p) {
    {
        LAS float* PWs = (LAS float*)(X.lds);
        LAS float* BBs = (LAS float*)(X.lds + 20480);
        LAS float* CCs = (LAS float*)(X.lds + 32768);
        float* KK = (float*)(p.ws + WS_KK); float* PWG = (float*)(p.ws + WS_PW); float* BBG = (float*)(p.ws + WS_BB);
        for (int item = X.blk; item < 256; item += X.G) {
            const int g = item >> 3, d = (item >> 2) & 1, lq = item & 3, gd = d * 32 + g;
            const float dt = expf(p.in[I_LDT][gd]);
            __syncthreads();
            for (int idx = X.tid; idx < 33 * 64; idx += 512) {
                const int j = idx >> 6, pp = idx & 63;
                const float lre = fminf(p.in[I_ARE][gd * 64 + pp], -1e-4f), lim = p.in[I_AIM][gd * 64 + pp];
                const float mag = expf(lre * dt * (float)j); float sn, cs; sincos_red(lim * dt * (float)j, sn, cs);
                PWs[2 * idx] = mag * cs; PWs[2 * idx + 1] = mag * sn;
            }
            for (int idx = X.tid; idx < 1024; idx += 512) {
                const int pp = idx >> 4;
                const float lre = fminf(p.in[I_ARE][gd * 64 + pp], -1e-4f), lim = p.in[I_AIM][gd * 64 + pp];
                const float mag = expf(lre * dt); float sn, cs; sincos_red(lim * dt, sn, cs);
                const float nr = mag * cs - 1.f, ni = mag * sn, den = 1.f / (lre * lre + lim * lim);
                const float cr = (nr * lre + ni * lim) * den, ci = (ni * lre - nr * lim) * den;
                const float br = p.in[I_BRE][(size_t)gd * 1024 + idx], bi = p.in[I_BIM][(size_t)gd * 1024 + idx];
                BBs[2 * idx] = cr * br - ci * bi; BBs[2 * idx + 1] = cr * bi + ci * br;
            }
            for (int idx = X.tid; idx < 1024; idx += 512) { CCs[2 * idx] = p.in[I_CRE][(size_t)gd * 1024 + idx]; CCs[2 * idx + 1] = p.in[I_CIM][(size_t)gd * 1024 + idx]; }
            __syncthreads();
#pragma unroll
            for (int i = 0; i < 4; ++i) {
                const int e = X.tid + 512 * i, lag = 8 * lq + (e >> 8), co = (e >> 4) & 15, ci = e & 15;
                float sum = 0.f;
                for (int pp = 0; pp < 64; ++pp) {
                    const float pr = PWs[2 * (lag * 64 + pp)], pi = PWs[2 * (lag * 64 + pp) + 1];
                    const float br = BBs[2 * (pp * 16 + ci)], bi = BBs[2 * (pp * 16 + ci) + 1];
                    const float tr = pr * br - pi * bi, ti = pr * bi + pi * br;
                    sum += CCs[2 * (co * 64 + pp)] * tr - CCs[2 * (co * 64 + pp) + 1] * ti;
                }
                KK[(size_t)((g * 2 + d) * 32 + lag) * 256 + co * 16 + ci] = sum;
            }
            if (lq == 0) {
                for (int idx = X.tid; idx < 33 * 64 * 2; idx += 512) PWG[(size_t)(g * 2 + d) * 33 * 64 * 2 + idx] = PWs[idx];
                for (int idx = X.tid; idx < 2048; idx += 512) BBG[(size_t)(g * 2 + d) * 2048 + idx] = BBs[idx];
            }
        }
        __syncthreads();
    }
    {
        LAS float* condS = (LAS float*)(X.lds + 65536);
        for (int i = X.tid; i < 9 * 1024; i += 512) { const int r = i >> 10, k = i & 1023; const float v = r < 8 ? p.in[I_C][r * 1024 + k] : p.in[I_CCTX][k]; condS[i] = siluf_(v); }
        __syncthreads();
        float* ADAP = (float*)(p.ws + WS_ADAP);
        for (int it = X.gw; it < 3072; it += X.NGW) {
            const int l = it / 1536, rem = it % 1536, cg = rem >> 4, kq = rem & 15, col = cg * 64 + X.lane;
            const float* wp = p.in[I_ADAW] + (size_t)l * 1024 * 6144 + (size_t)(kq * 64) * 6144 + col;
            float a0 = 0, a1 = 0, a2 = 0, a3 = 0, a4 = 0, a5 = 0, a6 = 0, a7 = 0, a8 = 0;
            float wv[64];
#pragma unroll
            for (int kk = 0; kk < 64; ++kk) wv[kk] = wp[(size_t)kk * 6144];
#pragma unroll
            for (int kk = 0; kk < 64; ++kk) {
                const float w = wv[kk]; const LAS float* cp = condS + kq * 64 + kk;
                a0 += cp[0] * w; a1 += cp[1024] * w; a2 += cp[2048] * w; a3 += cp[3072] * w; a4 += cp[4096] * w; a5 += cp[5120] * w; a6 += cp[6144] * w; a7 += cp[7168] * w; a8 += cp[8192] * w;
            }
            float* op = ADAP + (size_t)((kq * 2 + l) * 9) * 6144 + col;
            op[0] = a0; op[6144] = a1; op[2 * 6144] = a2; op[3 * 6144] = a3; op[4 * 6144] = a4; op[5 * 6144] = a5; op[6 * 6144] = a6; op[7 * 6144] = a7; op[8 * 6144] = a8;
        }
        __syncthreads();
    }
    {
        int rot = 0;
        conv_mat(X, p.in[I_WIN], 1024, 2048, (bf16_t*)(p.ws + WS_WIN), rot);
        conv_mat(X, p.in[I_GLUW], 512, 512, (bf16_t*)(p.ws + WS_GLU), rot);
        conv_mat(X, p.in[I_HOUT], 1024, 1024, (bf16_t*)(p.ws + WS_HOUT), rot);
        conv_mat(X, p.in[I_WQKV], 1024, 3072, (bf16_t*)(p.ws + WS_QKV), rot);
        conv_mat(X, p.in[I_NOUT], 1024, 1024, (bf16_t*)(p.ws + WS_NOUT), rot);
        conv_mat(X, p.in[I_RW], 1024, 64, (bf16_t*)(p.ws + WS_ROUT), rot);
        conv_mat(X, p.in[I_RW] + 65536, 1024, 64, (bf16_t*)(p.ws + WS_ROUT) + 256 * 1024, rot);
        for (int i = X.gw * 64 + X.lane; i < 2 * 192 * 128; i += X.NGW * 64) {
            const int l = i / (192 * 128), r = i % (192 * 128);
            *(u32x4*)((bf16_t*)(p.ws + WS_ROUT) + (size_t)l * 256 * 1024 + 64 * 1024 + (size_t)r * 8) = (u32x4){0u, 0u, 0u, 0u};
        }
    }
}

__device__ __forceinline__ void phase_p0b(const Ctx& X, const Params& p) {
    const int gt = X.blk * 512 + X.tid, NT = X.G * 512;
    float* MOD = (float*)(p.ws + WS_MOD); const float* ADAP = (const float*)(p.ws + WS_ADAP);
    for (int idx = gt; idx < 2 * 9 * 6144; idx += NT) {
        const int l = idx / (9 * 6144), col = idx % 6144;
        float s = p.in[I_ADAB][l * 6144 + col];
#pragma unroll
        for (int kq = 0; kq < 16; ++kq) s += ADAP[(size_t)kq * 110592 + idx];
        MOD[idx] = s;
    }
    const float* KK = (const float*)(p.ws + WS_KK); const float* PWG = (const float*)(p.ws + WS_PW); const float* BBG = (const float*)(p.ws + WS_BB);
    bf16_t* ME = (bf16_t*)(p.ws + WS_ME); bf16_t* WF = (bf16_t*)(p.ws + WS_WF);
    for (int ch = gt; ch < 32 * 512 * 96; ch += NT) {
        const int kc = ch % 96, n = (ch / 96) & 511, g = ch / (96 * 512), t = n >> 4, co = n & 15, k0 = kc * 8;
        float v[8];
        if (k0 < 512) {
            const int s_ = k0 >> 4, ci0 = k0 & 15;
            const int lf = t - s_, lb = s_ - t; const float mf = lf >= 0 ? 1.f : 0.f, mb = lb >= 0 ? 1.f : 0.f;
            const float* kf = KK + (size_t)((g * 2 + 0) * 32 + (lf >= 0 ? lf : 0)) * 256 + co * 16 + ci0;
            const float* kb = KK + (size_t)((g * 2 + 1) * 32 + (lb >= 0 ? lb : 0)) * 256 + co * 16 + ci0;
            const f32x4 f0 = *(const f32x4*)kf, f1 = *(const f32x4*)(kf + 4), b0 = *(const f32x4*)kb, b1 = *(const f32x4*)(kb + 4);
            const float dsk = p.in[I_S5D][16 * g + co];
#pragma unroll
            for (int j = 0; j < 4; ++j) {
                v[j] = f0[j] * mf + b0[j] * mb + ((s_ == t && ci0 + j == co) ? dsk : 0.f);
                v[4 + j] = f1[j] * mf + b1[j] * mb + ((s_ == t && ci0 + 4 + j == co) ? dsk : 0.f);
            }
        } else {
            const int kk = k0 - 512, d = kk >> 7, ri = (kk >> 6) & 1, p0 = kk & 63, jj = d == 0 ? t + 1 : 32 - t;
            const float* pw = PWG + ((size_t)((g * 2 + d) * 33 + jj) * 64 + p0) * 2;
            const float* crp = p.in[I_CRE] + (size_t)((d * 32 + g) * 16 + co) * 64 + p0; const float* cip = p.in[I_CIM] + (size_t)((d * 32 + g) * 16 + co) * 64 + p0;
            f32x4 pq[4];
#pragma unroll
            for (int q = 0; q < 4; ++q) pq[q] = *(const f32x4*)(pw + 4 * q);
            const f32x4 cr0 = *(const f32x4*)crp, cr1 = *(const f32x4*)(crp + 4), ci0v = *(const f32x4*)cip, ci1v = *(const f32x4*)(cip + 4);
#pragma unroll
            for (int j = 0; j < 8; ++j) {
                const float pr = pq[j >> 1][(j & 1) * 2], pi = pq[j >> 1][(j & 1) * 2 + 1];
                const float cr = j < 4 ? cr0[j & 3] : cr1[j & 3], cim = j < 4 ? ci0v[j & 3] : ci1v[j & 3];
                const float zr = cr * pr - cim * pi, zi = cr * pi + cim * pr;
                v[j] = ri == 0 ? zr : -zi;
            }
        }
        u32x4 w; w.x = pk2(v[0], v[1]); w.y = pk2(v[2], v[3]); w.z = pk2(v[4], v[5]); w.w = pk2(v[6], v[7]);
        *(u32x4*)(ME + ((size_t)(g * 512 + n)) * 768 + k0) = w;
    }
    for (int ch = gt; ch < 32 * 256 * 64; ch += NT) {
        const int kc = ch & 63, n = (ch >> 6) & 255, g = ch >> 14, d = n >> 7, ri = (n >> 6) & 1, pp = n & 63, k0 = kc * 8, s_ = k0 >> 4, ci0 = k0 & 15;
        const int jj = d == 0 ? 31 - s_ : s_;
        const float pr = PWG[((size_t)((g * 2 + d) * 33 + jj) * 64 + pp) * 2], pi = PWG[((size_t)((g * 2 + d) * 33 + jj) * 64 + pp) * 2 + 1];
        const float* bb = BBG + ((size_t)(g * 2 + d) * 1024 + pp * 16 + ci0) * 2;
        f32x4 bq[4];
#pragma unroll
        for (int q = 0; q < 4; ++q) bq[q] = *(const f32x4*)(bb + 4 * q);
        float v[8];
#pragma unroll
        for (int j = 0; j < 8; ++j) {
            const float br = bq[j >> 1][(j & 1) * 2], bi = bq[j >> 1][(j & 1) * 2 + 1];
            v[j] = ri == 0 ? (pr * br - pi * bi) : (pr * bi + pi * br);
        }
        u32x4 w; w.x = pk2(v[0], v[1]); w.y = pk2(v[2], v[3]); w.z = pk2(v[4], v[5]); w.w = pk2(v[6], v[7]);
        *(u32x4*)(WF + ((size_t)(g * 256 + n)) * 512 + k0) = w;
    }
}

template <int SRC>
__device__ __forceinline__ void norm_load(const Params& p, int row, int lane, f32x4 (&v)[4]) {
    if (SRC == 0) {
        const float* src = (row < NLAT ? p.in[I_X] + (size_t)row * DM : p.in[I_CTX] + (size_t)(row - NLAT) * DM) + 8 * lane;
        v[0] = *(const f32x4*)(src); v[1] = *(const f32x4*)(src + 4); v[2] = *(const f32x4*)(src + 512); v[3] = *(const f32x4*)(src + 516);
    } else {
        const bf16_t* src = (const bf16_t*)(p.ws + WS_XR) + (size_t)row * DM + 8 * lane;
        const u32x4 a = *(const u32x4*)(src), c = *(const u32x4*)(src + 512);
        v[0] = (f32x4){bflo(a.x), bfhi(a.x), bflo(a.y), bfhi(a.y)}; v[1] = (f32x4){bflo(a.z), bfhi(a.z), bflo(a.w), bfhi(a.w)};
        v[2] = (f32x4){bflo(c.x), bfhi(c.x), bflo(c.y), bfhi(c.y)}; v[3] = (f32x4){bflo(c.z), bfhi(c.z), bflo(c.w), bfhi(c.w)};
    }
}
template <int SRC>
__device__ __forceinline__ void phase_norm(const Ctx& X, const Params& p, int l, int ffn, int ntok) {
    const float* gain = (ffn ? p.in[I_NFG] : p.in[I_NMG]) + l * 1024;
    const float* mod = (const float*)(p.ws + WS_MOD) + (size_t)l * 9 * 6144;
    const int shi = ffn ? 3 : 0, sci = ffn ? 4 : 1;
    bf16_t* XA = (bf16_t*)(p.ws + WS_XA);
    const int rpw = (ntok + X.NGW - 1) / X.NGW, r0 = X.gw * rpw, r1 = (r0 + rpw) < ntok ? (r0 + rpw) : ntok;
    int curb = -1; f32x4 gm[4], sh[4];
    f32x4 vn[4];
    if (r0 < r1) norm_load<SRC>(p, r0, X.lane, vn);
    for (int row = r0; row < r1; ++row) {
        const int b = row < NLAT ? (row >> 11) : 8;
        if (b != curb) {
            curb = b;
#pragma unroll
            for (int j = 0; j < 4; ++j) {
                const int c = 8 * X.lane + 512 * (j >> 1) + 4 * (j & 1);
                const f32x4 g4 = *(const f32x4*)(gain + c), sc4 = *(const f32x4*)(mod + b * 6144 + sci * 1024 + c);
                sh[j] = *(const f32x4*)(mod + b * 6144 + shi * 1024 + c); gm[j] = g4 * (sc4 + 1.f);
            }
        }
        f32x4 v[4]; float ss = 0.f;
#pragma unroll
        for (int j = 0; j < 4; ++j) v[j] = vn[j];
        if (row + 1 < r1) norm_load<SRC>(p, row + 1, X.lane, vn);
#pragma unroll
        for (int j = 0; j < 4; ++j) ss += (v[j][0] * v[j][0] + v[j][1] * v[j][1]) + (v[j][2] * v[j][2] + v[j][3] * v[j][3]);
        const float rstd = rsqrtf(wave_sum(ss) * (1.f / 1024.f) + 1e-6f);
        const f32x4 o0 = v[0] * rstd * gm[0] + sh[0], o1 = v[1] * rstd * gm[1] + sh[1], o2 = v[2] * rstd * gm[2] + sh[2], o3 = v[3] * rstd * gm[3] + sh[3];
        *(u32x4*)(XA + (size_t)row * DM + 8 * X.lane) = pack8(o0, o1); *(u32x4*)(XA + (size_t)row * DM + 512 + 8 * X.lane) = pack8(o2, o3);
    }
}

__device__ __forceinline__ void phase_scan_conv(const Ctx& X, const Params& p) {
    const float* F = (const float*)(p.ws + WS_F); bf16_t* A2 = (bf16_t*)(p.ws + WS_A2); const float* PWG = (const float*)(p.ws + WS_PW);
    for (int gid = X.blk * 512 + X.tid; gid < 32768; gid += X.G * 512) {
        const int pp = gid & 63, d = (gid >> 6) & 1, g = (gid >> 7) & 31, b = gid >> 12;
        const float ar = PWG[((size_t)((g * 2 + d) * 33 + 32) * 64 + pp) * 2], ai = PWG[((size_t)((g * 2 + d) * 33 + 32) * 64 + pp) * 2 + 1];
        float sr = 0.f, si = 0.f;
        for (int s8 = 0; s8 < 72; s8 += 8) {
            float fr[8], fi[8]; size_t ro[8];
#pragma unroll
            for (int q = 0; q < 8; ++q) {
                const int step = s8 + q; int r;
                if (d == 0) r = step < 8 ? 512 + b * 8 + step : b * 64 + (step - 8);
                else        r = step < 8 ? 512 + b * 8 + (7 - step) : b * 64 + (71 - step);
                ro[q] = (size_t)(g * S5RP + r);
                fr[q] = F[ro[q] * 256 + d * 128 + pp]; fi[q] = F[ro[q] * 256 + d * 128 + 64 + pp];
            }
#pragma unroll
            for (int q = 0; q < 8; ++q) {
                A2[ro[q] * S5K + 512 + d * 128 + pp] = (bf16_t)f2bf(sr); A2[ro[q] * S5K + 512 + d * 128 + 64 + pp] = (bf16_t)f2bf(si);
                const float nr = ar * sr - ai * si + fr[q], ni = ar * si + ai * sr + fi[q];
                sr = nr; si = ni;
            }
        }
    }
    const bf16_t* BCV = (const bf16_t*)(p.ws + WS_BCV); bf16_t* Z = (bf16_t*)(p.ws + WS_Z); const float* cw = p.in[I_CONVW];
    for (int it = X.blk * 512 + X.tid; it < NTOK * 64; it += X.G * 512) {
        const int tok = it >> 6, c0 = (it & 63) * 8;
        const int pos = tok < NLAT ? (tok & 2047) : ((tok - NLAT) & 255), len = tok < NLAT ? 2048 : 256;
        const bf16_t* base = BCV + (size_t)tok * 1536;
        const u32x4 bg = *(const u32x4*)(base + c0), cg1 = *(const u32x4*)(base + 512 + c0), v1 = *(const u32x4*)(base + 1024 + c0);
        u32x4 cg0 = (u32x4){0u, 0u, 0u, 0u}, v0 = cg0, cg2 = cg0, v2 = cg0;
        if (pos > 0) { cg0 = *(const u32x4*)(base - 1536 + 512 + c0); v0 = *(const u32x4*)(base - 1536 + 1024 + c0); }
        if (pos < len - 1) { cg2 = *(const u32x4*)(base + 1536 + 512 + c0); v2 = *(const u32x4*)(base + 1536 + 1024 + c0); }
        float o[8];
#pragma unroll
        for (int j = 0; j < 4; ++j) {
            const float w0a = cw[c0 + 2 * j], w1a = cw[512 + c0 + 2 * j], w2a = cw[1024 + c0 + 2 * j];
            const float w0b = cw[c0 + 2 * j + 1], w1b = cw[512 + c0 + 2 * j + 1], w2b = cw[1024 + c0 + 2 * j + 1];
            o[2 * j] = bflo(bg[j]) * (w0a * bflo(cg0[j]) * bflo(v0[j]) + w1a * bflo(cg1[j]) * bflo(v1[j]) + w2a * bflo(cg2[j]) * bflo(v2[j]));
            o[2 * j + 1] = bfhi(bg[j]) * (w0b * bfhi(cg0[j]) * bfhi(v0[j]) + w1b * bfhi(cg1[j]) * bfhi(v1[j]) + w2b * bfhi(cg2[j]) * bfhi(v2[j]));
        }
        u32x4 w; w.x = pk2(o[0], o[1]); w.y = pk2(o[2], o[3]); w.z = pk2(o[4], o[5]); w.w = pk2(o[6], o[7]);
        *(u32x4*)(Z + (size_t)tok * 1024 + 512 + c0) = w;
    }
}

constexpr int RR_MAXT = 96, RR_KC = 256, RR_PITCH = RR_KC * 2 + 16;
constexpr int RR_A = 0, RR_B = RR_MAXT * RR_PITCH, RR_LG = RR_B + 64 * RR_PITCH;
__device__ __forceinline__ void phase_route(const Ctx& X, const Params& p, int l, int ntok) {
    LAS int* cnt = (LAS int*)(X.lds + MISC_OFF + M_CNT);
    if (X.tid < NEXP1) cnt[X.tid] = 0;
    const bf16_t* XA = (const bf16_t*)(p.ws + WS_XA); const bf16_t* RT = (const bf16_t*)(p.ws + WS_ROUT) + (size_t)l * 256 * 1024;
    int* toke = (int*)(p.ws + WS_TOKE); float* tokw = (float*)(p.ws + WS_TOKW); int* tokp = (int*)(p.ws + WS_TOKP);
    const float rb = p.in[I_RB][l * 64 + X.lane];
    const int tpb = (ntok + X.G - 1) / X.G, t0 = X.blk * tpb, t1 = (t0 + tpb) < ntok ? (t0 + tpb) : ntok, nrow = t1 - t0;
    const int lane = X.lane, grp = lane >> 3, fr = lane & 15, fq = lane >> 4;
    const int nt_ = X.wave & 3, mh = X.wave >> 2;
    f32x4 acc[3];
#pragma unroll
    for (int m = 0; m < 3; ++m) acc[m] = (f32x4){0.f, 0.f, 0.f, 0.f};
    u32x4 va[6], vb[4];
#define RR_LOAD(kc_) do { \
        _Pragma("unroll") for (int q = 0; q < 6; ++q) { const int i = X.tid + 512 * q, r = i >> 5, c = i & 31; const int rr = r < nrow ? r : 0; \
            va[q] = *(const u32x4*)(XA + (size_t)(t0 + rr) * DM + (kc_) + 8 * c); if (r >= nrow) va[q] = (u32x4){0u, 0u, 0u, 0u}; } \
        _Pragma("unroll") for (int q = 0; q < 4; ++q) { const int i = X.tid + 512 * q, r = i >> 5, c = i & 31; vb[q] = *(const u32x4*)(RT + (size_t)r * 1024 + (kc_) + 8 * c); } } while (0)
    RR_LOAD(0);
    for (int kc = 0; kc < 1024; kc += RR_KC) {
        __syncthreads();
#pragma unroll
        for (int q = 0; q < 6; ++q) { const int i = X.tid + 512 * q, r = i >> 5, c = i & 31; *(LAS u32x4*)(X.lds + RR_A + r * RR_PITCH + 16 * c) = va[q]; }
#pragma unroll
        for (int q = 0; q < 4; ++q) { const int i = X.tid + 512 * q, r = i >> 5, c = i & 31; *(LAS u32x4*)(X.lds + RR_B + r * RR_PITCH + 16 * c) = vb[q]; }
        __syncthreads();
        if (kc + RR_KC < 1024) RR_LOAD(kc + RR_KC);
#pragma unroll
        for (int ks = 0; ks < RR_KC / 32; ++ks) {
            const bf16x8 bfr = *(const LAS bf16x8*)(X.lds + RR_B + (16 * nt_ + fr) * RR_PITCH + 64 * ks + 16 * fq);
#pragma unroll
            for (int m = 0; m < 3; ++m) {
                const bf16x8 afr = *(const LAS bf16x8*)(X.lds + RR_A + (16 * (3 * mh + m) + fr) * RR_PITCH + 64 * ks + 16 * fq);
                acc[m] = __builtin_amdgcn_mfma_f32_16x16x32_bf16(afr, bfr, acc[m], 0, 0, 0);
            }
        }
    }
#undef RR_LOAD
    LAS float* LG = (LAS float*)(X.lds + RR_LG);
#pragma unroll
    for (int m = 0; m < 3; ++m)
#pragma unroll
        for (int j = 0; j < 4; ++j) LG[(16 * (3 * mh + m) + 4 * fq + j) * 64 + 16 * nt_ + fr] = acc[m][j];
    __syncthreads();
    for (int tok = t0 + X.wave; tok < t1; tok += 8) {
        const float score = sigmoidf_(LG[(tok - t0) * 64 + lane]);
        const float sel = score + rb;
        int rk = 0;
#pragma unroll
        for (int x = 1; x < 8; ++x) { const float o = __shfl_xor(sel, x); const int ol = lane ^ x; rk += ((o > sel) || (o == sel && ol < lane)) ? 1 : 0; }
        float gs = rk < 2 ? sel : 0.f;
        gs += __shfl_xor(gs, 1); gs += __shfl_xor(gs, 2); gs += __shfl_xor(gs, 4);
        int grk = 0;
#pragma unroll
        for (int x = 1; x < 8; ++x) { const float o = __shfl_xor(gs, 8 * x); const int og = grp ^ x; grk += ((o > gs) || (o == gs && og < grp)) ? 1 : 0; }
        const float msel = grk < 4 ? sel : -__builtin_inff();
        int rank = 0;
#pragma unroll
        for (int j = 0; j < 64; ++j) { const float sj = __builtin_bit_cast(float, __builtin_amdgcn_readlane(__builtin_bit_cast(int, msel), j)); rank += ((sj > msel) || (sj == msel && j < lane)) ? 1 : 0; }
        const bool chosen = rank < 8;
        const float wsum = wave_sum(chosen ? score : 0.f);
        if (chosen) {
            const int lpos = __hip_atomic_fetch_add(cnt + lane, 1, __ATOMIC_RELAXED, __HIP_MEMORY_SCOPE_WORKGROUP);
            toke[(size_t)tok * 8 + rank] = lane; tokw[(size_t)tok * 8 + rank] = score / wsum * 2.5f; tokp[(size_t)tok * 8 + rank] = lpos;
        }
    }
    __syncthreads();
    int* cntblk = (int*)(p.ws + WS_CNTBLK);
    if (X.tid < NEXP1) cntblk[X.blk * NEXP1 + X.tid] = X.tid < NEXP ? cnt[X.tid] : 0;
}

__device__ __forceinline__ void phase_slots(const Ctx& X, const Params& p, int ntok) {
    LAS int* part = (LAS int*)(X.lds + MISC_OFF + M_PART);
    LAS int* ptot = (LAS int*)(X.lds);
    LAS int* pbb = (LAS int*)(X.lds + 4096);
    LAS int* base = (LAS int*)(X.lds + MISC_OFF + M_BASE);
    LAS int* bbase = (LAS int*)(X.lds + MISC_OFF + M_BBASE);
    LAS int* tot = (LAS int*)(X.lds + 8192);
    LAS int* ntl = (LAS int*)(X.lds + MISC_OFF + M_NT);
    (void)part;
    const int* cntblk = (const int*)(p.ws + WS_CNTBLK);
    {
        const int e = X.tid & 127, pt = X.tid >> 7; int s = 0, sb = 0;
        if (e < NEXP) { const int b0 = (X.G * pt) / 4, b1 = (X.G * (pt + 1)) / 4;
            for (int b = b0; b < b1; ++b) { const int c = cntblk[b * NEXP1 + e]; s += c; sb += (b < X.blk) ? c : 0; } }
        ptot[pt * 128 + e] = s; pbb[pt * 128 + e] = sb;
    }
    __syncthreads();
    if (X.tid < NEXP) { tot[X.tid] = ptot[X.tid] + ptot[128 + X.tid] + ptot[256 + X.tid] + ptot[384 + X.tid]; bbase[X.tid] = pbb[X.tid] + pbb[128 + X.tid] + pbb[256 + X.tid] + pbb[384 + X.tid]; }
    __syncthreads();
    if (X.tid == 0) { int acc = 0; for (int e = 0; e < NEXP; ++e) { base[e] = acc; acc += (tot[e] + 255) & ~255; } base[NEXP] = acc; base[NEXP1] = acc + ntok; ntl[0] = (acc + ntok) >> 8; }
    __syncthreads();
    int* rowidx = (int*)(p.ws + WS_ROWIDX); int* tokslot = (int*)(p.ws + WS_YROW);
    const int* toke = (const int*)(p.ws + WS_TOKE); const int* tokp = (const int*)(p.ws + WS_TOKP);
    const int tpb = (ntok + X.G - 1) / X.G, t0 = X.blk * tpb, t1 = (t0 + tpb) < ntok ? (t0 + tpb) : ntok;
    for (int i = t0 * 8 + X.tid; i < t1 * 8; i += 512) {
        const int e = toke[i]; const int slot = base[e] + bbase[e] + tokp[i];
        rowidx[slot] = i >> 3; tokslot[(i >> 3) * 9 + (i & 7)] = slot;
    }
    const int sbase = base[NEXP];
    for (int tok = X.blk * 512 + X.tid; tok < ntok; tok += X.G * 512) { rowidx[sbase + tok] = tok; tokslot[tok * 9 + 8] = sbase + tok; }
    for (int e = X.blk; e < NEXP; e += X.G)
        for (int s = base[e] + tot[e] + X.tid; s < base[e + 1]; s += 512) rowidx[s] = 0;
    if (X.blk == 0) {
        int* TAB = (int*)(p.ws + WS_TAB);
        if (X.tid == 0) TAB[128] = ntl[0];
        for (int t = X.tid; t < ntl[0]; t += 512) { int e = NEXP; const int s = t * 256; for (int k = 0; k < NEXP; ++k) if (s >= base[k] && s < base[k + 1]) e = k; TAB[256 + t] = e; }
    }
}
__device__ __forceinline__ int load_tiles(const Ctx& X, const Params& p) {
    const int* TAB = (const int*)(p.ws + WS_TAB);
    LAS unsigned char* te = X.lds + MISC_OFF + M_TILE;
    const int nt = TAB[128];
    for (int t = X.tid; t < nt; t += 512) te[t] = (unsigned char)TAB[256 + t];
    __syncthreads();
    return __builtin_amdgcn_readfirstlane(nt);
}

template <bool NEXTNORM>
__device__ __forceinline__ void phase_combine(const Ctx& X, const Params& p, int l, int ntok, bool final_out, float rs) {
    const unsigned char* Y = (const unsigned char*)(p.ws + WS_Y); bf16_t* XR = (bf16_t*)(p.ws + WS_XR);
    const int* tokslot = (const int*)(p.ws + WS_YROW); const float* tokw = (const float*)(p.ws + WS_TOKW);
    const float* gate = (const float*)(p.ws + WS_MOD) + (size_t)l * 9 * 6144 + 5 * 1024;
    const float* gain = p.in[I_NMG] + (l + 1) * 1024; const float* modn = (const float*)(p.ws + WS_MOD) + (size_t)(l + 1) * 9 * 6144;
    bf16_t* XN = (bf16_t*)(p.ws + WS_ACT);
    for (int tok = X.gw; tok < ntok; tok += X.NGW) {
        const int b = tok < NLAT ? (tok >> 11) : 8, c = 16 * X.lane;
        float s[16];
#pragma unroll
        for (int q = 0; q < 16; ++q) s[q] = 0.f;
#pragma unroll
        for (int j = 0; j < 9; ++j) {
            const int slot = __builtin_amdgcn_readfirstlane(tokslot[tok * 9 + j]);
            const float w = j < 8 ? __builtin_bit_cast(float, __builtin_amdgcn_readfirstlane(__builtin_bit_cast(int, tokw[tok * 8 + (j & 7)]))) : 1.f;
            const u32x4 y = *(const u32x4*)(Y + ((size_t)slot * 1024 + c));
#pragma unroll
            for (int q = 0; q < 4; ++q) {
                const f32x2 lo = __builtin_amdgcn_cvt_pk_f32_fp8((int)y[q], false), hi = __builtin_amdgcn_cvt_pk_f32_fp8((int)y[q], true);
                s[4 * q] += w * lo.x; s[4 * q + 1] += w * lo.y; s[4 * q + 2] += w * hi.x; s[4 * q + 3] += w * hi.y;
            }
        }
        const float* gp = gate + b * 6144 + c; bf16_t* xp = XR + (size_t)tok * DM + c;
        const float sc = rs * (1.f / 16.f);
        const u32x4 xa = *(const u32x4*)xp, xc = *(const u32x4*)(xp + 8);
        f32x4 o[4]; float ss = 0.f;
        o[0] = (f32x4){bflo(xa.x), bfhi(xa.x), bflo(xa.y), bfhi(xa.y)}; o[1] = (f32x4){bflo(xa.z), bfhi(xa.z), bflo(xa.w), bfhi(xa.w)};
        o[2] = (f32x4){bflo(xc.x), bfhi(xc.x), bflo(xc.y), bfhi(xc.y)}; o[3] = (f32x4){bflo(xc.z), bfhi(xc.z), bflo(xc.w), bfhi(xc.w)};
#pragma unroll
        for (int q = 0; q < 4; ++q) {
            const f32x4 g = *(const f32x4*)(gp + 4 * q) * sc;
            o[q] = o[q] + g * (f32x4){s[4 * q], s[4 * q + 1], s[4 * q + 2], s[4 * q + 3]};
            if (final_out) *(f32x4*)(p.out + (size_t)tok * DM + c + 4 * q) = o[q];
            ss += (o[q][0] * o[q][0] + o[q][1] * o[q][1]) + (o[q][2] * o[q][2] + o[q][3] * o[q][3]);
        }
        if (!final_out) { *(u32x4*)xp = pack8(o[0], o[1]); *(u32x4*)(xp + 8) = pack8(o[2], o[3]); }
        if (NEXTNORM) {
            const float rstd = rsqrtf(wave_sum(ss) * (1.f / 1024.f) + 1e-6f);
            u32x4 w0, w1;
#pragma unroll
            for (int q = 0; q < 4; ++q) {
                const f32x4 g4 = *(const f32x4*)(gain + c + 4 * q), sc4 = *(const f32x4*)(modn + b * 6144 + 1024 + c + 4 * q), sh4 = *(const f32x4*)(modn + b * 6144 + c + 4 * q);
                const f32x4 v = o[q] * rstd * (g4 * (sc4 + 1.f)) + sh4;
                if (q < 2) { w0[2 * q] = pk2(v[0], v[1]); w0[2 * q + 1] = pk2(v[2], v[3]); } else { w1[2 * (q - 2)] = pk2(v[0], v[1]); w1[2 * (q - 2) + 1] = pk2(v[2], v[3]); }
            }
            *(u32x4*)(XN + (size_t)tok * DM + c) = w0; *(u32x4*)(XN + (size_t)tok * DM + c + 8) = w1;
        }
    }
}

constexpr int AT_KB = 8192, AT_VB = 64 * 136, AT_K0 = 0, AT_V0 = 4 * AT_KB, AT_BIAS = 4 * AT_KB + 4 * AT_VB + 256, AT_BPAD = 48;
#define ATT_TILE(kb_, vb_, t0_, LAT_, brow4_, rpen_) do { \
    f32x16 sa; \
    _Pragma("unroll") for (int i = 0; i < 16; ++i) sa[i] = 0.f; \
    _Pragma("unroll") for (int s = 0; s < 4; ++s) { \
        const bf16x8 kf = *(const LAS bf16x8*)((kb_) + ((t0_) + l31) * 128 + (((2 * s + hh) ^ (l31 & 7)) << 4)); \
        sa = __builtin_amdgcn_mfma_f32_32x32x16_bf16(kf, qf[s], sa, 0, 0, 0); } \
    float tmax = -1e30f; \
    if (LAT_) { \
        const LAS float* bp = (const LAS float*)((const LAS unsigned char*)biasL + (brow4_)); \
        _Pragma("unroll") for (int i = 0; i < 16; ++i) { sa[i] = (sa[i] + bp[(i & 3) + 8 * (i >> 2)]) + (pen[i] + (rpen_)); tmax = fmaxf(tmax, sa[i]); } \
    } else { \
        _Pragma("unroll") for (int i = 0; i < 16; ++i) tmax = fmaxf(tmax, sa[i]); \
    } \
    tmax = fmaxf(tmax, __shfl_xor(tmax, 32)); \
    if (__any(tmax > mrun)) { \
        const float mnew = fmaxf(mrun, tmax), alpha = __builtin_amdgcn_exp2f(mrun - mnew); \
        lrun *= alpha; mrun = mnew; \
        _Pragma("unroll") for (int i = 0; i < 16; ++i) { o0[i] *= alpha; o1[i] *= alpha; } } \
    float psum = 0.f; \
    _Pragma("unroll") for (int i = 0; i < 16; ++i) { sa[i] = __builtin_amdgcn_exp2f(sa[i] - mrun); psum += sa[i]; } \
    lrun += psum; \
    bf16x8 pf0, pf1; \
    { u32x4 w0, w1; \
      _Pragma("unroll") for (int j = 0; j < 4; ++j) { w0[j] = pk2(sa[2 * j], sa[2 * j + 1]); w1[j] = pk2(sa[8 + 2 * j], sa[8 + 2 * j + 1]); } \
      pf0 = __builtin_bit_cast(bf16x8, w0); pf1 = __builtin_bit_cast(bf16x8, w1); } \
    const LAS unsigned char* v0p = (vb_) + l31 * 136 + 2 * (t0_) + 8 * hh; const LAS unsigned char* v1p = v0p + 32 * 136; \
    const s16x4 a0 = *(const LAS s16x4*)(v0p), a1 = *(const LAS s16x4*)(v0p + 16), a2 = *(const LAS s16x4*)(v0p + 32), a3 = *(const LAS s16x4*)(v0p + 48); \
    const s16x4 c0 = *(const LAS s16x4*)(v1p), c1 = *(const LAS s16x4*)(v1p + 16), c2 = *(const LAS s16x4*)(v1p + 32), c3 = *(const LAS s16x4*)(v1p + 48); \
    const bf16x8 va0 = __builtin_shufflevector(a0, a1, 0, 1, 2, 3, 4, 5, 6, 7), va1 = __builtin_shufflevector(a2, a3, 0, 1, 2, 3, 4, 5, 6, 7); \
    const bf16x8 vb0 = __builtin_shufflevector(c0, c1, 0, 1, 2, 3, 4, 5, 6, 7), vb1 = __builtin_shufflevector(c2, c3, 0, 1, 2, 3, 4, 5, 6, 7); \
    o0 = __builtin_amdgcn_mfma_f32_32x32x16_bf16(va0, pf0, o0, 0, 0, 0); o0 = __builtin_amdgcn_mfma_f32_32x32x16_bf16(va1, pf1, o0, 0, 0, 0); \
    o1 = __builtin_amdgcn_mfma_f32_32x32x16_bf16(vb0, pf0, o1, 0, 0, 0); o1 = __builtin_amdgcn_mfma_f32_32x32x16_bf16(vb1, pf1, o1, 0, 0, 0); \
    } while (0)
#define ATT_TILE2(kbA_, vbA_, t0A_, kbB_, vbB_, t0B_, LAT_, brow4A_, rpenA_, brow4B_, rpenB_) do { \
    f32x16 sa0, sa1; \
    _Pragma("unroll") for (int i = 0; i < 16; ++i) { sa0[i] = 0.f; sa1[i] = 0.f; } \
    _Pragma("unroll") for (int s = 0; s < 4; ++s) { \
        const bf16x8 kf0 = *(const LAS bf16x8*)((kbA_) + ((t0A_) + l31) * 128 + (((2 * s + hh) ^ (l31 & 7)) << 4)); \
        const bf16x8 kf1 = *(const LAS bf16x8*)((kbB_) + ((t0B_) + l31) * 128 + (((2 * s + hh) ^ (l31 & 7)) << 4)); \
        sa0 = __builtin_amdgcn_mfma_f32_32x32x16_bf16(kf0, qf[s], sa0, 0, 0, 0); \
        sa1 = __builtin_amdgcn_mfma_f32_32x32x16_bf16(kf1, qf[s], sa1, 0, 0, 0); } \
    float tmax = -1e30f; \
    if (LAT_) { \
        const LAS float* bpA = (const LAS float*)((const LAS unsigned char*)biasL + (brow4A_)); const LAS float* bpB = (const LAS float*)((const LAS unsigned char*)biasL + (brow4B_)); \
        _Pragma("unroll") for (int i = 0; i < 16; ++i) { \
            sa0[i] = (sa0[i] + bpA[(i & 3) + 8 * (i >> 2)]) + (pen[i] + (rpenA_)); sa1[i] = (sa1[i] + bpB[(i & 3) + 8 * (i >> 2)]) + (pen[i] + (rpenB_)); \
            tmax = fmaxf(tmax, fmaxf(sa0[i], sa1[i])); } \
    } else { \
        _Pragma("unroll") for (int i = 0; i < 16; ++i) tmax = fmaxf(tmax, fmaxf(sa0[i], sa1[i])); \
    } \
    tmax = fmaxf(tmax, __shfl_xor(tmax, 32)); \
    if (__any(tmax > mrun)) { \
        const float mnew = fmaxf(mrun, tmax), alpha = __builtin_amdgcn_exp2f(mrun - mnew); \
        lrun *= alpha; mrun = mnew; \
        _Pragma("unroll") for (int i = 0; i < 16; ++i) { o0[i] *= alpha; o1[i] *= alpha; } } \
    float psumA = 0.f, psumB = 0.f; \
    _Pragma("unroll") for (int i = 0; i < 16; ++i) { sa0[i] = __builtin_amdgcn_exp2f(sa0[i] - mrun); sa1[i] = __builtin_amdgcn_exp2f(sa1[i] - mrun); psumA += sa0[i]; psumB += sa1[i]; } \
    lrun += psumA + psumB; \
    bf16x8 pf0, pf1, pf2, pf3; \
    { u32x4 w0, w1, w2, w3; \
      _Pragma("unroll") for (int j = 0; j < 4; ++j) { w0[j] = pk2(sa0[2 * j], sa0[2 * j + 1]); w1[j] = pk2(sa0[8 + 2 * j], sa0[8 + 2 * j + 1]); \
                                                      w2[j] = pk2(sa1[2 * j], sa1[2 * j + 1]); w3[j] = pk2(sa1[8 + 2 * j], sa1[8 + 2 * j + 1]); } \
      pf0 = __builtin_bit_cast(bf16x8, w0); pf1 = __builtin_bit_cast(bf16x8, w1); pf2 = __builtin_bit_cast(bf16x8, w2); pf3 = __builtin_bit_cast(bf16x8, w3); } \
    { const LAS unsigned char* v0p = (vbA_) + l31 * 136 + 2 * (t0A_) + 8 * hh; const LAS unsigned char* v1p = v0p + 32 * 136; \
      const s16x4 a0 = *(const LAS s16x4*)(v0p), a1 = *(const LAS s16x4*)(v0p + 16), a2 = *(const LAS s16x4*)(v0p + 32), a3 = *(const LAS s16x4*)(v0p + 48); \
      const s16x4 c0 = *(const LAS s16x4*)(v1p), c1 = *(const LAS s16x4*)(v1p + 16), c2 = *(const LAS s16x4*)(v1p + 32), c3 = *(const LAS s16x4*)(v1p + 48); \
      const bf16x8 va0 = __builtin_shufflevector(a0, a1, 0, 1, 2, 3, 4, 5, 6, 7), va1 = __builtin_shufflevector(a2, a3, 0, 1, 2, 3, 4, 5, 6, 7); \
      const bf16x8 vb0 = __builtin_shufflevector(c0, c1, 0, 1, 2, 3, 4, 5, 6, 7), vb1 = __builtin_shufflevector(c2, c3, 0, 1, 2, 3, 4, 5, 6, 7); \
      o0 = __builtin_amdgcn_mfma_f32_32x32x16_bf16(va0, pf0, o0, 0, 0, 0); o1 = __builtin_amdgcn_mfma_f32_32x32x16_bf16(vb0, pf0, o1, 0, 0, 0); \
      o0 = __builtin_amdgcn_mfma_f32_32x32x16_bf16(va1, pf1, o0, 0, 0, 0); o1 = __builtin_amdgcn_mfma_f32_32x32x16_bf16(vb1, pf1, o1, 0, 0, 0); } \
    { const LAS unsigned char* v0p = (vbB_) + l31 * 136 + 2 * (t0B_) + 8 * hh; const LAS unsigned char* v1p = v0p + 32 * 136; \
      const s16x4 a0 = *(const LAS s16x4*)(v0p), a1 = *(const LAS s16x4*)(v0p + 16), a2 = *(const LAS s16x4*)(v0p + 32), a3 = *(const LAS s16x4*)(v0p + 48); \
      const s16x4 c0 = *(const LAS s16x4*)(v1p), c1 = *(const LAS s16x4*)(v1p + 16), c2 = *(const LAS s16x4*)(v1p + 32), c3 = *(const LAS s16x4*)(v1p + 48); \
      const bf16x8 va0 = __builtin_shufflevector(a0, a1, 0, 1, 2, 3, 4, 5, 6, 7), va1 = __builtin_shufflevector(a2, a3, 0, 1, 2, 3, 4, 5, 6, 7); \
      const bf16x8 vb0 = __builtin_shufflevector(c0, c1, 0, 1, 2, 3, 4, 5, 6, 7), vb1 = __builtin_shufflevector(c2, c3, 0, 1, 2, 3, 4, 5, 6, 7); \
      o0 = __builtin_amdgcn_mfma_f32_32x32x16_bf16(va0, pf2, o0, 0, 0, 0); o1 = __builtin_amdgcn_mfma_f32_32x32x16_bf16(vb0, pf2, o1, 0, 0, 0); \
      o0 = __builtin_amdgcn_mfma_f32_32x32x16_bf16(va1, pf3, o0, 0, 0, 0); o1 = __builtin_amdgcn_mfma_f32_32x32x16_bf16(vb1, pf3, o1, 0, 0, 0); } \
    } while (0)
__device__ __forceinline__ void phase_attn(const Ctx& X, const Params& p) {
    const bf16_t* Q = (const bf16_t*)(p.ws + WS_Q); const bf16_t* Kb = (const bf16_t*)(p.ws + WS_K); const bf16_t* VT = (const bf16_t*)(p.ws + WS_VT);
    bf16_t* O = (bf16_t*)(p.ws + WS_O);
    LAS float* biasL = (LAS float*)(X.lds + AT_BIAS);
    const int lane = X.lane, l31 = lane & 31, hh = lane >> 5, tid = X.tid;
    const float LOG2E = 1.4426950408889634f;
    const int skey = tid >> 3, sch = tid & 7;
    for (int task = X.blk; task < 256; task += X.G) {
        const int b = task >> 5, h = (task >> 1) & 15, hf = task & 1;
        __syncthreads();
        for (int i = tid; i < 465 + 2 * AT_BPAD + 64; i += 512) { const int j = i - AT_BPAD; biasL[i] = (j >= 0 && j < 465) ? p.in[I_RPB][h * 465 + j] * LOG2E : 0.f; }
        const bf16_t* vcol = VT + (size_t)skey * DM + h * 64 + 8 * sch;
        const bf16_t* kcol = Kb + (size_t)skey * DM + h * 64 + 8 * sch;
        for (int gq = 0; gq < 4; ++gq) {
            const int R0 = 16 * hf + 4 * gq;
            const int rp = X.wave >> 2, cb = X.wave & 3, r = R0 + 2 * rp, c0 = 16 * cb;
            const int t0 = cb == 0 ? 0 : (cb == 1 ? 8 : (cb == 2 ? 24 : 32));
            const int rq = r + (l31 >> 4), qc = c0 + (l31 & 15);
            const int r0q = rq < 4 ? 0 : (rq > 28 ? 24 : rq - 4);
            const int r0lo = r < 4 ? 0 : (r > 28 ? 24 : r - 4), r0hi = (r + 1 < 4 ? 0 : (r + 1 > 28 ? 24 : r + 1 - 4)) + 7;
            const int rmin = R0 < 4 ? 0 : (R0 > 28 ? 24 : R0 - 4);
            const int rl = R0 + 3, rmax = (rl < 4 ? 0 : (rl > 28 ? 24 : rl - 4)) + 7;
            const int nl = rmax - rmin + 1, nsteps = 2 + ((nl + 1) >> 1);
            const size_t qtok = (size_t)b * 2048 + rq * 64 + qc;
            bf16x8 qf[4];
#pragma unroll
            for (int s = 0; s < 4; ++s) qf[s] = *(const bf16x8*)(Q + qtok * DM + h * 64 + 16 * s + 8 * hh);
            const int cs = qc < 8 ? 0 : (qc > 56 ? 48 : qc - 8);
            float pen[16];
#pragma unroll
            for (int i = 0; i < 16; ++i) { const int kc = t0 + (i & 3) + 8 * (i >> 2) + 4 * hh; pen[i] = (kc >= cs && kc < cs + 16) ? 0.f : -1e30f; }
            const int lb4 = 4 * ((7 - (l31 >> 4)) * 31 + t0 - qc + 15 + 4 * hh + AT_BPAD);
            f32x16 o0, o1;
#pragma unroll
            for (int i = 0; i < 16; ++i) { o0[i] = 0.f; o1[i] = 0.f; }
            float mrun = -1e30f, lrun = 0.f;
            u32x4 kA0, kA1, vA0, vA1, kB0, kB1, vB0, vB1;
#define ATT_ISSUE(st_, k0_, k1_, v0r_, v1r_) do { int s_ = (st_); s_ = s_ < nsteps ? s_ : nsteps - 1; \
                size_t kt0_, kt1_; \
                if (s_ < 2) { kt0_ = (size_t)NLAT + b * 256 + s_ * 128; kt1_ = kt0_ + 64; } \
                else { const int ra_ = rmin + 2 * (s_ - 2), rb_ = ra_ + 1 <= rmax ? ra_ + 1 : rmax; kt0_ = (size_t)b * 2048 + ra_ * 64; kt1_ = (size_t)b * 2048 + rb_ * 64; } \
                k0_ = *(const u32x4*)(kcol + kt0_ * DM); k1_ = *(const u32x4*)(kcol + kt1_ * DM); v0r_ = *(const u32x4*)(vcol + kt0_ * DM); v1r_ = *(const u32x4*)(vcol + kt1_ * DM); } while (0)
#define ATT_WRITE(nb_, k0_, k1_, v0r_, v1r_) do { \
                LAS unsigned char* kw_ = X.lds + AT_K0 + (nb_) * 2 * AT_KB + skey * 128 + ((sch ^ (skey & 7)) << 4); \
                *(LAS u32x4*)(kw_) = k0_; *(LAS u32x4*)(kw_ + AT_KB) = k1_; \
                LAS unsigned short* vw_ = (LAS unsigned short*)(X.lds + AT_V0 + (nb_) * 2 * AT_VB + (8 * sch) * 136 + skey * 2);        \
                _Pragma("unroll") for (int j_ = 0; j_ < 4; ++j_) { \
                    vw_[(2 * j_) * 68] = (unsigned short)(v0r_[j_] & 0xffffu); vw_[(2 * j_ + 1) * 68] = (unsigned short)(v0r_[j_] >> 16); \
                    vw_[AT_VB / 2 + (2 * j_) * 68] = (unsigned short)(v1r_[j_] & 0xffffu); vw_[AT_VB / 2 + (2 * j_ + 1) * 68] = (unsigned short)(v1r_[j_] >> 16); } } while (0)
#define ATT_STEP(st_, cur_) do { const int st = (st_); \
                const LAS unsigned char* kb = X.lds + AT_K0 + (cur_) * 2 * AT_KB; const LAS unsigned char* vb = X.lds + AT_V0 + (cur_) * 2 * AT_VB; \
                if (st < 2) { ATT_TILE2(kb, vb, 0, kb, vb, 32, false, 0, 0.f, 0, 0.f); ATT_TILE2(kb + AT_KB, vb + AT_VB, 0, kb + AT_KB, vb + AT_VB, 32, false, 0, 0.f, 0, 0.f); } \
                else { const int ka = rmin + 2 * (st - 2), kc2 = ka + 1; \
                    const bool ina = ka >= r0lo && ka <= r0hi, inb = kc2 <= rmax && kc2 >= r0lo && kc2 <= r0hi; \
                    const float rpa = (ka >= r0q && ka < r0q + 8) ? 0.f : -1e30f, rpb = (kc2 >= r0q && kc2 < r0q + 8) ? 0.f : -1e30f; \
                    const int bra = lb4 + 4 * 31 * (ka - r), brb = lb4 + 4 * 31 * (kc2 - r); \
                    if (ina && inb) { ATT_TILE2(kb, vb, t0, kb + AT_KB, vb + AT_VB, t0, true, bra, rpa, brb, rpb); } \
                    else if (ina) { ATT_TILE(kb, vb, t0, true, bra, rpa); } \
                    else if (inb) { ATT_TILE(kb + AT_KB, vb + AT_VB, t0, true, brb, rpb); } } } while (0)
            ATT_ISSUE(0, kA0, kA1, vA0, vA1);
            ATT_ISSUE(1, kB0, kB1, vB0, vB1);
            __syncthreads();
            ATT_WRITE(0, kA0, kA1, vA0, vA1);
            __syncthreads();
            for (int sp = 0; sp < nsteps; sp += 2) {
                ATT_ISSUE(sp + 2, kA0, kA1, vA0, vA1);
                ATT_STEP(sp, 0);
                ATT_WRITE(1, kB0, kB1, vB0, vB1);
                __syncthreads();
                if (sp + 1 < nsteps) {
                    ATT_ISSUE(sp + 3, kB0, kB1, vB0, vB1);
                    ATT_STEP(sp + 1, 1);
                    ATT_WRITE(0, kA0, kA1, vA0, vA1);
                    __syncthreads();
                }
            }
#undef ATT_ISSUE
#undef ATT_WRITE
#undef ATT_STEP
            const float ltot = lrun + __shfl_xor(lrun, 32), inv = 1.f / ltot;
            bf16_t* op = O + qtok * DM + h * 64;
#pragma unroll
            for (int g = 0; g < 4; ++g) {
                u32x2 w; w.x = pk2(o0[4 * g] * inv, o0[4 * g + 1] * inv); w.y = pk2(o0[4 * g + 2] * inv, o0[4 * g + 3] * inv);
                *(u32x2*)(op + 8 * g + 4 * hh) = w;
                u32x2 w2; w2.x = pk2(o1[4 * g] * inv, o1[4 * g + 1] * inv); w2.y = pk2(o1[4 * g + 2] * inv, o1[4 * g + 3] * inv);
                *(u32x2*)(op + 32 + 8 * g + 4 * hh) = w2;
            }
        }
    }
}
#undef ATT_TILE
#undef ATT_TILE2


constexpr int N_PHASES = 24;
constexpr int C0A = 4800, C0B = 6400, C0C = 7600;
constexpr int C1A = 6000, C1B = 7000;
#ifndef PROBE_LO
#define PROBE_LO 99
#define PROBE_HI (-1)
#endif
__host__ __device__ constexpr int nrep(int k) { return (k >= PROBE_LO && k <= PROBE_HI) ? 2 : 1; }
__global__ void __launch_bounds__(512, 2) fwd_kernel(Params p) {
    extern __shared__ __attribute__((aligned(16))) unsigned char lds_raw[];
    LAS unsigned char* lds = (LAS unsigned char*)lds_raw;
    const int wave0 = __builtin_amdgcn_readfirstlane((int)(threadIdx.x >> 6));
    for (int u = threadIdx.x; u < (LDS_BYTES - MISC_OFF) / 4; u += 512) ((LAS unsigned*)(lds + MISC_OFF))[u] = 0u;
    __syncthreads();
    XcdBarrier bar; bar.bar = (unsigned*)(p.ws + WS_CTL) + 4096; bar.x = 0; bar.st = (volatile LAS unsigned*)(lds + MISC_OFF + M_BAR);
    if (p.ph_hi - p.ph_lo > 1) bar = xcd_barrier_post((unsigned*)(p.ws + WS_CTL) + 4096, (volatile LAS unsigned*)(lds + MISC_OFF + M_BAR));
#define PH(k) (p.ph_lo <= (k) && (k) < p.ph_hi)
#define SEAM(k) do { if (PH(k) && PH((k) + 1)) xcd_barrier(bar, wave0); } while (0)
#define RUN(k, ...) do { if (PH(k)) { _Pragma("unroll") for (int rep_ = 0; rep_ < nrep(k); ++rep_) { const float rs_ = rep_ == 0 ? 1.f : 0.f; (void)rs_; { __VA_ARGS__ } if (rep_ + 1 < nrep(k)) xcd_barrier(bar, wave0); } } SEAM(k); } while (0)
    unsigned char* ws = p.ws;
    const float* MOD = (const float*)(ws + WS_MOD);

    RUN(0, const Ctx X = mkctx(lds, wave0); phase_p0a(X, p););
    RUN(1, const Ctx X = mkctx(lds, wave0); phase_p0b(X, p););
    RUN(2, const Ctx X = mkctx(lds, wave0); phase_norm<0>(X, p, 0, 0, NTOK););
    RUN(3,
        g8::RectSched S{72, 8, (int)gridDim.x, (int)blockIdx.x, 0u, 2048u, (const char*)(ws + WS_WIN), 2048u};
        EpiWin E{(bf16_t*)(ws + WS_A2), (bf16_t*)(ws + WS_BCV)};
        g8::gemm_phase(lds, wave0, (const char*)(ws + WS_XA), 1024, 2048u, S, E);
        { const Ctx X = mkctx(lds, wave0); int nidle; const int rk = idle_rank(576, X.G, X.blk, nidle);
          if (rk >= 0) conv_moe_items<0>(X, p, 0, (bf16_t*)(ws + WS_GU), (bf16_t*)(ws + WS_DN), 0, C0A, rk, nidle); });
    RUN(4,
        g8::BatchSched S{32, 3, 1, (int)gridDim.x, (int)blockIdx.x, 1536u, (const char*)(ws + WS_WF), 1024u, 256};
        EpiS5F E{(float*)(ws + WS_F)};
        g8::gemm_phase(lds, wave0, (const char*)(ws + WS_A2), 512, 1024u, S, E);
        { const Ctx X = mkctx(lds, wave0); int nidle; const int rk = moe_idle_rank(96, 1, X.G, X.blk, nidle);
          if (rk >= 0) conv_moe_items<0>(X, p, 0, (bf16_t*)(ws + WS_GU), (bf16_t*)(ws + WS_DN), C0A, C0B, rk, nidle); });
    RUN(5, const Ctx X = mkctx(lds, wave0); phase_scan_conv(X, p););
    RUN(6,
        g8::BatchSched S{32, 3, 2, (int)gridDim.x, (int)blockIdx.x, 1536u, (const char*)(ws + WS_ME), 1536u, 512};
        EpiS5Y E{(bf16_t*)(ws + WS_G)};
        g8::gemm_phase(lds, wave0, (const char*)(ws + WS_A2), 768, 1536u, S, E););
    RUN(7,
        g8::RectSched S{72, 2, (int)gridDim.x, (int)blockIdx.x, 0u, 1024u, (const char*)(ws + WS_GLU), 1024u};
        EpiGlu E{(const bf16_t*)(ws + WS_G), p.in[I_GLUB], (bf16_t*)(ws + WS_Z)};
        g8::gemm_phase(lds, wave0, (const char*)(ws + WS_G), 512, 1024u, S, E);
        { const Ctx X = mkctx(lds, wave0); int nidle; const int rk = idle_rank(144, X.G, X.blk, nidle);
          if (rk >= 0) conv_moe_items<0>(X, p, 0, (bf16_t*)(ws + WS_GU), (bf16_t*)(ws + WS_DN), C0B, C0C, rk, nidle); });
    RUN(8,
        g8::RectSched S{72, 4, (int)gridDim.x, (int)blockIdx.x, 0u, 2048u, (const char*)(ws + WS_HOUT), 2048u};
        EpiResid<true> E{p.in[I_X], p.in[I_CTX], MOD + 2 * 1024, (bf16_t*)(ws + WS_XR), 1.f};
        g8::gemm_phase(lds, wave0, (const char*)(ws + WS_Z), 1024, 2048u, S, E);
        { const Ctx X = mkctx(lds, wave0); int nidle; const int rk = idle_rank(288, X.G, X.blk, nidle);
          if (rk >= 0) conv_moe_items<0>(X, p, 0, (bf16_t*)(ws + WS_GU), (bf16_t*)(ws + WS_DN), C0C, 12480, rk, nidle); });
#define MOE_PHASES(P0, L, NTOKL, FINAL) \
    RUN(P0, const Ctx X = mkctx(lds, wave0); phase_norm<1>(X, p, L, 1, NTOKL);); \
    RUN(P0 + 1, const Ctx X = mkctx(lds, wave0); phase_route(X, p, L, NTOKL);); \
    RUN(P0 + 2, const Ctx X = mkctx(lds, wave0); phase_slots(X, p, NTOKL);); \
    RUN(P0 + 3, \
        const Ctx X = mkctx(lds, wave0); const int ntiles = load_tiles(X, p); \
        g8::MoeSched<true> S{ntiles, 2, (int)gridDim.x, (int)blockIdx.x, 2048u, (const char*)(ws + (L == 0 ? WS_GU : WS_GU1)), 2048u, 512, 0, 128, lds + MISC_OFF + M_TILE, (const int*)(ws + WS_ROWIDX)}; \
        EpiGU E{(bf16_t*)(ws + WS_ACT)}; \
        g8::gemm_phase(lds, wave0, (const char*)(ws + WS_XA), 1024, 2048u, S, E); \
        { const Ctx X2 = mkctx(lds, wave0); int nidle; const int rk = moe_idle_rank(ntiles, 2, X2.G, X2.blk, nidle);        \
          if (rk >= 0 && L == 0) conv_moe_items<1>(X2, p, 1, (bf16_t*)(ws + WS_GU1), nullptr, 0, C1A, rk, nidle); }); \
    RUN(P0 + 4, \
        const Ctx X = mkctx(lds, wave0); const int ntiles = load_tiles(X, p); \
        g8::MoeSched<false> S{ntiles, 4, (int)gridDim.x, (int)blockIdx.x, 512u, (const char*)(ws + WS_DN), 512u, 1024, 0, 256, lds + MISC_OFF + M_TILE, nullptr}; \
        EpiDN E{(unsigned char*)(ws + WS_Y)}; \
        g8::gemm_phase(lds, wave0, (const char*)(ws + WS_ACT), 256, 512u, S, E); \
        { const Ctx X2 = mkctx(lds, wave0); int nidle; const int rk = moe_idle_rank(ntiles, 4, X2.G, X2.blk, nidle); \
          if (rk >= 0 && L == 0) conv_moe_items<1>(X2, p, 1, (bf16_t*)(ws + WS_GU1), nullptr, C1A, C1B, rk, nidle); }); \
    RUN(P0 + 5, const Ctx X = mkctx(lds, wave0); phase_combine<!FINAL>(X, p, L, NTOKL, FINAL, 1.f););

    MOE_PHASES(9, 0, NTOK, false)
    RUN(15,
        g8::QkvSched S{(int)gridDim.x, (int)blockIdx.x, 2048u, (const char*)(ws + WS_QKV), 2048u};
        EpiQKV E{(bf16_t*)(ws + WS_Q), (bf16_t*)(ws + WS_K), (bf16_t*)(ws + WS_VT), p.in[I_QG], p.in[I_KG]};
        g8::gemm_phase(lds, wave0, (const char*)(ws + WS_ACT), 1024, 2048u, S, E);
        { const Ctx X = mkctx(lds, wave0); int nidle; const int rk = idle_rank(832, X.G, X.blk, nidle);
          if (rk >= 0) { conv_moe_items<1>(X, p, 1, (bf16_t*)(ws + WS_GU1), nullptr, C1B, 8320, rk, nidle);
                         conv_moe_items<2>(X, p, 1, nullptr, (bf16_t*)(ws + WS_DN), 0, 4160, rk, nidle); } });
    RUN(16, const Ctx X = mkctx(lds, wave0); phase_attn(X, p););
    RUN(17,
        g8::RectSched S{64, 4, (int)gridDim.x, (int)blockIdx.x, 0u, 2048u, (const char*)(ws + WS_NOUT), 2048u};
        EpiResid<false> E{nullptr, nullptr, MOD + 9 * 6144 + 2 * 1024, (bf16_t*)(ws + WS_XR), rs_};
        g8::gemm_phase(lds, wave0, (const char*)(ws + WS_O), 1024, 2048u, S, E););
    MOE_PHASES(18, 1, NLAT, true)
#undef PH
#undef SEAM
#undef RUN
}

extern "C" void kernel_launch(void* const* d_in, const int* in_sizes, int n_in, void* d_out, int out_size, void* d_ws, size_t ws_size, hipStream_t stream) {
    static int grid = 0;
    if (grid == 0) {
        int dev = 0, cus = 0, per_cu = 0;
        if (n_in != 34 || ws_size < WS_END) { fprintf(stderr, "kernel_launch: unexpected inputs (n_in %d, ws %zu, need %zu)\n", n_in, ws_size, (size_t)WS_END); grid = -1; return; }
        if (hipGetDevice(&dev) != hipSuccess || hipDeviceGetAttribute(&cus, hipDeviceAttributeMultiprocessorCount, dev) != hipSuccess) { grid = -1; return; }
        if (hipFuncSetAttribute((const void*)fwd_kernel, hipFuncAttributeMaxDynamicSharedMemorySize, LDS_BYTES) != hipSuccess) { fprintf(stderr, "kernel_launch: hipFuncSetAttribute failed\n"); grid = -1; return; }
        if (hipOccupancyMaxActiveBlocksPerMultiprocessor(&per_cu, (const void*)fwd_kernel, 512, LDS_BYTES) != hipSuccess || per_cu < 1) { fprintf(stderr, "kernel_launch: occupancy query says %d\n", per_cu); }
        (void)hipGetLastError();
        grid = cus;
    }
    if (grid < 0) return;
    (void)hipMemsetAsync((char*)d_ws + WS_CTL, 0, 64 * 1024, stream);
    Params p{};
    for (int i = 0; i < 34; ++i) p.in[i] = (const float*)d_in[i];
    p.out = (float*)d_out; p.ws = (unsigned char*)d_ws;
#if MK_ONE_LAUNCH
    p.ph_lo = 0; p.ph_hi = N_PHASES;
    hipLaunchKernelGGL(fwd_kernel, dim3(grid), dim3(512), LDS_BYTES, stream, p);
#else
    for (int k = 0; k < N_PHASES; ++k) { p.ph_lo = k; p.ph_hi = k + 1; hipLaunchKernelGGL(fwd_kernel, dim3(grid), dim3(512), LDS_BYTES, stream, p); }
#endif
}
```

```cpp
#include <hip/hip_runtime.h>
#include <stdint.h>
#include <stdio.h>

#ifndef MK_ONE_LAUNCH
#define MK_ONE_LAUNCH 1
#endif

#define GAS __attribute__((address_space(1)))
#define LAS __attribute__((address_space(3)))
typedef unsigned short bf16_t;
typedef short bf16x8 __attribute__((ext_vector_type(8)));
typedef short s16x4 __attribute__((ext_vector_type(4)));
typedef float f32x4 __attribute__((ext_vector_type(4)));
typedef float f32x2 __attribute__((ext_vector_type(2)));
typedef float f32x16 __attribute__((ext_vector_type(16)));
typedef unsigned u32x4 __attribute__((ext_vector_type(4)));
typedef unsigned u32x2 __attribute__((ext_vector_type(2)));

constexpr int NLAT = 16384, NCTX = 2048, NTOK = NLAT + NCTX, DM = 1024;
constexpr int SEQ = 2048, CTXL = 256, NB = 8;
constexpr int NEXP = 64, NEXP1 = 65, EDIM = 256;
constexpr int S5T = 32;
constexpr int S5R = 576, S5RP = 768;
constexpr int S5K = 768;
constexpr int MAXTILES = 712;

constexpr size_t MiB = 1ull << 20;
constexpr size_t WS_CTL = 0;
constexpr size_t WS_MOD = 1 * MiB;
constexpr size_t WS_WIN = 2 * MiB;
constexpr size_t WS_GLU = 6 * MiB;
constexpr size_t WS_HOUT = 7 * MiB;
constexpr size_t WS_QKV = 9 * MiB;
constexpr size_t WS_NOUT = 15 * MiB;
constexpr size_t WS_ROUT = 17 * MiB;
constexpr size_t WS_GU = 18 * MiB;
constexpr size_t WS_DN = 83 * MiB;
constexpr size_t WS_GU1 = 116 * MiB;
constexpr size_t WS_XR = 181 * MiB;
constexpr size_t WS_LOGIT = 253 * MiB;
constexpr size_t WS_TOKE = 258 * MiB;
constexpr size_t WS_TOKW = 259 * MiB;
constexpr size_t WS_TOKP = 260 * MiB;
constexpr size_t WS_ROWIDX = 261 * MiB;
constexpr size_t WS_YROW = 262 * MiB;
constexpr size_t WS_CNTBLK = 263 * MiB;
constexpr size_t WS_TAB = 263 * MiB + 512 * 1024;
constexpr size_t WS_XA = 264 * MiB;
constexpr size_t WS_OVL = 300 * MiB;
constexpr size_t WS_A2 = WS_OVL;
constexpr size_t WS_BCV = WS_OVL + 36 * MiB;
constexpr size_t WS_F = WS_OVL + 90 * MiB;
constexpr size_t WS_Z = WS_OVL + 114 * MiB;
constexpr size_t WS_G = WS_OVL + 150 * MiB;
constexpr size_t WS_ME = WS_OVL + 168 * MiB;
constexpr size_t WS_WF = WS_OVL + 192 * MiB;
constexpr size_t WS_KK = WS_OVL + 200 * MiB;
constexpr size_t WS_PW = WS_OVL + 202 * MiB;
constexpr size_t WS_BB = WS_OVL + 204 * MiB;
constexpr size_t WS_ADAP = WS_OVL + 205 * MiB;
constexpr size_t WS_Q = WS_OVL;
constexpr size_t WS_K = WS_OVL + 32 * MiB;
constexpr size_t WS_VT = WS_OVL + 68 * MiB;
constexpr size_t WS_O = WS_OVL + 104 * MiB;
constexpr size_t WS_Y = WS_XA;
constexpr size_t WS_ACT = WS_XA + 178 * MiB;
constexpr size_t WS_END = WS_ACT + 89 * MiB;

constexpr int RING_BYTES = 131072;
constexpr int MISC_OFF = RING_BYTES;
constexpr int LDS_BYTES = 147456;
constexpr int M_BAR = 0, M_CNT = 64, M_BASE = 384, M_BBASE = 704, M_TILE = 1024, M_PART = 2048, M_NT = 3200;

__device__ __forceinline__ unsigned f2bf(float f) { unsigned u = __builtin_bit_cast(unsigned, f); return (u + 0x7fffu + ((u >> 16) & 1u)) >> 16; }
typedef __bf16 hbf16x2 __attribute__((ext_vector_type(2)));
__device__ __forceinline__ unsigned pk2(float lo, float hi) { const f32x2 v = {lo, hi}; const hbf16x2 b = __builtin_convertvector(v, hbf16x2); return __builtin_bit_cast(unsigned, b); }
__device__ __forceinline__ float bflo(unsigned w) { return __builtin_bit_cast(float, w << 16); }
__device__ __forceinline__ float bfhi(unsigned w) { return __builtin_bit_cast(float, w & 0xffff0000u); }
__device__ __forceinline__ float bf1(bf16_t b) { return __builtin_bit_cast(float, ((unsigned)b) << 16); }
__device__ __forceinline__ float wave_sum(float v) {
#pragma unroll
    for (int o = 1; o < 64; o <<= 1) v += __shfl_xor(v, o);
    return v;
}
__device__ __forceinline__ float sigmoidf_(float x) { return 1.f / (1.f + __expf(-x)); }
__device__ __forceinline__ float siluf_(float x) { return x / (1.f + __expf(-x)); }
__device__ __forceinline__ float gelu_tanh(float x) {
    const float u = 0.7978845608028654f * (x + 0.044715f * x * x * x);
    const float e = __expf(2.f * u);
    const float t = 1.f - 2.f / (e + 1.f);
    return 0.5f * x * (1.f + t);
}

__device__ __forceinline__ int lane_id_opaque() { int l; asm volatile("v_mbcnt_lo_u32_b32 %0, -1, 0\n\tv_mbcnt_hi_u32_b32 %0, -1, %0" : "=v"(l)); return l; }

#define XB_TMO      128
#define XB_XCNT(j)  (256  + 64 * (j))
#define XB_XSUB(j)  (1280 + 64 * (j))
#define XB_XGEN(j)  (2304 + 64 * (j))
#define XB_TOP      3328
#define XB_TOPGEN   3392
#define XCD_BAR_WORDS 3456
#define XB_SPIN_CAP (1u << 18)
__device__ __forceinline__ unsigned xb_ld(unsigned* p)              { return __hip_atomic_load(p, __ATOMIC_RELAXED, __HIP_MEMORY_SCOPE_AGENT); }
__device__ __forceinline__ unsigned xb_add(unsigned* p, unsigned v) { return __hip_atomic_fetch_add(p, v, __ATOMIC_RELAXED, __HIP_MEMORY_SCOPE_AGENT); }
__device__ __forceinline__ unsigned xb_xcc_id() { return (unsigned)__builtin_amdgcn_s_getreg((3 << 11) | 20) & 0xFu; }
#define XB_SPIN(cond, bar) do { unsigned _sp = 0; while (cond) { __builtin_amdgcn_s_sleep(1); \
    if ((++_sp & 255u) == 0u) { if (xb_ld(&(bar)[XB_TMO])) break; if (_sp > XB_SPIN_CAP) { atomicAdd(&(bar)[XB_TMO], 1u); break; } } } } while (0)
struct XcdBarrier { unsigned* bar; unsigned x; volatile LAS unsigned* st; };
__device__ __forceinline__ XcdBarrier xcd_barrier_post(unsigned* bar, volatile LAS unsigned* st) {
    XcdBarrier b; b.bar = bar; b.x = xb_xcc_id(); b.st = st;
    if (threadIdx.x == 0) (void)xb_add(&bar[XB_XCNT(b.x)], 1u);
    return b;
}
__device__ __forceinline__ void xcd_barrier_complete(unsigned* bar, unsigned x, unsigned& nloc, unsigned& nx) {
    const unsigned G = gridDim.x * gridDim.y * gridDim.z;
    unsigned sum, cnt, mine, sp = 0u;
    for (;;) {
        sum = 0u; cnt = 0u; mine = 0u;
#pragma unroll
        for (unsigned j = 0; j < 16; ++j) { const unsigned c = xb_ld(&bar[XB_XCNT(j)]); sum += c; cnt += (c > 0u) ? 1u : 0u; mine = (j == x) ? c : mine; }
        if (sum == G) break;
        __builtin_amdgcn_s_sleep(1);
        if ((++sp & 255u) == 0u) { if (xb_ld(&bar[XB_TMO])) break; if (sp > XB_SPIN_CAP) { atomicAdd(&bar[XB_TMO], 1u); break; } }
    }
    nloc = mine > 0u ? mine : 1u; nx = cnt > 0u ? cnt : 1u;
}
__device__ __forceinline__ void xcd_barrier(const XcdBarrier& b, const int wave0) {
    asm volatile("s_waitcnt vmcnt(0)" ::: "memory");
    __syncthreads();
    if (wave0 == 0 && lane_id_opaque() == 0) {
        unsigned* bar = b.bar;
        __builtin_amdgcn_s_waitcnt(0);
        unsigned nloc = b.st[0], nx = b.st[1];
        if (nloc == 0u) { xcd_barrier_complete(bar, b.x, nloc, nx); b.st[0] = nloc; b.st[1] = nx; }
        const unsigned old = xb_add(&bar[XB_XSUB(b.x)], 1u);
        const unsigned gen = old / nloc;
        if (old + 1u == (gen + 1u) * nloc) {
            __builtin_amdgcn_fence(__ATOMIC_RELEASE, "agent");
            asm volatile("s_waitcnt vmcnt(0)" ::: "memory");
            const unsigned og = xb_add(&bar[XB_TOP], 1u);
            const unsigned tg = og / nx;
            if (og + 1u == (tg + 1u) * nx) xb_add(&bar[XB_TOPGEN], 1u);
            else XB_SPIN(xb_ld(&bar[XB_TOPGEN]) == tg, bar);
            __builtin_amdgcn_fence(__ATOMIC_ACQUIRE, "agent");
            xb_add(&bar[XB_XGEN(b.x)], 1u);
            asm volatile("s_waitcnt vmcnt(0)" ::: "memory");
        } else {
            XB_SPIN(xb_ld(&bar[XB_XGEN(b.x)]) == gen, bar);
            __builtin_amdgcn_fence(__ATOMIC_ACQUIRE, "agent");
            asm volatile("s_waitcnt vmcnt(0)" ::: "memory");
        }
    }
    __syncthreads();
}

namespace g8 {
constexpr int BM = 256, BK = 64, HALF = 128, HTB = HALF * BK * 2, STAGE_BYTES = 8 * HTB, NXCD = 8, WGM = 8;
__host__ __device__ __forceinline__ int lds_byte(int r, int c) { const int st = (r >> 4) * 2 + (c >> 5), rr = r & 15, cc = c & 31, ob = rr * 64 + cc * 2; return st * 1024 + (ob ^ (((ob >> 9) & 1) << 5)); }
__host__ __device__ __forceinline__ void stage_rc(int b, int& R, int& C) { const int st = b / 1024, sb = b % 1024, swz = sb ^ (((sb >> 9) & 1) << 5); R = (st >> 1) * 16 + swz / 64; C = (st & 1) * 32 + (swz % 64) / 2; }
__host__ __device__ __forceinline__ int perm32(int rho) { const int n = rho >> 4, i = rho & 15; return 8 * (i >> 2) + 4 * n + (i & 3); }

struct Unit { unsigned a0; const char* B; int p0, p1, p2; };

__device__ __forceinline__ void static_map(int L, int nM, int nN, int& pm, int& pn) {
    const int nwg = nM * nN; int wgid = L;
    { const int q = nwg / NXCD, r = nwg % NXCD, xcd = wgid % NXCD, off = wgid / NXCD; wgid = (xcd < r ? xcd * (q + 1) : r * (q + 1) + (xcd - r) * q) + off; }
    const int nig = WGM * nN, gid = wgid / nig, fm = gid * WGM, gsz = (nM - fm) < WGM ? (nM - fm) : WGM;
    pm = fm + ((wgid % nig) % gsz); pn = (wgid % nig) / gsz;
}

template <class Epi, class Sched>
__device__ __forceinline__ void gemm_phase(LAS unsigned char* lds, const int wid, const char* Abase, const int K, const unsigned ldb, const Sched& S, const Epi& E) {
    const int lane = lane_id_opaque();
    const int tid = wid * 64 + lane, wr = wid >> 2, wc = wid & 3, fr = lane & 15, fq = lane >> 4;
    const int nt = K / BK;
    unsigned voffB0;
    { int R0, C0; stage_rc(tid * 16, R0, C0);
      const int Rb0 = Epi::GUP ? (256 * ((R0 >> 4) & 1) + 32 * (R0 >> 5) + 8 * ((R0 & 15) >> 2) + (R0 & 3)) : Epi::WIDE ? (64 * (R0 >> 5) + 16 * ((R0 & 15) >> 2) + 4 * ((R0 >> 4) & 1) + (R0 & 3)) : Epi::HEADP ? (64 * (R0 >> 5) + perm32(R0 & 31)) : (Epi::PERM ? ((R0 & ~31) + perm32(R0 & 31)) : R0);
      voffB0 = (unsigned)Rb0 * ldb + (unsigned)C0 * 2u; }
    const size_t hstepB = (size_t)(Epi::GUP ? 4 : Epi::WIDE ? 8 : (Epi::HEADP ? 32 : HALF)) * ldb;
    const size_t p1stepB = (size_t)((Epi::WIDE || Epi::HEADP) ? 128 : 64) * ldb;
    const unsigned ldsw = (unsigned)wid * 1024u;
    const int aoff = lds_byte(wr * 64 + fr, fq * 8), boff = lds_byte(wc * 32 + fr, fq * 8);
#define G8_SA(b, h) (((b) * 2 + (h)) * HTB)
#define G8_SB(b, h) ((4 + (b) * 2 + (h)) * HTB)
#define G8_GLDS(gp, lo) __builtin_amdgcn_global_load_lds((const unsigned*)(gp), (LAS unsigned*)(lds + (lo)), 16, 0, 0)
#define G8_STAGE_A(bufoff, o0, o1, kb, h) do { \
        G8_GLDS(Abase + ((long)(kb) + (Sched::GATHER ? 0l : (long)((h) * 128) * (long)S.lda)) + (size_t)(o0), (bufoff) + ldsw); \
        G8_GLDS(Abase + ((long)(kb) + (Sched::GATHER ? 0l : (long)((h) * 128 + 64) * (long)S.lda)) + (size_t)(o1), (bufoff) + ldsw + 8192); } while (0)
#define G8_STAGE_B(bufoff, bp, kb) do { G8_GLDS((bp) + (size_t)(kb) + (size_t)voffB0, (bufoff) + ldsw); G8_GLDS((bp) + ((size_t)(kb) + p1stepB) + (size_t)voffB0, (bufoff) + ldsw + 8192); } while (0)
#define G8_LDA(dst, b, h) do { _Pragma("unroll") for (int m = 0; m < 4; ++m) _Pragma("unroll") for (int k = 0; k < 2; ++k) dst[m][k] = *(const LAS bf16x8*)(lds + G8_SA(b, h) + aoff + m * 2048 + k * 1024); } while (0)
#define G8_LDB(dst, b, h) do { _Pragma("unroll") for (int n = 0; n < 2; ++n) _Pragma("unroll") for (int k = 0; k < 2; ++k) dst[n][k] = *(const LAS bf16x8*)(lds + G8_SB(b, h) + boff + n * 2048 + k * 1024); } while (0)
#define G8_MMA(ai, bj, At, Bt) do { __builtin_amdgcn_s_setprio(1); _Pragma("unroll") for (int m = 0; m < 4; ++m) _Pragma("unroll") for (int n = 0; n < 2; ++n) _Pragma("unroll") for (int k = 0; k < 2; ++k) \
        acc[ai][bj][m][n] = __builtin_amdgcn_mfma_f32_16x16x32_bf16(Bt[n][k], At[m][k], acc[ai][bj][m][n], 0, 0, 0); __builtin_amdgcn_s_setprio(0); } while (0)
#define G8_WAIT_V(n) asm volatile("s_waitcnt vmcnt(" #n ")" ::: "memory")
#define G8_WAIT_L(n) asm volatile("s_waitcnt lgkmcnt(" #n ")" ::: "memory")
#define G8_BAR __builtin_amdgcn_s_barrier()
#define G8_SCHED __builtin_amdgcn_sched_barrier(0)
    Unit cur, nxt; int ui = 0;
    if (!S.next(0, cur)) return;
    f32x4 acc[2][2][4][2];
#pragma unroll
    for (int a = 0; a < 2; ++a)
#pragma unroll
        for (int b = 0; b < 2; ++b)
#pragma unroll
            for (int m = 0; m < 4; ++m)
#pragma unroll
                for (int n = 0; n < 2; ++n) acc[a][b][m][n] = (f32x4){0.f, 0.f, 0.f, 0.f};
    bf16x8 At[4][2], B0[2][2], B1[2][2];
    unsigned cA00, cA01, cA10, cA11;
    { int R0, C0, R1, C1; stage_rc(tid * 16, R0, C0); stage_rc(tid * 16 + 8192, R1, C1);
      cA00 = S.aoff(cur, R0) + (unsigned)C0 * 2u;
      if constexpr (Sched::GATHER) { cA01 = S.aoff(cur, R1) + (unsigned)C1 * 2u; cA10 = S.aoff(cur, HALF + R0) + (unsigned)C0 * 2u; cA11 = S.aoff(cur, HALF + R1) + (unsigned)C1 * 2u; }
      else { cA01 = cA00; cA10 = cA00; cA11 = cA00; } }
    const char* cB = cur.B;
    G8_STAGE_B(G8_SB(0, 0), cB, 0); G8_SCHED; G8_STAGE_B(G8_SB(0, 1), cB + hstepB, 0); G8_SCHED; G8_STAGE_A(G8_SA(0, 0), cA00, cA01, 0, 0); G8_SCHED; G8_STAGE_A(G8_SA(0, 1), cA10, cA11, 0, 1); G8_SCHED;
    if (wr == 1) G8_BAR;
    G8_WAIT_V(2); G8_BAR;
    G8_STAGE_B(G8_SB(1, 0), cB, 128); G8_SCHED; G8_STAGE_A(G8_SA(1, 0), cA00, cA01, 128, 0); G8_SCHED; G8_STAGE_B(G8_SB(1, 1), cB + hstepB, 128); G8_SCHED;
    G8_WAIT_V(6); G8_BAR;
    for (;;) {
        const bool has_next = S.next(ui + 1, nxt);
        unsigned nA00 = cA00, nA01 = cA01, nA10 = cA10, nA11 = cA11; const char* nB = cB; long dl = 0;
        if (has_next) {
            nB = nxt.B;
            if constexpr (!Sched::GATHER) dl = ((long)nxt.a0 - (long)cur.a0) * (long)S.lda;
            else { const int t2 = wid * 64 + lane_id_opaque(); int R0, C0, R1, C1; stage_rc(t2 * 16, R0, C0); stage_rc(t2 * 16 + 8192, R1, C1);
                nA00 = S.aoff(nxt, R0) + (unsigned)C0 * 2u; nA01 = S.aoff(nxt, R1) + (unsigned)C1 * 2u; nA10 = S.aoff(nxt, HALF + R0) + (unsigned)C0 * 2u; nA11 = S.aoff(nxt, HALF + R1) + (unsigned)C1 * 2u; }
        }
        for (int t = 0; t < nt; t += 2) {
            const bool last = (t == nt - 2);
            const unsigned kb = (unsigned)t * 128u;
            const unsigned kb2 = last ? 0u : kb + 256u;
            const char* b2 = last ? nB : cB;
            unsigned s00, s01, s10, s11; long ka2;
            if constexpr (Sched::GATHER) { s00 = last ? nA00 : cA00; s01 = last ? nA01 : cA01; s10 = last ? nA10 : cA10; s11 = last ? nA11 : cA11; ka2 = (long)kb2; }
            else { s00 = cA00; s01 = cA00; s10 = cA00; s11 = cA00; ka2 = last ? dl : (long)kb2; }
            G8_LDB(B0, 0, 0); G8_LDB(B1, 0, 1); G8_SCHED; G8_LDA(At, 0, 0); G8_STAGE_A(G8_SA(1, 1), cA10, cA11, kb + 128u, 1);
            G8_WAIT_V(8); G8_WAIT_L(0); G8_BAR; G8_MMA(0, 0, At, B0); G8_MMA(0, 1, At, B1); G8_BAR; G8_SCHED;
            G8_LDA(At, 0, 1); G8_STAGE_B(G8_SB(0, 0), b2, kb2); G8_STAGE_B(G8_SB(0, 1), b2 + hstepB, kb2); G8_STAGE_A(G8_SA(0, 0), s00, s01, ka2, 0);
            G8_WAIT_V(8); G8_WAIT_L(0); G8_BAR; G8_MMA(1, 0, At, B0); G8_MMA(1, 1, At, B1); G8_BAR; G8_SCHED;
            G8_LDB(B0, 1, 0); G8_LDB(B1, 1, 1); G8_SCHED; G8_LDA(At, 1, 0); G8_STAGE_A(G8_SA(0, 1), s10, s11, ka2, 1);
            G8_WAIT_V(8); G8_WAIT_L(0); G8_BAR; G8_MMA(0, 0, At, B0); G8_MMA(0, 1, At, B1); G8_BAR; G8_SCHED;
            G8_LDA(At, 1, 1); G8_STAGE_B(G8_SB(1, 0), b2, kb2 + 128u); G8_STAGE_B(G8_SB(1, 1), b2 + hstepB, kb2 + 128u); G8_STAGE_A(G8_SA(1, 0), s00, s01, ka2 + 128, 0);
            G8_WAIT_V(8); G8_WAIT_L(0); G8_BAR; G8_MMA(1, 0, At, B0); G8_MMA(1, 1, At, B1); G8_BAR; G8_SCHED;
        }
        if (wr == 0) G8_BAR;
        { const int l2 = lane_id_opaque(); E(acc, cur, wr, wc, l2 & 15, l2 >> 4); }
        if (!has_next) break;
#pragma unroll
        for (int a = 0; a < 2; ++a)
#pragma unroll
            for (int b = 0; b < 2; ++b)
#pragma unroll
                for (int m = 0; m < 4; ++m)
#pragma unroll
                    for (int n = 0; n < 2; ++n) acc[a][b][m][n] = (f32x4){0.f, 0.f, 0.f, 0.f};
        cur = nxt; cB = nB; ++ui;
        if constexpr (Sched::GATHER) { cA00 = nA00; cA01 = nA01; cA10 = nA10; cA11 = nA11; }
        else { cA00 += (unsigned)dl; cA01 = cA00; cA10 = cA00; cA11 = cA00; }
        if (wr == 1) G8_BAR;
    }
    G8_WAIT_V(0);
    G8_BAR;
#undef G8_SA
#undef G8_SB
#undef G8_GLDS
#undef G8_STAGE_A
#undef G8_STAGE_B
#undef G8_LDA
#undef G8_LDB
#undef G8_MMA
#undef G8_WAIT_V
#undef G8_WAIT_L
#undef G8_BAR
#undef G8_SCHED
}

struct RectSched {
    static constexpr bool GATHER = false;
    int nM, nN, G, c; unsigned row0, lda; const char* Bbase; unsigned ldb;
    __device__ __forceinline__ bool next(int i, Unit& u) const {
        const int L = i * G + c; if (L >= nM * nN) return false;
        int pm, pn; static_map(L, nM, nN, pm, pn);
        u.a0 = row0 + (unsigned)pm * 256u; u.B = Bbase + (size_t)pn * 256u * ldb; u.p0 = pm; u.p1 = pn; u.p2 = 0; return true;
    }
    __device__ __forceinline__ unsigned aoff(const Unit& u, int q) const { return (u.a0 + (unsigned)q) * lda; }
};
struct QkvSched {
    static constexpr bool GATHER = false;
    int G, c; unsigned lda; const char* Bbase; unsigned ldb;
    __device__ __forceinline__ bool next(int i, Unit& u) const {
        const int L = i * G + c; int pm, pn;
        if (L < 768) static_map(L, 64, 12, pm, pn);
        else if (L < 832) { const int l2 = L - 768; pm = 64 + (l2 & 7); pn = 4 + (l2 >> 3); }
        else return false;
        u.a0 = (unsigned)pm * 256u; u.B = Bbase + (size_t)pn * 256u * ldb; u.p0 = pm; u.p1 = pn; u.p2 = 0; return true;
    }
    __device__ __forceinline__ unsigned aoff(const Unit& u, int q) const { return (u.a0 + (unsigned)q) * lda; }
};
struct BatchSched {
    static constexpr bool GATHER = false;
    int nb, nM, nN, G, c; unsigned lda; const char* Bbase; unsigned ldb; int N;
    __device__ __forceinline__ bool next(int i, Unit& u) const {
        const int per = nM * nN; int L;
        if ((G & 7) == 0 && (nb & 7) == 0) {
            const int nx = (nb >> 3) * per, li = i * (G >> 3) + (c >> 3); if (li >= nx) return false;
            L = (c & 7) * nx + li;
        } else { L = i * G + c; if (L >= nb * per) return false; }
        const int g = L / per, rem = L % per, pm = rem / nN, pn = rem % nN;
        u.a0 = (unsigned)(g * S5RP + pm * 256); u.B = Bbase + ((size_t)g * N + (size_t)pn * 256u) * ldb; u.p0 = g; u.p1 = pm; u.p2 = pn; return true;
    }
    __device__ __forceinline__ unsigned aoff(const Unit& u, int q) const { return (u.a0 + (unsigned)q) * lda; }
};
template <bool GATHER_>
struct MoeSched {
    static constexpr bool GATHER = GATHER_;
    int ntiles, nN, G, c; unsigned lda; const char* Bbase; unsigned ldb; int Ne, pn0, bstep; const LAS unsigned char* tile_e; const int* rowidx;
    __device__ __forceinline__ void xrange(int x, int& tlo, int& nx) const { const int q = ntiles >> 3, r = ntiles & 7; nx = q + (x < r ? 1 : 0); tlo = x * q + (x < r ? x : r); }
    __device__ __forceinline__ bool next(int i, Unit& u) const {
        int tile, pn;
        if ((G & 7) == 0) {
            int tlo, nx; xrange(c & 7, tlo, nx);
            const int li = i * (G >> 3) + (c >> 3); if (li >= nx * nN) return false;
            tile = tlo + li / nN; pn = li % nN;
        } else { const int L = i * G + c; if (L >= ntiles * nN) return false; tile = L / nN; pn = L % nN; }
        const int e = __builtin_amdgcn_readfirstlane((int)tile_e[tile]);
        u.a0 = (unsigned)tile * 256u; u.B = Bbase + ((size_t)e * Ne + (size_t)(pn0 + pn) * (unsigned)bstep) * ldb; u.p0 = tile; u.p1 = pn; u.p2 = e; return true;
    }
    __device__ __forceinline__ unsigned aoff(const Unit& u, int q) const {
        if (GATHER) return (unsigned)rowidx[u.a0 + (unsigned)q] * lda;
        return (u.a0 + (unsigned)q) * lda;
    }
};
}

struct Params {
    const float* in[34];
    float* out;
    unsigned char* ws;
    int ph_lo, ph_hi;
};
enum { I_X = 0, I_C, I_CTX, I_CCTX, I_ADAW, I_ADAB, I_NMG, I_NFG, I_WIN, I_ARE, I_AIM, I_LDT, I_BRE, I_BIM, I_CRE, I_CIM, I_S5D, I_GLUW, I_GLUB, I_CONVW,
       I_HOUT, I_WQKV, I_QG, I_KG, I_RPB, I_NOUT, I_RW, I_RB, I_MG, I_MU, I_MD, I_SG, I_SU, I_SD };

using g8::Unit;
typedef f32x4 Acc[2][2][4][2];

__device__ __forceinline__ u32x4 pack8(const f32x4& a, const f32x4& b) {
    u32x4 w; w.x = pk2(a[0], a[1]); w.y = pk2(a[2], a[3]); w.z = pk2(b[0], b[1]); w.w = pk2(b[2], b[3]); return w;
}

struct EpiWin {
    static constexpr bool PERM = true, HEADP = false, WIDE = false, GUP = false;
    bf16_t* A2; bf16_t* BCV;
    __device__ __forceinline__ void operator()(const Acc& acc, const Unit& u, int wr, int wc, int fr, int fq) const {
#pragma unroll
        for (int ai = 0; ai < 2; ++ai)
#pragma unroll
            for (int m = 0; m < 4; ++m) {
                const int row = u.p0 * 256 + 128 * ai + 64 * wr + 16 * m + fr;
#pragma unroll
                for (int bj = 0; bj < 2; ++bj) {
                    const int col0 = u.p1 * 256 + 128 * bj + 32 * wc + 8 * fq;
                    const u32x4 w = pack8(acc[ai][bj][m][0], acc[ai][bj][m][1]);
                    if (u.p1 < 2) {
                        const int g = col0 >> 4, ci0 = col0 & 15, r = row >> 5, s = row & 31;
                        *(u32x4*)(A2 + ((size_t)(g * S5RP + r) * S5K + s * 16 + ci0)) = w;
                    } else {
                        *(u32x4*)(BCV + ((size_t)row * 1536 + (col0 - 512))) = w;
                    }
                }
            }
    }
};
struct EpiS5F {
    static constexpr bool PERM = false, HEADP = false, WIDE = false, GUP = false;
    float* F;
    __device__ __forceinline__ void operator()(const Acc& acc, const Unit& u, int wr, int wc, int fr, int fq) const {
#pragma unroll
        for (int ai = 0; ai < 2; ++ai)
#pragma unroll
            for (int m = 0; m < 4; ++m) {
                const int row = u.p1 * 256 + 128 * ai + 64 * wr + 16 * m + fr;
                float* rp = F + ((size_t)(u.p0 * S5RP + row) * 256);
#pragma unroll
                for (int bj = 0; bj < 2; ++bj)
#pragma unroll
                    for (int n = 0; n < 2; ++n) *(f32x4*)(rp + 128 * bj + 32 * wc + 16 * n + 4 * fq) = acc[ai][bj][m][n];
            }
    }
};
struct EpiS5Y {
    static constexpr bool PERM = true, HEADP = false, WIDE = false, GUP = false;
    bf16_t* Gb;
    __device__ __forceinline__ void operator()(const Acc& acc, const Unit& u, int wr, int wc, int fr, int fq) const {
#pragma unroll
        for (int ai = 0; ai < 2; ++ai)
#pragma unroll
            for (int m = 0; m < 4; ++m) {
                const int r = u.p1 * 256 + 128 * ai + 64 * wr + 16 * m + fr;
                if (r < S5R) {
#pragma unroll
                    for (int bj = 0; bj < 2; ++bj) {
                        const int col0 = u.p2 * 256 + 128 * bj + 32 * wc + 8 * fq;
                        const int t = col0 >> 4, co0 = col0 & 15;
                        f32x4 a = acc[ai][bj][m][0], b = acc[ai][bj][m][1];
#pragma unroll
                        for (int j = 0; j < 4; ++j) { a[j] = gelu_tanh(a[j]); b[j] = gelu_tanh(b[j]); }
                        *(u32x4*)(Gb + ((size_t)(r * S5T + t) * 512 + u.p0 * 16 + co0)) = pack8(a, b);
                    }
                }
            }
    }
};
struct EpiGlu {
    static constexpr bool PERM = true, HEADP = false, WIDE = false, GUP = false;
    const bf16_t* Gb; const float* bias; bf16_t* Z;
    __device__ __forceinline__ void operator()(const Acc& acc, const Unit& u, int wr, int wc, int fr, int fq) const {
#pragma unroll
        for (int ai = 0; ai < 2; ++ai)
#pragma unroll
            for (int m = 0; m < 4; ++m) {
                const int row = u.p0 * 256 + 128 * ai + 64 * wr + 16 * m + fr;
#pragma unroll
                for (int bj = 0; bj < 2; ++bj) {
                    const int col0 = u.p1 * 256 + 128 * bj + 32 * wc + 8 * fq;
                    const u32x4 gv = *(const u32x4*)(Gb + ((size_t)row * 512 + col0));
                    const f32x4 b0 = *(const f32x4*)(bias + col0), b1 = *(const f32x4*)(bias + col0 + 4);
                    f32x4 a = acc[ai][bj][m][0] + b0, b = acc[ai][bj][m][1] + b1;
                    a[0] = bflo(gv.x) * sigmoidf_(a[0]); a[1] = bfhi(gv.x) * sigmoidf_(a[1]); a[2] = bflo(gv.y) * sigmoidf_(a[2]); a[3] = bfhi(gv.y) * sigmoidf_(a[3]);
                    b[0] = bflo(gv.z) * sigmoidf_(b[0]); b[1] = bfhi(gv.z) * sigmoidf_(b[1]); b[2] = bflo(gv.w) * sigmoidf_(b[2]); b[3] = bfhi(gv.w) * sigmoidf_(b[3]);
                    *(u32x4*)(Z + ((size_t)row * 1024 + col0)) = pack8(a, b);
                }
            }
    }
};
template <bool SRCF32>
struct EpiResid {
    static constexpr bool PERM = true, HEADP = false, WIDE = true, GUP = false;
    const float* xlat; const float* xctx;
    const float* gate;
    bf16_t* XR; float rs;
    __device__ __forceinline__ void operator()(const Acc& acc, const Unit& u, int wr, int wc, int fr, int fq) const {
#pragma unroll
        for (int ai = 0; ai < 2; ++ai)
#pragma unroll
            for (int m = 0; m < 4; ++m) {
                const int row = u.p0 * 256 + 128 * ai + 64 * wr + 16 * m + fr;
                const int b = row < NLAT ? (row >> 11) : 8;
                const int col = u.p1 * 256 + 64 * wc + 16 * fq;
                const float* gp = gate + b * 6144 + col;
                f32x4 xv[4];
                if (SRCF32) {
                    const float* src = (row < NLAT ? xlat + (size_t)row * DM : xctx + (size_t)(row - NLAT) * DM) + col;
#pragma unroll
                    for (int q = 0; q < 4; ++q) xv[q] = *(const f32x4*)(src + 4 * q);
                } else {
                    const u32x4 a = *(const u32x4*)(XR + (size_t)row * DM + col), c = *(const u32x4*)(XR + (size_t)row * DM + col + 8);
                    xv[0] = (f32x4){bflo(a.x), bfhi(a.x), bflo(a.y), bfhi(a.y)}; xv[1] = (f32x4){bflo(a.z), bfhi(a.z), bflo(a.w), bfhi(a.w)};
                    xv[2] = (f32x4){bflo(c.x), bfhi(c.x), bflo(c.y), bfhi(c.y)}; xv[3] = (f32x4){bflo(c.z), bfhi(c.z), bflo(c.w), bfhi(c.w)};
                }
                const f32x4 o0 = xv[0] + *(const f32x4*)(gp) * (acc[ai][0][m][0] * rs), o1 = xv[1] + *(const f32x4*)(gp + 4) * (acc[ai][0][m][1] * rs);
                const f32x4 o2 = xv[2] + *(const f32x4*)(gp + 8) * (acc[ai][1][m][0] * rs), o3 = xv[3] + *(const f32x4*)(gp + 12) * (acc[ai][1][m][1] * rs);
                *(u32x4*)(XR + (size_t)row * DM + col) = pack8(o0, o1); *(u32x4*)(XR + (size_t)row * DM + col + 8) = pack8(o2, o3);
            }
    }
};
struct EpiGU {
    static constexpr bool PERM = false, HEADP = false, WIDE = false, GUP = true;
    bf16_t* ACT;
    __device__ __forceinline__ void operator()(const Acc& acc, const Unit& u, int wr, int wc, int fr, int fq) const {
#pragma unroll
        for (int ai = 0; ai < 2; ++ai)
#pragma unroll
            for (int m = 0; m < 4; ++m) {
                const int slot = u.p0 * 256 + 128 * ai + 64 * wr + 16 * m + fr;
                u32x4 o;
#pragma unroll
                for (int bj = 0; bj < 2; ++bj) {
                    const f32x4 g = acc[ai][bj][m][0], up = acc[ai][bj][m][1];
                    o[2 * bj] = pk2(siluf_(g[0]) * up[0], siluf_(g[1]) * up[1]); o[2 * bj + 1] = pk2(siluf_(g[2]) * up[2], siluf_(g[3]) * up[3]);
                }
                *(u32x4*)(ACT + ((size_t)slot * EDIM + u.p1 * 128 + 32 * wc + 8 * fq)) = o;
            }
    }
};
__device__ __forceinline__ float fp8c(float v) { return __builtin_amdgcn_fmed3f(v * 16.f, -440.f, 440.f); }
__device__ __forceinline__ u32x2 pack8_fp8(const f32x4& a, const f32x4& b) {
    int w0 = 0, w1 = 0;
    w0 = __builtin_amdgcn_cvt_pk_fp8_f32(fp8c(a[0]), fp8c(a[1]), w0, false); w0 = __builtin_amdgcn_cvt_pk_fp8_f32(fp8c(a[2]), fp8c(a[3]), w0, true);
    w1 = __builtin_amdgcn_cvt_pk_fp8_f32(fp8c(b[0]), fp8c(b[1]), w1, false); w1 = __builtin_amdgcn_cvt_pk_fp8_f32(fp8c(b[2]), fp8c(b[3]), w1, true);
    return (u32x2){(unsigned)w0, (unsigned)w1};
}
struct EpiDN {
    static constexpr bool PERM = true, HEADP = false, WIDE = true, GUP = false;
    unsigned char* Y;
    __device__ __forceinline__ void operator()(const Acc& acc, const Unit& u, int wr, int wc, int fr, int fq) const {
#pragma unroll
        for (int ai = 0; ai < 2; ++ai)
#pragma unroll
            for (int m = 0; m < 4; ++m) {
                const int slot = u.p0 * 256 + 128 * ai + 64 * wr + 16 * m + fr;
                const u32x2 lo = pack8_fp8(acc[ai][0][m][0], acc[ai][0][m][1]), hi = pack8_fp8(acc[ai][1][m][0], acc[ai][1][m][1]);
                *(u32x4*)(Y + ((size_t)slot * 1024 + u.p1 * 256 + 64 * wc + 16 * fq)) = (u32x4){lo.x, lo.y, hi.x, hi.y};
            }
    }
};
struct EpiQKV {
    static constexpr bool PERM = true, HEADP = true, WIDE = false, GUP = false;
    bf16_t* Q; bf16_t* Kb; bf16_t* VT; const float* qg; const float* kg;
    __device__ __forceinline__ void operator()(const Acc& acc, const Unit& u, int wr, int wc, int fr, int fq) const {
        const int region = u.p1 >> 2;
        if (region < 2) {
            const float* gp = (region == 0 ? qg : kg) + 8 * fq; const float gs = region == 0 ? 0.125f * 1.4426950408889634f : 1.f;
            f32x4 g[2][2];
#pragma unroll
            for (int bj = 0; bj < 2; ++bj)
#pragma unroll
                for (int n = 0; n < 2; ++n) g[bj][n] = *(const f32x4*)(gp + 32 * bj + 4 * n) * gs;
            bf16_t* dst = region == 0 ? Q : Kb;
#pragma unroll
            for (int ai = 0; ai < 2; ++ai)
#pragma unroll
                for (int m = 0; m < 4; ++m) {
                    const int row = u.p0 * 256 + 128 * ai + 64 * wr + 16 * m + fr;
                    float ss = 0.f;
#pragma unroll
                    for (int bj = 0; bj < 2; ++bj)
#pragma unroll
                        for (int n = 0; n < 2; ++n) { const f32x4 v = acc[ai][bj][m][n]; ss += (v[0] * v[0] + v[1] * v[1]) + (v[2] * v[2] + v[3] * v[3]); }
                    ss += __shfl_xor(ss, 16); ss += __shfl_xor(ss, 32);
                    const float rstd = rsqrtf(ss * (1.f / 64.f) + 1e-6f);
                    bf16_t* rp = dst + ((size_t)row * DM + (u.p1 & 3) * 256 + 64 * wc + 8 * fq);
#pragma unroll
                    for (int bj = 0; bj < 2; ++bj) *(u32x4*)(rp + 32 * bj) = pack8(acc[ai][bj][m][0] * rstd * g[bj][0], acc[ai][bj][m][1] * rstd * g[bj][1]);
                }
        } else {
#pragma unroll
            for (int ai = 0; ai < 2; ++ai)
#pragma unroll
                for (int m = 0; m < 4; ++m) {
                    const int row = u.p0 * 256 + 128 * ai + 64 * wr + 16 * m + fr;
                    bf16_t* rp = VT + ((size_t)row * DM + (u.p1 & 3) * 256 + 64 * wc + 8 * fq);
#pragma unroll
                    for (int bj = 0; bj < 2; ++bj) *(u32x4*)(rp + 32 * bj) = pack8(acc[ai][bj][m][0], acc[ai][bj][m][1]);
                }
        }
    }
};

struct Ctx { int tid, lane, wave, G, blk, gw, NGW; LAS unsigned char* lds; };
__device__ __forceinline__ Ctx mkctx(LAS unsigned char* lds, int wave0) {
    Ctx X; X.lane = lane_id_opaque(); X.wave = wave0; X.tid = wave0 * 64 + X.lane; X.G = gridDim.x; X.blk = blockIdx.x;
    X.gw = X.blk * 8 + X.wave; X.NGW = X.G * 8; X.lds = lds; return X;
}

template <int MODE> __device__ __forceinline__ int wrow(int n) { return MODE == 2 ? 256 + n : n; }
template <int MODE>
__device__ __forceinline__ void conv_item(const float* W, int N, bf16_t* WT, int ldk, int k0, int n0, LAS unsigned* T, int lane) {
    (void)T;
    const int nq = lane & 15, kg = lane >> 4;
    const float* wp = W + (size_t)(k0 + 16 * kg) * N + n0 + 4 * nq;
    f32x4 r[16];
#pragma unroll
    for (int i = 0; i < 16; ++i) r[i] = *(const f32x4*)(wp + (size_t)i * N);
#pragma unroll
    for (int j = 0; j < 4; ++j) {
        bf16_t* op = WT + (size_t)wrow<MODE>(n0 + 4 * nq + j) * ldk + k0 + 16 * kg;
        u32x4 lo, hi;
        lo.x = pk2(r[0][j], r[1][j]); lo.y = pk2(r[2][j], r[3][j]); lo.z = pk2(r[4][j], r[5][j]); lo.w = pk2(r[6][j], r[7][j]);
        hi.x = pk2(r[8][j], r[9][j]); hi.y = pk2(r[10][j], r[11][j]); hi.z = pk2(r[12][j], r[13][j]); hi.w = pk2(r[14][j], r[15][j]);
        *(u32x4*)op = lo; *(u32x4*)(op + 8) = hi;
    }
}
__device__ __forceinline__ void conv_mat(const Ctx& X, const float* W, int K, int N, bf16_t* WT, int& rot) {
    LAS unsigned* T = (LAS unsigned*)(X.lds + X.wave * 8192);
    const int nb = N / 64, nitems = (K / 64) * nb;
    int start = X.gw - rot; while (start < 0) start += X.NGW;
    for (int it = start; it < nitems; it += X.NGW) conv_item<0>(W, N, WT, K, (it / nb) * 64, (it % nb) * 64, T, X.lane);
    rot = (rot + nitems) % X.NGW;
}
template <int KIND>
__device__ __forceinline__ void conv_moe_items(const Ctx& X, const Params& p, int l, bf16_t* GU, bf16_t* DN, int it0, int it1, int rank, int nrank) {
    constexpr int PER = KIND == 0 ? 192 : (KIND == 1 ? 128 : 64);
    for (int it = it0 + rank * 8 + X.wave; it < it1; it += nrank * 8) {
        const int e = it / PER, r = it % PER, kind = KIND == 2 ? 2 : (r >> 6), q = r & 63;
        if (kind == 0) {
            const float* W = e < NEXP ? p.in[I_MG] + (size_t)(l * NEXP + e) * 262144 : p.in[I_SG] + (size_t)l * 262144;
            conv_item<1>(W, 256, GU + (size_t)e * 512 * 1024, 1024, (q >> 2) * 64, (q & 3) * 64, nullptr, X.lane);
        } else if (kind == 1) {
            const float* W = e < NEXP ? p.in[I_MU] + (size_t)(l * NEXP + e) * 262144 : p.in[I_SU] + (size_t)l * 262144;
            conv_item<2>(W, 256, GU + (size_t)e * 512 * 1024, 1024, (q >> 2) * 64, (q & 3) * 64, nullptr, X.lane);
        } else {
            const float* W = e < NEXP ? p.in[I_MD] + (size_t)(l * NEXP + e) * 262144 : p.in[I_SD] + (size_t)l * 262144;
            conv_item<0>(W, 1024, DN + (size_t)e * 1024 * 256, 256, (q >> 4) * 64, (q & 15) * 64, nullptr, X.lane);
        }
    }
}
__device__ __forceinline__ int moe_idle_rank(int ntiles, int nN, int G, int blk, int& nidle) {
    if ((G & 7) != 0) { const int nunits = ntiles * nN, nfull = nunits % G; if (nfull == 0) { nidle = G; return blk; } nidle = G - nfull; return blk >= nfull ? blk - nfull : -1; }
    const int B8 = G >> 3, q = ntiles >> 3, r = ntiles & 7;
    int maxc = 0;
    for (int x = 0; x < 8; ++x) { const int n = (q + (x < r ? 1 : 0)) * nN; const int cmax = (n + B8 - 1) / B8; maxc = cmax > maxc ? cmax : maxc; }
    int rank = -1, cnt = 0;
    for (int x = 0; x < 8; ++x) {
        const int n = (q + (x < r ? 1 : 0)) * nN;
        int jfull = n - (maxc - 1) * B8; jfull = jfull < 0 ? 0 : (jfull > B8 ? B8 : jfull);
        if (x == (blk & 7)) { const int j = blk >> 3; if (j >= jfull) rank = cnt + (j - jfull); }
        cnt += B8 - jfull;
    }
    if (cnt == 0) { nidle = G; return blk; }
    nidle = cnt; return rank;
}
__device__ __forceinline__ int idle_rank(int nunits, int G, int blk, int& nidle) {
    const int nfull = nunits % G;
    if (nfull == 0) { nidle = G; return blk; }
    nidle = G - nfull; return blk >= nfull ? blk - nfull : -1;
}

__device__ __forceinline__ void sincos_red(float x, float& s, float& c) {
    const float n = rintf(x * 0.15915494309189535f);
    float r = fmaf(-n, 6.28125f, x); r = fmaf(-n, 1.9353071795864769e-3f, r);
    s = __sinf(r); c = __cosf(r);
}

__device__ __forceinline__ void phase_p0a(const Ctx& X, const Params& p) {
    {
        LAS float* PWs = (LAS float*)(X.lds);
        LAS float* BBs = (LAS float*)(X.lds + 20480);
        LAS float* CCs = (LAS float*)(X.lds + 32768);
        float* KK = (float*)(p.ws + WS_KK); float* PWG = (float*)(p.ws + WS_PW); float* BBG = (float*)(p.ws + WS_BB);
        for (int item = X.blk; item < 256; item += X.G) {
            const int g = item >> 3, d = (item >> 2) & 1, lq = item & 3, gd = d * 32 + g;
            const float dt = expf(p.in[I_LDT][gd]);
            __syncthreads();
            for (int idx = X.tid; idx < 33 * 64; idx += 512) {
                const int j = idx >> 6, pp = idx & 63;
                const float lre = fminf(p.in[I_ARE][gd * 64 + pp], -1e-4f), lim = p.in[I_AIM][gd * 64 + pp];
                const float mag = expf(lre * dt * (float)j); float sn, cs; sincos_red(lim * dt * (float)j, sn, cs);
                PWs[2 * idx] = mag * cs; PWs[2 * idx + 1] = mag * sn;
            }
            for (int idx = X.tid; idx < 1024; idx += 512) {
                const int pp = idx >> 4;
                const float lre = fminf(p.in[I_ARE][gd * 64 + pp], -1e-4f), lim = p.in[I_AIM][gd * 64 + pp];
                const float mag = expf(lre * dt); float sn, cs; sincos_red(lim * dt, sn, cs);
                const float nr = mag * cs - 1.f, ni = mag * sn, den = 1.f / (lre * lre + lim * lim);
                const float cr = (nr * lre + ni * lim) * den, ci = (ni * lre - nr * lim) * den;
                const float br = p.in[I_BRE][(size_t)gd * 1024 + idx], bi = p.in[I_BIM][(size_t)gd * 1024 + idx];
                BBs[2 * idx] = cr * br - ci * bi; BBs[2 * idx + 1] = cr * bi + ci * br;
            }
            for (int idx = X.tid; idx < 1024; idx += 512) { CCs[2 * idx] = p.in[I_CRE][(size_t)gd * 1024 + idx]; CCs[2 * idx + 1] = p.in[I_CIM][(size_t)gd * 1024 + idx]; }
            __syncthreads();
#pragma unroll
            for (int i = 0; i < 4; ++i) {
                const int e = X.tid + 512 * i, lag = 8 * lq + (e >> 8), co = (e >> 4) & 15, ci = e & 15;
                float sum = 0.f;
                for (int pp = 0; pp < 64; ++pp) {
                    const float pr = PWs[2 * (lag * 64 + pp)], pi = PWs[2 * (lag * 64 + pp) + 1];
                    const float br = BBs[2 * (pp * 16 + ci)], bi = BBs[2 * (pp * 16 + ci) + 1];
                    const float tr = pr * br - pi * bi, ti = pr * bi + pi * br;
                    sum += CCs[2 * (co * 64 + pp)] * tr - CCs[2 * (co * 64 + pp) + 1] * ti;
                }
                KK[(size_t)((g * 2 + d) * 32 + lag) * 256 + co * 16 + ci] = sum;
            }
            if (lq == 0) {
                for (int idx = X.tid; idx < 33 * 64 * 2; idx += 512) PWG[(size_t)(g * 2 + d) * 33 * 64 * 2 + idx] = PWs[idx];
                for (int idx = X.tid; idx < 2048; idx += 512) BBG[(size_t)(g * 2 + d) * 2048 + idx] = BBs[idx];
            }
        }
        __syncthreads();
    }
    {
        LAS float* condS = (LAS float*)(X.lds + 65536);
        LAS float* red = (LAS float*)(X.lds);
        for (int i = X.tid; i < 9 * 1024; i += 512) { const int r = i >> 10, k = i & 1023; const float v = r < 8 ? p.in[I_C][r * 1024 + k] : p.in[I_CCTX][k]; condS[i] = siluf_(v); }
        __syncthreads();
        float* MOD = (float*)(p.ws + WS_MOD);
        for (int task = X.blk; task < 192; task += X.G) {
            const int l = task / 96, cg = task % 96, col = cg * 64 + X.lane;
            const float* wp = p.in[I_ADAW] + (size_t)l * 1024 * 6144 + (size_t)(X.wave * 128) * 6144 + col;
            float a0 = 0, a1 = 0, a2 = 0, a3 = 0, a4 = 0, a5 = 0, a6 = 0, a7 = 0, a8 = 0;
#pragma unroll
            for (int hb = 0; hb < 2; ++hb) {
                float wv[64];
#pragma unroll
                for (int kk = 0; kk < 64; ++kk) wv[kk] = wp[(size_t)(hb * 64 + kk) * 6144];
#pragma unroll
                for (int kk = 0; kk < 64; ++kk) {
                    const float w = wv[kk]; const LAS float* cp = condS + X.wave * 128 + hb * 64 + kk;
                    a0 += cp[0] * w; a1 += cp[1024] * w; a2 += cp[2048] * w; a3 += cp[3072] * w; a4 += cp[4096] * w; a5 += cp[5120] * w; a6 += cp[6144] * w; a7 += cp[7168] * w; a8 += cp[8192] * w;
                }
            }
            __syncthreads();
            LAS float* rp = red + X.wave * 576 + X.lane;
            rp[0] = a0; rp[64] = a1; rp[128] = a2; rp[192] = a3; rp[256] = a4; rp[320] = a5; rp[384] = a6; rp[448] = a7; rp[512] = a8;
            __syncthreads();
            for (int i = X.tid; i < 576; i += 512) {
                const int r = i >> 6, c = i & 63; float sum = p.in[I_ADAB][l * 6144 + cg * 64 + c];
#pragma unroll
                for (int w = 0; w < 8; ++w) sum += red[w * 576 + i];
                MOD[(size_t)(l * 9 + r) * 6144 + cg * 64 + c] = sum;
            }
        }
        __syncthreads();
    }
    {
        int rot = 0;
        conv_mat(X, p.in[I_WIN], 1024, 2048, (bf16_t*)(p.ws + WS_WIN), rot);
    }
}
__device__ __forceinline__ void conv_small(const Ctx& X, const Params& p, int rank, int nrank) {
    Ctx Y = X; Y.gw = rank * 8 + X.wave; Y.NGW = nrank * 8;
    int rot = 0;
    conv_mat(Y, p.in[I_GLUW], 512, 512, (bf16_t*)(p.ws + WS_GLU), rot);
    conv_mat(Y, p.in[I_HOUT], 1024, 1024, (bf16_t*)(p.ws + WS_HOUT), rot);
    conv_mat(Y, p.in[I_RW], 1024, 64, (bf16_t*)(p.ws + WS_ROUT), rot);
    conv_mat(Y, p.in[I_RW] + 65536, 1024, 64, (bf16_t*)(p.ws + WS_ROUT) + 256 * 1024, rot);
    conv_mat(Y, p.in[I_WQKV], 1024, 3072, (bf16_t*)(p.ws + WS_QKV), rot);
    conv_mat(Y, p.in[I_NOUT], 1024, 1024, (bf16_t*)(p.ws + WS_NOUT), rot);
}

__device__ __forceinline__ void phase_p0b(const Ctx& X, const Params& p) {
    const int gt = X.blk * 512 + X.tid, NT = X.G * 512;
    const float* KK = (const float*)(p.ws + WS_KK); const float* PWG = (const float*)(p.ws + WS_PW); const float* BBG = (const float*)(p.ws + WS_BB);
    bf16_t* ME = (bf16_t*)(p.ws + WS_ME); bf16_t* WF = (bf16_t*)(p.ws + WS_WF);
    for (int ch = gt; ch < 32 * 512 * 96; ch += NT) {
        const int kc = ch % 96, n = (ch / 96) & 511, g = ch / (96 * 512), t = n >> 4, co = n & 15, k0 = kc * 8;
        float v[8];
        if (k0 < 512) {
            const int s_ = k0 >> 4, ci0 = k0 & 15;
            const int lf = t - s_, lb = s_ - t; const float mf = lf >= 0 ? 1.f : 0.f, mb = lb >= 0 ? 1.f : 0.f;
            const float* kf = KK + (size_t)((g * 2 + 0) * 32 + (lf >= 0 ? lf : 0)) * 256 + co * 16 + ci0;
            const float* kb = KK + (size_t)((g * 2 + 1) * 32 + (lb >= 0 ? lb : 0)) * 256 + co * 16 + ci0;
            const f32x4 f0 = *(const f32x4*)kf, f1 = *(const f32x4*)(kf + 4), b0 = *(const f32x4*)kb, b1 = *(const f32x4*)(kb + 4);
            const float dsk = p.in[I_S5D][16 * g + co];
#pragma unroll
            for (int j = 0; j < 4; ++j) {
                v[j] = f0[j] * mf + b0[j] * mb + ((s_ == t && ci0 + j == co) ? dsk : 0.f);
                v[4 + j] = f1[j] * mf + b1[j] * mb + ((s_ == t && ci0 + 4 + j == co) ? dsk : 0.f);
            }
        } else {
            const int kk = k0 - 512, d = kk >> 7, ri = (kk >> 6) & 1, p0 = kk & 63, jj = d == 0 ? t + 1 : 32 - t;
            const float* pw = PWG + ((size_t)((g * 2 + d) * 33 + jj) * 64 + p0) * 2;
            const float* crp = p.in[I_CRE] + (size_t)((d * 32 + g) * 16 + co) * 64 + p0; const float* cip = p.in[I_CIM] + (size_t)((d * 32 + g) * 16 + co) * 64 + p0;
            f32x4 pq[4];
#pragma unroll
            for (int q = 0; q < 4; ++q) pq[q] = *(const f32x4*)(pw + 4 * q);
            const f32x4 cr0 = *(const f32x4*)crp, cr1 = *(const f32x4*)(crp + 4), ci0v = *(const f32x4*)cip, ci1v = *(const f32x4*)(cip + 4);
#pragma unroll
            for (int j = 0; j < 8; ++j) {
                const float pr = pq[j >> 1][(j & 1) * 2], pi = pq[j >> 1][(j & 1) * 2 + 1];
                const float cr = j < 4 ? cr0[j & 3] : cr1[j & 3], cim = j < 4 ? ci0v[j & 3] : ci1v[j & 3];
                const float zr = cr * pr - cim * pi, zi = cr * pi + cim * pr;
                v[j] = ri == 0 ? zr : -zi;
            }
        }
        u32x4 w; w.x = pk2(v[0], v[1]); w.y = pk2(v[2], v[3]); w.z = pk2(v[4], v[5]); w.w = pk2(v[6], v[7]);
        *(u32x4*)(ME + ((size_t)(g * 512 + n)) * 768 + k0) = w;
    }
    for (int ch = gt; ch < 32 * 256 * 64; ch += NT) {
        const int kc = ch & 63, n = (ch >> 6) & 255, g = ch >> 14, d = n >> 7, ri = (n >> 6) & 1, pp = n & 63, k0 = kc * 8, s_ = k0 >> 4, ci0 = k0 & 15;
        const int jj = d == 0 ? 31 - s_ : s_;
        const float pr = PWG[((size_t)((g * 2 + d) * 33 + jj) * 64 + pp) * 2], pi = PWG[((size_t)((g * 2 + d) * 33 + jj) * 64 + pp) * 2 + 1];
        const float* bb = BBG + ((size_t)(g * 2 + d) * 1024 + pp * 16 + ci0) * 2;
        f32x4 bq[4];
#pragma unroll
        for (int q = 0; q < 4; ++q) bq[q] = *(const f32x4*)(bb + 4 * q);
        float v[8];
#pragma unroll
        for (int j = 0; j < 8; ++j) {
            const float br = bq[j >> 1][(j & 1) * 2], bi = bq[j >> 1][(j & 1) * 2 + 1];
            v[j] = ri == 0 ? (pr * br - pi * bi) : (pr * bi + pi * br);
        }
        u32x4 w; w.x = pk2(v[0], v[1]); w.y = pk2(v[2], v[3]); w.z = pk2(v[4], v[5]); w.w = pk2(v[6], v[7]);
        *(u32x4*)(WF + ((size_t)(g * 256 + n)) * 512 + k0) = w;
    }
}

template <int SRC>
__device__ __forceinline__ void norm_load(const Params& p, int row, int lane, f32x4 (&v)[4]) {
    if (SRC == 0) {
        const float* src = (row < NLAT ? p.in[I_X] + (size_t)row * DM : p.in[I_CTX] + (size_t)(row - NLAT) * DM) + 8 * lane;
        v[0] = *(const f32x4*)(src); v[1] = *(const f32x4*)(src + 4); v[2] = *(const f32x4*)(src + 512); v[3] = *(const f32x4*)(src + 516);
    } else {
        const bf16_t* src = (const bf16_t*)(p.ws + WS_XR) + (size_t)row * DM + 8 * lane;
        const u32x4 a = *(const u32x4*)(src), c = *(const u32x4*)(src + 512);
        v[0] = (f32x4){bflo(a.x), bfhi(a.x), bflo(a.y), bfhi(a.y)}; v[1] = (f32x4){bflo(a.z), bfhi(a.z), bflo(a.w), bfhi(a.w)};
        v[2] = (f32x4){bflo(c.x), bfhi(c.x), bflo(c.y), bfhi(c.y)}; v[3] = (f32x4){bflo(c.z), bfhi(c.z), bflo(c.w), bfhi(c.w)};
    }
}
template <int SRC>
__device__ __forceinline__ void phase_norm(const Ctx& X, const Params& p, int l, int ffn, int ntok) {
    const float* gain = (ffn ? p.in[I_NFG] : p.in[I_NMG]) + l * 1024;
    const float* mod = (const float*)(p.ws + WS_MOD) + (size_t)l * 9 * 6144;
    const int shi = ffn ? 3 : 0, sci = ffn ? 4 : 1;
    bf16_t* XA = (bf16_t*)(p.ws + WS_XA);
    const int rpw = (ntok + X.NGW - 1) / X.NGW, r0 = X.gw * rpw, r1 = (r0 + rpw) < ntok ? (r0 + rpw) : ntok;
    int curb = -1; f32x4 gm[4], sh[4];
    f32x4 vn[4];
    if (r0 < r1) norm_load<SRC>(p, r0, X.lane, vn);
    for (int row = r0; row < r1; ++row) {
        const int b = row < NLAT ? (row >> 11) : 8;
        if (b != curb) {
            curb = b;
#pragma unroll
            for (int j = 0; j < 4; ++j) {
                const int c = 8 * X.lane + 512 * (j >> 1) + 4 * (j & 1);
                const f32x4 g4 = *(const f32x4*)(gain + c), sc4 = *(const f32x4*)(mod + b * 6144 + sci * 1024 + c);
                sh[j] = *(const f32x4*)(mod + b * 6144 + shi * 1024 + c); gm[j] = g4 * (sc4 + 1.f);
            }
        }
        f32x4 v[4]; float ss = 0.f;
#pragma unroll
        for (int j = 0; j < 4; ++j) v[j] = vn[j];
        if (row + 1 < r1) norm_load<SRC>(p, row + 1, X.lane, vn);
#pragma unroll
        for (int j = 0; j < 4; ++j) ss += (v[j][0] * v[j][0] + v[j][1] * v[j][1]) + (v[j][2] * v[j][2] + v[j][3] * v[j][3]);
        const float rstd = rsqrtf(wave_sum(ss) * (1.f / 1024.f) + 1e-6f);
        const f32x4 o0 = v[0] * rstd * gm[0] + sh[0], o1 = v[1] * rstd * gm[1] + sh[1], o2 = v[2] * rstd * gm[2] + sh[2], o3 = v[3] * rstd * gm[3] + sh[3];
        *(u32x4*)(XA + (size_t)row * DM + 8 * X.lane) = pack8(o0, o1); *(u32x4*)(XA + (size_t)row * DM + 512 + 8 * X.lane) = pack8(o2, o3);
    }
}

__device__ __forceinline__ void phase_scan_conv(const Ctx& X, const Params& p) {
    const float* F = (const float*)(p.ws + WS_F); bf16_t* A2 = (bf16_t*)(p.ws + WS_A2); const float* PWG = (const float*)(p.ws + WS_PW);
    for (int gid = X.blk * 512 + X.tid; gid < 32768; gid += X.G * 512) {
        const int pp = gid & 63, d = (gid >> 6) & 1, g = (gid >> 7) & 31, b = gid >> 12;
        const float ar = PWG[((size_t)((g * 2 + d) * 33 + 32) * 64 + pp) * 2], ai = PWG[((size_t)((g * 2 + d) * 33 + 32) * 64 + pp) * 2 + 1];
        float sr = 0.f, si = 0.f;
        for (int s8 = 0; s8 < 72; s8 += 8) {
            float fr[8], fi[8]; size_t ro[8];
#pragma unroll
            for (int q = 0; q < 8; ++q) {
                const int step = s8 + q; int r;
                if (d == 0) r = step < 8 ? 512 + b * 8 + step : b * 64 + (step - 8);
                else        r = step < 8 ? 512 + b * 8 + (7 - step) : b * 64 + (71 - step);
                ro[q] = (size_t)(g * S5RP + r);
                fr[q] = F[ro[q] * 256 + d * 128 + pp]; fi[q] = F[ro[q] * 256 + d * 128 + 64 + pp];
            }
#pragma unroll
            for (int q = 0; q < 8; ++q) {
                A2[ro[q] * S5K + 512 + d * 128 + pp] = (bf16_t)f2bf(sr); A2[ro[q] * S5K + 512 + d * 128 + 64 + pp] = (bf16_t)f2bf(si);
                const float nr = ar * sr - ai * si + fr[q], ni = ar * si + ai * sr + fi[q];
                sr = nr; si = ni;
            }
        }
    }
    const bf16_t* BCV = (const bf16_t*)(p.ws + WS_BCV); bf16_t* Z = (bf16_t*)(p.ws + WS_Z); const float* cw = p.in[I_CONVW];
    for (int it = X.blk * 512 + X.tid; it < NTOK * 64; it += X.G * 512) {
        const int tok = it >> 6, c0 = (it & 63) * 8;
        const int pos = tok < NLAT ? (tok & 2047) : ((tok - NLAT) & 255), len = tok < NLAT ? 2048 : 256;
        const bf16_t* base = BCV + (size_t)tok * 1536;
        const u32x4 bg = *(const u32x4*)(base + c0), cg1 = *(const u32x4*)(base + 512 + c0), v1 = *(const u32x4*)(base + 1024 + c0);
        u32x4 cg0 = (u32x4){0u, 0u, 0u, 0u}, v0 = cg0, cg2 = cg0, v2 = cg0;
        if (pos > 0) { cg0 = *(const u32x4*)(base - 1536 + 512 + c0); v0 = *(const u32x4*)(base - 1536 + 1024 + c0); }
        if (pos < len - 1) { cg2 = *(const u32x4*)(base + 1536 + 512 + c0); v2 = *(const u32x4*)(base + 1536 + 1024 + c0); }
        float o[8];
#pragma unroll
        for (int j = 0; j < 4; ++j) {
            const float w0a = cw[c0 + 2 * j], w1a = cw[512 + c0 + 2 * j], w2a = cw[1024 + c0 + 2 * j];
            const float w0b = cw[c0 + 2 * j + 1], w1b = cw[512 + c0 + 2 * j + 1], w2b = cw[1024 + c0 + 2 * j + 1];
            o[2 * j] = bflo(bg[j]) * (w0a * bflo(cg0[j]) * bflo(v0[j]) + w1a * bflo(cg1[j]) * bflo(v1[j]) + w2a * bflo(cg2[j]) * bflo(v2[j]));
            o[2 * j + 1] = bfhi(bg[j]) * (w0b * bfhi(cg0[j]) * bfhi(v0[j]) + w1b * bfhi(cg1[j]) * bfhi(v1[j]) + w2b * bfhi(cg2[j]) * bfhi(v2[j]));
        }
        u32x4 w; w.x = pk2(o[0], o[1]); w.y = pk2(o[2], o[3]); w.z = pk2(o[4], o[5]); w.w = pk2(o[6], o[7]);
        *(u32x4*)(Z + (size_t)tok * 1024 + 512 + c0) = w;
    }
}

constexpr int RR_MAXT = 96, RR_KC = 256, RR_PITCH = RR_KC * 2 + 16;
constexpr int RR_A = 0, RR_B = RR_MAXT * RR_PITCH, RR_LG = RR_B + 64 * RR_PITCH;
__device__ __forceinline__ void phase_route(const Ctx& X, const Params& p, int l, int ntok) {
    LAS int* cnt = (LAS int*)(X.lds + MISC_OFF + M_CNT);
    if (X.tid < NEXP1) cnt[X.tid] = 0;
    const bf16_t* XA = (const bf16_t*)(p.ws + WS_XA); const bf16_t* RT = (const bf16_t*)(p.ws + WS_ROUT) + (size_t)l * 256 * 1024;
    int* toke = (int*)(p.ws + WS_TOKE); float* tokw = (float*)(p.ws + WS_TOKW); int* tokp = (int*)(p.ws + WS_TOKP);
    const float rb = p.in[I_RB][l * 64 + X.lane];
    const int tpb = (ntok + X.G - 1) / X.G, t0 = X.blk * tpb, t1 = (t0 + tpb) < ntok ? (t0 + tpb) : ntok, nrow = t1 - t0;
    const int lane = X.lane, grp = lane >> 3, fr = lane & 15, fq = lane >> 4;
    const int nt_ = X.wave & 3, mh = X.wave >> 2;
    f32x4 acc[3];
#pragma unroll
    for (int m = 0; m < 3; ++m) acc[m] = (f32x4){0.f, 0.f, 0.f, 0.f};
    u32x4 va[6], vb[4];
#define RR_LOAD(kc_) do { \
        _Pragma("unroll") for (int q = 0; q < 6; ++q) { const int i = X.tid + 512 * q, r = i >> 5, c = i & 31; const int rr = r < nrow ? r : 0; \
            va[q] = *(const u32x4*)(XA + (size_t)(t0 + rr) * DM + (kc_) + 8 * c); if (r >= nrow) va[q] = (u32x4){0u, 0u, 0u, 0u}; } \
        _Pragma("unroll") for (int q = 0; q < 4; ++q) { const int i = X.tid + 512 * q, r = i >> 5, c = i & 31; vb[q] = *(const u32x4*)(RT + (size_t)r * 1024 + (kc_) + 8 * c); } } while (0)
    RR_LOAD(0);
    for (int kc = 0; kc < 1024; kc += RR_KC) {
        __syncthreads();
#pragma unroll
        for (int q = 0; q < 6; ++q) { const int i = X.tid + 512 * q, r = i >> 5, c = i & 31; *(LAS u32x4*)(X.lds + RR_A + r * RR_PITCH + 16 * c) = va[q]; }
#pragma unroll
        for (int q = 0; q < 4; ++q) { const int i = X.tid + 512 * q, r = i >> 5, c = i & 31; *(LAS u32x4*)(X.lds + RR_B + r * RR_PITCH + 16 * c) = vb[q]; }
        __syncthreads();
        if (kc + RR_KC < 1024) RR_LOAD(kc + RR_KC);
#pragma unroll
        for (int ks = 0; ks < RR_KC / 32; ++ks) {
            const bf16x8 bfr = *(const LAS bf16x8*)(X.lds + RR_B + (16 * nt_ + fr) * RR_PITCH + 64 * ks + 16 * fq);
#pragma unroll
            for (int m = 0; m < 3; ++m) {
                const bf16x8 afr = *(const LAS bf16x8*)(X.lds + RR_A + (16 * (3 * mh + m) + fr) * RR_PITCH + 64 * ks + 16 * fq);
                acc[m] = __builtin_amdgcn_mfma_f32_16x16x32_bf16(afr, bfr, acc[m], 0, 0, 0);
            }
        }
    }
#undef RR_LOAD
    LAS float* LG = (LAS float*)(X.lds + RR_LG);
#pragma unroll
    for (int m = 0; m < 3; ++m)
#pragma unroll
        for (int j = 0; j < 4; ++j) LG[(16 * (3 * mh + m) + 4 * fq + j) * 64 + 16 * nt_ + fr] = acc[m][j];
    __syncthreads();
    for (int tok = t0 + X.wave; tok < t1; tok += 8) {
        const float score = sigmoidf_(LG[(tok - t0) * 64 + lane]);
        const float sel = score + rb;
        int rk = 0;
#pragma unroll
        for (int x = 1; x < 8; ++x) { const float o = __shfl_xor(sel, x); const int ol = lane ^ x; rk += ((o > sel) || (o == sel && ol < lane)) ? 1 : 0; }
        float gs = rk < 2 ? sel : 0.f;
        gs += __shfl_xor(gs, 1); gs += __shfl_xor(gs, 2); gs += __shfl_xor(gs, 4);
        int grk = 0;
#pragma unroll
        for (int x = 1; x < 8; ++x) { const float o = __shfl_xor(gs, 8 * x); const int og = grp ^ x; grk += ((o > gs) || (o == gs && og < grp)) ? 1 : 0; }
        const float msel = grk < 4 ? sel : -__builtin_inff();
        int rank = 0;
#pragma unroll
        for (int j = 0; j < 64; ++j) { const float sj = __builtin_bit_cast(float, __builtin_amdgcn_readlane(__builtin_bit_cast(int, msel), j)); rank += ((sj > msel) || (sj == msel && j < lane)) ? 1 : 0; }
        const bool chosen = rank < 8;
        const float wsum = wave_sum(chosen ? score : 0.f);
        if (chosen) {
            const int lpos = __hip_atomic_fetch_add(cnt + lane, 1, __ATOMIC_RELAXED, __HIP_MEMORY_SCOPE_WORKGROUP);
            toke[(size_t)tok * 8 + rank] = lane; tokw[(size_t)tok * 8 + rank] = score / wsum * 2.5f; tokp[(size_t)tok * 8 + rank] = lpos;
        }
    }
    __syncthreads();
    int* cntblk = (int*)(p.ws + WS_CNTBLK);
    if (X.tid < NEXP1) cntblk[X.blk * NEXP1 + X.tid] = X.tid < NEXP ? cnt[X.tid] : 0;
}

__device__ __forceinline__ void phase_slots(const Ctx& X, const Params& p, int ntok) {
    LAS int* part = (LAS int*)(X.lds + MISC_OFF + M_PART);
    LAS int* ptot = (LAS int*)(X.lds);
    LAS int* pbb = (LAS int*)(X.lds + 4096);
    LAS int* base = (LAS int*)(X.lds + MISC_OFF + M_BASE);
    LAS int* bbase = (LAS int*)(X.lds + MISC_OFF + M_BBASE);
    LAS int* tot = (LAS int*)(X.lds + 8192);
    LAS int* ntl = (LAS int*)(X.lds + MISC_OFF + M_NT);
    (void)part;
    const int* cntblk = (const int*)(p.ws + WS_CNTBLK);
    {
        const int e = X.tid & 127, pt = X.tid >> 7; int s = 0, sb = 0;
        if (e < NEXP) { const int b0 = (X.G * pt) / 4, b1 = (X.G * (pt + 1)) / 4;
            for (int b = b0; b < b1; ++b) { const int c = cntblk[b * NEXP1 + e]; s += c; sb += (b < X.blk) ? c : 0; } }
        ptot[pt * 128 + e] = s; pbb[pt * 128 + e] = sb;
    }
    __syncthreads();
    if (X.tid < NEXP) { tot[X.tid] = ptot[X.tid] + ptot[128 + X.tid] + ptot[256 + X.tid] + ptot[384 + X.tid]; bbase[X.tid] = pbb[X.tid] + pbb[128 + X.tid] + pbb[256 + X.tid] + pbb[384 + X.tid]; }
    __syncthreads();
    if (X.tid == 0) { int acc = 0; for (int e = 0; e < NEXP; ++e) { base[e] = acc; acc += (tot[e] + 255) & ~255; } base[NEXP] = acc; base[NEXP1] = acc + ntok; ntl[0] = (acc + ntok) >> 8; }
    __syncthreads();
    int* rowidx = (int*)(p.ws + WS_ROWIDX); int* tokslot = (int*)(p.ws + WS_YROW);
    const int* toke = (const int*)(p.ws + WS_TOKE); const int* tokp = (const int*)(p.ws + WS_TOKP);
    const int tpb = (ntok + X.G - 1) / X.G, t0 = X.blk * tpb, t1 = (t0 + tpb) < ntok ? (t0 + tpb) : ntok;
    for (int i = t0 * 8 + X.tid; i < t1 * 8; i += 512) {
        const int e = toke[i]; const int slot = base[e] + bbase[e] + tokp[i];
        rowidx[slot] = i >> 3; tokslot[(i >> 3) * 9 + (i & 7)] = slot;
    }
    const int sbase = base[NEXP];
    for (int tok = X.blk * 512 + X.tid; tok < ntok; tok += X.G * 512) { rowidx[sbase + tok] = tok; tokslot[tok * 9 + 8] = sbase + tok; }
    for (int e = X.blk; e < NEXP; e += X.G)
        for (int s = base[e] + tot[e] + X.tid; s < base[e + 1]; s += 512) rowidx[s] = 0;
    if (X.blk == 0) {
        int* TAB = (int*)(p.ws + WS_TAB);
        if (X.tid == 0) TAB[128] = ntl[0];
        for (int t = X.tid; t < ntl[0]; t += 512) { int e = NEXP; const int s = t * 256; for (int k = 0; k < NEXP; ++k) if (s >= base[k] && s < base[k + 1]) e = k; TAB[256 + t] = e; }
    }
}
__device__ __forceinline__ int load_tiles(const Ctx& X, const Params& p) {
    const int* TAB = (const int*)(p.ws + WS_TAB);
    LAS unsigned char* te = X.lds + MISC_OFF + M_TILE;
    const int nt = TAB[128];
    for (int t = X.tid; t < nt; t += 512) te[t] = (unsigned char)TAB[256 + t];
    __syncthreads();
    return __builtin_amdgcn_readfirstlane(nt);
}

template <bool NEXTNORM>
__device__ __forceinline__ void phase_combine(const Ctx& X, const Params& p, int l, int ntok, bool final_out, float rs) {
    const unsigned char* Y = (const unsigned char*)(p.ws + WS_Y); bf16_t* XR = (bf16_t*)(p.ws + WS_XR);
    const int* tokslot = (const int*)(p.ws + WS_YROW); const float* tokw = (const float*)(p.ws + WS_TOKW);
    const float* gate = (const float*)(p.ws + WS_MOD) + (size_t)l * 9 * 6144 + 5 * 1024;
    const float* gain = p.in[I_NMG] + (l + 1) * 1024; const float* modn = (const float*)(p.ws + WS_MOD) + (size_t)(l + 1) * 9 * 6144;
    bf16_t* XN = (bf16_t*)(p.ws + WS_ACT);
    for (int tok = X.gw; tok < ntok; tok += X.NGW) {
        const int b = tok < NLAT ? (tok >> 11) : 8, c = 16 * X.lane;
        float s[16];
#pragma unroll
        for (int q = 0; q < 16; ++q) s[q] = 0.f;
#pragma unroll
        for (int j = 0; j < 9; ++j) {
            const int slot = __builtin_amdgcn_readfirstlane(tokslot[tok * 9 + j]);
            const float w = j < 8 ? __builtin_bit_cast(float, __builtin_amdgcn_readfirstlane(__builtin_bit_cast(int, tokw[tok * 8 + (j & 7)]))) : 1.f;
            const u32x4 y = *(const u32x4*)(Y + ((size_t)slot * 1024 + c));
#pragma unroll
            for (int q = 0; q < 4; ++q) {
                const f32x2 lo = __builtin_amdgcn_cvt_pk_f32_fp8((int)y[q], false), hi = __builtin_amdgcn_cvt_pk_f32_fp8((int)y[q], true);
                s[4 * q] += w * lo.x; s[4 * q + 1] += w * lo.y; s[4 * q + 2] += w * hi.x; s[4 * q + 3] += w * hi.y;
            }
        }
        const float* gp = gate + b * 6144 + c; bf16_t* xp = XR + (size_t)tok * DM + c;
        const float sc = rs * (1.f / 16.f);
        const u32x4 xa = *(const u32x4*)xp, xc = *(const u32x4*)(xp + 8);
        f32x4 o[4]; float ss = 0.f;
        o[0] = (f32x4){bflo(xa.x), bfhi(xa.x), bflo(xa.y), bfhi(xa.y)}; o[1] = (f32x4){bflo(xa.z), bfhi(xa.z), bflo(xa.w), bfhi(xa.w)};
        o[2] = (f32x4){bflo(xc.x), bfhi(xc.x), bflo(xc.y), bfhi(xc.y)}; o[3] = (f32x4){bflo(xc.z), bfhi(xc.z), bflo(xc.w), bfhi(xc.w)};
#pragma unroll
        for (int q = 0; q < 4; ++q) {
            const f32x4 g = *(const f32x4*)(gp + 4 * q) * sc;
            o[q] = o[q] + g * (f32x4){s[4 * q], s[4 * q + 1], s[4 * q + 2], s[4 * q + 3]};
            if (final_out) *(f32x4*)(p.out + (size_t)tok * DM + c + 4 * q) = o[q];
            ss += (o[q][0] * o[q][0] + o[q][1] * o[q][1]) + (o[q][2] * o[q][2] + o[q][3] * o[q][3]);
        }
        if (!final_out) { *(u32x4*)xp = pack8(o[0], o[1]); *(u32x4*)(xp + 8) = pack8(o[2], o[3]); }
        if (NEXTNORM) {
            const float rstd = rsqrtf(wave_sum(ss) * (1.f / 1024.f) + 1e-6f);
            u32x4 w0, w1;
#pragma unroll
            for (int q = 0; q < 4; ++q) {
                const f32x4 g4 = *(const f32x4*)(gain + c + 4 * q), sc4 = *(const f32x4*)(modn + b * 6144 + 1024 + c + 4 * q), sh4 = *(const f32x4*)(modn + b * 6144 + c + 4 * q);
                const f32x4 v = o[q] * rstd * (g4 * (sc4 + 1.f)) + sh4;
                if (q < 2) { w0[2 * q] = pk2(v[0], v[1]); w0[2 * q + 1] = pk2(v[2], v[3]); } else { w1[2 * (q - 2)] = pk2(v[0], v[1]); w1[2 * (q - 2) + 1] = pk2(v[2], v[3]); }
            }
            *(u32x4*)(XN + (size_t)tok * DM + c) = w0; *(u32x4*)(XN + (size_t)tok * DM + c + 8) = w1;
        }
    }
}

constexpr int AT_KB = 8192, AT_VB = 64 * 136, AT_K0 = 0, AT_V0 = 4 * AT_KB, AT_BIAS = 4 * AT_KB + 4 * AT_VB + 256, AT_BPAD = 48;
#define ATT_TILE(kb_, vb_, t0_, LAT_, brow4_, rpen_) do { \
    f32x16 sa; \
    _Pragma("unroll") for (int i = 0; i < 16; ++i) sa[i] = 0.f; \
    _Pragma("unroll") for (int s = 0; s < 4; ++s) { \
        const bf16x8 kf = *(const LAS bf16x8*)((kb_) + ((t0_) + l31) * 128 + (((2 * s + hh) ^ (l31 & 7)) << 4)); \
        sa = __builtin_amdgcn_mfma_f32_32x32x16_bf16(kf, qf[s], sa, 0, 0, 0); } \
    float tmax = -1e30f; \
    if (LAT_) { \
        const LAS float* bp = (const LAS float*)((const LAS unsigned char*)biasL + (brow4_)); \
        _Pragma("unroll") for (int i = 0; i < 16; ++i) { sa[i] = (sa[i] + bp[(i & 3) + 8 * (i >> 2)]) + (pen[i] + (rpen_)); tmax = fmaxf(tmax, sa[i]); } \
    } else { \
        _Pragma("unroll") for (int i = 0; i < 16; ++i) tmax = fmaxf(tmax, sa[i]); \
    } \
    tmax = fmaxf(tmax, __shfl_xor(tmax, 32)); \
    if (__any(tmax > mrun)) { \
        const float mnew = fmaxf(mrun, tmax), alpha = __builtin_amdgcn_exp2f(mrun - mnew); \
        lrun *= alpha; mrun = mnew; \
        _Pragma("unroll") for (int i = 0; i < 16; ++i) { o0[i] *= alpha; o1[i] *= alpha; } } \
    float psum = 0.f; \
    _Pragma("unroll") for (int i = 0; i < 16; ++i) { sa[i] = __builtin_amdgcn_exp2f(sa[i] - mrun); psum += sa[i]; } \
    lrun += psum; \
    bf16x8 pf0, pf1; \
    { u32x4 w0, w1; \
      _Pragma("unroll") for (int j = 0; j < 4; ++j) { w0[j] = pk2(sa[2 * j], sa[2 * j + 1]); w1[j] = pk2(sa[8 + 2 * j], sa[8 + 2 * j + 1]); } \
      pf0 = __builtin_bit_cast(bf16x8, w0); pf1 = __builtin_bit_cast(bf16x8, w1); } \
    const LAS unsigned char* v0p = (vb_) + l31 * 136 + 2 * (t0_) + 8 * hh; const LAS unsigned char* v1p = v0p + 32 * 136; \
    const s16x4 a0 = *(const LAS s16x4*)(v0p), a1 = *(const LAS s16x4*)(v0p + 16), a2 = *(const LAS s16x4*)(v0p + 32), a3 = *(const LAS s16x4*)(v0p + 48); \
    const s16x4 c0 = *(const LAS s16x4*)(v1p), c1 = *(const LAS s16x4*)(v1p + 16), c2 = *(const LAS s16x4*)(v1p + 32), c3 = *(const LAS s16x4*)(v1p + 48); \
    const bf16x8 va0 = __builtin_shufflevector(a0, a1, 0, 1, 2, 3, 4, 5, 6, 7), va1 = __builtin_shufflevector(a2, a3, 0, 1, 2, 3, 4, 5, 6, 7); \
    const bf16x8 vb0 = __builtin_shufflevector(c0, c1, 0, 1, 2, 3, 4, 5, 6, 7), vb1 = __builtin_shufflevector(c2, c3, 0, 1, 2, 3, 4, 5, 6, 7); \
    o0 = __builtin_amdgcn_mfma_f32_32x32x16_bf16(va0, pf0, o0, 0, 0, 0); o0 = __builtin_amdgcn_mfma_f32_32x32x16_bf16(va1, pf1, o0, 0, 0, 0); \
    o1 = __builtin_amdgcn_mfma_f32_32x32x16_bf16(vb0, pf0, o1, 0, 0, 0); o1 = __builtin_amdgcn_mfma_f32_32x32x16_bf16(vb1, pf1, o1, 0, 0, 0); \
    } while (0)
#define ATT_TILE2(kbA_, vbA_, t0A_, kbB_, vbB_, t0B_, LAT_, brow4A_, rpenA_, brow4B_, rpenB_) do { \
    f32x16 sa0, sa1; \
    _Pragma("unroll") for (int i = 0; i < 16; ++i) { sa0[i] = 0.f; sa1[i] = 0.f; } \
    _Pragma("unroll") for (int s = 0; s < 4; ++s) { \
        const bf16x8 kf0 = *(const LAS bf16x8*)((kbA_) + ((t0A_) + l31) * 128 + (((2 * s + hh) ^ (l31 & 7)) << 4)); \
        const bf16x8 kf1 = *(const LAS bf16x8*)((kbB_) + ((t0B_) + l31) * 128 + (((2 * s + hh) ^ (l31 & 7)) << 4)); \
        sa0 = __builtin_amdgcn_mfma_f32_32x32x16_bf16(kf0, qf[s], sa0, 0, 0, 0); \
        sa1 = __builtin_amdgcn_mfma_f32_32x32x16_bf16(kf1, qf[s], sa1, 0, 0, 0); } \
    float tmax = -1e30f; \
    if (LAT_) { \
        const LAS float* bpA = (const LAS float*)((const LAS unsigned char*)biasL + (brow4A_)); const LAS float* bpB = (const LAS float*)((const LAS unsigned char*)biasL + (brow4B_)); \
        _Pragma("unroll") for (int i = 0; i < 16; ++i) { \
            sa0[i] = (sa0[i] + bpA[(i & 3) + 8 * (i >> 2)]) + (pen[i] + (rpenA_)); sa1[i] = (sa1[i] + bpB[(i & 3) + 8 * (i >> 2)]) + (pen[i] + (rpenB_)); \
            tmax = fmaxf(tmax, fmaxf(sa0[i], sa1[i])); } \
    } else { \
        _Pragma("unroll") for (int i = 0; i < 16; ++i) tmax = fmaxf(tmax, fmaxf(sa0[i], sa1[i])); \
    } \
    tmax = fmaxf(tmax, __shfl_xor(tmax, 32)); \
    if (__any(tmax > mrun)) { \
        const float mnew = fmaxf(mrun, tmax), alpha = __builtin_amdgcn_exp2f(mrun - mnew); \
        lrun *= alpha; mrun = mnew; \
        _Pragma("unroll") for (int i = 0; i < 16; ++i) { o0[i] *= alpha; o1[i] *= alpha; } } \
    float psumA = 0.f, psumB = 0.f; \
    _Pragma("unroll") for (int i = 0; i < 16; ++i) { sa0[i] = __builtin_amdgcn_exp2f(sa0[i] - mrun); sa1[i] = __builtin_amdgcn_exp2f(sa1[i] - mrun); psumA += sa0[i]; psumB += sa1[i]; } \
    lrun += psumA + psumB; \
    bf16x8 pf0, pf1, pf2, pf3; \
    { u32x4 w0, w1, w2, w3; \
      _Pragma("unroll") for (int j = 0; j < 4; ++j) { w0[j] = pk2(sa0[2 * j], sa0[2 * j + 1]); w1[j] = pk2(sa0[8 + 2 * j], sa0[8 + 2 * j + 1]); \
                                                      w2[j] = pk2(sa1[2 * j], sa1[2 * j + 1]); w3[j] = pk2(sa1[8 + 2 * j], sa1[8 + 2 * j + 1]); } \
      pf0 = __builtin_bit_cast(bf16x8, w0); pf1 = __builtin_bit_cast(bf16x8, w1); pf2 = __builtin_bit_cast(bf16x8, w2); pf3 = __builtin_bit_cast(bf16x8, w3); } \
    { const LAS unsigned char* v0p = (vbA_) + l31 * 136 + 2 * (t0A_) + 8 * hh; const LAS unsigned char* v1p = v0p + 32 * 136; \
      const s16x4 a0 = *(const LAS s16x4*)(v0p), a1 = *(const LAS s16x4*)(v0p + 16), a2 = *(const LAS s16x4*)(v0p + 32), a3 = *(const LAS s16x4*)(v0p + 48); \
      const s16x4 c0 = *(const LAS s16x4*)(v1p), c1 = *(const LAS s16x4*)(v1p + 16), c2 = *(const LAS s16x4*)(v1p + 32), c3 = *(const LAS s16x4*)(v1p + 48); \
      const bf16x8 va0 = __builtin_shufflevector(a0, a1, 0, 1, 2, 3, 4, 5, 6, 7), va1 = __builtin_shufflevector(a2, a3, 0, 1, 2, 3, 4, 5, 6, 7); \
      const bf16x8 vb0 = __builtin_shufflevector(c0, c1, 0, 1, 2, 3, 4, 5, 6, 7), vb1 = __builtin_shufflevector(c2, c3, 0, 1, 2, 3, 4, 5, 6, 7); \
      o0 = __builtin_amdgcn_mfma_f32_32x32x16_bf16(va0, pf0, o0, 0, 0, 0); o1 = __builtin_amdgcn_mfma_f32_32x32x16_bf16(vb0, pf0, o1, 0, 0, 0); \
      o0 = __builtin_amdgcn_mfma_f32_32x32x16_bf16(va1, pf1, o0, 0, 0, 0); o1 = __builtin_amdgcn_mfma_f32_32x32x16_bf16(vb1, pf1, o1, 0, 0, 0); } \
    { const LAS unsigned char* v0p = (vbB_) + l31 * 136 + 2 * (t0B_) + 8 * hh; const LAS unsigned char* v1p = v0p + 32 * 136; \
      const s16x4 a0 = *(const LAS s16x4*)(v0p), a1 = *(const LAS s16x4*)(v0p + 16), a2 = *(const LAS s16x4*)(v0p + 32), a3 = *(const LAS s16x4*)(v0p + 48); \
      const s16x4 c0 = *(const LAS s16x4*)(v1p), c1 = *(const LAS s16x4*)(v1p + 16), c2 = *(const LAS s16x4*)(v1p + 32), c3 = *(const LAS s16x4*)(v1p + 48); \
      const bf16x8 va0 = __builtin_shufflevector(a0, a1, 0, 1, 2, 3, 4, 5, 6, 7), va1 = __builtin_shufflevector(a2, a3, 0, 1, 2, 3, 4, 5, 6, 7); \
      const bf16x8 vb0 = __builtin_shufflevector(c0, c1, 0, 1, 2, 3, 4, 5, 6, 7), vb1 = __builtin_shufflevector(c2, c3, 0, 1, 2, 3, 4, 5, 6, 7); \
      o0 = __builtin_amdgcn_mfma_f32_32x32x16_bf16(va0, pf2, o0, 0, 0, 0); o1 = __builtin_amdgcn_mfma_f32_32x32x16_bf16(vb0, pf2, o1, 0, 0, 0); \
      o0 = __builtin_amdgcn_mfma_f32_32x32x16_bf16(va1, pf3, o0, 0, 0, 0); o1 = __builtin_amdgcn_mfma_f32_32x32x16_bf16(vb1, pf3, o1, 0, 0, 0); } \
    } while (0)
__device__ __forceinline__ void phase_attn(const Ctx& X, const Params& p) {
    const bf16_t* Q = (const bf16_t*)(p.ws + WS_Q); const bf16_t* Kb = (const bf16_t*)(p.ws + WS_K); const bf16_t* VT = (const bf16_t*)(p.ws + WS_VT);
    bf16_t* O = (bf16_t*)(p.ws + WS_O);
    LAS float* biasL = (LAS float*)(X.lds + AT_BIAS);
    const int lane = X.lane, l31 = lane & 31, hh = lane >> 5, tid = X.tid;
    const float LOG2E = 1.4426950408889634f;
    const int skey = tid >> 3, sch = tid & 7;
    for (int task = X.blk; task < 256; task += X.G) {
        const int b = task >> 5, h = (task >> 1) & 15, hf = task & 1;
        __syncthreads();
        for (int i = tid; i < 465 + 2 * AT_BPAD + 64; i += 512) { const int j = i - AT_BPAD; biasL[i] = (j >= 0 && j < 465) ? p.in[I_RPB][h * 465 + j] * LOG2E : 0.f; }
        const bf16_t* vcol = VT + (size_t)skey * DM + h * 64 + 8 * sch;
        const bf16_t* kcol = Kb + (size_t)skey * DM + h * 64 + 8 * sch;
        for (int gq = 0; gq < 4; ++gq) {
            const int R0 = 16 * hf + 4 * gq;
            const int rp = X.wave >> 2, cb = X.wave & 3, r = R0 + 2 * rp, c0 = 16 * cb;
            const int t0 = cb == 0 ? 0 : (cb == 1 ? 8 : (cb == 2 ? 24 : 32));
            const int rq = r + (l31 >> 4), qc = c0 + (l31 & 15);
            const int r0q = rq < 4 ? 0 : (rq > 28 ? 24 : rq - 4);
            const int r0lo = r < 4 ? 0 : (r > 28 ? 24 : r - 4), r0hi = (r + 1 < 4 ? 0 : (r + 1 > 28 ? 24 : r + 1 - 4)) + 7;
            const int rmin = R0 < 4 ? 0 : (R0 > 28 ? 24 : R0 - 4);
            const int rl = R0 + 3, rmax = (rl < 4 ? 0 : (rl > 28 ? 24 : rl - 4)) + 7;
            const int nl = rmax - rmin + 1, nsteps = 2 + ((nl + 1) >> 1);
            const size_t qtok = (size_t)b * 2048 + rq * 64 + qc;
            bf16x8 qf[4];
#pragma unroll
            for (int s = 0; s < 4; ++s) qf[s] = *(const bf16x8*)(Q + qtok * DM + h * 64 + 16 * s + 8 * hh);
            const int cs = qc < 8 ? 0 : (qc > 56 ? 48 : qc - 8);
            float pen[16];
#pragma unroll
            for (int i = 0; i < 16; ++i) { const int kc = t0 + (i & 3) + 8 * (i >> 2) + 4 * hh; pen[i] = (kc >= cs && kc < cs + 16) ? 0.f : -1e30f; }
            const int lb4 = 4 * ((7 - (l31 >> 4)) * 31 + t0 - qc + 15 + 4 * hh + AT_BPAD);
            f32x16 o0, o1;
#pragma unroll
            for (int i = 0; i < 16; ++i) { o0[i] = 0.f; o1[i] = 0.f; }
            float mrun = -1e30f, lrun = 0.f;
            u32x4 kA0, kA1, vA0, vA1, kB0, kB1, vB0, vB1;
#define ATT_ISSUE(st_, k0_, k1_, v0r_, v1r_) do { int s_ = (st_); s_ = s_ < nsteps ? s_ : nsteps - 1; \
                size_t kt0_, kt1_; \
                if (s_ < 2) { kt0_ = (size_t)NLAT + b * 256 + s_ * 128; kt1_ = kt0_ + 64; } \
                else { const int ra_ = rmin + 2 * (s_ - 2), rb_ = ra_ + 1 <= rmax ? ra_ + 1 : rmax; kt0_ = (size_t)b * 2048 + ra_ * 64; kt1_ = (size_t)b * 2048 + rb_ * 64; } \
                k0_ = *(const u32x4*)(kcol + kt0_ * DM); k1_ = *(const u32x4*)(kcol + kt1_ * DM); v0r_ = *(const u32x4*)(vcol + kt0_ * DM); v1r_ = *(const u32x4*)(vcol + kt1_ * DM); } while (0)
#define ATT_WRITE(nb_, k0_, k1_, v0r_, v1r_) do { \
                LAS unsigned char* kw_ = X.lds + AT_K0 + (nb_) * 2 * AT_KB + skey * 128 + ((sch ^ (skey & 7)) << 4); \
                *(LAS u32x4*)(kw_) = k0_; *(LAS u32x4*)(kw_ + AT_KB) = k1_; \
                LAS unsigned short* vw_ = (LAS unsigned short*)(X.lds + AT_V0 + (nb_) * 2 * AT_VB + (8 * sch) * 136 + skey * 2);        \
                _Pragma("unroll") for (int j_ = 0; j_ < 4; ++j_) { \
                    vw_[(2 * j_) * 68] = (unsigned short)(v0r_[j_] & 0xffffu); vw_[(2 * j_ + 1) * 68] = (unsigned short)(v0r_[j_] >> 16); \
                    vw_[AT_VB / 2 + (2 * j_) * 68] = (unsigned short)(v1r_[j_] & 0xffffu); vw_[AT_VB / 2 + (2 * j_ + 1) * 68] = (unsigned short)(v1r_[j_] >> 16); } } while (0)
#define ATT_STEP(st_, cur_) do { const int st = (st_); \
                const LAS unsigned char* kb = X.lds + AT_K0 + (cur_) * 2 * AT_KB; const LAS unsigned char* vb = X.lds + AT_V0 + (cur_) * 2 * AT_VB; \
                if (st < 2) { ATT_TILE2(kb, vb, 0, kb, vb, 32, false, 0, 0.f, 0, 0.f); ATT_TILE2(kb + AT_KB, vb + AT_VB, 0, kb + AT_KB, vb + AT_VB, 32, false, 0, 0.f, 0, 0.f); } \
                else { const int ka = rmin + 2 * (st - 2), kc2 = ka + 1; \
                    const bool ina = ka >= r0lo && ka <= r0hi, inb = kc2 <= rmax && kc2 >= r0lo && kc2 <= r0hi; \
                    const float rpa = (ka >= r0q && ka < r0q + 8) ? 0.f : -1e30f, rpb = (kc2 >= r0q && kc2 < r0q + 8) ? 0.f : -1e30f; \
                    const int bra = lb4 + 4 * 31 * (ka - r), brb = lb4 + 4 * 31 * (kc2 - r); \
                    if (ina && inb) { ATT_TILE2(kb, vb, t0, kb + AT_KB, vb + AT_VB, t0, true, bra, rpa, brb, rpb); } \
                    else if (ina) { ATT_TILE(kb, vb, t0, true, bra, rpa); } \
                    else if (inb) { ATT_TILE(kb + AT_KB, vb + AT_VB, t0, true, brb, rpb); } } } while (0)
            ATT_ISSUE(0, kA0, kA1, vA0, vA1);
            ATT_ISSUE(1, kB0, kB1, vB0, vB1);
            __syncthreads();
            ATT_WRITE(0, kA0, kA1, vA0, vA1);
            __syncthreads();
            for (int sp = 0; sp < nsteps; sp += 2) {
                ATT_ISSUE(sp + 2, kA0, kA1, vA0, vA1);
                ATT_STEP(sp, 0);
                ATT_WRITE(1, kB0, kB1, vB0, vB1);
                __syncthreads();
                if (sp + 1 < nsteps) {
                    ATT_ISSUE(sp + 3, kB0, kB1, vB0, vB1);
                    ATT_STEP(sp + 1, 1);
                    ATT_WRITE(0, kA0, kA1, vA0, vA1);
                    __syncthreads();
                }
            }
#undef ATT_ISSUE
#undef ATT_WRITE
#undef ATT_STEP
            const float ltot = lrun + __shfl_xor(lrun, 32), inv = 1.f / ltot;
            bf16_t* op = O + qtok * DM + h * 64;
#pragma unroll
            for (int g = 0; g < 4; ++g) {
                u32x2 w; w.x = pk2(o0[4 * g] * inv, o0[4 * g + 1] * inv); w.y = pk2(o0[4 * g + 2] * inv, o0[4 * g + 3] * inv);
                *(u32x2*)(op + 8 * g + 4 * hh) = w;
                u32x2 w2; w2.x = pk2(o1[4 * g] * inv, o1[4 * g + 1] * inv); w2.y = pk2(o1[4 * g + 2] * inv, o1[4 * g + 3] * inv);
                *(u32x2*)(op + 32 + 8 * g + 4 * hh) = w2;
            }
        }
    }
}
#undef ATT_TILE
#undef ATT_TILE2


constexpr int N_PHASES = 23;
constexpr int C0A = 4800, C0B = 6400, C0C = 7600;
constexpr int C1A = 6000, C1B = 7000;
#ifndef PROBE_LO
#define PROBE_LO 99
#define PROBE_HI (-1)
#endif
__host__ __device__ constexpr int nrep(int k) { return (k >= PROBE_LO && k <= PROBE_HI) ? 2 : 1; }
__global__ void __launch_bounds__(512, 2) fwd_kernel(Params p) {
    extern __shared__ __attribute__((aligned(16))) unsigned char lds_raw[];
    LAS unsigned char* lds = (LAS unsigned char*)lds_raw;
    const int wave0 = __builtin_amdgcn_readfirstlane((int)(threadIdx.x >> 6));
    for (int u = threadIdx.x; u < (LDS_BYTES - MISC_OFF) / 4; u += 512) ((LAS unsigned*)(lds + MISC_OFF))[u] = 0u;
    __syncthreads();
    XcdBarrier bar; bar.bar = (unsigned*)(p.ws + WS_CTL) + 4096; bar.x = 0; bar.st = (volatile LAS unsigned*)(lds + MISC_OFF + M_BAR);
    if (p.ph_hi - p.ph_lo > 1) bar = xcd_barrier_post((unsigned*)(p.ws + WS_CTL) + 4096, (volatile LAS unsigned*)(lds + MISC_OFF + M_BAR));
#define PH(k) (p.ph_lo <= (k) && (k) < p.ph_hi)
#define SEAM(k) do { if (PH(k) && PH((k) + 1)) xcd_barrier(bar, wave0); } while (0)
#define RUN(k, ...) do { if (PH(k)) { _Pragma("unroll") for (int rep_ = 0; rep_ < nrep(k); ++rep_) { const float rs_ = rep_ == 0 ? 1.f : 0.f; (void)rs_; { __VA_ARGS__ } if (rep_ + 1 < nrep(k)) xcd_barrier(bar, wave0); } } SEAM(k); } while (0)
    unsigned char* ws = p.ws;
    const float* MOD = (const float*)(ws + WS_MOD);

    RUN(0, const Ctx X = mkctx(lds, wave0); phase_p0a(X, p););
    RUN(1, const Ctx X = mkctx(lds, wave0); phase_norm<0>(X, p, 0, 0, NTOK); phase_p0b(X, p););
    RUN(2,
        g8::RectSched S{72, 8, (int)gridDim.x, (int)blockIdx.x, 0u, 2048u, (const char*)(ws + WS_WIN), 2048u};
        EpiWin E{(bf16_t*)(ws + WS_A2), (bf16_t*)(ws + WS_BCV)};
        g8::gemm_phase(lds, wave0, (const char*)(ws + WS_XA), 1024, 2048u, S, E);
        { const Ctx X = mkctx(lds, wave0); int nidle; const int rk = idle_rank(576, X.G, X.blk, nidle);
          if (rk >= 0) { conv_small(X, p, rk, nidle); conv_moe_items<0>(X, p, 0, (bf16_t*)(ws + WS_GU), (bf16_t*)(ws + WS_DN), 0, C0A, rk, nidle); } });
    RUN(3,
        g8::BatchSched S{32, 3, 1, (int)gridDim.x, (int)blockIdx.x, 1536u, (const char*)(ws + WS_WF), 1024u, 256};
        EpiS5F E{(float*)(ws + WS_F)};
        g8::gemm_phase(lds, wave0, (const char*)(ws + WS_A2), 512, 1024u, S, E);
        { const Ctx X = mkctx(lds, wave0); int nidle; const int rk = moe_idle_rank(96, 1, X.G, X.blk, nidle);
          if (rk >= 0) conv_moe_items<0>(X, p, 0, (bf16_t*)(ws + WS_GU), (bf16_t*)(ws + WS_DN), C0A, C0B, rk, nidle); });
    RUN(4, const Ctx X = mkctx(lds, wave0); phase_scan_conv(X, p););
    RUN(5,
        g8::BatchSched S{32, 3, 2, (int)gridDim.x, (int)blockIdx.x, 1536u, (const char*)(ws + WS_ME), 1536u, 512};
        EpiS5Y E{(bf16_t*)(ws + WS_G)};
        g8::gemm_phase(lds, wave0, (const char*)(ws + WS_A2), 768, 1536u, S, E););
    RUN(6,
        g8::RectSched S{72, 2, (int)gridDim.x, (int)blockIdx.x, 0u, 1024u, (const char*)(ws + WS_GLU), 1024u};
        EpiGlu E{(const bf16_t*)(ws + WS_G), p.in[I_GLUB], (bf16_t*)(ws + WS_Z)};
        g8::gemm_phase(lds, wave0, (const char*)(ws + WS_G), 512, 1024u, S, E);
        { const Ctx X = mkctx(lds, wave0); int nidle; const int rk = idle_rank(144, X.G, X.blk, nidle);
          if (rk >= 0) conv_moe_items<0>(X, p, 0, (bf16_t*)(ws + WS_GU), (bf16_t*)(ws + WS_DN), C0B, C0C, rk, nidle); });
    RUN(7,
        g8::RectSched S{72, 4, (int)gridDim.x, (int)blockIdx.x, 0u, 2048u, (const char*)(ws + WS_HOUT), 2048u};
        EpiResid<true> E{p.in[I_X], p.in[I_CTX], MOD + 2 * 1024, (bf16_t*)(ws + WS_XR), 1.f};
        g8::gemm_phase(lds, wave0, (const char*)(ws + WS_Z), 1024, 2048u, S, E);
        { const Ctx X = mkctx(lds, wave0); int nidle; const int rk = idle_rank(288, X.G, X.blk, nidle);
          if (rk >= 0) conv_moe_items<0>(X, p, 0, (bf16_t*)(ws + WS_GU), (bf16_t*)(ws + WS_DN), C0C, 12480, rk, nidle); });
#define MOE_PHASES(P0, L, NTOKL, FINAL) \
    RUN(P0, const Ctx X = mkctx(lds, wave0); phase_norm<1>(X, p, L, 1, NTOKL);); \
    RUN(P0 + 1, const Ctx X = mkctx(lds, wave0); phase_route(X, p, L, NTOKL);); \
    RUN(P0 + 2, const Ctx X = mkctx(lds, wave0); phase_slots(X, p, NTOKL);); \
    RUN(P0 + 3, \
        const Ctx X = mkctx(lds, wave0); const int ntiles = load_tiles(X, p); \
        g8::MoeSched<true> S{ntiles, 2, (int)gridDim.x, (int)blockIdx.x, 2048u, (const char*)(ws + (L == 0 ? WS_GU : WS_GU1)), 2048u, 512, 0, 128, lds + MISC_OFF + M_TILE, (const int*)(ws + WS_ROWIDX)}; \
        EpiGU E{(bf16_t*)(ws + WS_ACT)}; \
        g8::gemm_phase(lds, wave0, (const char*)(ws + WS_XA), 1024, 2048u, S, E); \
        { const Ctx X2 = mkctx(lds, wave0); int nidle; const int rk = moe_idle_rank(ntiles, 2, X2.G, X2.blk, nidle);        \
          if (rk >= 0 && L == 0) conv_moe_items<1>(X2, p, 1, (bf16_t*)(ws + WS_GU1), nullptr, 0, C1A, rk, nidle); }); \
    RUN(P0 + 4, \
        const Ctx X = mkctx(lds, wave0); const int ntiles = load_tiles(X, p); \
        g8::MoeSched<false> S{ntiles, 4, (int)gridDim.x, (int)blockIdx.x, 512u, (const char*)(ws + WS_DN), 512u, 1024, 0, 256, lds + MISC_OFF + M_TILE, nullptr}; \
        EpiDN E{(unsigned char*)(ws + WS_Y)}; \
        g8::gemm_phase(lds, wave0, (const char*)(ws + WS_ACT), 256, 512u, S, E); \
        { const Ctx X2 = mkctx(lds, wave0); int nidle; const int rk = moe_idle_rank(ntiles, 4, X2.G, X2.blk, nidle); \
          if (rk >= 0 && L == 0) conv_moe_items<1>(X2, p, 1, (bf16_t*)(ws + WS_GU1), nullptr, C1A, C1B, rk, nidle); }); \
    RUN(P0 + 5, const Ctx X = mkctx(lds, wave0); phase_combine<!FINAL>(X, p, L, NTOKL, FINAL, 1.f););

    MOE_PHASES(8, 0, NTOK, false)
    RUN(14,
        g8::QkvSched S{(int)gridDim.x, (int)blockIdx.x, 2048u, (const char*)(ws + WS_QKV), 2048u};
        EpiQKV E{(bf16_t*)(ws + WS_Q), (bf16_t*)(ws + WS_K), (bf16_t*)(ws + WS_VT), p.in[I_QG], p.in[I_KG]};
        g8::gemm_phase(lds, wave0, (const char*)(ws + WS_ACT), 1024, 2048u, S, E);
        { const Ctx X = mkctx(lds, wave0); int nidle; const int rk = idle_rank(832, X.G, X.blk, nidle);
          if (rk >= 0) { conv_moe_items<1>(X, p, 1, (bf16_t*)(ws + WS_GU1), nullptr, C1B, 8320, rk, nidle);
                         conv_moe_items<2>(X, p, 1, nullptr, (bf16_t*)(ws + WS_DN), 0, 4160, rk, nidle); } });
    RUN(15, const Ctx X = mkctx(lds, wave0); phase_attn(X, p););
    RUN(16,
        g8::RectSched S{64, 4, (int)gridDim.x, (int)blockIdx.x, 0u, 2048u, (const char*)(ws + WS_NOUT), 2048u};
        EpiResid<false> E{nullptr, nullptr, MOD + 9 * 6144 + 2 * 1024, (bf16_t*)(ws + WS_XR), rs_};
        g8::gemm_phase(lds, wave0, (const char*)(ws + WS_O), 1024, 2048u, S, E););
    MOE_PHASES(17, 1, NLAT, true)
#undef PH
#undef SEAM
#undef RUN
}

extern "C" void kernel_launch(void* const* d_in, const int* in_sizes, int n_in, void* d_out, int out_size, void* d_ws, size_t ws_size, hipStream_t stream) {
    static int grid = 0;
    if (grid == 0) {
        int dev = 0, cus = 0, per_cu = 0;
        if (n_in != 34 || ws_size < WS_END) { fprintf(stderr, "kernel_launch: unexpected inputs (n_in %d, ws %zu, need %zu)\n", n_in, ws_size, (size_t)WS_END); grid = -1; return; }
        if (hipGetDevice(&dev) != hipSuccess || hipDeviceGetAttribute(&cus, hipDeviceAttributeMultiprocessorCount, dev) != hipSuccess) { grid = -1; return; }
        if (hipFuncSetAttribute((const void*)fwd_kernel, hipFuncAttributeMaxDynamicSharedMemorySize, LDS_BYTES) != hipSuccess) { fprintf(stderr, "kernel_launch: hipFuncSetAttribute failed\n"); grid = -1; return; }
        if (hipOccupancyMaxActiveBlocksPerMultiprocessor(&per_cu, (const void*)fwd_kernel, 512, LDS_BYTES) != hipSuccess || per_cu < 1) { fprintf(stderr, "kernel_launch: occupancy query says %d\n", per_cu); }
        (void)hipGetLastError();
        grid = cus;
    }
    if (grid < 0) return;
    (void)hipMemsetAsync((char*)d_ws + WS_CTL, 0, 64 * 1024, stream);
    Params p{};
    for (int i = 0; i < 34; ++i) p.in[i] = (const float*)d_in[i];
    p.out = (float*)d_out; p.ws = (unsigned char*)d_ws;
#if MK_ONE_LAUNCH
    p.ph_lo = 0; p.ph_hi = N_PHASES;
    hipLaunchKernelGGL(fwd_kernel, dim3(grid), dim3(512), LDS_BYTES, stream, p);
#else
    for (int k = 0; k < N_PHASES; ++k) { p.ph_lo = k; p.ph_hi = k + 1; hipLaunchKernelGGL(fwd_kernel, dim3(grid), dim3(512), LDS_BYTES, stream, p); }
#endif
}
```

```cpp
#include <hip/hip_runtime.h>
#include <stdint.h>
#include <stdio.h>

#ifndef MK_ONE_LAUNCH
#define MK_ONE_LAUNCH 1
#endif

#define GAS __attribute__((address_space(1)))
#define LAS __attribute__((address_space(3)))
typedef unsigned short bf16_t;
typedef short bf16x8 __attribute__((ext_vector_type(8)));
typedef short s16x4 __attribute__((ext_vector_type(4)));
typedef float f32x4 __attribute__((ext_vector_type(4)));
typedef float f32x2 __attribute__((ext_vector_type(2)));
typedef float f32x16 __attribute__((ext_vector_type(16)));
typedef unsigned u32x4 __attribute__((ext_vector_type(4)));
typedef unsigned u32x2 __attribute__((ext_vector_type(2)));

constexpr int NLAT = 16384, NCTX = 2048, NTOK = NLAT + NCTX, DM = 1024;
constexpr int SEQ = 2048, CTXL = 256, NB = 8;
constexpr int NEXP = 64, NEXP1 = 65, EDIM = 256;
constexpr int S5T = 32;
constexpr int S5R = 576, S5RP = 768;
constexpr int S5K = 768;
constexpr int MAXTILES = 712;

constexpr size_t MiB = 1ull << 20;
constexpr size_t WS_CTL = 0;
constexpr size_t WS_MOD = 1 * MiB;
constexpr size_t WS_WIN = 2 * MiB;
constexpr size_t WS_GLU = 6 * MiB;
constexpr size_t WS_HOUT = 7 * MiB;
constexpr size_t WS_QKV = 9 * MiB;
constexpr size_t WS_NOUT = 15 * MiB;
constexpr size_t WS_ROUT = 17 * MiB;
constexpr size_t WS_GU = 18 * MiB;
constexpr size_t WS_DN = 83 * MiB;
constexpr size_t WS_GU1 = 116 * MiB;
constexpr size_t WS_XR = 181 * MiB;
constexpr size_t WS_LOGIT = 253 * MiB;
constexpr size_t WS_TOKE = 258 * MiB;
constexpr size_t WS_TOKW = 259 * MiB;
constexpr size_t WS_TOKP = 260 * MiB;
constexpr size_t WS_ROWIDX = 261 * MiB;
constexpr size_t WS_YROW = 262 * MiB;
constexpr size_t WS_CNTBLK = 263 * MiB;
constexpr size_t WS_TAB = 263 * MiB + 512 * 1024;
constexpr size_t WS_XA = 264 * MiB;
constexpr size_t WS_OVL = 300 * MiB;
constexpr size_t WS_A2 = WS_OVL;
constexpr size_t WS_BCV = WS_OVL + 36 * MiB;
constexpr size_t WS_F = WS_OVL + 90 * MiB;
constexpr size_t WS_Z = WS_OVL + 114 * MiB;
constexpr size_t WS_G = WS_OVL + 150 * MiB;
constexpr size_t WS_ME = WS_OVL + 168 * MiB;
constexpr size_t WS_WF = WS_OVL + 192 * MiB;
constexpr size_t WS_KK = WS_OVL + 200 * MiB;
constexpr size_t WS_PW = WS_OVL + 202 * MiB;
constexpr size_t WS_BB = WS_OVL + 204 * MiB;
constexpr size_t WS_ADAP = WS_OVL + 205 * MiB;
constexpr size_t WS_Q = WS_OVL;
constexpr size_t WS_K = WS_OVL + 32 * MiB;
constexpr size_t WS_VT = WS_OVL + 68 * MiB;
constexpr size_t WS_O = WS_OVL + 104 * MiB;
constexpr size_t WS_Y = WS_XA;
constexpr size_t WS_ACT = WS_XA + 178 * MiB;
constexpr size_t WS_END = WS_ACT + 89 * MiB;

constexpr int RING_BYTES = 131072;
constexpr int MISC_OFF = RING_BYTES;
constexpr int LDS_BYTES = 147456;
constexpr int M_BAR = 0, M_CNT = 64, M_BASE = 384, M_BBASE = 704, M_TILE = 1024, M_PART = 2048, M_NT = 3200;

__device__ __forceinline__ unsigned f2bf(float f) { unsigned u = __builtin_bit_cast(unsigned, f); return (u + 0x7fffu + ((u >> 16) & 1u)) >> 16; }
typedef __bf16 hbf16x2 __attribute__((ext_vector_type(2)));
__device__ __forceinline__ unsigned pk2(float lo, float hi) { const f32x2 v = {lo, hi}; const hbf16x2 b = __builtin_convertvector(v, hbf16x2); return __builtin_bit_cast(unsigned, b); }
__device__ __forceinline__ float bflo(unsigned w) { return __builtin_bit_cast(float, w << 16); }
__device__ __forceinline__ float bfhi(unsigned w) { return __builtin_bit_cast(float, w & 0xffff0000u); }
__device__ __forceinline__ float bf1(bf16_t b) { return __builtin_bit_cast(float, ((unsigned)b) << 16); }
__device__ __forceinline__ float wave_sum(float v) {
#pragma unroll
    for (int o = 1; o < 64; o <<= 1) v += __shfl_xor(v, o);
    return v;
}
__device__ __forceinline__ float sigmoidf_(float x) { return __builtin_amdgcn_rcpf(1.f + __expf(-x)); }
__device__ __forceinline__ float siluf_(float x) { return x * __builtin_amdgcn_rcpf(1.f + __expf(-x)); }
__device__ __forceinline__ float gelu_tanh(float x) {
    const float q = x * __builtin_fmaf(x * x, 0.044715f, 1.f);
    const float e = __builtin_amdgcn_exp2f(q * (-2.f * 0.7978845608028654f * 1.4426950408889634f));
    return x * __builtin_amdgcn_rcpf(1.f + e);
}

__device__ __forceinline__ int lane_id_opaque() { int l; asm volatile("v_mbcnt_lo_u32_b32 %0, -1, 0\n\tv_mbcnt_hi_u32_b32 %0, -1, %0" : "=v"(l)); return l; }

#define XB_TMO      128
#define XB_XCNT(j)  (256  + 64 * (j))
#define XB_XSUB(j)  (1280 + 64 * (j))
#define XB_XGEN(j)  (2304 + 64 * (j))
#define XB_TOP      3328
#define XB_TOPGEN   3392
#define XCD_BAR_WORDS 3456
#define XB_SPIN_CAP (1u << 18)
__device__ __forceinline__ unsigned xb_ld(unsigned* p)              { return __hip_atomic_load(p, __ATOMIC_RELAXED, __HIP_MEMORY_SCOPE_AGENT); }
__device__ __forceinline__ unsigned xb_add(unsigned* p, unsigned v) { return __hip_atomic_fetch_add(p, v, __ATOMIC_RELAXED, __HIP_MEMORY_SCOPE_AGENT); }
__device__ __forceinline__ unsigned xb_xcc_id() { return (unsigned)__builtin_amdgcn_s_getreg((3 << 11) | 20) & 0xFu; }
#define XB_SPIN(cond, bar) do { unsigned _sp = 0; while (cond) { __builtin_amdgcn_s_sleep(1); \
    if ((++_sp & 255u) == 0u) { if (xb_ld(&(bar)[XB_TMO])) break; if (_sp > XB_SPIN_CAP) { atomicAdd(&(bar)[XB_TMO], 1u); break; } } } } while (0)
struct XcdBarrier { unsigned* bar; unsigned x; volatile LAS unsigned* st; };
__device__ __forceinline__ XcdBarrier xcd_barrier_post(unsigned* bar, volatile LAS unsigned* st) {
    XcdBarrier b; b.bar = bar; b.x = xb_xcc_id(); b.st = st;
    if (threadIdx.x == 0) (void)xb_add(&bar[XB_XCNT(b.x)], 1u);
    return b;
}
__device__ __forceinline__ void xcd_barrier_complete(unsigned* bar, unsigned x, unsigned& nloc, unsigned& nx) {
    const unsigned G = gridDim.x * gridDim.y * gridDim.z;
    unsigned sum, cnt, mine, sp = 0u;
    for (;;) {
        sum = 0u; cnt = 0u; mine = 0u;
#pragma unroll
        for (unsigned j = 0; j < 16; ++j) { const unsigned c = xb_ld(&bar[XB_XCNT(j)]); sum += c; cnt += (c > 0u) ? 1u : 0u; mine = (j == x) ? c : mine; }
        if (sum == G) break;
        __builtin_amdgcn_s_sleep(1);
        if ((++sp & 255u) == 0u) { if (xb_ld(&bar[XB_TMO])) break; if (sp > XB_SPIN_CAP) { atomicAdd(&bar[XB_TMO], 1u); break; } }
    }
    nloc = mine > 0u ? mine : 1u; nx = cnt > 0u ? cnt : 1u;
}
__device__ __forceinline__ void xcd_barrier(const XcdBarrier& b, const int wave0) {
    asm volatile("s_waitcnt vmcnt(0)" ::: "memory");
    __syncthreads();
    if (wave0 == 0 && lane_id_opaque() == 0) {
        unsigned* bar = b.bar;
        __builtin_amdgcn_s_waitcnt(0);
        unsigned nloc = b.st[0], nx = b.st[1];
        if (nloc == 0u) { xcd_barrier_complete(bar, b.x, nloc, nx); b.st[0] = nloc; b.st[1] = nx; }
        const unsigned old = xb_add(&bar[XB_XSUB(b.x)], 1u);
        const unsigned gen = old / nloc;
        if (old + 1u == (gen + 1u) * nloc) {
            __builtin_amdgcn_fence(__ATOMIC_RELEASE, "agent");
            asm volatile("s_waitcnt vmcnt(0)" ::: "memory");
            const unsigned og = xb_add(&bar[XB_TOP], 1u);
            const unsigned tg = og / nx;
            if (og + 1u == (tg + 1u) * nx) xb_add(&bar[XB_TOPGEN], 1u);
            else XB_SPIN(xb_ld(&bar[XB_TOPGEN]) == tg, bar);
            __builtin_amdgcn_fence(__ATOMIC_ACQUIRE, "agent");
            xb_add(&bar[XB_XGEN(b.x)], 1u);
            asm volatile("s_waitcnt vmcnt(0)" ::: "memory");
        } else {
            XB_SPIN(xb_ld(&bar[XB_XGEN(b.x)]) == gen, bar);
            __builtin_amdgcn_fence(__ATOMIC_ACQUIRE, "agent");
            asm volatile("s_waitcnt vmcnt(0)" ::: "memory");
        }
    }
    __syncthreads();
}

namespace g8 {
constexpr int BM = 256, BK = 64, HALF = 128, HTB = HALF * BK * 2, STAGE_BYTES = 8 * HTB, NXCD = 8, WGM = 8;
__host__ __device__ __forceinline__ int lds_byte(int r, int c) { const int st = (r >> 4) * 2 + (c >> 5), rr = r & 15, cc = c & 31, ob = rr * 64 + cc * 2; return st * 1024 + (ob ^ (((ob >> 9) & 1) << 5)); }
__host__ __device__ __forceinline__ void stage_rc(int b, int& R, int& C) { const int st = b / 1024, sb = b % 1024, swz = sb ^ (((sb >> 9) & 1) << 5); R = (st >> 1) * 16 + swz / 64; C = (st & 1) * 32 + (swz % 64) / 2; }
__host__ __device__ __forceinline__ int perm32(int rho) { const int n = rho >> 4, i = rho & 15; return 8 * (i >> 2) + 4 * n + (i & 3); }

struct Unit { unsigned a0; const char* B; int p0, p1, p2; };

__device__ __forceinline__ void static_map(int L, int nM, int nN, int& pm, int& pn) {
    const int nwg = nM * nN; int wgid = L;
    { const int q = nwg / NXCD, r = nwg % NXCD, xcd = wgid % NXCD, off = wgid / NXCD; wgid = (xcd < r ? xcd * (q + 1) : r * (q + 1) + (xcd - r) * q) + off; }
    const int nig = WGM * nN, gid = wgid / nig, fm = gid * WGM, gsz = (nM - fm) < WGM ? (nM - fm) : WGM;
    pm = fm + ((wgid % nig) % gsz); pn = (wgid % nig) / gsz;
}

template <class Epi, class Sched>
__device__ __forceinline__ void gemm_phase(LAS unsigned char* lds, const int wid, const char* Abase, const int K, const unsigned ldb, const Sched& S, const Epi& E) {
    const int lane = lane_id_opaque();
    const int tid = wid * 64 + lane, wr = wid >> 2, wc = wid & 3, fr = lane & 15, fq = lane >> 4;
    const int nt = K / BK;
    unsigned voffB0;
    { int R0, C0; stage_rc(tid * 16, R0, C0);
      const int Rb0 = Epi::GUP ? (256 * ((R0 >> 4) & 1) + 32 * (R0 >> 5) + 8 * ((R0 & 15) >> 2) + (R0 & 3)) : Epi::WIDE ? (64 * (R0 >> 5) + 16 * ((R0 & 15) >> 2) + 4 * ((R0 >> 4) & 1) + (R0 & 3)) : Epi::HEADP ? (64 * (R0 >> 5) + perm32(R0 & 31)) : (Epi::PERM ? ((R0 & ~31) + perm32(R0 & 31)) : R0);
      voffB0 = (unsigned)Rb0 * ldb + (unsigned)C0 * 2u; }
    const size_t hstepB = (size_t)(Epi::GUP ? 4 : Epi::WIDE ? 8 : (Epi::HEADP ? 32 : HALF)) * ldb;
    const size_t p1stepB = (size_t)((Epi::WIDE || Epi::HEADP) ? 128 : 64) * ldb;
    const unsigned ldsw = (unsigned)wid * 1024u;
    const int aoff = lds_byte(wr * 64 + fr, fq * 8), boff = lds_byte(wc * 32 + fr, fq * 8);
#define G8_SA(b, h) (((b) * 2 + (h)) * HTB)
#define G8_SB(b, h) ((4 + (b) * 2 + (h)) * HTB)
#define G8_GLDS(gp, lo) __builtin_amdgcn_global_load_lds((const unsigned*)(gp), (LAS unsigned*)(lds + (lo)), 16, 0, 0)
#define G8_STAGE_A(bufoff, o0, o1, kb, h) do { \
        G8_GLDS(Abase + ((long)(kb) + (Sched::GATHER ? 0l : (long)((h) * 128) * (long)S.lda)) + (size_t)(o0), (bufoff) + ldsw); \
        G8_GLDS(Abase + ((long)(kb) + (Sched::GATHER ? 0l : (long)((h) * 128 + 64) * (long)S.lda)) + (size_t)(o1), (bufoff) + ldsw + 8192); } while (0)
#define G8_STAGE_B(bufoff, bp, kb) do { G8_GLDS((bp) + (size_t)(kb) + (size_t)voffB0, (bufoff) + ldsw); G8_GLDS((bp) + ((size_t)(kb) + p1stepB) + (size_t)voffB0, (bufoff) + ldsw + 8192); } while (0)
#define G8_LDA(dst, b, h) do { _Pragma("unroll") for (int m = 0; m < 4; ++m) _Pragma("unroll") for (int k = 0; k < 2; ++k) dst[m][k] = *(const LAS bf16x8*)(lds + G8_SA(b, h) + aoff + m * 2048 + k * 1024); } while (0)
#define G8_LDB(dst, b, h) do { _Pragma("unroll") for (int n = 0; n < 2; ++n) _Pragma("unroll") for (int k = 0; k < 2; ++k) dst[n][k] = *(const LAS bf16x8*)(lds + G8_SB(b, h) + boff + n * 2048 + k * 1024); } while (0)
#define G8_MMA(ai, bj, At, Bt) do { __builtin_amdgcn_s_setprio(1); _Pragma("unroll") for (int m = 0; m < 4; ++m) _Pragma("unroll") for (int n = 0; n < 2; ++n) _Pragma("unroll") for (int k = 0; k < 2; ++k) \
        acc[ai][bj][m][n] = __builtin_amdgcn_mfma_f32_16x16x32_bf16(Bt[n][k], At[m][k], acc[ai][bj][m][n], 0, 0, 0); __builtin_amdgcn_s_setprio(0); } while (0)
#define G8_WAIT_V(n) asm volatile("s_waitcnt vmcnt(" #n ")" ::: "memory")
#define G8_WAIT_L(n) asm volatile("s_waitcnt lgkmcnt(" #n ")" ::: "memory")
#define G8_BAR __builtin_amdgcn_s_barrier()
#define G8_SCHED __builtin_amdgcn_sched_barrier(0)
    Unit cur, nxt; int ui = 0;
    if (!S.next(0, cur)) return;
    f32x4 acc[2][2][4][2];
#pragma unroll
    for (int a = 0; a < 2; ++a)
#pragma unroll
        for (int b = 0; b < 2; ++b)
#pragma unroll
            for (int m = 0; m < 4; ++m)
#pragma unroll
                for (int n = 0; n < 2; ++n) acc[a][b][m][n] = (f32x4){0.f, 0.f, 0.f, 0.f};
    bf16x8 At[4][2], B0[2][2], B1[2][2];
    unsigned cA00, cA01, cA10, cA11;
    { int R0, C0, R1, C1; stage_rc(tid * 16, R0, C0); stage_rc(tid * 16 + 8192, R1, C1);
      cA00 = S.aoff(cur, R0) + (unsigned)C0 * 2u;
      if constexpr (Sched::GATHER) { cA01 = S.aoff(cur, R1) + (unsigned)C1 * 2u; cA10 = S.aoff(cur, HALF + R0) + (unsigned)C0 * 2u; cA11 = S.aoff(cur, HALF + R1) + (unsigned)C1 * 2u; }
      else { cA01 = cA00; cA10 = cA00; cA11 = cA00; } }
    const char* cB = cur.B;
    G8_STAGE_B(G8_SB(0, 0), cB, 0); G8_SCHED; G8_STAGE_B(G8_SB(0, 1), cB + hstepB, 0); G8_SCHED; G8_STAGE_A(G8_SA(0, 0), cA00, cA01, 0, 0); G8_SCHED; G8_STAGE_A(G8_SA(0, 1), cA10, cA11, 0, 1); G8_SCHED;
    if (wr == 1) G8_BAR;
    G8_WAIT_V(2); G8_BAR;
    G8_STAGE_B(G8_SB(1, 0), cB, 128); G8_SCHED; G8_STAGE_A(G8_SA(1, 0), cA00, cA01, 128, 0); G8_SCHED; G8_STAGE_B(G8_SB(1, 1), cB + hstepB, 128); G8_SCHED;
    G8_WAIT_V(6); G8_BAR;
    for (;;) {
        const bool has_next = S.next(ui + 1, nxt);
        unsigned nA00 = cA00, nA01 = cA01, nA10 = cA10, nA11 = cA11; const char* nB = cB; long dl = 0;
        if (has_next) {
            nB = nxt.B;
            if constexpr (!Sched::GATHER) dl = ((long)nxt.a0 - (long)cur.a0) * (long)S.lda;
            else { const int t2 = wid * 64 + lane_id_opaque(); int R0, C0, R1, C1; stage_rc(t2 * 16, R0, C0); stage_rc(t2 * 16 + 8192, R1, C1);
                nA00 = S.aoff(nxt, R0) + (unsigned)C0 * 2u; nA01 = S.aoff(nxt, R1) + (unsigned)C1 * 2u; nA10 = S.aoff(nxt, HALF + R0) + (unsigned)C0 * 2u; nA11 = S.aoff(nxt, HALF + R1) + (unsigned)C1 * 2u; }
        }
        for (int t = 0; t < nt; t += 2) {
            const bool last = (t == nt - 2);
            const unsigned kb = (unsigned)t * 128u;
            const unsigned kb2 = last ? 0u : kb + 256u;
            const char* b2 = last ? nB : cB;
            unsigned s00, s01, s10, s11; long ka2;
            if constexpr (Sched::GATHER) { s00 = last ? nA00 : cA00; s01 = last ? nA01 : cA01; s10 = last ? nA10 : cA10; s11 = last ? nA11 : cA11; ka2 = (long)kb2; }
            else { s00 = cA00; s01 = cA00; s10 = cA00; s11 = cA00; ka2 = last ? dl : (long)kb2; }
            G8_LDB(B0, 0, 0); G8_LDB(B1, 0, 1); G8_SCHED; G8_LDA(At, 0, 0); G8_STAGE_A(G8_SA(1, 1), cA10, cA11, kb + 128u, 1);
            G8_WAIT_V(8); G8_WAIT_L(0); G8_BAR; G8_MMA(0, 0, At, B0); G8_MMA(0, 1, At, B1); G8_BAR; G8_SCHED;
            G8_LDA(At, 0, 1); G8_STAGE_B(G8_SB(0, 0), b2, kb2); G8_STAGE_B(G8_SB(0, 1), b2 + hstepB, kb2); G8_STAGE_A(G8_SA(0, 0), s00, s01, ka2, 0);
            G8_WAIT_V(8); G8_WAIT_L(0); G8_BAR; G8_MMA(1, 0, At, B0); G8_MMA(1, 1, At, B1); G8_BAR; G8_SCHED;
            G8_LDB(B0, 1, 0); G8_LDB(B1, 1, 1); G8_SCHED; G8_LDA(At, 1, 0); G8_STAGE_A(G8_SA(0, 1), s10, s11, ka2, 1);
            G8_WAIT_V(8); G8_WAIT_L(0); G8_BAR; G8_MMA(0, 0, At, B0); G8_MMA(0, 1, At, B1); G8_BAR; G8_SCHED;
            G8_LDA(At, 1, 1); G8_STAGE_B(G8_SB(1, 0), b2, kb2 + 128u); G8_STAGE_B(G8_SB(1, 1), b2 + hstepB, kb2 + 128u); G8_STAGE_A(G8_SA(1, 0), s00, s01, ka2 + 128, 0);
            G8_WAIT_V(8); G8_WAIT_L(0); G8_BAR; G8_MMA(1, 0, At, B0); G8_MMA(1, 1, At, B1); G8_BAR; G8_SCHED;
        }
        if (wr == 0) G8_BAR;
        { const int l2 = lane_id_opaque(); E(acc, cur, wr, wc, l2 & 15, l2 >> 4); }
        if (!has_next) break;
#pragma unroll
        for (int a = 0; a < 2; ++a)
#pragma unroll
            for (int b = 0; b < 2; ++b)
#pragma unroll
                for (int m = 0; m < 4; ++m)
#pragma unroll
                    for (int n = 0; n < 2; ++n) acc[a][b][m][n] = (f32x4){0.f, 0.f, 0.f, 0.f};
        cur = nxt; cB = nB; ++ui;
        if constexpr (Sched::GATHER) { cA00 = nA00; cA01 = nA01; cA10 = nA10; cA11 = nA11; }
        else { cA00 += (unsigned)dl; cA01 = cA00; cA10 = cA00; cA11 = cA00; }
        if (wr == 1) G8_BAR;
    }
    G8_WAIT_V(0);
    G8_BAR;
#undef G8_SA
#undef G8_SB
#undef G8_GLDS
#undef G8_STAGE_A
#undef G8_STAGE_B
#undef G8_LDA
#undef G8_LDB
#undef G8_MMA
#undef G8_WAIT_V
#undef G8_WAIT_L
#undef G8_BAR
#undef G8_SCHED
}

struct RectSched {
    static constexpr bool GATHER = false;
    int nM, nN, G, c; unsigned row0, lda; const char* Bbase; unsigned ldb;
    __device__ __forceinline__ bool next(int i, Unit& u) const {
        const int L = i * G + c; if (L >= nM * nN) return false;
        int pm, pn; static_map(L, nM, nN, pm, pn);
        u.a0 = row0 + (unsigned)pm * 256u; u.B = Bbase + (size_t)pn * 256u * ldb; u.p0 = pm; u.p1 = pn; u.p2 = 0; return true;
    }
    __device__ __forceinline__ unsigned aoff(const Unit& u, int q) const { return (u.a0 + (unsigned)q) * lda; }
};
struct QkvSched {
    static constexpr bool GATHER = false;
    int G, c; unsigned lda; const char* Bbase; unsigned ldb;
    __device__ __forceinline__ bool next(int i, Unit& u) const {
        const int L = i * G + c; int pm, pn;
        if (L < 768) static_map(L, 64, 12, pm, pn);
        else if (L < 832) { const int l2 = L - 768; pm = 64 + (l2 & 7); pn = 4 + (l2 >> 3); }
        else return false;
        u.a0 = (unsigned)pm * 256u; u.B = Bbase + (size_t)pn * 256u * ldb; u.p0 = pm; u.p1 = pn; u.p2 = 0; return true;
    }
    __device__ __forceinline__ unsigned aoff(const Unit& u, int q) const { return (u.a0 + (unsigned)q) * lda; }
};
struct BatchSched {
    static constexpr bool GATHER = false;
    int nb, nM, nN, G, c; unsigned lda; const char* Bbase; unsigned ldb; int N;
    __device__ __forceinline__ bool next(int i, Unit& u) const {
        const int per = nM * nN; int L;
        if ((G & 7) == 0 && (nb & 7) == 0) {
            const int nx = (nb >> 3) * per, li = i * (G >> 3) + (c >> 3); if (li >= nx) return false;
            L = (c & 7) * nx + li;
        } else { L = i * G + c; if (L >= nb * per) return false; }
        const int g = L / per, rem = L % per, pm = rem / nN, pn = rem % nN;
        u.a0 = (unsigned)(g * S5RP + pm * 256); u.B = Bbase + ((size_t)g * N + (size_t)pn * 256u) * ldb; u.p0 = g; u.p1 = pm; u.p2 = pn; return true;
    }
    __device__ __forceinline__ unsigned aoff(const Unit& u, int q) const { return (u.a0 + (unsigned)q) * lda; }
};
template <bool GATHER_>
struct MoeSched {
    static constexpr bool GATHER = GATHER_;
    int ntiles, nN, G, c; unsigned lda; const char* Bbase; unsigned ldb; int Ne, pn0, bstep; const LAS unsigned char* tile_e; const int* rowidx;
    __device__ __forceinline__ void xrange(int x, int& tlo, int& nx) const { const int q = ntiles >> 3, r = ntiles & 7; nx = q + (x < r ? 1 : 0); tlo = x * q + (x < r ? x : r); }
    __device__ __forceinline__ bool next(int i, Unit& u) const {
        int tile, pn;
        if ((G & 7) == 0) {
            int tlo, nx; xrange(c & 7, tlo, nx);
            const int li = i * (G >> 3) + (c >> 3); if (li >= nx * nN) return false;
            tile = tlo + li / nN; pn = li % nN;
        } else { const int L = i * G + c; if (L >= ntiles * nN) return false; tile = L / nN; pn = L % nN; }
        const int e = __builtin_amdgcn_readfirstlane((int)tile_e[tile]);
        u.a0 = (unsigned)tile * 256u; u.B = Bbase + ((size_t)e * Ne + (size_t)(pn0 + pn) * (unsigned)bstep) * ldb; u.p0 = tile; u.p1 = pn; u.p2 = e; return true;
    }
    __device__ __forceinline__ unsigned aoff(const Unit& u, int q) const {
        if (GATHER) return (unsigned)rowidx[u.a0 + (unsigned)q] * lda;
        return (u.a0 + (unsigned)q) * lda;
    }
};
}

struct Params {
    const float* in[34];
    float* out;
    unsigned char* ws;
    int ph_lo, ph_hi;
};
enum { I_X = 0, I_C, I_CTX, I_CCTX, I_ADAW, I_ADAB, I_NMG, I_NFG, I_WIN, I_ARE, I_AIM, I_LDT, I_BRE, I_BIM, I_CRE, I_CIM, I_S5D, I_GLUW, I_GLUB, I_CONVW,
       I_HOUT, I_WQKV, I_QG, I_KG, I_RPB, I_NOUT, I_RW, I_RB, I_MG, I_MU, I_MD, I_SG, I_SU, I_SD };

using g8::Unit;
typedef f32x4 Acc[2][2][4][2];

__device__ __forceinline__ u32x4 pack8(const f32x4& a, const f32x4& b) {
    u32x4 w; w.x = pk2(a[0], a[1]); w.y = pk2(a[2], a[3]); w.z = pk2(b[0], b[1]); w.w = pk2(b[2], b[3]); return w;
}

struct EpiWin {
    static constexpr bool PERM = true, HEADP = false, WIDE = false, GUP = false;
    bf16_t* A2; bf16_t* BCV;
    __device__ __forceinline__ void operator()(const Acc& acc, const Unit& u, int wr, int wc, int fr, int fq) const {
#pragma unroll
        for (int ai = 0; ai < 2; ++ai)
#pragma unroll
            for (int m = 0; m < 4; ++m) {
                const int row = u.p0 * 256 + 128 * ai + 64 * wr + 16 * m + fr;
#pragma unroll
                for (int bj = 0; bj < 2; ++bj) {
                    const int col0 = u.p1 * 256 + 128 * bj + 32 * wc + 8 * fq;
                    const u32x4 w = pack8(acc[ai][bj][m][0], acc[ai][bj][m][1]);
                    if (u.p1 < 2) {
                        const int g = col0 >> 4, ci0 = col0 & 15, r = row >> 5, s = row & 31;
                        *(u32x4*)(A2 + ((size_t)(g * S5RP + r) * S5K + s * 16 + ci0)) = w;
                    } else {
                        *(u32x4*)(BCV + ((size_t)row * 1536 + (col0 - 512))) = w;
                    }
                }
            }
    }
};
struct EpiS5F {
    static constexpr bool PERM = false, HEADP = false, WIDE = false, GUP = false;
    float* F;
    __device__ __forceinline__ void operator()(const Acc& acc, const Unit& u, int wr, int wc, int fr, int fq) const {
#pragma unroll
        for (int ai = 0; ai < 2; ++ai)
#pragma unroll
            for (int m = 0; m < 4; ++m) {
                const int row = u.p1 * 256 + 128 * ai + 64 * wr + 16 * m + fr;
                float* rp = F + ((size_t)(u.p0 * S5RP + row) * 256);
#pragma unroll
                for (int bj = 0; bj < 2; ++bj)
#pragma unroll
                    for (int n = 0; n < 2; ++n) *(f32x4*)(rp + 128 * bj + 32 * wc + 16 * n + 4 * fq) = acc[ai][bj][m][n];
            }
    }
};
struct EpiS5Y {
    static constexpr bool PERM = true, HEADP = false, WIDE = false, GUP = false;
    bf16_t* Gb;
    __device__ __forceinline__ void operator()(const Acc& acc, const Unit& u, int wr, int wc, int fr, int fq) const {
#pragma unroll
        for (int ai = 0; ai < 2; ++ai)
#pragma unroll
            for (int m = 0; m < 4; ++m) {
                const int r = u.p1 * 256 + 128 * ai + 64 * wr + 16 * m + fr;
                if (r < S5R) {
#pragma unroll
                    for (int bj = 0; bj < 2; ++bj) {
                        const int col0 = u.p2 * 256 + 128 * bj + 32 * wc + 8 * fq;
                        const int t = col0 >> 4, co0 = col0 & 15;
                        f32x4 a = acc[ai][bj][m][0], b = acc[ai][bj][m][1];
#pragma unroll
                        for (int j = 0; j < 4; ++j) { a[j] = gelu_tanh(a[j]); b[j] = gelu_tanh(b[j]); }
                        *(u32x4*)(Gb + ((size_t)(r * S5T + t) * 512 + u.p0 * 16 + co0)) = pack8(a, b);
                    }
                }
            }
    }
};
struct EpiGlu {
    static constexpr bool PERM = true, HEADP = false, WIDE = false, GUP = false;
    const bf16_t* Gb; const float* bias; bf16_t* Z;
    __device__ __forceinline__ void operator()(const Acc& acc, const Unit& u, int wr, int wc, int fr, int fq) const {
        const int row0 = u.p0 * 256 + 64 * wr + fr, col0 = u.p1 * 256 + 32 * wc + 8 * fq;
        f32x4 bv[2][2];
#pragma unroll
        for (int bj = 0; bj < 2; ++bj) { bv[bj][0] = *(const f32x4*)(bias + col0 + 128 * bj); bv[bj][1] = *(const f32x4*)(bias + col0 + 128 * bj + 4); }
        u32x4 gv[8][2];
#pragma unroll
        for (int i = 0; i < 8; ++i)
#pragma unroll
            for (int bj = 0; bj < 2; ++bj) gv[i][bj] = *(const u32x4*)(Gb + ((size_t)(row0 + 128 * (i >> 2) + 16 * (i & 3)) * 512 + col0 + 128 * bj));
#pragma unroll
        for (int i = 0; i < 8; ++i) {
            const int ai = i >> 2, m = i & 3; const int row = row0 + 128 * ai + 16 * m;
#pragma unroll
            for (int bj = 0; bj < 2; ++bj) {
                const u32x4 g = gv[i][bj];
                f32x4 a = acc[ai][bj][m][0] + bv[bj][0], b = acc[ai][bj][m][1] + bv[bj][1];
                a[0] = bflo(g.x) * sigmoidf_(a[0]); a[1] = bfhi(g.x) * sigmoidf_(a[1]); a[2] = bflo(g.y) * sigmoidf_(a[2]); a[3] = bfhi(g.y) * sigmoidf_(a[3]);
                b[0] = bflo(g.z) * sigmoidf_(b[0]); b[1] = bfhi(g.z) * sigmoidf_(b[1]); b[2] = bflo(g.w) * sigmoidf_(b[2]); b[3] = bfhi(g.w) * sigmoidf_(b[3]);
                *(u32x4*)(Z + ((size_t)row * 1024 + col0 + 128 * bj)) = pack8(a, b);
            }
        }
    }
};
struct EpiResid {
    static constexpr bool PERM = true, HEADP = false, WIDE = true, GUP = false;
    const float* gate;
    bf16_t* XR; float rs;
    __device__ __forceinline__ void operator()(const Acc& acc, const Unit& u, int wr, int wc, int fr, int fq) const {
        const int row0 = u.p0 * 256 + 64 * wr + fr, col = u.p1 * 256 + 64 * wc + 16 * fq;
        const int b = (u.p0 * 256) < NLAT ? ((u.p0 * 256) >> 11) : 8;
        const float* gp = gate + b * 6144 + col;
        f32x4 g[4];
#pragma unroll
        for (int q = 0; q < 4; ++q) g[q] = *(const f32x4*)(gp + 4 * q) * rs;
        u32x4 xa[8], xc[8];
#pragma unroll
        for (int i = 0; i < 8; ++i) { const bf16_t* xp = XR + (size_t)(row0 + 128 * (i >> 2) + 16 * (i & 3)) * DM + col; xa[i] = *(const u32x4*)xp; xc[i] = *(const u32x4*)(xp + 8); }
#pragma unroll
        for (int i = 0; i < 8; ++i) {
            const int ai = i >> 2, m = i & 3;
            bf16_t* xp = XR + (size_t)(row0 + 128 * ai + 16 * m) * DM + col;
            const f32x4 x0 = (f32x4){bflo(xa[i].x), bfhi(xa[i].x), bflo(xa[i].y), bfhi(xa[i].y)}, x1 = (f32x4){bflo(xa[i].z), bfhi(xa[i].z), bflo(xa[i].w), bfhi(xa[i].w)};
            const f32x4 x2 = (f32x4){bflo(xc[i].x), bfhi(xc[i].x), bflo(xc[i].y), bfhi(xc[i].y)}, x3 = (f32x4){bflo(xc[i].z), bfhi(xc[i].z), bflo(xc[i].w), bfhi(xc[i].w)};
            const f32x4 o0 = x0 + g[0] * acc[ai][0][m][0], o1 = x1 + g[1] * acc[ai][0][m][1], o2 = x2 + g[2] * acc[ai][1][m][0], o3 = x3 + g[3] * acc[ai][1][m][1];
            *(u32x4*)xp = pack8(o0, o1); *(u32x4*)(xp + 8) = pack8(o2, o3);
        }
    }
};
struct EpiGU {
    static constexpr bool PERM = false, HEADP = false, WIDE = false, GUP = true;
    bf16_t* ACT;
    __device__ __forceinline__ void operator()(const Acc& acc, const Unit& u, int wr, int wc, int fr, int fq) const {
#pragma unroll
        for (int ai = 0; ai < 2; ++ai)
#pragma unroll
            for (int m = 0; m < 4; ++m) {
                const int slot = u.p0 * 256 + 128 * ai + 64 * wr + 16 * m + fr;
                u32x4 o;
#pragma unroll
                for (int bj = 0; bj < 2; ++bj) {
                    const f32x4 g = acc[ai][bj][m][0], up = acc[ai][bj][m][1];
                    o[2 * bj] = pk2(siluf_(g[0]) * up[0], siluf_(g[1]) * up[1]); o[2 * bj + 1] = pk2(siluf_(g[2]) * up[2], siluf_(g[3]) * up[3]);
                }
                *(u32x4*)(ACT + ((size_t)slot * EDIM + u.p1 * 128 + 32 * wc + 8 * fq)) = o;
            }
    }
};
__device__ __forceinline__ float fp8c(float v) { return __builtin_amdgcn_fmed3f(v * 16.f, -440.f, 440.f); }
__device__ __forceinline__ u32x2 pack8_fp8(const f32x4& a, const f32x4& b) {
    int w0 = 0, w1 = 0;
    w0 = __builtin_amdgcn_cvt_pk_fp8_f32(fp8c(a[0]), fp8c(a[1]), w0, false); w0 = __builtin_amdgcn_cvt_pk_fp8_f32(fp8c(a[2]), fp8c(a[3]), w0, true);
    w1 = __builtin_amdgcn_cvt_pk_fp8_f32(fp8c(b[0]), fp8c(b[1]), w1, false); w1 = __builtin_amdgcn_cvt_pk_fp8_f32(fp8c(b[2]), fp8c(b[3]), w1, true);
    return (u32x2){(unsigned)w0, (unsigned)w1};
}
struct EpiDN {
    static constexpr bool PERM = true, HEADP = false, WIDE = true, GUP = false;
    unsigned char* Y;
    __device__ __forceinline__ void operator()(const Acc& acc, const Unit& u, int wr, int wc, int fr, int fq) const {
#pragma unroll
        for (int ai = 0; ai < 2; ++ai)
#pragma unroll
            for (int m = 0; m < 4; ++m) {
                const int slot = u.p0 * 256 + 128 * ai + 64 * wr + 16 * m + fr;
                const u32x2 lo = pack8_fp8(acc[ai][0][m][0], acc[ai][0][m][1]), hi = pack8_fp8(acc[ai][1][m][0], acc[ai][1][m][1]);
                *(u32x4*)(Y + ((size_t)slot * 1024 + u.p1 * 256 + 64 * wc + 16 * fq)) = (u32x4){lo.x, lo.y, hi.x, hi.y};
            }
    }
};
struct EpiQKV {
    static constexpr bool PERM = true, HEADP = true, WIDE = false, GUP = false;
    bf16_t* Q; bf16_t* Kb; bf16_t* VT; const float* qg; const float* kg;
    __device__ __forceinline__ void operator()(const Acc& acc, const Unit& u, int wr, int wc, int fr, int fq) const {
        const int region = u.p1 >> 2;
        if (region < 2) {
            const float* gp = (region == 0 ? qg : kg) + 8 * fq; const float gs = region == 0 ? 0.125f * 1.4426950408889634f : 1.f;
            f32x4 g[2][2];
#pragma unroll
            for (int bj = 0; bj < 2; ++bj)
#pragma unroll
                for (int n = 0; n < 2; ++n) g[bj][n] = *(const f32x4*)(gp + 32 * bj + 4 * n) * gs;
            bf16_t* dst = region == 0 ? Q : Kb;
#pragma unroll
            for (int ai = 0; ai < 2; ++ai)
#pragma unroll
                for (int m = 0; m < 4; ++m) {
                    const int row = u.p0 * 256 + 128 * ai + 64 * wr + 16 * m + fr;
                    float ss = 0.f;
#pragma unroll
                    for (int bj = 0; bj < 2; ++bj)
#pragma unroll
                        for (int n = 0; n < 2; ++n) { const f32x4 v = acc[ai][bj][m][n]; ss += (v[0] * v[0] + v[1] * v[1]) + (v[2] * v[2] + v[3] * v[3]); }
                    ss += __shfl_xor(ss, 16); ss += __shfl_xor(ss, 32);
                    const float rstd = rsqrtf(ss * (1.f / 64.f) + 1e-6f);
                    bf16_t* rp = dst + ((size_t)row * DM + (u.p1 & 3) * 256 + 64 * wc + 8 * fq);
#pragma unroll
                    for (int bj = 0; bj < 2; ++bj) *(u32x4*)(rp + 32 * bj) = pack8(acc[ai][bj][m][0] * rstd * g[bj][0], acc[ai][bj][m][1] * rstd * g[bj][1]);
                }
        } else {
#pragma unroll
            for (int ai = 0; ai < 2; ++ai)
#pragma unroll
                for (int m = 0; m < 4; ++m) {
                    const int row = u.p0 * 256 + 128 * ai + 64 * wr + 16 * m + fr;
                    bf16_t* rp = VT + ((size_t)row * DM + (u.p1 & 3) * 256 + 64 * wc + 8 * fq);
#pragma unroll
                    for (int bj = 0; bj < 2; ++bj) *(u32x4*)(rp + 32 * bj) = pack8(acc[ai][bj][m][0], acc[ai][bj][m][1]);
                }
        }
    }
};

struct Ctx { int tid, lane, wave, G, blk, gw, NGW; LAS unsigned char* lds; };
__device__ __forceinline__ Ctx mkctx(LAS unsigned char* lds, int wave0) {
    Ctx X; X.lane = lane_id_opaque(); X.wave = wave0; X.tid = wave0 * 64 + X.lane; X.G = gridDim.x; X.blk = blockIdx.x;
    X.gw = X.blk * 8 + X.wave; X.NGW = X.G * 8; X.lds = lds; return X;
}

template <int MODE> __device__ __forceinline__ int wrow(int n) { return MODE == 2 ? 256 + n : n; }
template <int MODE>
__device__ __forceinline__ void conv_item(const float* W, int N, bf16_t* WT, int ldk, int k0, int n0, LAS unsigned* T, int lane) {
    (void)T;
    const int nq = lane & 15, kg = lane >> 4;
    const float* wp = W + (size_t)(k0 + 16 * kg) * N + n0 + 4 * nq;
    f32x4 r[16];
#pragma unroll
    for (int i = 0; i < 16; ++i) r[i] = *(const f32x4*)(wp + (size_t)i * N);
#pragma unroll
    for (int j = 0; j < 4; ++j) {
        bf16_t* op = WT + (size_t)wrow<MODE>(n0 + 4 * nq + j) * ldk + k0 + 16 * kg;
        u32x4 lo, hi;
        lo.x = pk2(r[0][j], r[1][j]); lo.y = pk2(r[2][j], r[3][j]); lo.z = pk2(r[4][j], r[5][j]); lo.w = pk2(r[6][j], r[7][j]);
        hi.x = pk2(r[8][j], r[9][j]); hi.y = pk2(r[10][j], r[11][j]); hi.z = pk2(r[12][j], r[13][j]); hi.w = pk2(r[14][j], r[15][j]);
        *(u32x4*)op = lo; *(u32x4*)(op + 8) = hi;
    }
}
__device__ __forceinline__ void conv_mat(const Ctx& X, const float* W, int K, int N, bf16_t* WT, int& rot) {
    LAS unsigned* T = (LAS unsigned*)(X.lds + X.wave * 8192);
    const int nb = N / 64, nitems = (K / 64) * nb;
    int start = X.gw - rot; while (start < 0) start += X.NGW;
    for (int it = start; it < nitems; it += X.NGW) conv_item<0>(W, N, WT, K, (it / nb) * 64, (it % nb) * 64, T, X.lane);
    rot = (rot + nitems) % X.NGW;
}
template <int KIND>
__device__ __forceinline__ void conv_moe_items(const Ctx& X, const Params& p, int l, bf16_t* GU, bf16_t* DN, int it0, int it1, int rank, int nrank) {
    constexpr int PER = KIND == 0 ? 192 : (KIND == 1 ? 128 : 64);
    for (int it = it0 + rank * 8 + X.wave; it < it1; it += nrank * 8) {
        const int e = it / PER, r = it % PER, kind = KIND == 2 ? 2 : (r >> 6), q = r & 63;
        if (kind == 0) {
            const float* W = e < NEXP ? p.in[I_MG] + (size_t)(l * NEXP + e) * 262144 : p.in[I_SG] + (size_t)l * 262144;
            conv_item<1>(W, 256, GU + (size_t)e * 512 * 1024, 1024, (q >> 2) * 64, (q & 3) * 64, nullptr, X.lane);
        } else if (kind == 1) {
            const float* W = e < NEXP ? p.in[I_MU] + (size_t)(l * NEXP + e) * 262144 : p.in[I_SU] + (size_t)l * 262144;
            conv_item<2>(W, 256, GU + (size_t)e * 512 * 1024, 1024, (q >> 2) * 64, (q & 3) * 64, nullptr, X.lane);
        } else {
            const float* W = e < NEXP ? p.in[I_MD] + (size_t)(l * NEXP + e) * 262144 : p.in[I_SD] + (size_t)l * 262144;
            conv_item<0>(W, 1024, DN + (size_t)e * 1024 * 256, 256, (q >> 4) * 64, (q & 15) * 64, nullptr, X.lane);
        }
    }
}
__device__ __forceinline__ int moe_idle_rank(int ntiles, int nN, int G, int blk, int& nidle) {
    if ((G & 7) != 0) { const int nunits = ntiles * nN, nfull = nunits % G; if (nfull == 0) { nidle = G; return blk; } nidle = G - nfull; return blk >= nfull ? blk - nfull : -1; }
    const int B8 = G >> 3, q = ntiles >> 3, r = ntiles & 7;
    int maxc = 0;
    for (int x = 0; x < 8; ++x) { const int n = (q + (x < r ? 1 : 0)) * nN; const int cmax = (n + B8 - 1) / B8; maxc = cmax > maxc ? cmax : maxc; }
    int rank = -1, cnt = 0;
    for (int x = 0; x < 8; ++x) {
        const int n = (q + (x < r ? 1 : 0)) * nN;
        int jfull = n - (maxc - 1) * B8; jfull = jfull < 0 ? 0 : (jfull > B8 ? B8 : jfull);
        if (x == (blk & 7)) { const int j = blk >> 3; if (j >= jfull) rank = cnt + (j - jfull); }
        cnt += B8 - jfull;
    }
    if (cnt == 0) { nidle = G; return blk; }
    nidle = cnt; return rank;
}
__device__ __forceinline__ int idle_rank(int nunits, int G, int blk, int& nidle) {
    const int nfull = nunits % G;
    if (nfull == 0) { nidle = G; return blk; }
    nidle = G - nfull; return blk >= nfull ? blk - nfull : -1;
}

__device__ __forceinline__ void sincos_red(float x, float& s, float& c) {
    const float n = rintf(x * 0.15915494309189535f);
    float r = fmaf(-n, 6.28125f, x); r = fmaf(-n, 1.9353071795864769e-3f, r);
    s = __sinf(r); c = __cosf(r);
}

__device__ __forceinline__ void phase_p0a(const Ctx& X, const Params& p) {
    {
        LAS float* PWs = (LAS float*)(X.lds);
        LAS float* BBs = (LAS float*)(X.lds + 20480);
        LAS float* CCs = (LAS float*)(X.lds + 32768);
        float* KK = (float*)(p.ws + WS_KK); float* PWG = (float*)(p.ws + WS_PW); float* BBG = (float*)(p.ws + WS_BB);
        for (int item = X.blk; item < 256; item += X.G) {
            const int g = item >> 3, d = (item >> 2) & 1, lq = item & 3, gd = d * 32 + g;
            const float dt = expf(p.in[I_LDT][gd]);
            __syncthreads();
            for (int idx = X.tid; idx < 33 * 64; idx += 512) {
                const int j = idx >> 6, pp = idx & 63;
                const float lre = fminf(p.in[I_ARE][gd * 64 + pp], -1e-4f), lim = p.in[I_AIM][gd * 64 + pp];
                const float mag = expf(lre * dt * (float)j); float sn, cs; sincos_red(lim * dt * (float)j, sn, cs);
                PWs[2 * idx] = mag * cs; PWs[2 * idx + 1] = mag * sn;
            }
            for (int idx = X.tid; idx < 1024; idx += 512) {
                const int pp = idx >> 4;
                const float lre = fminf(p.in[I_ARE][gd * 64 + pp], -1e-4f), lim = p.in[I_AIM][gd * 64 + pp];
                const float mag = expf(lre * dt); float sn, cs; sincos_red(lim * dt, sn, cs);
                const float nr = mag * cs - 1.f, ni = mag * sn, den = 1.f / (lre * lre + lim * lim);
                const float cr = (nr * lre + ni * lim) * den, ci = (ni * lre - nr * lim) * den;
                const float br = p.in[I_BRE][(size_t)gd * 1024 + idx], bi = p.in[I_BIM][(size_t)gd * 1024 + idx];
                BBs[2 * idx] = cr * br - ci * bi; BBs[2 * idx + 1] = cr * bi + ci * br;
            }
            for (int idx = X.tid; idx < 1024; idx += 512) { CCs[2 * idx] = p.in[I_CRE][(size_t)gd * 1024 + idx]; CCs[2 * idx + 1] = p.in[I_CIM][(size_t)gd * 1024 + idx]; }
            __syncthreads();
#pragma unroll
            for (int i = 0; i < 4; ++i) {
                const int e = X.tid + 512 * i, lag = 8 * lq + (e >> 8), co = (e >> 4) & 15, ci = e & 15;
                float sum = 0.f;
                for (int pp = 0; pp < 64; ++pp) {
                    const float pr = PWs[2 * (lag * 64 + pp)], pi = PWs[2 * (lag * 64 + pp) + 1];
                    const float br = BBs[2 * (pp * 16 + ci)], bi = BBs[2 * (pp * 16 + ci) + 1];
                    const float tr = pr * br - pi * bi, ti = pr * bi + pi * br;
                    sum += CCs[2 * (co * 64 + pp)] * tr - CCs[2 * (co * 64 + pp) + 1] * ti;
                }
                KK[(size_t)((g * 2 + d) * 32 + lag) * 256 + co * 16 + ci] = sum;
            }
            if (lq == 0) {
                for (int idx = X.tid; idx < 33 * 64 * 2; idx += 512) PWG[(size_t)(g * 2 + d) * 33 * 64 * 2 + idx] = PWs[idx];
                for (int idx = X.tid; idx < 2048; idx += 512) BBG[(size_t)(g * 2 + d) * 2048 + idx] = BBs[idx];
            }
        }
        __syncthreads();
    }
    {
        LAS float* condS = (LAS float*)(X.lds + 65536);
        LAS float* red = (LAS float*)(X.lds);
        for (int i = X.tid; i < 9 * 1024; i += 512) { const int r = i >> 10, k = i & 1023; const float v = r < 8 ? p.in[I_C][r * 1024 + k] : p.in[I_CCTX][k]; condS[i] = siluf_(v); }
        __syncthreads();
        float* MOD = (float*)(p.ws + WS_MOD);
        for (int task = X.blk; task < 192; task += X.G) {
            const int l = task / 96, cg = task % 96, col = cg * 64 + X.lane;
            const float* wp = p.in[I_ADAW] + (size_t)l * 1024 * 6144 + (size_t)(X.wave * 128) * 6144 + col;
            float a0 = 0, a1 = 0, a2 = 0, a3 = 0, a4 = 0, a5 = 0, a6 = 0, a7 = 0, a8 = 0;
#pragma unroll
            for (int hb = 0; hb < 2; ++hb) {
                float wv[64];
#pragma unroll
                for (int kk = 0; kk < 64; ++kk) wv[kk] = wp[(size_t)(hb * 64 + kk) * 6144];
#pragma unroll
                for (int kk = 0; kk < 64; ++kk) {
                    const float w = wv[kk]; const LAS float* cp = condS + X.wave * 128 + hb * 64 + kk;
                    a0 += cp[0] * w; a1 += cp[1024] * w; a2 += cp[2048] * w; a3 += cp[3072] * w; a4 += cp[4096] * w; a5 += cp[5120] * w; a6 += cp[6144] * w; a7 += cp[7168] * w; a8 += cp[8192] * w;
                }
            }
            __syncthreads();
            LAS float* rp = red + X.wave * 576 + X.lane;
            rp[0] = a0; rp[64] = a1; rp[128] = a2; rp[192] = a3; rp[256] = a4; rp[320] = a5; rp[384] = a6; rp[448] = a7; rp[512] = a8;
            __syncthreads();
            for (int i = X.tid; i < 576; i += 512) {
                const int r = i >> 6, c = i & 63; float sum = p.in[I_ADAB][l * 6144 + cg * 64 + c];
#pragma unroll
                for (int w = 0; w < 8; ++w) sum += red[w * 576 + i];
                MOD[(size_t)(l * 9 + r) * 6144 + cg * 64 + c] = sum;
            }
        }
        __syncthreads();
    }
    {
        int rot = 0;
        conv_mat(X, p.in[I_WIN], 1024, 2048, (bf16_t*)(p.ws + WS_WIN), rot);
    }
}
__device__ __forceinline__ void conv_small(const Ctx& X, const Params& p, int rank, int nrank) {
    Ctx Y = X; Y.gw = rank * 8 + X.wave; Y.NGW = nrank * 8;
    int rot = 0;
    conv_mat(Y, p.in[I_GLUW], 512, 512, (bf16_t*)(p.ws + WS_GLU), rot);
    conv_mat(Y, p.in[I_HOUT], 1024, 1024, (bf16_t*)(p.ws + WS_HOUT), rot);
    conv_mat(Y, p.in[I_RW], 1024, 64, (bf16_t*)(p.ws + WS_ROUT), rot);
    conv_mat(Y, p.in[I_RW] + 65536, 1024, 64, (bf16_t*)(p.ws + WS_ROUT) + 256 * 1024, rot);
    conv_mat(Y, p.in[I_WQKV], 1024, 3072, (bf16_t*)(p.ws + WS_QKV), rot);
    conv_mat(Y, p.in[I_NOUT], 1024, 1024, (bf16_t*)(p.ws + WS_NOUT), rot);
}

__device__ __forceinline__ void phase_p0b(const Ctx& X, const Params& p) {
    const int gt = X.blk * 512 + X.tid, NT = X.G * 512;
    const float* KK = (const float*)(p.ws + WS_KK); const float* PWG = (const float*)(p.ws + WS_PW); const float* BBG = (const float*)(p.ws + WS_BB);
    bf16_t* ME = (bf16_t*)(p.ws + WS_ME); bf16_t* WF = (bf16_t*)(p.ws + WS_WF);
    for (int ch = gt; ch < 32 * 512 * 96; ch += NT) {
        const int kc = ch % 96, n = (ch / 96) & 511, g = ch / (96 * 512), t = n >> 4, co = n & 15, k0 = kc * 8;
        float v[8];
        if (k0 < 512) {
            const int s_ = k0 >> 4, ci0 = k0 & 15;
            const int lf = t - s_, lb = s_ - t; const float mf = lf >= 0 ? 1.f : 0.f, mb = lb >= 0 ? 1.f : 0.f;
            const float* kf = KK + (size_t)((g * 2 + 0) * 32 + (lf >= 0 ? lf : 0)) * 256 + co * 16 + ci0;
            const float* kb = KK + (size_t)((g * 2 + 1) * 32 + (lb >= 0 ? lb : 0)) * 256 + co * 16 + ci0;
            const f32x4 f0 = *(const f32x4*)kf, f1 = *(const f32x4*)(kf + 4), b0 = *(const f32x4*)kb, b1 = *(const f32x4*)(kb + 4);
            const float dsk = p.in[I_S5D][16 * g + co];
#pragma unroll
            for (int j = 0; j < 4; ++j) {
                v[j] = f0[j] * mf + b0[j] * mb + ((s_ == t && ci0 + j == co) ? dsk : 0.f);
                v[4 + j] = f1[j] * mf + b1[j] * mb + ((s_ == t && ci0 + 4 + j == co) ? dsk : 0.f);
            }
        } else {
            const int kk = k0 - 512, d = kk >> 7, ri = (kk >> 6) & 1, p0 = kk & 63, jj = d == 0 ? t + 1 : 32 - t;
            const float* pw = PWG + ((size_t)((g * 2 + d) * 33 + jj) * 64 + p0) * 2;
            const float* crp = p.in[I_CRE] + (size_t)((d * 32 + g) * 16 + co) * 64 + p0; const float* cip = p.in[I_CIM] + (size_t)((d * 32 + g) * 16 + co) * 64 + p0;
            f32x4 pq[4];
#pragma unroll
            for (int q = 0; q < 4; ++q) pq[q] = *(const f32x4*)(pw + 4 * q);
            const f32x4 cr0 = *(const f32x4*)crp, cr1 = *(const f32x4*)(crp + 4), ci0v = *(const f32x4*)cip, ci1v = *(const f32x4*)(cip + 4);
#pragma unroll
            for (int j = 0; j < 8; ++j) {
                const float pr = pq[j >> 1][(j & 1) * 2], pi = pq[j >> 1][(j & 1) * 2 + 1];
                const float cr = j < 4 ? cr0[j & 3] : cr1[j & 3], cim = j < 4 ? ci0v[j & 3] : ci1v[j & 3];
                const float zr = cr * pr - cim * pi, zi = cr * pi + cim * pr;
                v[j] = ri == 0 ? zr : -zi;
            }
        }
        u32x4 w; w.x = pk2(v[0], v[1]); w.y = pk2(v[2], v[3]); w.z = pk2(v[4], v[5]); w.w = pk2(v[6], v[7]);
        *(u32x4*)(ME + ((size_t)(g * 512 + n)) * 768 + k0) = w;
    }
    for (int ch = gt; ch < 32 * 256 * 64; ch += NT) {
        const int kc = ch & 63, n = (ch >> 6) & 255, g = ch >> 14, d = n >> 7, ri = (n >> 6) & 1, pp = n & 63, k0 = kc * 8, s_ = k0 >> 4, ci0 = k0 & 15;
        const int jj = d == 0 ? 31 - s_ : s_;
        const float pr = PWG[((size_t)((g * 2 + d) * 33 + jj) * 64 + pp) * 2], pi = PWG[((size_t)((g * 2 + d) * 33 + jj) * 64 + pp) * 2 + 1];
        const float* bb = BBG + ((size_t)(g * 2 + d) * 1024 + pp * 16 + ci0) * 2;
        f32x4 bq[4];
#pragma unroll
        for (int q = 0; q < 4; ++q) bq[q] = *(const f32x4*)(bb + 4 * q);
        float v[8];
#pragma unroll
        for (int j = 0; j < 8; ++j) {
            const float br = bq[j >> 1][(j & 1) * 2], bi = bq[j >> 1][(j & 1) * 2 + 1];
            v[j] = ri == 0 ? (pr * br - pi * bi) : (pr * bi + pi * br);
        }
        u32x4 w; w.x = pk2(v[0], v[1]); w.y = pk2(v[2], v[3]); w.z = pk2(v[4], v[5]); w.w = pk2(v[6], v[7]);
        *(u32x4*)(WF + ((size_t)(g * 256 + n)) * 512 + k0) = w;
    }
}

template <int SRC>
__device__ __forceinline__ void norm_load(const Params& p, int row, int lane, f32x4 (&v)[4]) {
    if (SRC == 0) {
        const float* src = (row < NLAT ? p.in[I_X] + (size_t)row * DM : p.in[I_CTX] + (size_t)(row - NLAT) * DM) + 8 * lane;
        v[0] = *(const f32x4*)(src); v[1] = *(const f32x4*)(src + 4); v[2] = *(const f32x4*)(src + 512); v[3] = *(const f32x4*)(src + 516);
    } else {
        const bf16_t* src = (const bf16_t*)(p.ws + WS_XR) + (size_t)row * DM + 8 * lane;
        const u32x4 a = *(const u32x4*)(src), c = *(const u32x4*)(src + 512);
        v[0] = (f32x4){bflo(a.x), bfhi(a.x), bflo(a.y), bfhi(a.y)}; v[1] = (f32x4){bflo(a.z), bfhi(a.z), bflo(a.w), bfhi(a.w)};
        v[2] = (f32x4){bflo(c.x), bfhi(c.x), bflo(c.y), bfhi(c.y)}; v[3] = (f32x4){bflo(c.z), bfhi(c.z), bflo(c.w), bfhi(c.w)};
    }
}
template <int SRC>
__device__ __forceinline__ void phase_norm(const Ctx& X, const Params& p, int l, int ffn, int ntok) {
    const float* gain = (ffn ? p.in[I_NFG] : p.in[I_NMG]) + l * 1024;
    const float* mod = (const float*)(p.ws + WS_MOD) + (size_t)l * 9 * 6144;
    const int shi = ffn ? 3 : 0, sci = ffn ? 4 : 1;
    bf16_t* XA = (bf16_t*)(p.ws + WS_XA);
    const int rpw = (ntok + X.NGW - 1) / X.NGW, r0 = X.gw * rpw, r1 = (r0 + rpw) < ntok ? (r0 + rpw) : ntok;
    int curb = -1; f32x4 gm[4], sh[4];
    f32x4 vn[4];
    if (r0 < r1) norm_load<SRC>(p, r0, X.lane, vn);
    for (int row = r0; row < r1; ++row) {
        const int b = row < NLAT ? (row >> 11) : 8;
        if (b != curb) {
            curb = b;
#pragma unroll
            for (int j = 0; j < 4; ++j) {
                const int c = 8 * X.lane + 512 * (j >> 1) + 4 * (j & 1);
                const f32x4 g4 = *(const f32x4*)(gain + c), sc4 = *(const f32x4*)(mod + b * 6144 + sci * 1024 + c);
                sh[j] = *(const f32x4*)(mod + b * 6144 + shi * 1024 + c); gm[j] = g4 * (sc4 + 1.f);
            }
        }
        f32x4 v[4]; float ss = 0.f;
#pragma unroll
        for (int j = 0; j < 4; ++j) v[j] = vn[j];
        if (row + 1 < r1) norm_load<SRC>(p, row + 1, X.lane, vn);
#pragma unroll
        for (int j = 0; j < 4; ++j) ss += (v[j][0] * v[j][0] + v[j][1] * v[j][1]) + (v[j][2] * v[j][2] + v[j][3] * v[j][3]);
        const float rstd = rsqrtf(wave_sum(ss) * (1.f / 1024.f) + 1e-6f);
        const f32x4 o0 = v[0] * rstd * gm[0] + sh[0], o1 = v[1] * rstd * gm[1] + sh[1], o2 = v[2] * rstd * gm[2] + sh[2], o3 = v[3] * rstd * gm[3] + sh[3];
        *(u32x4*)(XA + (size_t)row * DM + 8 * X.lane) = pack8(o0, o1); *(u32x4*)(XA + (size_t)row * DM + 512 + 8 * X.lane) = pack8(o2, o3);
        if (SRC == 0) {
            bf16_t* XRw = (bf16_t*)(p.ws + WS_XR);
            *(u32x4*)(XRw + (size_t)row * DM + 8 * X.lane) = pack8(v[0], v[1]); *(u32x4*)(XRw + (size_t)row * DM + 512 + 8 * X.lane) = pack8(v[2], v[3]);
        }
    }
}

__device__ __forceinline__ void phase_scan_conv(const Ctx& X, const Params& p) {
    const float* F = (const float*)(p.ws + WS_F); bf16_t* A2 = (bf16_t*)(p.ws + WS_A2); const float* PWG = (const float*)(p.ws + WS_PW);
    for (int gid = X.blk * 512 + X.tid; gid < 32768; gid += X.G * 512) {
        const int pp = gid & 63, d = (gid >> 6) & 1, g = (gid >> 7) & 31, b = gid >> 12;
        const float ar = PWG[((size_t)((g * 2 + d) * 33 + 32) * 64 + pp) * 2], ai = PWG[((size_t)((g * 2 + d) * 33 + 32) * 64 + pp) * 2 + 1];
        float sr = 0.f, si = 0.f;
        for (int s8 = 0; s8 < 72; s8 += 8) {
            float fr[8], fi[8]; size_t ro[8];
#pragma unroll
            for (int q = 0; q < 8; ++q) {
                const int step = s8 + q; int r;
                if (d == 0) r = step < 8 ? 512 + b * 8 + step : b * 64 + (step - 8);
                else        r = step < 8 ? 512 + b * 8 + (7 - step) : b * 64 + (71 - step);
                ro[q] = (size_t)(g * S5RP + r);
                fr[q] = F[ro[q] * 256 + d * 128 + pp]; fi[q] = F[ro[q] * 256 + d * 128 + 64 + pp];
            }
#pragma unroll
            for (int q = 0; q < 8; ++q) {
                A2[ro[q] * S5K + 512 + d * 128 + pp] = (bf16_t)f2bf(sr); A2[ro[q] * S5K + 512 + d * 128 + 64 + pp] = (bf16_t)f2bf(si);
                const float nr = ar * sr - ai * si + fr[q], ni = ar * si + ai * sr + fi[q];
                sr = nr; si = ni;
            }
        }
    }
    const bf16_t* BCV = (const bf16_t*)(p.ws + WS_BCV); bf16_t* Z = (bf16_t*)(p.ws + WS_Z); const float* cw = p.in[I_CONVW];
    for (int it = X.blk * 512 + X.tid; it < NTOK * 64; it += X.G * 512) {
        const int tok = it >> 6, c0 = (it & 63) * 8;
        const int pos = tok < NLAT ? (tok & 2047) : ((tok - NLAT) & 255), len = tok < NLAT ? 2048 : 256;
        const bf16_t* base = BCV + (size_t)tok * 1536;
        const u32x4 bg = *(const u32x4*)(base + c0), cg1 = *(const u32x4*)(base + 512 + c0), v1 = *(const u32x4*)(base + 1024 + c0);
        u32x4 cg0 = (u32x4){0u, 0u, 0u, 0u}, v0 = cg0, cg2 = cg0, v2 = cg0;
        if (pos > 0) { cg0 = *(const u32x4*)(base - 1536 + 512 + c0); v0 = *(const u32x4*)(base - 1536 + 1024 + c0); }
        if (pos < len - 1) { cg2 = *(const u32x4*)(base + 1536 + 512 + c0); v2 = *(const u32x4*)(base + 1536 + 1024 + c0); }
        float o[8];
#pragma unroll
        for (int j = 0; j < 4; ++j) {
            const float w0a = cw[c0 + 2 * j], w1a = cw[512 + c0 + 2 * j], w2a = cw[1024 + c0 + 2 * j];
            const float w0b = cw[c0 + 2 * j + 1], w1b = cw[512 + c0 + 2 * j + 1], w2b = cw[1024 + c0 + 2 * j + 1];
            o[2 * j] = bflo(bg[j]) * (w0a * bflo(cg0[j]) * bflo(v0[j]) + w1a * bflo(cg1[j]) * bflo(v1[j]) + w2a * bflo(cg2[j]) * bflo(v2[j]));
            o[2 * j + 1] = bfhi(bg[j]) * (w0b * bfhi(cg0[j]) * bfhi(v0[j]) + w1b * bfhi(cg1[j]) * bfhi(v1[j]) + w2b * bfhi(cg2[j]) * bfhi(v2[j]));
        }
        u32x4 w; w.x = pk2(o[0], o[1]); w.y = pk2(o[2], o[3]); w.z = pk2(o[4], o[5]); w.w = pk2(o[6], o[7]);
        *(u32x4*)(Z + (size_t)tok * 1024 + 512 + c0) = w;
    }
}

constexpr int RR_MAXT = 96, RR_KC = 256, RR_PITCH = RR_KC * 2 + 16;
constexpr int RR_A = 0, RR_B = RR_MAXT * RR_PITCH, RR_LG = RR_B + 64 * RR_PITCH;
__device__ __forceinline__ void phase_route(const Ctx& X, const Params& p, int l, int ntok) {
    LAS int* cnt = (LAS int*)(X.lds + MISC_OFF + M_CNT);
    if (X.tid < NEXP1) cnt[X.tid] = 0;
    const bf16_t* XA = (const bf16_t*)(p.ws + WS_XA); const bf16_t* RT = (const bf16_t*)(p.ws + WS_ROUT) + (size_t)l * 256 * 1024;
    int* toke = (int*)(p.ws + WS_TOKE); float* tokw = (float*)(p.ws + WS_TOKW); int* tokp = (int*)(p.ws + WS_TOKP);
    const float rb = p.in[I_RB][l * 64 + X.lane];
    const int tpb = (ntok + X.G - 1) / X.G, t0 = X.blk * tpb, t1 = (t0 + tpb) < ntok ? (t0 + tpb) : ntok, nrow = t1 - t0;
    const int lane = X.lane, grp = lane >> 3, fr = lane & 15, fq = lane >> 4;
    const int nt_ = X.wave & 3, mh = X.wave >> 2;
    f32x4 acc[3];
#pragma unroll
    for (int m = 0; m < 3; ++m) acc[m] = (f32x4){0.f, 0.f, 0.f, 0.f};
    u32x4 va[6], vb[4];
#define RR_LOAD(kc_) do { \
        _Pragma("unroll") for (int q = 0; q < 6; ++q) { const int i = X.tid + 512 * q, r = i >> 5, c = i & 31; const int rr = r < nrow ? r : 0; \
            va[q] = *(const u32x4*)(XA + (size_t)(t0 + rr) * DM + (kc_) + 8 * c); if (r >= nrow) va[q] = (u32x4){0u, 0u, 0u, 0u}; } \
        _Pragma("unroll") for (int q = 0; q < 4; ++q) { const int i = X.tid + 512 * q, r = i >> 5, c = i & 31; vb[q] = *(const u32x4*)(RT + (size_t)r * 1024 + (kc_) + 8 * c); } } while (0)
    RR_LOAD(0);
    for (int kc = 0; kc < 1024; kc += RR_KC) {
        __syncthreads();
#pragma unroll
        for (int q = 0; q < 6; ++q) { const int i = X.tid + 512 * q, r = i >> 5, c = i & 31; *(LAS u32x4*)(X.lds + RR_A + r * RR_PITCH + 16 * c) = va[q]; }
#pragma unroll
        for (int q = 0; q < 4; ++q) { const int i = X.tid + 512 * q, r = i >> 5, c = i & 31; *(LAS u32x4*)(X.lds + RR_B + r * RR_PITCH + 16 * c) = vb[q]; }
        __syncthreads();
        if (kc + RR_KC < 1024) RR_LOAD(kc + RR_KC);
#pragma unroll
        for (int ks = 0; ks < RR_KC / 32; ++ks) {
            const bf16x8 bfr = *(const LAS bf16x8*)(X.lds + RR_B + (16 * nt_ + fr) * RR_PITCH + 64 * ks + 16 * fq);
#pragma unroll
            for (int m = 0; m < 3; ++m) {
                const bf16x8 afr = *(const LAS bf16x8*)(X.lds + RR_A + (16 * (3 * mh + m) + fr) * RR_PITCH + 64 * ks + 16 * fq);
                acc[m] = __builtin_amdgcn_mfma_f32_16x16x32_bf16(afr, bfr, acc[m], 0, 0, 0);
            }
        }
    }
#undef RR_LOAD
    LAS float* LG = (LAS float*)(X.lds + RR_LG);
#pragma unroll
    for (int m = 0; m < 3; ++m)
#pragma unroll
        for (int j = 0; j < 4; ++j) LG[(16 * (3 * mh + m) + 4 * fq + j) * 64 + 16 * nt_ + fr] = acc[m][j];
    __syncthreads();
    for (int tok = t0 + X.wave; tok < t1; tok += 8) {
        const float score = sigmoidf_(LG[(tok - t0) * 64 + lane]);
        const float sel = score + rb;
        int rk = 0;
#pragma unroll
        for (int x = 1; x < 8; ++x) { const float o = __shfl_xor(sel, x); const int ol = lane ^ x; rk += ((o > sel) || (o == sel && ol < lane)) ? 1 : 0; }
        float gs = rk < 2 ? sel : 0.f;
        gs += __shfl_xor(gs, 1); gs += __shfl_xor(gs, 2); gs += __shfl_xor(gs, 4);
        int grk = 0;
#pragma unroll
        for (int x = 1; x < 8; ++x) { const float o = __shfl_xor(gs, 8 * x); const int og = grp ^ x; grk += ((o > gs) || (o == gs && og < grp)) ? 1 : 0; }
        const float msel = grk < 4 ? sel : -__builtin_inff();
        int rank = 0;
#pragma unroll
        for (int j = 0; j < 64; ++j) { const float sj = __builtin_bit_cast(float, __builtin_amdgcn_readlane(__builtin_bit_cast(int, msel), j)); rank += ((sj > msel) || (sj == msel && j < lane)) ? 1 : 0; }
        const bool chosen = rank < 8;
        const float wsum = wave_sum(chosen ? score : 0.f);
        if (chosen) {
            const int lpos = __hip_atomic_fetch_add(cnt + lane, 1, __ATOMIC_RELAXED, __HIP_MEMORY_SCOPE_WORKGROUP);
            toke[(size_t)tok * 8 + rank] = lane; tokw[(size_t)tok * 8 + rank] = score / wsum * 2.5f; tokp[(size_t)tok * 8 + rank] = lpos;
        }
    }
    __syncthreads();
    int* cntblk = (int*)(p.ws + WS_CNTBLK);
    if (X.tid < NEXP1) cntblk[X.blk * NEXP1 + X.tid] = X.tid < NEXP ? cnt[X.tid] : 0;
}

__device__ __forceinline__ void phase_slots(const Ctx& X, const Params& p, int ntok) {
    LAS int* part = (LAS int*)(X.lds + MISC_OFF + M_PART);
    LAS int* ptot = (LAS int*)(X.lds);
    LAS int* pbb = (LAS int*)(X.lds + 4096);
    LAS int* base = (LAS int*)(X.lds + MISC_OFF + M_BASE);
    LAS int* bbase = (LAS int*)(X.lds + MISC_OFF + M_BBASE);
    LAS int* tot = (LAS int*)(X.lds + 8192);
    LAS int* ntl = (LAS int*)(X.lds + MISC_OFF + M_NT);
    (void)part;
    const int* cntblk = (const int*)(p.ws + WS_CNTBLK);
    {
        const int e = X.tid & 127, pt = X.tid >> 7; int s = 0, sb = 0;
        if (e < NEXP) { const int b0 = (X.G * pt) / 4, b1 = (X.G * (pt + 1)) / 4;
            for (int b = b0; b < b1; ++b) { const int c = cntblk[b * NEXP1 + e]; s += c; sb += (b < X.blk) ? c : 0; } }
        ptot[pt * 128 + e] = s; pbb[pt * 128 + e] = sb;
    }
    __syncthreads();
    if (X.tid < NEXP) { tot[X.tid] = ptot[X.tid] + ptot[128 + X.tid] + ptot[256 + X.tid] + ptot[384 + X.tid]; bbase[X.tid] = pbb[X.tid] + pbb[128 + X.tid] + pbb[256 + X.tid] + pbb[384 + X.tid]; }
    __syncthreads();
    if (X.tid == 0) { int acc = 0; for (int e = 0; e < NEXP; ++e) { base[e] = acc; acc += (tot[e] + 255) & ~255; } base[NEXP] = acc; base[NEXP1] = acc + ntok; ntl[0] = (acc + ntok) >> 8; }
    __syncthreads();
    int* rowidx = (int*)(p.ws + WS_ROWIDX); int* tokslot = (int*)(p.ws + WS_YROW);
    const int* toke = (const int*)(p.ws + WS_TOKE); const int* tokp = (const int*)(p.ws + WS_TOKP);
    const int tpb = (ntok + X.G - 1) / X.G, t0 = X.blk * tpb, t1 = (t0 + tpb) < ntok ? (t0 + tpb) : ntok;
    for (int i = t0 * 8 + X.tid; i < t1 * 8; i += 512) {
        const int e = toke[i]; const int slot = base[e] + bbase[e] + tokp[i];
        rowidx[slot] = i >> 3; tokslot[(i >> 3) * 9 + (i & 7)] = slot;
    }
    const int sbase = base[NEXP];
    for (int tok = X.blk * 512 + X.tid; tok < ntok; tok += X.G * 512) { rowidx[sbase + tok] = tok; tokslot[tok * 9 + 8] = sbase + tok; }
    for (int e = X.blk; e < NEXP; e += X.G)
        for (int s = base[e] + tot[e] + X.tid; s < base[e + 1]; s += 512) rowidx[s] = 0;
    if (X.blk == 0) {
        int* TAB = (int*)(p.ws + WS_TAB);
        if (X.tid == 0) TAB[128] = ntl[0];
        for (int t = X.tid; t < ntl[0]; t += 512) { int e = NEXP; const int s = t * 256; for (int k = 0; k < NEXP; ++k) if (s >= base[k] && s < base[k + 1]) e = k; TAB[256 + t] = e; }
    }
}
__device__ __forceinline__ int load_tiles(const Ctx& X, const Params& p) {
    const int* TAB = (const int*)(p.ws + WS_TAB);
    LAS unsigned char* te = X.lds + MISC_OFF + M_TILE;
    const int nt = TAB[128];
    for (int t = X.tid; t < nt; t += 512) te[t] = (unsigned char)TAB[256 + t];
    __syncthreads();
    return __builtin_amdgcn_readfirstlane(nt);
}

template <bool NEXTNORM>
__device__ __forceinline__ void phase_combine(const Ctx& X, const Params& p, int l, int ntok, bool final_out, float rs) {
    const unsigned char* Y = (const unsigned char*)(p.ws + WS_Y); bf16_t* XR = (bf16_t*)(p.ws + WS_XR);
    const int* tokslot = (const int*)(p.ws + WS_YROW); const float* tokw = (const float*)(p.ws + WS_TOKW);
    const float* gate = (const float*)(p.ws + WS_MOD) + (size_t)l * 9 * 6144 + 5 * 1024;
    const float* gain = p.in[I_NMG] + (l + 1) * 1024; const float* modn = (const float*)(p.ws + WS_MOD) + (size_t)(l + 1) * 9 * 6144;
    bf16_t* XN = (bf16_t*)(p.ws + WS_ACT);
    for (int tok = X.gw; tok < ntok; tok += X.NGW) {
        const int b = tok < NLAT ? (tok >> 11) : 8, c = 16 * X.lane;
        float s[16];
#pragma unroll
        for (int q = 0; q < 16; ++q) s[q] = 0.f;
#pragma unroll
        for (int j = 0; j < 9; ++j) {
            const int slot = __builtin_amdgcn_readfirstlane(tokslot[tok * 9 + j]);
            const float w = j < 8 ? __builtin_bit_cast(float, __builtin_amdgcn_readfirstlane(__builtin_bit_cast(int, tokw[tok * 8 + (j & 7)]))) : 1.f;
            const u32x4 y = *(const u32x4*)(Y + ((size_t)slot * 1024 + c));
#pragma unroll
            for (int q = 0; q < 4; ++q) {
                const f32x2 lo = __builtin_amdgcn_cvt_pk_f32_fp8((int)y[q], false), hi = __builtin_amdgcn_cvt_pk_f32_fp8((int)y[q], true);
                s[4 * q] += w * lo.x; s[4 * q + 1] += w * lo.y; s[4 * q + 2] += w * hi.x; s[4 * q + 3] += w * hi.y;
            }
        }
        const float* gp = gate + b * 6144 + c; bf16_t* xp = XR + (size_t)tok * DM + c;
        const float sc = rs * (1.f / 16.f);
        const u32x4 xa = *(const u32x4*)xp, xc = *(const u32x4*)(xp + 8);
        f32x4 o[4]; float ss = 0.f;
        o[0] = (f32x4){bflo(xa.x), bfhi(xa.x), bflo(xa.y), bfhi(xa.y)}; o[1] = (f32x4){bflo(xa.z), bfhi(xa.z), bflo(xa.w), bfhi(xa.w)};
        o[2] = (f32x4){bflo(xc.x), bfhi(xc.x), bflo(xc.y), bfhi(xc.y)}; o[3] = (f32x4){bflo(xc.z), bfhi(xc.z), bflo(xc.w), bfhi(xc.w)};
#pragma unroll
        for (int q = 0; q < 4; ++q) {
            const f32x4 g = *(const f32x4*)(gp + 4 * q) * sc;
            o[q] = o[q] + g * (f32x4){s[4 * q], s[4 * q + 1], s[4 * q + 2], s[4 * q + 3]};
            if (final_out) *(f32x4*)(p.out + (size_t)tok * DM + c + 4 * q) = o[q];
            ss += (o[q][0] * o[q][0] + o[q][1] * o[q][1]) + (o[q][2] * o[q][2] + o[q][3] * o[q][3]);
        }
        if (!final_out) { *(u32x4*)xp = pack8(o[0], o[1]); *(u32x4*)(xp + 8) = pack8(o[2], o[3]); }
        if (NEXTNORM) {
            const float rstd = rsqrtf(wave_sum(ss) * (1.f / 1024.f) + 1e-6f);
            u32x4 w0, w1;
#pragma unroll
            for (int q = 0; q < 4; ++q) {
                const f32x4 g4 = *(const f32x4*)(gain + c + 4 * q), sc4 = *(const f32x4*)(modn + b * 6144 + 1024 + c + 4 * q), sh4 = *(const f32x4*)(modn + b * 6144 + c + 4 * q);
                const f32x4 v = o[q] * rstd * (g4 * (sc4 + 1.f)) + sh4;
                if (q < 2) { w0[2 * q] = pk2(v[0], v[1]); w0[2 * q + 1] = pk2(v[2], v[3]); } else { w1[2 * (q - 2)] = pk2(v[0], v[1]); w1[2 * (q - 2) + 1] = pk2(v[2], v[3]); }
            }
            *(u32x4*)(XN + (size_t)tok * DM + c) = w0; *(u32x4*)(XN + (size_t)tok * DM + c + 8) = w1;
        }
    }
}

constexpr int AT_KB = 8192, AT_VB = 64 * 136, AT_K0 = 0, AT_V0 = 4 * AT_KB, AT_BIAS = 4 * AT_KB + 4 * AT_VB + 256, AT_BPAD = 48;
#define ATT_TILE(kb_, vb_, t0_, LAT_, brow4_, rpen_) do { \
    f32x16 sa; \
    _Pragma("unroll") for (int i = 0; i < 16; ++i) sa[i] = 0.f; \
    _Pragma("unroll") for (int s = 0; s < 4; ++s) { \
        const bf16x8 kf = *(const LAS bf16x8*)((kb_) + ((t0_) + l31) * 128 + (((2 * s + hh) ^ (l31 & 7)) << 4)); \
        sa = __builtin_amdgcn_mfma_f32_32x32x16_bf16(kf, qf[s], sa, 0, 0, 0); } \
    float tmax = -1e30f; \
    if (LAT_) { \
        const LAS float* bp = (const LAS float*)((const LAS unsigned char*)biasL + (brow4_)); \
        _Pragma("unroll") for (int i = 0; i < 16; ++i) { sa[i] = (sa[i] + bp[(i & 3) + 8 * (i >> 2)]) + (pen[i] + (rpen_)); tmax = fmaxf(tmax, sa[i]); } \
    } else { \
        _Pragma("unroll") for (int i = 0; i < 16; ++i) tmax = fmaxf(tmax, sa[i]); \
    } \
    tmax = fmaxf(tmax, __shfl_xor(tmax, 32)); \
    if (__any(tmax > mrun)) { \
        const float mnew = fmaxf(mrun, tmax), alpha = __builtin_amdgcn_exp2f(mrun - mnew); \
        lrun *= alpha; mrun = mnew; \
        _Pragma("unroll") for (int i = 0; i < 16; ++i) { o0[i] *= alpha; o1[i] *= alpha; } } \
    float psum = 0.f; \
    _Pragma("unroll") for (int i = 0; i < 16; ++i) { sa[i] = __builtin_amdgcn_exp2f(sa[i] - mrun); psum += sa[i]; } \
    lrun += psum; \
    bf16x8 pf0, pf1; \
    { u32x4 w0, w1; \
      _Pragma("unroll") for (int j = 0; j < 4; ++j) { w0[j] = pk2(sa[2 * j], sa[2 * j + 1]); w1[j] = pk2(sa[8 + 2 * j], sa[8 + 2 * j + 1]); } \
      pf0 = __builtin_bit_cast(bf16x8, w0); pf1 = __builtin_bit_cast(bf16x8, w1); } \
    const LAS unsigned char* v0p = (vb_) + l31 * 136 + 2 * (t0_) + 8 * hh; const LAS unsigned char* v1p = v0p + 32 * 136; \
    const s16x4 a0 = *(const LAS s16x4*)(v0p), a1 = *(const LAS s16x4*)(v0p + 16), a2 = *(const LAS s16x4*)(v0p + 32), a3 = *(const LAS s16x4*)(v0p + 48); \
    const s16x4 c0 = *(const LAS s16x4*)(v1p), c1 = *(const LAS s16x4*)(v1p + 16), c2 = *(const LAS s16x4*)(v1p + 32), c3 = *(const LAS s16x4*)(v1p + 48); \
    const bf16x8 va0 = __builtin_shufflevector(a0, a1, 0, 1, 2, 3, 4, 5, 6, 7), va1 = __builtin_shufflevector(a2, a3, 0, 1, 2, 3, 4, 5, 6, 7); \
    const bf16x8 vb0 = __builtin_shufflevector(c0, c1, 0, 1, 2, 3, 4, 5, 6, 7), vb1 = __builtin_shufflevector(c2, c3, 0, 1, 2, 3, 4, 5, 6, 7); \
    o0 = __builtin_amdgcn_mfma_f32_32x32x16_bf16(va0, pf0, o0, 0, 0, 0); o0 = __builtin_amdgcn_mfma_f32_32x32x16_bf16(va1, pf1, o0, 0, 0, 0); \
    o1 = __builtin_amdgcn_mfma_f32_32x32x16_bf16(vb0, pf0, o1, 0, 0, 0); o1 = __builtin_amdgcn_mfma_f32_32x32x16_bf16(vb1, pf1, o1, 0, 0, 0); \
    } while (0)
#define ATT_TILE2(kbA_, vbA_, t0A_, kbB_, vbB_, t0B_, LAT_, brow4A_, rpenA_, brow4B_, rpenB_) do { \
    f32x16 sa0, sa1; \
    _Pragma("unroll") for (int i = 0; i < 16; ++i) { sa0[i] = 0.f; sa1[i] = 0.f; } \
    _Pragma("unroll") for (int s = 0; s < 4; ++s) { \
        const bf16x8 kf0 = *(const LAS bf16x8*)((kbA_) + ((t0A_) + l31) * 128 + (((2 * s + hh) ^ (l31 & 7)) << 4)); \
        const bf16x8 kf1 = *(const LAS bf16x8*)((kbB_) + ((t0B_) + l31) * 128 + (((2 * s + hh) ^ (l31 & 7)) << 4)); \
        sa0 = __builtin_amdgcn_mfma_f32_32x32x16_bf16(kf0, qf[s], sa0, 0, 0, 0); \
        sa1 = __builtin_amdgcn_mfma_f32_32x32x16_bf16(kf1, qf[s], sa1, 0, 0, 0); } \
    float tmax = -1e30f; \
    if (LAT_) { \
        const LAS float* bpA = (const LAS float*)((const LAS unsigned char*)biasL + (brow4A_)); const LAS float* bpB = (const LAS float*)((const LAS unsigned char*)biasL + (brow4B_)); \
        _Pragma("unroll") for (int i = 0; i < 16; ++i) { \
            sa0[i] = (sa0[i] + bpA[(i & 3) + 8 * (i >> 2)]) + (pen[i] + (rpenA_)); sa1[i] = (sa1[i] + bpB[(i & 3) + 8 * (i >> 2)]) + (pen[i] + (rpenB_)); \
            tmax = fmaxf(tmax, fmaxf(sa0[i], sa1[i])); } \
    } else { \
        _Pragma("unroll") for (int i = 0; i < 16; ++i) tmax = fmaxf(tmax, fmaxf(sa0[i], sa1[i])); \
    } \
    tmax = fmaxf(tmax, __shfl_xor(tmax, 32)); \
    if (__any(tmax > mrun)) { \
        const float mnew = fmaxf(mrun, tmax), alpha = __builtin_amdgcn_exp2f(mrun - mnew); \
        lrun *= alpha; mrun = mnew; \
        _Pragma("unroll") for (int i = 0; i < 16; ++i) { o0[i] *= alpha; o1[i] *= alpha; } } \
    float psumA = 0.f, psumB = 0.f; \
    _Pragma("unroll") for (int i = 0; i < 16; ++i) { sa0[i] = __builtin_amdgcn_exp2f(sa0[i] - mrun); sa1[i] = __builtin_amdgcn_exp2f(sa1[i] - mrun); psumA += sa0[i]; psumB += sa1[i]; } \
    lrun += psumA + psumB; \
    bf16x8 pf0, pf1, pf2, pf3; \
    { u32x4 w0, w1, w2, w3; \
      _Pragma("unroll") for (int j = 0; j < 4; ++j) { w0[j] = pk2(sa0[2 * j], sa0[2 * j + 1]); w1[j] = pk2(sa0[8 + 2 * j], sa0[8 + 2 * j + 1]); \
                                                      w2[j] = pk2(sa1[2 * j], sa1[2 * j + 1]); w3[j] = pk2(sa1[8 + 2 * j], sa1[8 + 2 * j + 1]); } \
      pf0 = __builtin_bit_cast(bf16x8, w0); pf1 = __builtin_bit_cast(bf16x8, w1); pf2 = __builtin_bit_cast(bf16x8, w2); pf3 = __builtin_bit_cast(bf16x8, w3); } \
    { const LAS unsigned char* v0p = (vbA_) + l31 * 136 + 2 * (t0A_) + 8 * hh; const LAS unsigned char* v1p = v0p + 32 * 136; \
      const s16x4 a0 = *(const LAS s16x4*)(v0p), a1 = *(const LAS s16x4*)(v0p + 16), a2 = *(const LAS s16x4*)(v0p + 32), a3 = *(const LAS s16x4*)(v0p + 48); \
      const s16x4 c0 = *(const LAS s16x4*)(v1p), c1 = *(const LAS s16x4*)(v1p + 16), c2 = *(const LAS s16x4*)(v1p + 32), c3 = *(const LAS s16x4*)(v1p + 48); \
      const bf16x8 va0 = __builtin_shufflevector(a0, a1, 0, 1, 2, 3, 4, 5, 6, 7), va1 = __builtin_shufflevector(a2, a3, 0, 1, 2, 3, 4, 5, 6, 7); \
      const bf16x8 vb0 = __builtin_shufflevector(c0, c1, 0, 1, 2, 3, 4, 5, 6, 7), vb1 = __builtin_shufflevector(c2, c3, 0, 1, 2, 3, 4, 5, 6, 7); \
      o0 = __builtin_amdgcn_mfma_f32_32x32x16_bf16(va0, pf0, o0, 0, 0, 0); o1 = __builtin_amdgcn_mfma_f32_32x32x16_bf16(vb0, pf0, o1, 0, 0, 0); \
      o0 = __builtin_amdgcn_mfma_f32_32x32x16_bf16(va1, pf1, o0, 0, 0, 0); o1 = __builtin_amdgcn_mfma_f32_32x32x16_bf16(vb1, pf1, o1, 0, 0, 0); } \
    { const LAS unsigned char* v0p = (vbB_) + l31 * 136 + 2 * (t0B_) + 8 * hh; const LAS unsigned char* v1p = v0p + 32 * 136; \
      const s16x4 a0 = *(const LAS s16x4*)(v0p), a1 = *(const LAS s16x4*)(v0p + 16), a2 = *(const LAS s16x4*)(v0p + 32), a3 = *(const LAS s16x4*)(v0p + 48); \
      const s16x4 c0 = *(const LAS s16x4*)(v1p), c1 = *(const LAS s16x4*)(v1p + 16), c2 = *(const LAS s16x4*)(v1p + 32), c3 = *(const LAS s16x4*)(v1p + 48); \
      const bf16x8 va0 = __builtin_shufflevector(a0, a1, 0, 1, 2, 3, 4, 5, 6, 7), va1 = __builtin_shufflevector(a2, a3, 0, 1, 2, 3, 4, 5, 6, 7); \
      const bf16x8 vb0 = __builtin_shufflevector(c0, c1, 0, 1, 2, 3, 4, 5, 6, 7), vb1 = __builtin_shufflevector(c2, c3, 0, 1, 2, 3, 4, 5, 6, 7); \
      o0 = __builtin_amdgcn_mfma_f32_32x32x16_bf16(va0, pf2, o0, 0, 0, 0); o1 = __builtin_amdgcn_mfma_f32_32x32x16_bf16(vb0, pf2, o1, 0, 0, 0); \
      o0 = __builtin_amdgcn_mfma_f32_32x32x16_bf16(va1, pf3, o0, 0, 0, 0); o1 = __builtin_amdgcn_mfma_f32_32x32x16_bf16(vb1, pf3, o1, 0, 0, 0); } \
    } while (0)
__device__ __forceinline__ void phase_attn(const Ctx& X, const Params& p) {
    const bf16_t* Q = (const bf16_t*)(p.ws + WS_Q); const bf16_t* Kb = (const bf16_t*)(p.ws + WS_K); const bf16_t* VT = (const bf16_t*)(p.ws + WS_VT);
    bf16_t* O = (bf16_t*)(p.ws + WS_O);
    LAS float* biasL = (LAS float*)(X.lds + AT_BIAS);
    const int lane = X.lane, l31 = lane & 31, hh = lane >> 5, tid = X.tid;
    const float LOG2E = 1.4426950408889634f;
    const int skey = tid >> 3, sch = tid & 7;
    for (int task = X.blk; task < 256; task += X.G) {
        const int b = task >> 5, h = (task >> 1) & 15, hf = task & 1;
        __syncthreads();
        for (int i = tid; i < 465 + 2 * AT_BPAD + 64; i += 512) { const int j = i - AT_BPAD; biasL[i] = (j >= 0 && j < 465) ? p.in[I_RPB][h * 465 + j] * LOG2E : 0.f; }
        const bf16_t* vcol = VT + (size_t)skey * DM + h * 64 + 8 * sch;
        const bf16_t* kcol = Kb + (size_t)skey * DM + h * 64 + 8 * sch;
        for (int gq = 0; gq < 4; ++gq) {
            const int R0 = 16 * hf + 4 * gq;
            const int rp = X.wave >> 2, cb = X.wave & 3, r = R0 + 2 * rp, c0 = 16 * cb;
            const int t0 = cb == 0 ? 0 : (cb == 1 ? 8 : (cb == 2 ? 24 : 32));
            const int rq = r + (l31 >> 4), qc = c0 + (l31 & 15);
            const int r0q = rq < 4 ? 0 : (rq > 28 ? 24 : rq - 4);
            const int r0lo = r < 4 ? 0 : (r > 28 ? 24 : r - 4), r0hi = (r + 1 < 4 ? 0 : (r + 1 > 28 ? 24 : r + 1 - 4)) + 7;
            const int rmin = R0 < 4 ? 0 : (R0 > 28 ? 24 : R0 - 4);
            const int rl = R0 + 3, rmax = (rl < 4 ? 0 : (rl > 28 ? 24 : rl - 4)) + 7;
            const int nl = rmax - rmin + 1, nsteps = 2 + ((nl + 1) >> 1);
            const size_t qtok = (size_t)b * 2048 + rq * 64 + qc;
            bf16x8 qf[4];
#pragma unroll
            for (int s = 0; s < 4; ++s) qf[s] = *(const bf16x8*)(Q + qtok * DM + h * 64 + 16 * s + 8 * hh);
            const int cs = qc < 8 ? 0 : (qc > 56 ? 48 : qc - 8);
            float pen[16];
#pragma unroll
            for (int i = 0; i < 16; ++i) { const int kc = t0 + (i & 3) + 8 * (i >> 2) + 4 * hh; pen[i] = (kc >= cs && kc < cs + 16) ? 0.f : -1e30f; }
            const int lb4 = 4 * ((7 - (l31 >> 4)) * 31 + t0 - qc + 15 + 4 * hh + AT_BPAD);
            f32x16 o0, o1;
#pragma unroll
            for (int i = 0; i < 16; ++i) { o0[i] = 0.f; o1[i] = 0.f; }
            float mrun = -1e30f, lrun = 0.f;
            u32x4 kA0, kA1, vA0, vA1, kB0, kB1, vB0, vB1;
#define ATT_ISSUE(st_, k0_, k1_, v0r_, v1r_) do { int s_ = (st_); s_ = s_ < nsteps ? s_ : nsteps - 1; \
                size_t kt0_, kt1_; \
                if (s_ < 2) { kt0_ = (size_t)NLAT + b * 256 + s_ * 128; kt1_ = kt0_ + 64; } \
                else { const int ra_ = rmin + 2 * (s_ - 2), rb_ = ra_ + 1 <= rmax ? ra_ + 1 : rmax; kt0_ = (size_t)b * 2048 + ra_ * 64; kt1_ = (size_t)b * 2048 + rb_ * 64; } \
                k0_ = *(const u32x4*)(kcol + kt0_ * DM); k1_ = *(const u32x4*)(kcol + kt1_ * DM); v0r_ = *(const u32x4*)(vcol + kt0_ * DM); v1r_ = *(const u32x4*)(vcol + kt1_ * DM); } while (0)
#define ATT_WRITE(nb_, k0_, k1_, v0r_, v1r_) do { \
                LAS unsigned char* kw_ = X.lds + AT_K0 + (nb_) * 2 * AT_KB + skey * 128 + ((sch ^ (skey & 7)) << 4); \
                *(LAS u32x4*)(kw_) = k0_; *(LAS u32x4*)(kw_ + AT_KB) = k1_; \
                LAS unsigned short* vw_ = (LAS unsigned short*)(X.lds + AT_V0 + (nb_) * 2 * AT_VB + (8 * sch) * 136 + skey * 2);        \
                _Pragma("unroll") for (int j_ = 0; j_ < 4; ++j_) { \
                    vw_[(2 * j_) * 68] = (unsigned short)(v0r_[j_] & 0xffffu); vw_[(2 * j_ + 1) * 68] = (unsigned short)(v0r_[j_] >> 16); \
                    vw_[AT_VB / 2 + (2 * j_) * 68] = (unsigned short)(v1r_[j_] & 0xffffu); vw_[AT_VB / 2 + (2 * j_ + 1) * 68] = (unsigned short)(v1r_[j_] >> 16); } } while (0)
#define ATT_STEP(st_, cur_) do { const int st = (st_); \
                const LAS unsigned char* kb = X.lds + AT_K0 + (cur_) * 2 * AT_KB; const LAS unsigned char* vb = X.lds + AT_V0 + (cur_) * 2 * AT_VB; \
                if (st < 2) { ATT_TILE2(kb, vb, 0, kb, vb, 32, false, 0, 0.f, 0, 0.f); ATT_TILE2(kb + AT_KB, vb + AT_VB, 0, kb + AT_KB, vb + AT_VB, 32, false, 0, 0.f, 0, 0.f); } \
                else { const int ka = rmin + 2 * (st - 2), kc2 = ka + 1; \
                    const bool ina = ka >= r0lo && ka <= r0hi, inb = kc2 <= rmax && kc2 >= r0lo && kc2 <= r0hi; \
                    const float rpa = (ka >= r0q && ka < r0q + 8) ? 0.f : -1e30f, rpb = (kc2 >= r0q && kc2 < r0q + 8) ? 0.f : -1e30f; \
                    const int bra = lb4 + 4 * 31 * (ka - r), brb = lb4 + 4 * 31 * (kc2 - r); \
                    if (ina && inb) { ATT_TILE2(kb, vb, t0, kb + AT_KB, vb + AT_VB, t0, true, bra, rpa, brb, rpb); } \
                    else if (ina) { ATT_TILE(kb, vb, t0, true, bra, rpa); } \
                    else if (inb) { ATT_TILE(kb + AT_KB, vb + AT_VB, t0, true, brb, rpb); } } } while (0)
            ATT_ISSUE(0, kA0, kA1, vA0, vA1);
            ATT_ISSUE(1, kB0, kB1, vB0, vB1);
            __syncthreads();
            ATT_WRITE(0, kA0, kA1, vA0, vA1);
            __syncthreads();
            for (int sp = 0; sp < nsteps; sp += 2) {
                ATT_ISSUE(sp + 2, kA0, kA1, vA0, vA1);
                ATT_STEP(sp, 0);
                ATT_WRITE(1, kB0, kB1, vB0, vB1);
                __syncthreads();
                if (sp + 1 < nsteps) {
                    ATT_ISSUE(sp + 3, kB0, kB1, vB0, vB1);
                    ATT_STEP(sp + 1, 1);
                    ATT_WRITE(0, kA0, kA1, vA0, vA1);
                    __syncthreads();
                }
            }
#undef ATT_ISSUE
#undef ATT_WRITE
#undef ATT_STEP
            const float ltot = lrun + __shfl_xor(lrun, 32), inv = 1.f / ltot;
            bf16_t* op = O + qtok * DM + h * 64;
#pragma unroll
            for (int g = 0; g < 4; ++g) {
                u32x2 w; w.x = pk2(o0[4 * g] * inv, o0[4 * g + 1] * inv); w.y = pk2(o0[4 * g + 2] * inv, o0[4 * g + 3] * inv);
                *(u32x2*)(op + 8 * g + 4 * hh) = w;
                u32x2 w2; w2.x = pk2(o1[4 * g] * inv, o1[4 * g + 1] * inv); w2.y = pk2(o1[4 * g + 2] * inv, o1[4 * g + 3] * inv);
                *(u32x2*)(op + 32 + 8 * g + 4 * hh) = w2;
            }
        }
    }
}
#undef ATT_TILE
#undef ATT_TILE2


constexpr int N_PHASES = 23;
constexpr int C0A = 4800, C0B = 6400, C0C = 7600;
constexpr int C1A = 6000, C1B = 7000;
#ifndef PROBE_LO
#define PROBE_LO 99
#define PROBE_HI (-1)
#endif
__host__ __device__ constexpr int nrep(int k) { return (k >= PROBE_LO && k <= PROBE_HI) ? 2 : 1; }
__global__ void __launch_bounds__(512, 2) fwd_kernel(Params p) {
    extern __shared__ __attribute__((aligned(16))) unsigned char lds_raw[];
    LAS unsigned char* lds = (LAS unsigned char*)lds_raw;
    const int wave0 = __builtin_amdgcn_readfirstlane((int)(threadIdx.x >> 6));
    for (int u = threadIdx.x; u < (LDS_BYTES - MISC_OFF) / 4; u += 512) ((LAS unsigned*)(lds + MISC_OFF))[u] = 0u;
    __syncthreads();
    XcdBarrier bar; bar.bar = (unsigned*)(p.ws + WS_CTL) + 4096; bar.x = 0; bar.st = (volatile LAS unsigned*)(lds + MISC_OFF + M_BAR);
    if (p.ph_hi - p.ph_lo > 1) bar = xcd_barrier_post((unsigned*)(p.ws + WS_CTL) + 4096, (volatile LAS unsigned*)(lds + MISC_OFF + M_BAR));
#define PH(k) (p.ph_lo <= (k) && (k) < p.ph_hi)
#define SEAM(k) do { if (PH(k) && PH((k) + 1)) xcd_barrier(bar, wave0); } while (0)
#define RUN(k, ...) do { if (PH(k)) { _Pragma("unroll") for (int rep_ = 0; rep_ < nrep(k); ++rep_) { const float rs_ = rep_ == 0 ? 1.f : 0.f; (void)rs_; { __VA_ARGS__ } if (rep_ + 1 < nrep(k)) xcd_barrier(bar, wave0); } } SEAM(k); } while (0)
    unsigned char* ws = p.ws;
    const float* MOD = (const float*)(ws + WS_MOD);

    RUN(0, const Ctx X = mkctx(lds, wave0); phase_p0a(X, p););
    RUN(1, const Ctx X = mkctx(lds, wave0); phase_norm<0>(X, p, 0, 0, NTOK); phase_p0b(X, p););
    RUN(2,
        g8::RectSched S{72, 8, (int)gridDim.x, (int)blockIdx.x, 0u, 2048u, (const char*)(ws + WS_WIN), 2048u};
        EpiWin E{(bf16_t*)(ws + WS_A2), (bf16_t*)(ws + WS_BCV)};
        g8::gemm_phase(lds, wave0, (const char*)(ws + WS_XA), 1024, 2048u, S, E);
        { const Ctx X = mkctx(lds, wave0); int nidle; const int rk = idle_rank(576, X.G, X.blk, nidle);
          if (rk >= 0) { conv_small(X, p, rk, nidle); conv_moe_items<0>(X, p, 0, (bf16_t*)(ws + WS_GU), (bf16_t*)(ws + WS_DN), 0, C0A, rk, nidle); } });
    RUN(3,
        g8::BatchSched S{32, 3, 1, (int)gridDim.x, (int)blockIdx.x, 1536u, (const char*)(ws + WS_WF), 1024u, 256};
        EpiS5F E{(float*)(ws + WS_F)};
        g8::gemm_phase(lds, wave0, (const char*)(ws + WS_A2), 512, 1024u, S, E);
        { const Ctx X = mkctx(lds, wave0); int nidle; const int rk = moe_idle_rank(96, 1, X.G, X.blk, nidle);
          if (rk >= 0) conv_moe_items<0>(X, p, 0, (bf16_t*)(ws + WS_GU), (bf16_t*)(ws + WS_DN), C0A, C0B, rk, nidle); });
    RUN(4, const Ctx X = mkctx(lds, wave0); phase_scan_conv(X, p););
    RUN(5,
        g8::BatchSched S{32, 3, 2, (int)gridDim.x, (int)blockIdx.x, 1536u, (const char*)(ws + WS_ME), 1536u, 512};
        EpiS5Y E{(bf16_t*)(ws + WS_G)};
        g8::gemm_phase(lds, wave0, (const char*)(ws + WS_A2), 768, 1536u, S, E););
    RUN(6,
        g8::RectSched S{72, 2, (int)gridDim.x, (int)blockIdx.x, 0u, 1024u, (const char*)(ws + WS_GLU), 1024u};
        EpiGlu E{(const bf16_t*)(ws + WS_G), p.in[I_GLUB], (bf16_t*)(ws + WS_Z)};
        g8::gemm_phase(lds, wave0, (const char*)(ws + WS_G), 512, 1024u, S, E);
        { const Ctx X = mkctx(lds, wave0); int nidle; const int rk = idle_rank(144, X.G, X.blk, nidle);
          if (rk >= 0) conv_moe_items<0>(X, p, 0, (bf16_t*)(ws + WS_GU), (bf16_t*)(ws + WS_DN), C0B, C0C, rk, nidle); });
    RUN(7,
        g8::RectSched S{72, 4, (int)gridDim.x, (int)blockIdx.x, 0u, 2048u, (const char*)(ws + WS_HOUT), 2048u};
        EpiResid E{MOD + 2 * 1024, (bf16_t*)(ws + WS_XR), rs_};
        g8::gemm_phase(lds, wave0, (const char*)(ws + WS_Z), 1024, 2048u, S, E);
        { const Ctx X = mkctx(lds, wave0); int nidle; const int rk = idle_rank(288, X.G, X.blk, nidle);
          if (rk >= 0) conv_moe_items<0>(X, p, 0, (bf16_t*)(ws + WS_GU), (bf16_t*)(ws + WS_DN), C0C, 12480, rk, nidle); });
#define MOE_PHASES(P0, L, NTOKL, FINAL) \
    RUN(P0, const Ctx X = mkctx(lds, wave0); phase_norm<1>(X, p, L, 1, NTOKL);); \
    RUN(P0 + 1, const Ctx X = mkctx(lds, wave0); phase_route(X, p, L, NTOKL);); \
    RUN(P0 + 2, const Ctx X = mkctx(lds, wave0); phase_slots(X, p, NTOKL);); \
    RUN(P0 + 3, \
        const Ctx X = mkctx(lds, wave0); const int ntiles = load_tiles(X, p); \
        g8::MoeSched<true> S{ntiles, 2, (int)gridDim.x, (int)blockIdx.x, 2048u, (const char*)(ws + (L == 0 ? WS_GU : WS_GU1)), 2048u, 512, 0, 128, lds + MISC_OFF + M_TILE, (const int*)(ws + WS_ROWIDX)}; \
        EpiGU E{(bf16_t*)(ws + WS_ACT)}; \
        g8::gemm_phase(lds, wave0, (const char*)(ws + WS_XA), 1024, 2048u, S, E); \
        { const Ctx X2 = mkctx(lds, wave0); int nidle; const int rk = moe_idle_rank(ntiles, 2, X2.G, X2.blk, nidle);        \
          if (rk >= 0 && L == 0) conv_moe_items<1>(X2, p, 1, (bf16_t*)(ws + WS_GU1), nullptr, 0, C1A, rk, nidle); }); \
    RUN(P0 + 4, \
        const Ctx X = mkctx(lds, wave0); const int ntiles = load_tiles(X, p); \
        g8::MoeSched<false> S{ntiles, 4, (int)gridDim.x, (int)blockIdx.x, 512u, (const char*)(ws + WS_DN), 512u, 1024, 0, 256, lds + MISC_OFF + M_TILE, nullptr}; \
        EpiDN E{(unsigned char*)(ws + WS_Y)}; \
        g8::gemm_phase(lds, wave0, (const char*)(ws + WS_ACT), 256, 512u, S, E); \
        { const Ctx X2 = mkctx(lds, wave0); int nidle; const int rk = moe_idle_rank(ntiles, 4, X2.G, X2.blk, nidle); \
          if (rk >= 0 && L == 0) conv_moe_items<1>(X2, p, 1, (bf16_t*)(ws + WS_GU1), nullptr, C1A, C1B, rk, nidle); }); \
    RUN(P0 + 5, const Ctx X = mkctx(lds, wave0); phase_combine<!FINAL>(X, p, L, NTOKL, FINAL, 1.f););

    MOE_PHASES(8, 0, NTOK, false)
    RUN(14,
        g8::QkvSched S{(int)gridDim.x, (int)blockIdx.x, 2048u, (const char*)(ws + WS_QKV), 2048u};
        EpiQKV E{(bf16_t*)(ws + WS_Q), (bf16_t*)(ws + WS_K), (bf16_t*)(ws + WS_VT), p.in[I_QG], p.in[I_KG]};
        g8::gemm_phase(lds, wave0, (const char*)(ws + WS_ACT), 1024, 2048u, S, E);
        { const Ctx X = mkctx(lds, wave0); int nidle; const int rk = idle_rank(832, X.G, X.blk, nidle);
          if (rk >= 0) { conv_moe_items<1>(X, p, 1, (bf16_t*)(ws + WS_GU1), nullptr, C1B, 8320, rk, nidle);
                         conv_moe_items<2>(X, p, 1, nullptr, (bf16_t*)(ws + WS_DN), 0, 4160, rk, nidle); } });
    RUN(15, const Ctx X = mkctx(lds, wave0); phase_attn(X, p););
    RUN(16,
        g8::RectSched S{64, 4, (int)gridDim.x, (int)blockIdx.x, 0u, 2048u, (const char*)(ws + WS_NOUT), 2048u};
        EpiResid E{MOD + 9 * 6144 + 2 * 1024, (bf16_t*)(ws + WS_XR), rs_};
        g8::gemm_phase(lds, wave0, (const char*)(ws + WS_O), 1024, 2048u, S, E););
    MOE_PHASES(17, 1, NLAT, true)
#undef PH
#undef SEAM
#undef RUN
}

extern "C" void kernel_launch(void* const* d_in, const int* in_sizes, int n_in, void* d_out, int out_size, void* d_ws, size_t ws_size, hipStream_t stream) {
    static int grid = 0;
    if (grid == 0) {
        int dev = 0, cus = 0, per_cu = 0;
        if (n_in != 34 || ws_size < WS_END) { fprintf(stderr, "kernel_launch: unexpected inputs (n_in %d, ws %zu, need %zu)\n", n_in, ws_size, (size_t)WS_END); grid = -1; return; }
        if (hipGetDevice(&dev) != hipSuccess || hipDeviceGetAttribute(&cus, hipDeviceAttributeMultiprocessorCount, dev) != hipSuccess) { grid = -1; return; }
        if (hipFuncSetAttribute((const void*)fwd_kernel, hipFuncAttributeMaxDynamicSharedMemorySize, LDS_BYTES) != hipSuccess) { fprintf(stderr, "kernel_launch: hipFuncSetAttribute failed\n"); grid = -1; return; }
        if (hipOccupancyMaxActiveBlocksPerMultiprocessor(&per_cu, (const void*)fwd_kernel, 512, LDS_BYTES) != hipSuccess || per_cu < 1) { fprintf(stderr, "kernel_launch: occupancy query says %d\n", per_cu); }
        (void)hipGetLastError();
        grid = cus;
    }
    if (grid < 0) return;
    (void)hipMemsetAsync((char*)d_ws + WS_CTL, 0, 64 * 1024, stream);
    Params p{};
    for (int i = 0; i < 34; ++i) p.in[i] = (const float*)d_in[i];
    p.out = (float*)d_out; p.ws = (unsigned char*)d_ws;
#if MK_ONE_LAUNCH
    p.ph_lo = 0; p.ph_hi = N_PHASES;
    hipLaunchKernelGGL(fwd_kernel, dim3(grid), dim3(512), LDS_BYTES, stream, p);
#else
    for (int k = 0; k < N_PHASES; ++k) { p.ph_lo = k; p.ph_hi = k + 1; hipLaunchKernelGGL(fwd_kernel, dim3(grid), dim3(512), LDS_BYTES, stream, p); }
#endif
}
```

```cpp
#include <hip/hip_runtime.h>
#include <stdint.h>
#include <stdio.h>

#ifndef MK_ONE_LAUNCH
#define MK_ONE_LAUNCH 1
#endif

#define GAS __attribute__((address_space(1)))
#define LAS __attribute__((address_space(3)))
typedef unsigned short bf16_t;
typedef short bf16x8 __attribute__((ext_vector_type(8)));
typedef short s16x4 __attribute__((ext_vector_type(4)));
typedef float f32x4 __attribute__((ext_vector_type(4)));
typedef float f32x2 __attribute__((ext_vector_type(2)));
typedef float f32x16 __attribute__((ext_vector_type(16)));
typedef unsigned u32x4 __attribute__((ext_vector_type(4)));
typedef unsigned u32x2 __attribute__((ext_vector_type(2)));

constexpr int NLAT = 16384, NCTX = 2048, NTOK = NLAT + NCTX, DM = 1024;
constexpr int SEQ = 2048, CTXL = 256, NB = 8;
constexpr int NEXP = 64, NEXP1 = 65, EDIM = 256;
constexpr int S5T = 32;
constexpr int S5R = 576, S5RP = 768;
constexpr int S5K = 768;
constexpr int MAXTILES = 712;

constexpr size_t MiB = 1ull << 20;
constexpr size_t WS_CTL = 0;
constexpr size_t WS_MOD = 1 * MiB;
constexpr size_t WS_WIN = 2 * MiB;
constexpr size_t WS_GLU = 6 * MiB;
constexpr size_t WS_HOUT = 7 * MiB;
constexpr size_t WS_QKV = 9 * MiB;
constexpr size_t WS_NOUT = 15 * MiB;
constexpr size_t WS_ROUT = 17 * MiB;
constexpr size_t WS_GU = 18 * MiB;
constexpr size_t WS_DN = 83 * MiB;
constexpr size_t WS_GU1 = 116 * MiB;
constexpr size_t WS_XR = 181 * MiB;
constexpr size_t WS_LOGIT = 253 * MiB;
constexpr size_t WS_TOKE = 258 * MiB;
constexpr size_t WS_TOKW = 259 * MiB;
constexpr size_t WS_TOKP = 260 * MiB;
constexpr size_t WS_ROWIDX = 261 * MiB;
constexpr size_t WS_YROW = 262 * MiB;
constexpr size_t WS_CNTBLK = 263 * MiB;
constexpr size_t WS_TAB = 263 * MiB + 512 * 1024;
constexpr size_t WS_XA = 264 * MiB;
constexpr size_t WS_OVL = 300 * MiB;
constexpr size_t WS_A2 = WS_OVL;
constexpr size_t WS_BCV = WS_OVL + 36 * MiB;
constexpr size_t WS_F = WS_OVL + 90 * MiB;
constexpr size_t WS_Z = WS_OVL + 114 * MiB;
constexpr size_t WS_G = WS_OVL + 150 * MiB;
constexpr size_t WS_ME = WS_OVL + 168 * MiB;
constexpr size_t WS_WF = WS_OVL + 192 * MiB;
constexpr size_t WS_KK = WS_OVL + 200 * MiB;
constexpr size_t WS_PW = WS_OVL + 202 * MiB;
constexpr size_t WS_BB = WS_OVL + 204 * MiB;
constexpr size_t WS_ADAP = WS_OVL + 205 * MiB;
constexpr size_t WS_Q = WS_OVL;
constexpr size_t WS_K = WS_OVL + 32 * MiB;
constexpr size_t WS_VT = WS_OVL + 68 * MiB;
constexpr size_t WS_O = WS_OVL + 104 * MiB;
constexpr size_t WS_Y = WS_XA;
constexpr size_t WS_ACT = WS_XA + 178 * MiB;
constexpr size_t WS_END = WS_ACT + 89 * MiB;

constexpr int RING_BYTES = 131072;
constexpr int MISC_OFF = RING_BYTES;
constexpr int LDS_BYTES = 147456;
constexpr int M_BAR = LDS_BYTES - MISC_OFF - 64, M_CNT = 64, M_BASE = 384, M_BBASE = 704, M_TILE = 1024, M_PART = 2048, M_NT = 3200;

__device__ __forceinline__ unsigned f2bf(float f) { unsigned u = __builtin_bit_cast(unsigned, f); return (u + 0x7fffu + ((u >> 16) & 1u)) >> 16; }
typedef __bf16 hbf16x2 __attribute__((ext_vector_type(2)));
__device__ __forceinline__ unsigned pk2(float lo, float hi) { const f32x2 v = {lo, hi}; const hbf16x2 b = __builtin_convertvector(v, hbf16x2); return __builtin_bit_cast(unsigned, b); }
__device__ __forceinline__ float bflo(unsigned w) { return __builtin_bit_cast(float, w << 16); }
__device__ __forceinline__ float bfhi(unsigned w) { return __builtin_bit_cast(float, w & 0xffff0000u); }
__device__ __forceinline__ float bf1(bf16_t b) { return __builtin_bit_cast(float, ((unsigned)b) << 16); }
__device__ __forceinline__ float wave_sum(float v) {
#pragma unroll
    for (int o = 1; o < 64; o <<= 1) v += __shfl_xor(v, o);
    return v;
}
__device__ __forceinline__ float wave_max_uniform(float v) {
#define WMX_STEP(ctrl_, rmask_) v = fmaxf(v, __builtin_bit_cast(float, __builtin_amdgcn_update_dpp(__builtin_bit_cast(int, v), __builtin_bit_cast(int, v), ctrl_, rmask_, 0xf, false)))
    WMX_STEP(0x111, 0xf); WMX_STEP(0x112, 0xf); WMX_STEP(0x114, 0xf); WMX_STEP(0x118, 0xf);
    WMX_STEP(0x142, 0xa); WMX_STEP(0x143, 0xc);
#undef WMX_STEP
    return __builtin_bit_cast(float, __builtin_amdgcn_readlane(__builtin_bit_cast(int, v), 63));
}
__device__ __forceinline__ float wave_sum_uniform(float v) {
#define WSM_STEP(ctrl_, rmask_) v += __builtin_bit_cast(float, __builtin_amdgcn_update_dpp(0, __builtin_bit_cast(int, v), ctrl_, rmask_, 0xf, true))
    WSM_STEP(0x111, 0xf); WSM_STEP(0x112, 0xf); WSM_STEP(0x114, 0xf); WSM_STEP(0x118, 0xf);
    WSM_STEP(0x142, 0xa); WSM_STEP(0x143, 0xc);
#undef WSM_STEP
    return __builtin_bit_cast(float, __builtin_amdgcn_readlane(__builtin_bit_cast(int, v), 63));
}
template <int X> __device__ __forceinline__ float dpp_xor8(float v) {
    int r = __builtin_bit_cast(int, v);
    if (X & 4) { r = __builtin_amdgcn_update_dpp(r, r, 0x141, 0xf, 0xf, false);
        constexpr int Y = (X ^ 7) & 3;
        if (Y == 1) r = __builtin_amdgcn_update_dpp(r, r, 0xB1, 0xf, 0xf, false); else if (Y == 2) r = __builtin_amdgcn_update_dpp(r, r, 0x4E, 0xf, 0xf, false); else if (Y == 3) r = __builtin_amdgcn_update_dpp(r, r, 0x1B, 0xf, 0xf, false);
    } else {
        if (X == 1) r = __builtin_amdgcn_update_dpp(r, r, 0xB1, 0xf, 0xf, false); else if (X == 2) r = __builtin_amdgcn_update_dpp(r, r, 0x4E, 0xf, 0xf, false); else if (X == 3) r = __builtin_amdgcn_update_dpp(r, r, 0x1B, 0xf, 0xf, false);
    }
    return __builtin_bit_cast(float, r);
}
__device__ __forceinline__ float add_xor16(float v) { const auto r = __builtin_amdgcn_permlane16_swap(__builtin_bit_cast(unsigned, v), __builtin_bit_cast(unsigned, v), false, false);
    return __builtin_bit_cast(float, (unsigned)r[0]) + __builtin_bit_cast(float, (unsigned)r[1]); }
__device__ __forceinline__ float add_xor32(float v) { const auto r = __builtin_amdgcn_permlane32_swap(__builtin_bit_cast(unsigned, v), __builtin_bit_cast(unsigned, v), false, false);
    return __builtin_bit_cast(float, (unsigned)r[0]) + __builtin_bit_cast(float, (unsigned)r[1]); }
__device__ __forceinline__ float sigmoidf_(float x) { return __builtin_amdgcn_rcpf(1.f + __expf(-x)); }
__device__ __forceinline__ float siluf_(float x) { return x * __builtin_amdgcn_rcpf(1.f + __expf(-x)); }
__device__ __forceinline__ float gelu_tanh(float x) {
    const float q = x * __builtin_fmaf(x * x, 0.044715f, 1.f);
    const float e = __builtin_amdgcn_exp2f(q * (-2.f * 0.7978845608028654f * 1.4426950408889634f));
    return x * __builtin_amdgcn_rcpf(1.f + e);
}

__device__ __forceinline__ int lane_id_opaque() { int l; asm volatile("v_mbcnt_lo_u32_b32 %0, -1, 0\n\tv_mbcnt_hi_u32_b32 %0, -1, %0" : "=v"(l)); return l; }

#define XB_TMO      128
#define XB_XCNT(j)  (256  + 64 * (j))
#define XB_XSUB(j)  (1280 + 64 * (j))
#define XB_XGEN(j)  (2304 + 64 * (j))
#define XB_TOP      3328
#define XB_TOPGEN   3392
#define XCD_BAR_WORDS 3456
#define XB_SPIN_CAP (1u << 18)
__device__ __forceinline__ unsigned xb_ld(unsigned* p)              { return __hip_atomic_load(p, __ATOMIC_RELAXED, __HIP_MEMORY_SCOPE_AGENT); }
__device__ __forceinline__ unsigned xb_add(unsigned* p, unsigned v) { return __hip_atomic_fetch_add(p, v, __ATOMIC_RELAXED, __HIP_MEMORY_SCOPE_AGENT); }
__device__ __forceinline__ unsigned xb_xcc_id() { return (unsigned)__builtin_amdgcn_s_getreg((3 << 11) | 20) & 0xFu; }
#define XB_SPIN(cond, bar) do { unsigned _sp = 0; while (cond) { __builtin_amdgcn_s_sleep(1); \
    if ((++_sp & 255u) == 0u) { if (xb_ld(&(bar)[XB_TMO])) break; if (_sp > XB_SPIN_CAP) { atomicAdd(&(bar)[XB_TMO], 1u); break; } } } } while (0)
struct XcdBarrier { unsigned* bar; unsigned x; volatile LAS unsigned* st; };
__device__ __forceinline__ XcdBarrier xcd_barrier_post(unsigned* bar, volatile LAS unsigned* st) {
    XcdBarrier b; b.bar = bar; b.x = xb_xcc_id(); b.st = st;
    if (threadIdx.x == 0) (void)xb_add(&bar[XB_XCNT(b.x)], 1u);
    return b;
}
__device__ __forceinline__ void xcd_barrier_complete(unsigned* bar, unsigned x, unsigned& nloc, unsigned& nx) {
    const unsigned G = gridDim.x * gridDim.y * gridDim.z;
    unsigned sum, cnt, mine, sp = 0u;
    for (;;) {
        sum = 0u; cnt = 0u; mine = 0u;
#pragma unroll
        for (unsigned j = 0; j < 16; ++j) { const unsigned c = xb_ld(&bar[XB_XCNT(j)]); sum += c; cnt += (c > 0u) ? 1u : 0u; mine = (j == x) ? c : mine; }
        if (sum == G) break;
        __builtin_amdgcn_s_sleep(1);
        if ((++sp & 255u) == 0u) { if (xb_ld(&bar[XB_TMO])) break; if (sp > XB_SPIN_CAP) { atomicAdd(&bar[XB_TMO], 1u); break; } }
    }
    nloc = mine > 0u ? mine : 1u; nx = cnt > 0u ? cnt : 1u;
}
__device__ __forceinline__ void xcd_barrier(const XcdBarrier& b, const int wave0) {
    asm volatile("s_waitcnt vmcnt(0)" ::: "memory");
    __syncthreads();
    if (wave0 == 0 && lane_id_opaque() == 0) {
        unsigned* bar = b.bar;
        __builtin_amdgcn_s_waitcnt(0);
        unsigned nloc = b.st[0], nx = b.st[1];
        if (nloc == 0u) { xcd_barrier_complete(bar, b.x, nloc, nx); b.st[0] = nloc; b.st[1] = nx; }
        const unsigned old = xb_add(&bar[XB_XSUB(b.x)], 1u);
        const unsigned gen = old / nloc;
        if (old + 1u == (gen + 1u) * nloc) {
            __builtin_amdgcn_fence(__ATOMIC_RELEASE, "agent");
            asm volatile("s_waitcnt vmcnt(0)" ::: "memory");
            const unsigned og = xb_add(&bar[XB_TOP], 1u);
            const unsigned tgt = (og / nx + 1u) * nx;
            if (og + 1u != tgt) XB_SPIN(xb_ld(&bar[XB_TOP]) < tgt, bar);
            __builtin_amdgcn_fence(__ATOMIC_ACQUIRE, "agent");
            asm volatile("s_waitcnt vmcnt(0)" ::: "memory");
        } else {
            const unsigned tgt = (gen + 1u) * nx;
            XB_SPIN(xb_ld(&bar[XB_TOP]) < tgt, bar);
            __builtin_amdgcn_fence(__ATOMIC_ACQUIRE, "agent");
            asm volatile("s_waitcnt vmcnt(0)" ::: "memory");
        }
    }
    __syncthreads();
}

namespace g8 {
constexpr int BM = 256, BK = 64, HALF = 128, HTB = HALF * BK * 2, STAGE_BYTES = 8 * HTB, NXCD = 8, WGM = 8;
__host__ __device__ __forceinline__ int lds_byte(int r, int c) { const int st = (r >> 4) * 2 + (c >> 5), rr = r & 15, cc = c & 31, ob = rr * 64 + cc * 2; return st * 1024 + (ob ^ (((ob >> 9) & 1) << 5)); }
__host__ __device__ __forceinline__ void stage_rc(int b, int& R, int& C) { const int st = b / 1024, sb = b % 1024, swz = sb ^ (((sb >> 9) & 1) << 5); R = (st >> 1) * 16 + swz / 64; C = (st & 1) * 32 + (swz % 64) / 2; }
__host__ __device__ __forceinline__ int perm32(int rho) { const int n = rho >> 4, i = rho & 15; return 8 * (i >> 2) + 4 * n + (i & 3); }

struct Unit { unsigned a0; const char* B; int p0, p1, p2; };

__device__ __forceinline__ void static_map(int L, int nM, int nN, int& pm, int& pn) {
    const int nwg = nM * nN; int wgid = L;
    { const int q = nwg / NXCD, r = nwg % NXCD, xcd = wgid % NXCD, off = wgid / NXCD; wgid = (xcd < r ? xcd * (q + 1) : r * (q + 1) + (xcd - r) * q) + off; }
    const int nig = WGM * nN, gid = wgid / nig, fm = gid * WGM, gsz = (nM - fm) < WGM ? (nM - fm) : WGM;
    pm = fm + ((wgid % nig) % gsz); pn = (wgid % nig) / gsz;
}

template <class Epi, class Sched>
__device__ __forceinline__ void gemm_phase(LAS unsigned char* lds, const int wid, const char* Abase, const int K, const unsigned ldb, const Sched& S, const Epi& E) {
    const int lane = lane_id_opaque();
    const int tid = wid * 64 + lane, wr = wid >> 2, wc = wid & 3, fr = lane & 15, fq = lane >> 4;
    const int nt = K / BK;
    unsigned voffB0;
    { int R0, C0; stage_rc(tid * 16, R0, C0);
      const int Rb0 = Epi::GUP ? (256 * ((R0 >> 4) & 1) + 32 * (R0 >> 5) + 8 * ((R0 & 15) >> 2) + (R0 & 3)) : Epi::WIDE ? (64 * (R0 >> 5) + 16 * ((R0 & 15) >> 2) + 4 * ((R0 >> 4) & 1) + (R0 & 3)) : Epi::HEADP ? (64 * (R0 >> 5) + perm32(R0 & 31)) : (Epi::PERM ? ((R0 & ~31) + perm32(R0 & 31)) : R0);
      voffB0 = (unsigned)Rb0 * ldb + (unsigned)C0 * 2u; }
    const size_t hstepB = (size_t)(Epi::GUP ? 4 : Epi::WIDE ? 8 : (Epi::HEADP ? 32 : HALF)) * ldb;
    const size_t p1stepB = (size_t)((Epi::WIDE || Epi::HEADP) ? 128 : 64) * ldb;
    const unsigned ldsw = (unsigned)wid * 1024u;
    const int aoff = lds_byte(wr * 64 + fr, fq * 8), boff = lds_byte(wc * 32 + fr, fq * 8);
#define G8_SA(b, h) (((b) * 2 + (h)) * HTB)
#define G8_SB(b, h) ((4 + (b) * 2 + (h)) * HTB)
#define G8_GLDS(gp, lo) __builtin_amdgcn_global_load_lds((const unsigned*)(gp), (LAS unsigned*)(lds + (lo)), 16, 0, 0)
#define G8_STAGE_A(bufoff, o0, o1, kb, h) do { \
        G8_GLDS(Abase + ((long)(kb) + (Sched::GATHER ? 0l : (long)((h) * 128) * (long)S.lda)) + (size_t)(o0), (bufoff) + ldsw); \
        G8_GLDS(Abase + ((long)(kb) + (Sched::GATHER ? 0l : (long)((h) * 128 + 64) * (long)S.lda)) + (size_t)(o1), (bufoff) + ldsw + 8192); } while (0)
#define G8_STAGE_B(bufoff, bp, kb) do { G8_GLDS((bp) + (size_t)(kb) + (size_t)voffB0, (bufoff) + ldsw); G8_GLDS((bp) + ((size_t)(kb) + p1stepB) + (size_t)voffB0, (bufoff) + ldsw + 8192); } while (0)
#define G8_LDA(dst, b, h) do { _Pragma("unroll") for (int m = 0; m < 4; ++m) _Pragma("unroll") for (int k = 0; k < 2; ++k) dst[m][k] = *(const LAS bf16x8*)(lds + G8_SA(b, h) + aoff + m * 2048 + k * 1024); } while (0)
#define G8_LDB(dst, b, h) do { _Pragma("unroll") for (int n = 0; n < 2; ++n) _Pragma("unroll") for (int k = 0; k < 2; ++k) dst[n][k] = *(const LAS bf16x8*)(lds + G8_SB(b, h) + boff + n * 2048 + k * 1024); } while (0)
#define G8_MMA(ai, bj, At, Bt) do { __builtin_amdgcn_s_setprio(1); _Pragma("unroll") for (int m = 0; m < 4; ++m) _Pragma("unroll") for (int n = 0; n < 2; ++n) _Pragma("unroll") for (int k = 0; k < 2; ++k) \
        acc[ai][bj][m][n] = __builtin_amdgcn_mfma_f32_16x16x32_bf16(Bt[n][k], At[m][k], acc[ai][bj][m][n], 0, 0, 0); __builtin_amdgcn_s_setprio(0); } while (0)
#define G8_WAIT_V(n) asm volatile("s_waitcnt vmcnt(" #n ")" ::: "memory")
#define G8_WAIT_L(n) asm volatile("s_waitcnt lgkmcnt(" #n ")" ::: "memory")
#define G8_BAR __builtin_amdgcn_s_barrier()
#define G8_SCHED __builtin_amdgcn_sched_barrier(0)
    Unit cur, nxt; int ui = 0;
    if (!S.next(0, cur)) return;
    f32x4 acc[2][2][4][2];
#pragma unroll
    for (int a = 0; a < 2; ++a)
#pragma unroll
        for (int b = 0; b < 2; ++b)
#pragma unroll
            for (int m = 0; m < 4; ++m)
#pragma unroll
                for (int n = 0; n < 2; ++n) acc[a][b][m][n] = (f32x4){0.f, 0.f, 0.f, 0.f};
    bf16x8 At[4][2], B0[2][2], B1[2][2];
    unsigned cA00, cA01, cA10, cA11;
    { int R0, C0, R1, C1; stage_rc(tid * 16, R0, C0); stage_rc(tid * 16 + 8192, R1, C1);
      cA00 = S.aoff(cur, R0) + (unsigned)C0 * 2u;
      if constexpr (Sched::GATHER) { cA01 = S.aoff(cur, R1) + (unsigned)C1 * 2u; cA10 = S.aoff(cur, HALF + R0) + (unsigned)C0 * 2u; cA11 = S.aoff(cur, HALF + R1) + (unsigned)C1 * 2u; }
      else { cA01 = cA00; cA10 = cA00; cA11 = cA00; } }
    const char* cB = cur.B;
    G8_STAGE_B(G8_SB(0, 0), cB, 0); G8_SCHED; G8_STAGE_B(G8_SB(0, 1), cB + hstepB, 0); G8_SCHED; G8_STAGE_A(G8_SA(0, 0), cA00, cA01, 0, 0); G8_SCHED; G8_STAGE_A(G8_SA(0, 1), cA10, cA11, 0, 1); G8_SCHED;
    if (wr == 1) G8_BAR;
    G8_WAIT_V(2); G8_BAR;
    G8_STAGE_B(G8_SB(1, 0), cB, 128); G8_SCHED; G8_STAGE_A(G8_SA(1, 0), cA00, cA01, 128, 0); G8_SCHED; G8_STAGE_B(G8_SB(1, 1), cB + hstepB, 128); G8_SCHED;
    G8_WAIT_V(6); G8_BAR;
    for (;;) {
        const bool has_next = S.next(ui + 1, nxt);
        unsigned nA00 = cA00, nA01 = cA01, nA10 = cA10, nA11 = cA11; const char* nB = cB; long dl = 0;
        if (has_next) {
            nB = nxt.B;
            if constexpr (!Sched::GATHER) dl = ((long)nxt.a0 - (long)cur.a0) * (long)S.lda;
            else { const int t2 = wid * 64 + lane_id_opaque(); int R0, C0, R1, C1; stage_rc(t2 * 16, R0, C0); stage_rc(t2 * 16 + 8192, R1, C1);
                nA00 = S.aoff(nxt, R0) + (unsigned)C0 * 2u; nA01 = S.aoff(nxt, R1) + (unsigned)C1 * 2u; nA10 = S.aoff(nxt, HALF + R0) + (unsigned)C0 * 2u; nA11 = S.aoff(nxt, HALF + R1) + (unsigned)C1 * 2u; }
        }
        for (int t = 0; t < nt; t += 2) {
            const bool last = (t == nt - 2);
            const unsigned kb = (unsigned)t * 128u;
            const unsigned kb2 = last ? 0u : kb + 256u;
            const char* b2 = last ? nB : cB;
            unsigned s00, s01, s10, s11; long ka2;
            if constexpr (Sched::GATHER) { s00 = last ? nA00 : cA00; s01 = last ? nA01 : cA01; s10 = last ? nA10 : cA10; s11 = last ? nA11 : cA11; ka2 = (long)kb2; }
            else { s00 = cA00; s01 = cA00; s10 = cA00; s11 = cA00; ka2 = last ? dl : (long)kb2; }
            G8_LDB(B0, 0, 0); G8_LDB(B1, 0, 1); G8_SCHED; G8_LDA(At, 0, 0); G8_STAGE_A(G8_SA(1, 1), cA10, cA11, kb + 128u, 1);
            G8_WAIT_V(8); G8_WAIT_L(0); G8_BAR; G8_MMA(0, 0, At, B0); G8_MMA(0, 1, At, B1); G8_BAR; G8_SCHED;
            G8_LDA(At, 0, 1); G8_STAGE_B(G8_SB(0, 0), b2, kb2); G8_STAGE_B(G8_SB(0, 1), b2 + hstepB, kb2); G8_STAGE_A(G8_SA(0, 0), s00, s01, ka2, 0);
            G8_WAIT_V(8); G8_WAIT_L(0); G8_BAR; G8_MMA(1, 0, At, B0); G8_MMA(1, 1, At, B1); G8_BAR; G8_SCHED;
            G8_LDB(B0, 1, 0); G8_LDB(B1, 1, 1); G8_SCHED; G8_LDA(At, 1, 0); G8_STAGE_A(G8_SA(0, 1), s10, s11, ka2, 1);
            G8_WAIT_V(8); G8_WAIT_L(0); G8_BAR; G8_MMA(0, 0, At, B0); G8_MMA(0, 1, At, B1); G8_BAR; G8_SCHED;
            G8_LDA(At, 1, 1); G8_STAGE_B(G8_SB(1, 0), b2, kb2 + 128u); G8_STAGE_B(G8_SB(1, 1), b2 + hstepB, kb2 + 128u); G8_STAGE_A(G8_SA(1, 0), s00, s01, ka2 + 128, 0);
            G8_WAIT_V(8); G8_WAIT_L(0); G8_BAR; G8_MMA(1, 0, At, B0); G8_MMA(1, 1, At, B1); G8_BAR; G8_SCHED;
        }
        if (wr == 0) G8_BAR;
        { const int l2 = lane_id_opaque(); E(acc, cur, wr, wc, l2 & 15, l2 >> 4); }
        if (!has_next) break;
#pragma unroll
        for (int a = 0; a < 2; ++a)
#pragma unroll
            for (int b = 0; b < 2; ++b)
#pragma unroll
                for (int m = 0; m < 4; ++m)
#pragma unroll
                    for (int n = 0; n < 2; ++n) acc[a][b][m][n] = (f32x4){0.f, 0.f, 0.f, 0.f};
        cur = nxt; cB = nB; ++ui;
        if constexpr (Sched::GATHER) { cA00 = nA00; cA01 = nA01; cA10 = nA10; cA11 = nA11; }
        else { cA00 += (unsigned)dl; cA01 = cA00; cA10 = cA00; cA11 = cA00; }
        if (wr == 1) G8_BAR;
    }
    G8_WAIT_V(0);
    G8_BAR;
#undef G8_SA
#undef G8_SB
#undef G8_GLDS
#undef G8_STAGE_A
#undef G8_STAGE_B
#undef G8_LDA
#undef G8_LDB
#undef G8_MMA
#undef G8_WAIT_V
#undef G8_WAIT_L
#undef G8_BAR
#undef G8_SCHED
}

struct RectSched {
    static constexpr bool GATHER = false;
    int nM, nN, G, c; unsigned row0, lda; const char* Bbase; unsigned ldb;
    __device__ __forceinline__ bool next(int i, Unit& u) const {
        const int L = i * G + c; if (L >= nM * nN) return false;
        int pm, pn; static_map(L, nM, nN, pm, pn);
        u.a0 = row0 + (unsigned)pm * 256u; u.B = Bbase + (size_t)pn * 256u * ldb; u.p0 = pm; u.p1 = pn; u.p2 = 0; return true;
    }
    __device__ __forceinline__ unsigned aoff(const Unit& u, int q) const { return (u.a0 + (unsigned)q) * lda; }
};
struct QkvSched {
    static constexpr bool GATHER = false;
    int G, c; unsigned lda; const char* Bbase; unsigned ldb;
    __device__ __forceinline__ bool next(int i, Unit& u) const {
        const int L = i * G + c; int pm, pn;
        if (L < 768) static_map(L, 64, 12, pm, pn);
        else if (L < 832) { const int l2 = L - 768; pm = 64 + (l2 & 7); pn = 4 + (l2 >> 3); }
        else return false;
        u.a0 = (unsigned)pm * 256u; u.B = Bbase + (size_t)pn * 256u * ldb; u.p0 = pm; u.p1 = pn; u.p2 = 0; return true;
    }
    __device__ __forceinline__ unsigned aoff(const Unit& u, int q) const { return (u.a0 + (unsigned)q) * lda; }
};
struct BatchSched {
    static constexpr bool GATHER = false;
    int nb, nM, nN, G, c; unsigned lda; const char* Bbase; unsigned ldb; int N;
    __device__ __forceinline__ bool next(int i, Unit& u) const {
        const int per = nM * nN; int L;
        if ((G & 7) == 0 && (nb & 7) == 0) {
            const int nx = (nb >> 3) * per, li = i * (G >> 3) + (c >> 3); if (li >= nx) return false;
            L = (c & 7) * nx + li;
        } else { L = i * G + c; if (L >= nb * per) return false; }
        const int g = L / per, rem = L % per, pm = rem / nN, pn = rem % nN;
        u.a0 = (unsigned)(g * S5RP + pm * 256); u.B = Bbase + ((size_t)g * N + (size_t)pn * 256u) * ldb; u.p0 = g; u.p1 = pm; u.p2 = pn; return true;
    }
    __device__ __forceinline__ unsigned aoff(const Unit& u, int q) const { return (u.a0 + (unsigned)q) * lda; }
};
template <bool GATHER_>
struct MoeSched {
    static constexpr bool GATHER = GATHER_;
    int ntiles, nN, G, c; unsigned lda; const char* Bbase; unsigned ldb; int Ne, pn0, bstep; const LAS unsigned char* tile_e; const int* rowidx;
    __device__ __forceinline__ void xrange(int x, int& tlo, int& nx) const { const int q = ntiles >> 3, r = ntiles & 7; nx = q + (x < r ? 1 : 0); tlo = x * q + (x < r ? x : r); }
    __device__ __forceinline__ bool next(int i, Unit& u) const {
        int tile, pn;
        if ((G & 7) == 0) {
            int tlo, nx; xrange(c & 7, tlo, nx);
            const int li = i * (G >> 3) + (c >> 3); if (li >= nx * nN) return false;
            tile = tlo + li / nN; pn = li % nN;
        } else { const int L = i * G + c; if (L >= ntiles * nN) return false; tile = L / nN; pn = L % nN; }
        const int e = __builtin_amdgcn_readfirstlane((int)tile_e[tile]);
        u.a0 = (unsigned)tile * 256u; u.B = Bbase + ((size_t)e * Ne + (size_t)(pn0 + pn) * (unsigned)bstep) * ldb; u.p0 = tile; u.p1 = pn; u.p2 = e; return true;
    }
    __device__ __forceinline__ unsigned aoff(const Unit& u, int q) const {
        if (GATHER) return (unsigned)rowidx[u.a0 + (unsigned)q] * lda;
        return (u.a0 + (unsigned)q) * lda;
    }
};
}

struct Params {
    const float* in[34];
    float* out;
    unsigned char* ws;
    int ph_lo, ph_hi;
};
enum { I_X = 0, I_C, I_CTX, I_CCTX, I_ADAW, I_ADAB, I_NMG, I_NFG, I_WIN, I_ARE, I_AIM, I_LDT, I_BRE, I_BIM, I_CRE, I_CIM, I_S5D, I_GLUW, I_GLUB, I_CONVW,
       I_HOUT, I_WQKV, I_QG, I_KG, I_RPB, I_NOUT, I_RW, I_RB, I_MG, I_MU, I_MD, I_SG, I_SU, I_SD };

using g8::Unit;
typedef f32x4 Acc[2][2][4][2];

__device__ __forceinline__ u32x4 pack8(const f32x4& a, const f32x4& b) {
    u32x4 w; w.x = pk2(a[0], a[1]); w.y = pk2(a[2], a[3]); w.z = pk2(b[0], b[1]); w.w = pk2(b[2], b[3]); return w;
}

struct EpiWin {
    static constexpr bool PERM = true, HEADP = false, WIDE = false, GUP = false;
    bf16_t* A2; bf16_t* BCV;
    __device__ __forceinline__ void operator()(const Acc& acc, const Unit& u, int wr, int wc, int fr, int fq) const {
#pragma unroll
        for (int ai = 0; ai < 2; ++ai)
#pragma unroll
            for (int m = 0; m < 4; ++m) {
                const int row = u.p0 * 256 + 128 * ai + 64 * wr + 16 * m + fr;
#pragma unroll
                for (int bj = 0; bj < 2; ++bj) {
                    const int col0 = u.p1 * 256 + 128 * bj + 32 * wc + 8 * fq;
                    const u32x4 w = pack8(acc[ai][bj][m][0], acc[ai][bj][m][1]);
                    if (u.p1 < 2) {
                        const int g = col0 >> 4, ci0 = col0 & 15, r = row >> 5, s = row & 31;
                        *(u32x4*)(A2 + ((size_t)(g * S5RP + r) * S5K + s * 16 + ci0)) = w;
                    } else {
                        *(u32x4*)(BCV + ((size_t)row * 1536 + (col0 - 512))) = w;
                    }
                }
            }
    }
};
struct EpiS5F {
    static constexpr bool PERM = false, HEADP = false, WIDE = false, GUP = false;
    float* F;
    __device__ __forceinline__ void operator()(const Acc& acc, const Unit& u, int wr, int wc, int fr, int fq) const {
#pragma unroll
        for (int ai = 0; ai < 2; ++ai)
#pragma unroll
            for (int m = 0; m < 4; ++m) {
                const int row = u.p1 * 256 + 128 * ai + 64 * wr + 16 * m + fr;
                float* rp = F + ((size_t)(u.p0 * S5RP + row) * 256);
#pragma unroll
                for (int bj = 0; bj < 2; ++bj)
#pragma unroll
                    for (int n = 0; n < 2; ++n) *(f32x4*)(rp + 128 * bj + 32 * wc + 16 * n + 4 * fq) = acc[ai][bj][m][n];
            }
    }
};
struct EpiS5Y {
    static constexpr bool PERM = true, HEADP = false, WIDE = false, GUP = false;
    bf16_t* Gb;
    __device__ __forceinline__ void operator()(const Acc& acc, const Unit& u, int wr, int wc, int fr, int fq) const {
#pragma unroll
        for (int ai = 0; ai < 2; ++ai)
#pragma unroll
            for (int m = 0; m < 4; ++m) {
                const int r = u.p1 * 256 + 128 * ai + 64 * wr + 16 * m + fr;
                if (r < S5R) {
#pragma unroll
                    for (int bj = 0; bj < 2; ++bj) {
                        const int col0 = u.p2 * 256 + 128 * bj + 32 * wc + 8 * fq;
                        const int t = col0 >> 4, co0 = col0 & 15;
                        f32x4 a = acc[ai][bj][m][0], b = acc[ai][bj][m][1];
#pragma unroll
                        for (int j = 0; j < 4; ++j) { a[j] = gelu_tanh(a[j]); b[j] = gelu_tanh(b[j]); }
                        *(u32x4*)(Gb + ((size_t)(r * S5T + t) * 512 + u.p0 * 16 + co0)) = pack8(a, b);
                    }
                }
            }
    }
};
struct EpiGlu {
    static constexpr bool PERM = true, HEADP = false, WIDE = false, GUP = false;
    const bf16_t* Gb; const float* bias; bf16_t* Z;
    __device__ __forceinline__ void operator()(const Acc& acc, const Unit& u, int wr, int wc, int fr, int fq) const {
        const int row0 = u.p0 * 256 + 64 * wr + fr, col0 = u.p1 * 256 + 32 * wc + 8 * fq;
        f32x4 bv[2][2];
#pragma unroll
        for (int bj = 0; bj < 2; ++bj) { bv[bj][0] = *(const f32x4*)(bias + col0 + 128 * bj); bv[bj][1] = *(const f32x4*)(bias + col0 + 128 * bj + 4); }
        u32x4 gv[8][2];
#pragma unroll
        for (int i = 0; i < 8; ++i)
#pragma unroll
            for (int bj = 0; bj < 2; ++bj) gv[i][bj] = *(const u32x4*)(Gb + ((size_t)(row0 + 128 * (i >> 2) + 16 * (i & 3)) * 512 + col0 + 128 * bj));
#pragma unroll
        for (int i = 0; i < 8; ++i) {
            const int ai = i >> 2, m = i & 3; const int row = row0 + 128 * ai + 16 * m;
#pragma unroll
            for (int bj = 0; bj < 2; ++bj) {
                const u32x4 g = gv[i][bj];
                f32x4 a = acc[ai][bj][m][0] + bv[bj][0], b = acc[ai][bj][m][1] + bv[bj][1];
                a[0] = bflo(g.x) * sigmoidf_(a[0]); a[1] = bfhi(g.x) * sigmoidf_(a[1]); a[2] = bflo(g.y) * sigmoidf_(a[2]); a[3] = bfhi(g.y) * sigmoidf_(a[3]);
                b[0] = bflo(g.z) * sigmoidf_(b[0]); b[1] = bfhi(g.z) * sigmoidf_(b[1]); b[2] = bflo(g.w) * sigmoidf_(b[2]); b[3] = bfhi(g.w) * sigmoidf_(b[3]);
                *(u32x4*)(Z + ((size_t)row * 1024 + col0 + 128 * bj)) = pack8(a, b);
            }
        }
    }
};
struct EpiResid {
    static constexpr bool PERM = true, HEADP = false, WIDE = true, GUP = false;
    const float* gate;
    bf16_t* XR; float rs;
    __device__ __forceinline__ void operator()(const Acc& acc, const Unit& u, int wr, int wc, int fr, int fq) const {
        const int row0 = u.p0 * 256 + 64 * wr + fr, col = u.p1 * 256 + 64 * wc + 16 * fq;
        const int b = (u.p0 * 256) < NLAT ? ((u.p0 * 256) >> 11) : 8;
        const float* gp = gate + b * 6144 + col;
        f32x4 g[4];
#pragma unroll
        for (int q = 0; q < 4; ++q) g[q] = *(const f32x4*)(gp + 4 * q) * rs;
        u32x4 xa[8], xc[8];
#pragma unroll
        for (int i = 0; i < 8; ++i) { const bf16_t* xp = XR + (size_t)(row0 + 128 * (i >> 2) + 16 * (i & 3)) * DM + col; xa[i] = *(const u32x4*)xp; xc[i] = *(const u32x4*)(xp + 8); }
#pragma unroll
        for (int i = 0; i < 8; ++i) {
            const int ai = i >> 2, m = i & 3;
            bf16_t* xp = XR + (size_t)(row0 + 128 * ai + 16 * m) * DM + col;
            const f32x4 x0 = (f32x4){bflo(xa[i].x), bfhi(xa[i].x), bflo(xa[i].y), bfhi(xa[i].y)}, x1 = (f32x4){bflo(xa[i].z), bfhi(xa[i].z), bflo(xa[i].w), bfhi(xa[i].w)};
            const f32x4 x2 = (f32x4){bflo(xc[i].x), bfhi(xc[i].x), bflo(xc[i].y), bfhi(xc[i].y)}, x3 = (f32x4){bflo(xc[i].z), bfhi(xc[i].z), bflo(xc[i].w), bfhi(xc[i].w)};
            const f32x4 o0 = x0 + g[0] * acc[ai][0][m][0], o1 = x1 + g[1] * acc[ai][0][m][1], o2 = x2 + g[2] * acc[ai][1][m][0], o3 = x3 + g[3] * acc[ai][1][m][1];
            *(u32x4*)xp = pack8(o0, o1); *(u32x4*)(xp + 8) = pack8(o2, o3);
        }
    }
};
struct EpiGU {
    static constexpr bool PERM = false, HEADP = false, WIDE = false, GUP = true;
    bf16_t* ACT;
    __device__ __forceinline__ void operator()(const Acc& acc, const Unit& u, int wr, int wc, int fr, int fq) const {
#pragma unroll
        for (int ai = 0; ai < 2; ++ai)
#pragma unroll
            for (int m = 0; m < 4; ++m) {
                const int slot = u.p0 * 256 + 128 * ai + 64 * wr + 16 * m + fr;
                u32x4 o;
#pragma unroll
                for (int bj = 0; bj < 2; ++bj) {
                    const f32x4 g = acc[ai][bj][m][0], up = acc[ai][bj][m][1];
                    o[2 * bj] = pk2(siluf_(g[0]) * up[0], siluf_(g[1]) * up[1]); o[2 * bj + 1] = pk2(siluf_(g[2]) * up[2], siluf_(g[3]) * up[3]);
                }
                *(u32x4*)(ACT + ((size_t)slot * EDIM + u.p1 * 128 + 32 * wc + 8 * fq)) = o;
            }
    }
};
__device__ __forceinline__ float fp8c(float v) { return __builtin_amdgcn_fmed3f(v * 16.f, -440.f, 440.f); }
__device__ __forceinline__ u32x2 pack8_fp8(const f32x4& a, const f32x4& b) {
    int w0 = 0, w1 = 0;
    w0 = __builtin_amdgcn_cvt_pk_fp8_f32(fp8c(a[0]), fp8c(a[1]), w0, false); w0 = __builtin_amdgcn_cvt_pk_fp8_f32(fp8c(a[2]), fp8c(a[3]), w0, true);
    w1 = __builtin_amdgcn_cvt_pk_fp8_f32(fp8c(b[0]), fp8c(b[1]), w1, false); w1 = __builtin_amdgcn_cvt_pk_fp8_f32(fp8c(b[2]), fp8c(b[3]), w1, true);
    return (u32x2){(unsigned)w0, (unsigned)w1};
}
struct EpiDN {
    static constexpr bool PERM = true, HEADP = false, WIDE = true, GUP = false;
    unsigned char* Y;
    __device__ __forceinline__ void operator()(const Acc& acc, const Unit& u, int wr, int wc, int fr, int fq) const {
#pragma unroll
        for (int ai = 0; ai < 2; ++ai)
#pragma unroll
            for (int m = 0; m < 4; ++m) {
                const int slot = u.p0 * 256 + 128 * ai + 64 * wr + 16 * m + fr;
                const u32x2 lo = pack8_fp8(acc[ai][0][m][0], acc[ai][0][m][1]), hi = pack8_fp8(acc[ai][1][m][0], acc[ai][1][m][1]);
                *(u32x4*)(Y + ((size_t)slot * 1024 + u.p1 * 256 + 64 * wc + 16 * fq)) = (u32x4){lo.x, lo.y, hi.x, hi.y};
            }
    }
};
struct EpiQKV {
    static constexpr bool PERM = true, HEADP = true, WIDE = false, GUP = false;
    bf16_t* Q; bf16_t* Kb; bf16_t* VT; const float* qg; const float* kg;
    __device__ __forceinline__ void operator()(const Acc& acc, const Unit& u, int wr, int wc, int fr, int fq) const {
        const int region = u.p1 >> 2;
        if (region < 2) {
            const float* gp = (region == 0 ? qg : kg) + 8 * fq; const float gs = region == 0 ? 0.125f * 1.4426950408889634f : 1.f;
            f32x4 g[2][2];
#pragma unroll
            for (int bj = 0; bj < 2; ++bj)
#pragma unroll
                for (int n = 0; n < 2; ++n) g[bj][n] = *(const f32x4*)(gp + 32 * bj + 4 * n) * gs;
            bf16_t* dst = region == 0 ? Q : Kb;
#pragma unroll
            for (int ai = 0; ai < 2; ++ai)
#pragma unroll
                for (int m = 0; m < 4; ++m) {
                    const int row = u.p0 * 256 + 128 * ai + 64 * wr + 16 * m + fr;
                    float ss = 0.f;
#pragma unroll
                    for (int bj = 0; bj < 2; ++bj)
#pragma unroll
                        for (int n = 0; n < 2; ++n) { const f32x4 v = acc[ai][bj][m][n]; ss += (v[0] * v[0] + v[1] * v[1]) + (v[2] * v[2] + v[3] * v[3]); }
                    ss = add_xor16(ss); ss = add_xor32(ss);
                    const float rstd = rsqrtf(ss * (1.f / 64.f) + 1e-6f);
                    bf16_t* rp = dst + ((size_t)row * DM + (u.p1 & 3) * 256 + 64 * wc + 8 * fq);
#pragma unroll
                    for (int bj = 0; bj < 2; ++bj) *(u32x4*)(rp + 32 * bj) = pack8(acc[ai][bj][m][0] * rstd * g[bj][0], acc[ai][bj][m][1] * rstd * g[bj][1]);
                }
        } else {
#pragma unroll
            for (int ai = 0; ai < 2; ++ai)
#pragma unroll
                for (int m = 0; m < 4; ++m) {
                    const int row = u.p0 * 256 + 128 * ai + 64 * wr + 16 * m + fr;
                    bf16_t* rp = VT + ((size_t)row * DM + (u.p1 & 3) * 256 + 64 * wc + 8 * fq);
#pragma unroll
                    for (int bj = 0; bj < 2; ++bj) *(u32x4*)(rp + 32 * bj) = pack8(acc[ai][bj][m][0], acc[ai][bj][m][1]);
                }
        }
    }
};

struct Ctx { int tid, lane, wave, G, blk, gw, NGW; LAS unsigned char* lds; };
__device__ __forceinline__ Ctx mkctx(LAS unsigned char* lds, int wave0) {
    Ctx X; X.lane = lane_id_opaque(); X.wave = wave0; X.tid = wave0 * 64 + X.lane; X.G = gridDim.x; X.blk = blockIdx.x;
    X.gw = X.blk * 8 + X.wave; X.NGW = X.G * 8; X.lds = lds; return X;
}

template <int MODE> __device__ __forceinline__ int wrow(int n) { return MODE == 2 ? 256 + n : n; }
template <int MODE>
__device__ __forceinline__ void conv_item(const float* W, int N, bf16_t* WT, int ldk, int k0, int n0, LAS unsigned* T, int lane) {
    (void)T;
    const int nq = lane & 15, kg = lane >> 4;
    const float* wp = W + (size_t)(k0 + 16 * kg) * N + n0 + 4 * nq;
    f32x4 r[16];
#pragma unroll
    for (int i = 0; i < 16; ++i) r[i] = *(const f32x4*)(wp + (size_t)i * N);
#pragma unroll
    for (int j = 0; j < 4; ++j) {
        bf16_t* op = WT + (size_t)wrow<MODE>(n0 + 4 * nq + j) * ldk + k0 + 16 * kg;
        u32x4 lo, hi;
        lo.x = pk2(r[0][j], r[1][j]); lo.y = pk2(r[2][j], r[3][j]); lo.z = pk2(r[4][j], r[5][j]); lo.w = pk2(r[6][j], r[7][j]);
        hi.x = pk2(r[8][j], r[9][j]); hi.y = pk2(r[10][j], r[11][j]); hi.z = pk2(r[12][j], r[13][j]); hi.w = pk2(r[14][j], r[15][j]);
        *(u32x4*)op = lo; *(u32x4*)(op + 8) = hi;
    }
}
__device__ __forceinline__ void conv_mat(const Ctx& X, const float* W, int K, int N, bf16_t* WT, int& rot) {
    LAS unsigned* T = (LAS unsigned*)(X.lds + X.wave * 8192);
    const int nb = N / 64, nitems = (K / 64) * nb;
    int start = X.gw - rot; while (start < 0) start += X.NGW;
    for (int it = start; it < nitems; it += X.NGW) conv_item<0>(W, N, WT, K, (it / nb) * 64, (it % nb) * 64, T, X.lane);
    rot = (rot + nitems) % X.NGW;
}
template <int KIND>
__device__ __forceinline__ void conv_moe_items(const Ctx& X, const Params& p, int l, bf16_t* GU, bf16_t* DN, int it0, int it1, int rank, int nrank) {
    constexpr int PER = KIND == 0 ? 192 : (KIND == 1 ? 128 : 64);
    for (int it = it0 + rank * 8 + X.wave; it < it1; it += nrank * 8) {
        const int e = it / PER, r = it % PER, kind = KIND == 2 ? 2 : (r >> 6), q = r & 63;
        if (kind == 0) {
            const float* W = e < NEXP ? p.in[I_MG] + (size_t)(l * NEXP + e) * 262144 : p.in[I_SG] + (size_t)l * 262144;
            conv_item<1>(W, 256, GU + (size_t)e * 512 * 1024, 1024, (q >> 2) * 64, (q & 3) * 64, nullptr, X.lane);
        } else if (kind == 1) {
            const float* W = e < NEXP ? p.in[I_MU] + (size_t)(l * NEXP + e) * 262144 : p.in[I_SU] + (size_t)l * 262144;
            conv_item<2>(W, 256, GU + (size_t)e * 512 * 1024, 1024, (q >> 2) * 64, (q & 3) * 64, nullptr, X.lane);
        } else {
            const float* W = e < NEXP ? p.in[I_MD] + (size_t)(l * NEXP + e) * 262144 : p.in[I_SD] + (size_t)l * 262144;
            conv_item<0>(W, 1024, DN + (size_t)e * 1024 * 256, 256, (q >> 4) * 64, (q & 15) * 64, nullptr, X.lane);
        }
    }
}
__device__ __forceinline__ int moe_idle_rank(int ntiles, int nN, int G, int blk, int& nidle) {
    if ((G & 7) != 0) { const int nunits = ntiles * nN, nfull = nunits % G; if (nfull == 0) { nidle = G; return blk; } nidle = G - nfull; return blk >= nfull ? blk - nfull : -1; }
    const int B8 = G >> 3, q = ntiles >> 3, r = ntiles & 7;
    int maxc = 0;
    for (int x = 0; x < 8; ++x) { const int n = (q + (x < r ? 1 : 0)) * nN; const int cmax = (n + B8 - 1) / B8; maxc = cmax > maxc ? cmax : maxc; }
    int rank = -1, cnt = 0;
    for (int x = 0; x < 8; ++x) {
        const int n = (q + (x < r ? 1 : 0)) * nN;
        int jfull = n - (maxc - 1) * B8; jfull = jfull < 0 ? 0 : (jfull > B8 ? B8 : jfull);
        if (x == (blk & 7)) { const int j = blk >> 3; if (j >= jfull) rank = cnt + (j - jfull); }
        cnt += B8 - jfull;
    }
    if (cnt == 0) { nidle = G; return blk; }
    nidle = cnt; return rank;
}
__device__ __forceinline__ int idle_rank(int nunits, int G, int blk, int& nidle) {
    const int nfull = nunits % G;
    if (nfull == 0) { nidle = G; return blk; }
    nidle = G - nfull; return blk >= nfull ? blk - nfull : -1;
}

__device__ __forceinline__ void sincos_red(float x, float& s, float& c) {
    const float n = rintf(x * 0.15915494309189535f);
    float r = fmaf(-n, 6.28125f, x); r = fmaf(-n, 1.9353071795864769e-3f, r);
    s = __sinf(r); c = __cosf(r);
}

__device__ __forceinline__ void phase_p0a(const Ctx& X, const Params& p) {
    {
        LAS float* PWs = (LAS float*)(X.lds);
        LAS float* BBs = (LAS float*)(X.lds + 20480);
        LAS float* CCs = (LAS float*)(X.lds + 32768);
        LAS f32x2* TTs = (LAS f32x2*)(X.lds + 49152);
        float* KK = (float*)(p.ws + WS_KK); float* PWG = (float*)(p.ws + WS_PW); float* BBG = (float*)(p.ws + WS_BB);
        for (int item = X.blk; item < 256; item += X.G) {
            const int g = item >> 3, d = (item >> 2) & 1, lq = item & 3, gd = d * 32 + g;
            const float dt = expf(p.in[I_LDT][gd]);
            __syncthreads();
            const float lre0 = fminf(p.in[I_ARE][gd * 64 + (X.tid & 63)], -1e-4f), lim0 = p.in[I_AIM][gd * 64 + (X.tid & 63)];
            for (int idx = X.tid; idx < 33 * 64; idx += 512) {
                const int j = idx >> 6;
                const float lre = lre0, lim = lim0;
                const float mag = expf(lre * dt * (float)j); float sn, cs; sincos_red(lim * dt * (float)j, sn, cs);
                PWs[2 * idx] = mag * cs; PWs[2 * idx + 1] = mag * sn;
            }
            for (int idx = X.tid; idx < 1024; idx += 512) {
                const int pp = idx >> 4;
                const float lre = fminf(p.in[I_ARE][gd * 64 + pp], -1e-4f), lim = p.in[I_AIM][gd * 64 + pp];
                const float mag = expf(lre * dt); float sn, cs; sincos_red(lim * dt, sn, cs);
                const float nr = mag * cs - 1.f, ni = mag * sn, den = 1.f / (lre * lre + lim * lim);
                const float cr = (nr * lre + ni * lim) * den, ci = (ni * lre - nr * lim) * den;
                const float br = p.in[I_BRE][(size_t)gd * 1024 + idx], bi = p.in[I_BIM][(size_t)gd * 1024 + idx];
                BBs[2 * idx] = cr * br - ci * bi; BBs[2 * idx + 1] = cr * bi + ci * br;
            }
            for (int idx = X.tid; idx < 1024; idx += 512) { const int co_ = idx >> 6, pp_ = idx & 63; CCs[2 * (co_ * 65 + pp_)] = p.in[I_CRE][(size_t)gd * 1024 + idx]; CCs[2 * (co_ * 65 + pp_) + 1] = p.in[I_CIM][(size_t)gd * 1024 + idx]; }
            __syncthreads();
            for (int idx = X.tid; idx < 8 * 64 * 16; idx += 512) {
                const int lagl = idx >> 10, pp = (idx >> 4) & 63, ci = idx & 15, lag = 8 * lq + lagl;
                const float pr = PWs[2 * (lag * 64 + pp)], pi = PWs[2 * (lag * 64 + pp) + 1];
                const float br = BBs[2 * (pp * 16 + ci)], bi = BBs[2 * (pp * 16 + ci) + 1];
                TTs[idx] = (f32x2){pr * br - pi * bi, pr * bi + pi * br};
            }
            __syncthreads();
            {
                const int co = (X.tid >> 4) & 15, ci = X.tid & 15, lagb = X.tid >> 8;
                float sum[4] = {0.f, 0.f, 0.f, 0.f};
                for (int pp = 0; pp < 64; ++pp) {
                    const f32x2 cc = *(const LAS f32x2*)(CCs + 2 * (co * 65 + pp));
#pragma unroll
                    for (int i = 0; i < 4; ++i) { const f32x2 t = TTs[((lagb + 2 * i) * 64 + pp) * 16 + ci]; sum[i] += cc.x * t.x - cc.y * t.y; }
                }
#pragma unroll
                for (int i = 0; i < 4; ++i) KK[(size_t)((g * 2 + d) * 32 + 8 * lq + lagb + 2 * i) * 256 + co * 16 + ci] = sum[i];
            }
            if (lq == 0) {
                for (int idx = X.tid; idx < 33 * 64 * 2; idx += 512) PWG[(size_t)(g * 2 + d) * 33 * 64 * 2 + idx] = PWs[idx];
                for (int idx = X.tid; idx < 2048; idx += 512) BBG[(size_t)(g * 2 + d) * 2048 + idx] = BBs[idx];
            }
        }
        __syncthreads();
    }
    {
        LAS float* condS = (LAS float*)(X.lds + 65536);
        LAS float* red = (LAS float*)(X.lds);
        {
            float cv[18];
#pragma unroll
            for (int q = 0; q < 18; ++q) { const int i = X.tid + 512 * q, r = q >> 1, k = i & 1023; cv[q] = r < 8 ? p.in[I_C][r * 1024 + k] : p.in[I_CCTX][k]; }
#pragma unroll
            for (int q = 0; q < 18; ++q) condS[X.tid + 512 * q] = siluf_(cv[q]);
        }
        __syncthreads();
        float* MOD = (float*)(p.ws + WS_MOD);
        for (int task = X.blk; task < 192; task += X.G) {
            const int l = task / 96, cg = task % 96, col = cg * 64 + X.lane;
            const float* wp = p.in[I_ADAW] + (size_t)l * 1024 * 6144 + (size_t)(X.wave * 128) * 6144 + col;
            float a0 = 0, a1 = 0, a2 = 0, a3 = 0, a4 = 0, a5 = 0, a6 = 0, a7 = 0, a8 = 0;
#pragma unroll
            for (int hb = 0; hb < 2; ++hb) {
                float wv[64];
#pragma unroll
                for (int kk = 0; kk < 64; ++kk) wv[kk] = wp[(size_t)(hb * 64 + kk) * 6144];
#pragma unroll
                for (int kk = 0; kk < 64; ++kk) {
                    const float w = wv[kk]; const LAS float* cp = condS + X.wave * 128 + hb * 64 + kk;
                    a0 += cp[0] * w; a1 += cp[1024] * w; a2 += cp[2048] * w; a3 += cp[3072] * w; a4 += cp[4096] * w; a5 += cp[5120] * w; a6 += cp[6144] * w; a7 += cp[7168] * w; a8 += cp[8192] * w;
                }
            }
            __syncthreads();
            LAS float* rp = red + X.wave * 576 + X.lane;
            rp[0] = a0; rp[64] = a1; rp[128] = a2; rp[192] = a3; rp[256] = a4; rp[320] = a5; rp[384] = a6; rp[448] = a7; rp[512] = a8;
            __syncthreads();
            for (int i = X.tid; i < 576; i += 512) {
                const int r = i >> 6, c = i & 63; float sum = p.in[I_ADAB][l * 6144 + cg * 64 + c];
#pragma unroll
                for (int w = 0; w < 8; ++w) sum += red[w * 576 + i];
                MOD[(size_t)(l * 9 + r) * 6144 + cg * 64 + c] = sum;
            }
        }
        __syncthreads();
    }
    {
        int rot = 0;
        if (X.G >= 192 + 32) { if (X.blk >= 192) { Ctx Y = X; Y.gw = (X.blk - 192) * 8 + X.wave; Y.NGW = (X.G - 192) * 8; conv_mat(Y, p.in[I_WIN], 1024, 2048, (bf16_t*)(p.ws + WS_WIN), rot); } }
        else conv_mat(X, p.in[I_WIN], 1024, 2048, (bf16_t*)(p.ws + WS_WIN), rot);
    }
}
__device__ __forceinline__ void conv_small(const Ctx& X, const Params& p, int rank, int nrank) {
    Ctx Y = X; Y.gw = rank * 8 + X.wave; Y.NGW = nrank * 8;
    int rot = 0;
    conv_mat(Y, p.in[I_GLUW], 512, 512, (bf16_t*)(p.ws + WS_GLU), rot);
    conv_mat(Y, p.in[I_HOUT], 1024, 1024, (bf16_t*)(p.ws + WS_HOUT), rot);
    conv_mat(Y, p.in[I_RW], 1024, 64, (bf16_t*)(p.ws + WS_ROUT), rot);
    conv_mat(Y, p.in[I_RW] + 65536, 1024, 64, (bf16_t*)(p.ws + WS_ROUT) + 256 * 1024, rot);
    conv_mat(Y, p.in[I_WQKV], 1024, 3072, (bf16_t*)(p.ws + WS_QKV), rot);
    conv_mat(Y, p.in[I_NOUT], 1024, 1024, (bf16_t*)(p.ws + WS_NOUT), rot);
}

__device__ __forceinline__ void phase_p0b(const Ctx& X, const Params& p) {
    const int gt = X.blk * 512 + X.tid, NT = X.G * 512;
    const float* KK = (const float*)(p.ws + WS_KK); const float* PWG = (const float*)(p.ws + WS_PW); const float* BBG = (const float*)(p.ws + WS_BB);
    bf16_t* ME = (bf16_t*)(p.ws + WS_ME); bf16_t* WF = (bf16_t*)(p.ws + WS_WF);
    {
        constexpr int N = 32 * 512 * 64, U = 4;
        for (int ch0 = gt; ch0 < N; ch0 += U * NT) {
            f32x4 f0[U], f1[U], b0[U], b1[U]; float dsk[U];
#pragma unroll
            for (int u = 0; u < U; ++u) {
                const int chx = ch0 + u * NT, ch = chx < N ? chx : N - 1;
                const int kc = ch & 63, n = (ch >> 6) & 511, g = ch >> 15, t = n >> 4, co = n & 15, k0 = kc * 8, s_ = k0 >> 4, ci0 = k0 & 15;
                const int lf = t - s_, lb = s_ - t;
                const float* kf = KK + (size_t)((g * 2 + 0) * 32 + (lf >= 0 ? lf : 0)) * 256 + co * 16 + ci0;
                const float* kb = KK + (size_t)((g * 2 + 1) * 32 + (lb >= 0 ? lb : 0)) * 256 + co * 16 + ci0;
                f0[u] = *(const f32x4*)kf; f1[u] = *(const f32x4*)(kf + 4); b0[u] = *(const f32x4*)kb; b1[u] = *(const f32x4*)(kb + 4);
                dsk[u] = p.in[I_S5D][16 * g + co];
            }
#pragma unroll
            for (int u = 0; u < U; ++u) {
                const int ch = ch0 + u * NT;
                const int kc = ch & 63, n = (ch >> 6) & 511, g = ch >> 15, t = n >> 4, co = n & 15, k0 = kc * 8, s_ = k0 >> 4, ci0 = k0 & 15;
                const int lf = t - s_, lb = s_ - t; const float mf = lf >= 0 ? 1.f : 0.f, mb = lb >= 0 ? 1.f : 0.f;
                float v[8];
#pragma unroll
                for (int j = 0; j < 4; ++j) {
                    v[j] = f0[u][j] * mf + b0[u][j] * mb + ((s_ == t && ci0 + j == co) ? dsk[u] : 0.f);
                    v[4 + j] = f1[u][j] * mf + b1[u][j] * mb + ((s_ == t && ci0 + 4 + j == co) ? dsk[u] : 0.f);
                }
                u32x4 w; w.x = pk2(v[0], v[1]); w.y = pk2(v[2], v[3]); w.z = pk2(v[4], v[5]); w.w = pk2(v[6], v[7]);
                if (ch < N) *(u32x4*)(ME + ((size_t)(g * 512 + n)) * 768 + k0) = w;
            }
        }
    }
    {
        constexpr int N = 32 * 512 * 32, U = 2;
        for (int ch0 = gt; ch0 < N; ch0 += U * NT) {
            f32x4 pq[U][4], cr0[U], cr1[U], ci0v[U], ci1v[U];
#pragma unroll
            for (int u = 0; u < U; ++u) {
                const int chx = ch0 + u * NT, ch = chx < N ? chx : N - 1;
                const int kc = ch & 31, n = (ch >> 5) & 511, g = ch >> 14, t = n >> 4, co = n & 15, kk = kc * 8;
                const int d = kk >> 7, p0 = kk & 63, jj = d == 0 ? t + 1 : 32 - t;
                const float* pw = PWG + ((size_t)((g * 2 + d) * 33 + jj) * 64 + p0) * 2;
                const float* crp = p.in[I_CRE] + (size_t)((d * 32 + g) * 16 + co) * 64 + p0; const float* cip = p.in[I_CIM] + (size_t)((d * 32 + g) * 16 + co) * 64 + p0;
#pragma unroll
                for (int q = 0; q < 4; ++q) pq[u][q] = *(const f32x4*)(pw + 4 * q);
                cr0[u] = *(const f32x4*)crp; cr1[u] = *(const f32x4*)(crp + 4); ci0v[u] = *(const f32x4*)cip; ci1v[u] = *(const f32x4*)(cip + 4);
            }
#pragma unroll
            for (int u = 0; u < U; ++u) {
                const int ch = ch0 + u * NT;
                const int kc = ch & 31, n = (ch >> 5) & 511, g = ch >> 14, kk = kc * 8, ri = (kk >> 6) & 1;
                float v[8];
#pragma unroll
                for (int j = 0; j < 8; ++j) {
                    const float pr = pq[u][j >> 1][(j & 1) * 2], pi = pq[u][j >> 1][(j & 1) * 2 + 1];
                    const float cr = j < 4 ? cr0[u][j & 3] : cr1[u][j & 3], cim = j < 4 ? ci0v[u][j & 3] : ci1v[u][j & 3];
                    const float zr = cr * pr - cim * pi, zi = cr * pi + cim * pr;
                    v[j] = ri == 0 ? zr : -zi;
                }
                u32x4 w; w.x = pk2(v[0], v[1]); w.y = pk2(v[2], v[3]); w.z = pk2(v[4], v[5]); w.w = pk2(v[6], v[7]);
                if (ch < N) *(u32x4*)(ME + ((size_t)(g * 512 + n)) * 768 + 512 + kk) = w;
            }
        }
    }
    {
        constexpr int N = 32 * 256 * 64, U = 4;
        for (int ch0 = gt; ch0 < N; ch0 += U * NT) {
            f32x4 bq[U][4]; float prr[U], pii[U];
#pragma unroll
            for (int u = 0; u < U; ++u) {
                const int chx = ch0 + u * NT, ch = chx < N ? chx : N - 1;
                const int kc = ch & 63, n = (ch >> 6) & 255, g = ch >> 14, d = n >> 7, pp = n & 63, k0 = kc * 8, s_ = k0 >> 4, ci0 = k0 & 15;
                const int jj = d == 0 ? 31 - s_ : s_;
                prr[u] = PWG[((size_t)((g * 2 + d) * 33 + jj) * 64 + pp) * 2]; pii[u] = PWG[((size_t)((g * 2 + d) * 33 + jj) * 64 + pp) * 2 + 1];
                const float* bb = BBG + ((size_t)(g * 2 + d) * 1024 + pp * 16 + ci0) * 2;
#pragma unroll
                for (int q = 0; q < 4; ++q) bq[u][q] = *(const f32x4*)(bb + 4 * q);
            }
#pragma unroll
            for (int u = 0; u < U; ++u) {
                const int ch = ch0 + u * NT;
                const int kc = ch & 63, n = (ch >> 6) & 255, g = ch >> 14, ri = (n >> 6) & 1, k0 = kc * 8;
                float v[8];
#pragma unroll
                for (int j = 0; j < 8; ++j) {
                    const float br = bq[u][j >> 1][(j & 1) * 2], bi = bq[u][j >> 1][(j & 1) * 2 + 1];
                    v[j] = ri == 0 ? (prr[u] * br - pii[u] * bi) : (prr[u] * bi + pii[u] * br);
                }
                u32x4 w; w.x = pk2(v[0], v[1]); w.y = pk2(v[2], v[3]); w.z = pk2(v[4], v[5]); w.w = pk2(v[6], v[7]);
                if (ch < N) *(u32x4*)(WF + ((size_t)(g * 256 + n)) * 512 + k0) = w;
            }
        }
    }
}

template <int SRC>
__device__ __forceinline__ void norm_load(const Params& p, int row, int lane, f32x4 (&v)[4]) {
    if (SRC == 0) {
        const float* src = (row < NLAT ? p.in[I_X] + (size_t)row * DM : p.in[I_CTX] + (size_t)(row - NLAT) * DM) + 8 * lane;
        v[0] = *(const f32x4*)(src); v[1] = *(const f32x4*)(src + 4); v[2] = *(const f32x4*)(src + 512); v[3] = *(const f32x4*)(src + 516);
    } else {
        const bf16_t* src = (const bf16_t*)(p.ws + WS_XR) + (size_t)row * DM + 8 * lane;
        const u32x4 a = *(const u32x4*)(src), c = *(const u32x4*)(src + 512);
        v[0] = (f32x4){bflo(a.x), bfhi(a.x), bflo(a.y), bfhi(a.y)}; v[1] = (f32x4){bflo(a.z), bfhi(a.z), bflo(a.w), bfhi(a.w)};
        v[2] = (f32x4){bflo(c.x), bfhi(c.x), bflo(c.y), bfhi(c.y)}; v[3] = (f32x4){bflo(c.z), bfhi(c.z), bflo(c.w), bfhi(c.w)};
    }
}
template <int SRC>
__device__ __forceinline__ void phase_norm(const Ctx& X, const Params& p, int l, int ffn, int ntok) {
    const float* gain = (ffn ? p.in[I_NFG] : p.in[I_NMG]) + l * 1024;
    const float* mod = (const float*)(p.ws + WS_MOD) + (size_t)l * 9 * 6144;
    const int shi = ffn ? 3 : 0, sci = ffn ? 4 : 1;
    bf16_t* XA = (bf16_t*)(p.ws + WS_XA);
    const int rpw = (ntok + X.NGW - 1) / X.NGW, r0 = X.gw * rpw, r1 = (r0 + rpw) < ntok ? (r0 + rpw) : ntok;
    int curb = -1; f32x4 gm[4], sh[4];
    f32x4 vn[4];
    if (r0 < r1) norm_load<SRC>(p, r0, X.lane, vn);
    for (int row = r0; row < r1; ++row) {
        const int b = row < NLAT ? (row >> 11) : 8;
        if (b != curb) {
            curb = b;
#pragma unroll
            for (int j = 0; j < 4; ++j) {
                const int c = 8 * X.lane + 512 * (j >> 1) + 4 * (j & 1);
                const f32x4 g4 = *(const f32x4*)(gain + c), sc4 = *(const f32x4*)(mod + b * 6144 + sci * 1024 + c);
                sh[j] = *(const f32x4*)(mod + b * 6144 + shi * 1024 + c); gm[j] = g4 * (sc4 + 1.f);
            }
        }
        f32x4 v[4]; float ss = 0.f;
#pragma unroll
        for (int j = 0; j < 4; ++j) v[j] = vn[j];
        if (row + 1 < r1) norm_load<SRC>(p, row + 1, X.lane, vn);
#pragma unroll
        for (int j = 0; j < 4; ++j) ss += (v[j][0] * v[j][0] + v[j][1] * v[j][1]) + (v[j][2] * v[j][2] + v[j][3] * v[j][3]);
        const float rstd = rsqrtf(wave_sum_uniform(ss) * (1.f / 1024.f) + 1e-6f);
        const f32x4 o0 = v[0] * rstd * gm[0] + sh[0], o1 = v[1] * rstd * gm[1] + sh[1], o2 = v[2] * rstd * gm[2] + sh[2], o3 = v[3] * rstd * gm[3] + sh[3];
        *(u32x4*)(XA + (size_t)row * DM + 8 * X.lane) = pack8(o0, o1); *(u32x4*)(XA + (size_t)row * DM + 512 + 8 * X.lane) = pack8(o2, o3);
        if (SRC == 0) {
            bf16_t* XRw = (bf16_t*)(p.ws + WS_XR);
            *(u32x4*)(XRw + (size_t)row * DM + 8 * X.lane) = pack8(v[0], v[1]); *(u32x4*)(XRw + (size_t)row * DM + 512 + 8 * X.lane) = pack8(v[2], v[3]);
        }
    }
}

__device__ __forceinline__ void phase_scan_conv(const Ctx& X, const Params& p) {
    const float* F = (const float*)(p.ws + WS_F); bf16_t* A2 = (bf16_t*)(p.ws + WS_A2); const float* PWG = (const float*)(p.ws + WS_PW);
    for (int gid = X.blk * 512 + X.tid; gid < 32768; gid += X.G * 512) {
        const int pp = gid & 63, d = (gid >> 6) & 1, g = (gid >> 7) & 31, b = gid >> 12;
        const float ar = PWG[((size_t)((g * 2 + d) * 33 + 32) * 64 + pp) * 2], ai = PWG[((size_t)((g * 2 + d) * 33 + 32) * 64 + pp) * 2 + 1];
        float sr = 0.f, si = 0.f;
        for (int s8 = 0; s8 < 72; s8 += 24) {
            float fr[24], fi[24];
#pragma unroll
            for (int q = 0; q < 24; ++q) {
                const int step = s8 + q; int r;
                if (d == 0) r = step < 8 ? 512 + b * 8 + step : b * 64 + (step - 8);
                else        r = step < 8 ? 512 + b * 8 + (7 - step) : b * 64 + (71 - step);
                const size_t ro = (size_t)(g * S5RP + r);
                fr[q] = F[ro * 256 + d * 128 + pp]; fi[q] = F[ro * 256 + d * 128 + 64 + pp];
            }
#pragma unroll
            for (int q = 0; q < 24; ++q) {
                const int step = s8 + q; int r;
                if (d == 0) r = step < 8 ? 512 + b * 8 + step : b * 64 + (step - 8);
                else        r = step < 8 ? 512 + b * 8 + (7 - step) : b * 64 + (71 - step);
                const size_t ro = (size_t)(g * S5RP + r);
                A2[ro * S5K + 512 + d * 128 + pp] = (bf16_t)f2bf(sr); A2[ro * S5K + 512 + d * 128 + 64 + pp] = (bf16_t)f2bf(si);
                const float nr = ar * sr - ai * si + fr[q], ni = ar * si + ai * sr + fi[q];
                sr = nr; si = ni;
            }
        }
    }
    const bf16_t* BCV = (const bf16_t*)(p.ws + WS_BCV); bf16_t* Z = (bf16_t*)(p.ws + WS_Z); const float* cw = p.in[I_CONVW];
    const int cskip = X.G >= 128 ? 64 : 0;
    if (X.blk >= cskip) {
        const int nthr = (X.G - cskip) * 512, it0 = (X.blk - cskip) * 512 + X.tid;
        const bool cinv = (nthr & 63) == 0;
        constexpr int U = 3;
        float wq[24];
        { const int c0 = (it0 & 63) * 8;
#pragma unroll
          for (int j = 0; j < 8; ++j) { wq[j] = cw[c0 + j]; wq[8 + j] = cw[512 + c0 + j]; wq[16 + j] = cw[1024 + c0 + j]; } }
        for (int itb = it0; itb < NTOK * 64; itb += U * nthr) {
            u32x4 bg[U], cg0[U], cg1[U], cg2[U], v0[U], v1[U], v2[U];
#pragma unroll
            for (int u = 0; u < U; ++u) {
                const int itx = itb + u * nthr, it = itx < NTOK * 64 ? itx : NTOK * 64 - 1;
                const int tok = it >> 6, c0 = (it & 63) * 8;
                const int pos = tok < NLAT ? (tok & 2047) : ((tok - NLAT) & 255), len = tok < NLAT ? 2048 : 256;
                const bf16_t* base = BCV + (size_t)tok * 1536;
                const bf16_t* bm = pos > 0 ? base - 1536 : base; const bf16_t* bp = pos < len - 1 ? base + 1536 : base;
                bg[u] = *(const u32x4*)(base + c0); cg1[u] = *(const u32x4*)(base + 512 + c0); v1[u] = *(const u32x4*)(base + 1024 + c0);
                cg0[u] = *(const u32x4*)(bm + 512 + c0); v0[u] = *(const u32x4*)(bm + 1024 + c0);
                cg2[u] = *(const u32x4*)(bp + 512 + c0); v2[u] = *(const u32x4*)(bp + 1024 + c0);
            }
#pragma unroll
            for (int u = 0; u < U; ++u) {
                const int it = itb + u * nthr;
                const int tok = it >> 6, c0 = (it & 63) * 8;
                const int pos = tok < NLAT ? (tok & 2047) : ((tok - NLAT) & 255), len = tok < NLAT ? 2048 : 256;
                const float m0 = pos > 0 ? 1.f : 0.f, m2 = pos < len - 1 ? 1.f : 0.f;
                if (!cinv) {
#pragma unroll
                    for (int j = 0; j < 8; ++j) { wq[j] = cw[c0 + j]; wq[8 + j] = cw[512 + c0 + j]; wq[16 + j] = cw[1024 + c0 + j]; }
                }
                float o[8];
#pragma unroll
                for (int j = 0; j < 4; ++j) {
                    o[2 * j] = bflo(bg[u][j]) * (m0 * wq[2 * j] * bflo(cg0[u][j]) * bflo(v0[u][j]) + wq[8 + 2 * j] * bflo(cg1[u][j]) * bflo(v1[u][j]) + m2 * wq[16 + 2 * j] * bflo(cg2[u][j]) * bflo(v2[u][j]));
                    o[2 * j + 1] = bfhi(bg[u][j]) * (m0 * wq[2 * j + 1] * bfhi(cg0[u][j]) * bfhi(v0[u][j]) + wq[8 + 2 * j + 1] * bfhi(cg1[u][j]) * bfhi(v1[u][j]) + m2 * wq[16 + 2 * j + 1] * bfhi(cg2[u][j]) * bfhi(v2[u][j]));
                }
                u32x4 w; w.x = pk2(o[0], o[1]); w.y = pk2(o[2], o[3]); w.z = pk2(o[4], o[5]); w.w = pk2(o[6], o[7]);
                if (it < NTOK * 64) *(u32x4*)(Z + (size_t)tok * 1024 + 512 + c0) = w;
            }
        }
    }
}

constexpr int RR_MAXT = 96, RR_KC = 256, RR_PITCH = RR_KC * 2 + 16;
constexpr int RR_A = 0, RR_B = RR_MAXT * RR_PITCH, RR_LG = RR_B + 64 * RR_PITCH;
__device__ __forceinline__ void phase_route(const Ctx& X, const Params& p, int l, int ntok) {
    LAS int* cnt = (LAS int*)(X.lds + MISC_OFF + M_CNT);
    if (X.tid < NEXP1) cnt[X.tid] = 0;
    const bf16_t* XA = (const bf16_t*)(p.ws + WS_XA); const bf16_t* RT = (const bf16_t*)(p.ws + WS_ROUT) + (size_t)l * 256 * 1024;
    int* toke = (int*)(p.ws + WS_TOKE); float* tokw = (float*)(p.ws + WS_TOKW); int* tokp = (int*)(p.ws + WS_TOKP);
    const float rb = p.in[I_RB][l * 64 + X.lane];
    const int tpb = (ntok + X.G - 1) / X.G, t0 = X.blk * tpb, t1 = (t0 + tpb) < ntok ? (t0 + tpb) : ntok, nrow = t1 - t0;
    const int lane = X.lane, grp = lane >> 3, fr = lane & 15, fq = lane >> 4;
    const int nt_ = X.wave & 3, mh = X.wave >> 2;
    f32x4 acc[3];
#pragma unroll
    for (int m = 0; m < 3; ++m) acc[m] = (f32x4){0.f, 0.f, 0.f, 0.f};
    u32x4 va[6], vb[4];
#define RR_LOAD(kc_) do { \
        _Pragma("unroll") for (int q = 0; q < 6; ++q) { const int i = X.tid + 512 * q, r = i >> 5, c = i & 31; const int rr = r < nrow ? r : 0; \
            va[q] = *(const u32x4*)(XA + (size_t)(t0 + rr) * DM + (kc_) + 8 * c); if (r >= nrow) va[q] = (u32x4){0u, 0u, 0u, 0u}; } \
        _Pragma("unroll") for (int q = 0; q < 4; ++q) { const int i = X.tid + 512 * q, r = i >> 5, c = i & 31; vb[q] = *(const u32x4*)(RT + (size_t)r * 1024 + (kc_) + 8 * c); } } while (0)
    RR_LOAD(0);
    for (int kc = 0; kc < 1024; kc += RR_KC) {
        __syncthreads();
#pragma unroll
        for (int q = 0; q < 6; ++q) { const int i = X.tid + 512 * q, r = i >> 5, c = i & 31; *(LAS u32x4*)(X.lds + RR_A + r * RR_PITCH + 16 * c) = va[q]; }
#pragma unroll
        for (int q = 0; q < 4; ++q) { const int i = X.tid + 512 * q, r = i >> 5, c = i & 31; *(LAS u32x4*)(X.lds + RR_B + r * RR_PITCH + 16 * c) = vb[q]; }
        __syncthreads();
        if (kc + RR_KC < 1024) RR_LOAD(kc + RR_KC);
#pragma unroll
        for (int ks = 0; ks < RR_KC / 32; ++ks) {
            const bf16x8 bfr = *(const LAS bf16x8*)(X.lds + RR_B + (16 * nt_ + fr) * RR_PITCH + 64 * ks + 16 * fq);
#pragma unroll
            for (int m = 0; m < 3; ++m) {
                const bf16x8 afr = *(const LAS bf16x8*)(X.lds + RR_A + (16 * (3 * mh + m) + fr) * RR_PITCH + 64 * ks + 16 * fq);
                acc[m] = __builtin_amdgcn_mfma_f32_16x16x32_bf16(afr, bfr, acc[m], 0, 0, 0);
            }
        }
    }
#undef RR_LOAD
    LAS float* LG = (LAS float*)(X.lds + RR_LG);
#pragma unroll
    for (int m = 0; m < 3; ++m)
#pragma unroll
        for (int j = 0; j < 4; ++j) LG[(16 * (3 * mh + m) + 4 * fq + j) * 64 + 16 * nt_ + fr] = acc[m][j];
    __syncthreads();
    for (int tok = t0 + X.wave; tok < t1; tok += 8) {
        const float score = sigmoidf_(LG[(tok - t0) * 64 + lane]);
        const float sel = score + rb;
        int rk = 0;
#pragma unroll
        for (int x = 1; x < 8; ++x) {
            const float o = x == 1 ? dpp_xor8<1>(sel) : x == 2 ? dpp_xor8<2>(sel) : x == 3 ? dpp_xor8<3>(sel) : x == 4 ? dpp_xor8<4>(sel) : x == 5 ? dpp_xor8<5>(sel) : x == 6 ? dpp_xor8<6>(sel) : dpp_xor8<7>(sel);
            const int ol = lane ^ x; rk += ((o > sel) || (o == sel && ol < lane)) ? 1 : 0; }
        float gs = rk < 2 ? sel : 0.f;
        gs += dpp_xor8<1>(gs); gs += dpp_xor8<2>(gs); gs += dpp_xor8<7>(gs);
        int grk = 0;
#pragma unroll
        for (int og = 0; og < 8; ++og) { const float o = __builtin_bit_cast(float, __builtin_amdgcn_readlane(__builtin_bit_cast(int, gs), 8 * og)); grk += ((o > gs) || (o == gs && og < grp)) ? 1 : 0; }
        const float msel = grk < 4 ? sel : -__builtin_inff();
        int rank = 8; float cur = msel;
#pragma unroll
        for (int it = 0; it < 8; ++it) {
            const float m = wave_max_uniform(cur);
            const int idx = __builtin_ctzll(__ballot(cur == m));
            if (lane == idx) { rank = it; cur = -__builtin_inff(); }
        }
        const bool chosen = rank < 8;
        const float wsum = wave_sum_uniform(chosen ? score : 0.f);
        if (chosen) {
            const int lpos = __hip_atomic_fetch_add(cnt + lane, 1, __ATOMIC_RELAXED, __HIP_MEMORY_SCOPE_WORKGROUP);
            toke[(size_t)tok * 8 + rank] = lane; tokw[(size_t)tok * 8 + rank] = score / wsum * 2.5f; tokp[(size_t)tok * 8 + rank] = lpos;
        }
    }
    __syncthreads();
    int* cntblk = (int*)(p.ws + WS_CNTBLK);
    if (X.tid < NEXP1) cntblk[X.blk * NEXP1 + X.tid] = X.tid < NEXP ? cnt[X.tid] : 0;
}

__device__ __forceinline__ void phase_slots(const Ctx& X, const Params& p, int ntok) {
    LAS int* part = (LAS int*)(X.lds + MISC_OFF + M_PART);
    LAS int* ptot = (LAS int*)(X.lds);
    LAS int* pbb = (LAS int*)(X.lds + 4096);
    LAS int* base = (LAS int*)(X.lds + MISC_OFF + M_BASE);
    LAS int* bbase = (LAS int*)(X.lds + MISC_OFF + M_BBASE);
    LAS int* tot = (LAS int*)(X.lds + 8192);
    LAS int* ntl = (LAS int*)(X.lds + MISC_OFF + M_NT);
    (void)part;
    const int* cntblk = (const int*)(p.ws + WS_CNTBLK);
    {
        const int e = X.tid & 63, pt = X.tid >> 6; int s = 0, sb = 0;
        if ((X.G & 7) == 0 && X.G <= 256) {
            const int nb8 = X.G >> 3, b0 = nb8 * pt;
            int c[32];
#pragma unroll
            for (int k = 0; k < 32; ++k) c[k] = cntblk[(b0 + (k < nb8 ? k : 0)) * NEXP1 + e];
#pragma unroll
            for (int k = 0; k < 32; ++k) { const int v = k < nb8 ? c[k] : 0; s += v; sb += (b0 + k < X.blk) ? v : 0; }
        } else {
            const int b0 = (X.G * pt) / 8, b1 = (X.G * (pt + 1)) / 8;
            for (int b = b0; b < b1; ++b) { const int c = cntblk[b * NEXP1 + e]; s += c; sb += (b < X.blk) ? c : 0; }
        }
        ptot[pt * 64 + e] = s; pbb[pt * 64 + e] = sb;
    }
    __syncthreads();
    if (X.tid < NEXP) { int t_ = 0, b_ = 0;
#pragma unroll
        for (int q = 0; q < 8; ++q) { t_ += ptot[q * 64 + X.tid]; b_ += pbb[q * 64 + X.tid]; }
        tot[X.tid] = t_; bbase[X.tid] = b_; }
    __syncthreads();
    if (X.tid == 0) { int acc = 0; for (int e = 0; e < NEXP; ++e) { base[e] = acc; acc += (tot[e] + 255) & ~255; } base[NEXP] = acc; base[NEXP1] = acc + ntok; ntl[0] = (acc + ntok) >> 8; }
    __syncthreads();
    int* rowidx = (int*)(p.ws + WS_ROWIDX); int* tokslot = (int*)(p.ws + WS_YROW);
    const int* toke = (const int*)(p.ws + WS_TOKE); const int* tokp = (const int*)(p.ws + WS_TOKP);
    const int tpb = (ntok + X.G - 1) / X.G, t0 = X.blk * tpb, t1 = (t0 + tpb) < ntok ? (t0 + tpb) : ntok;
    for (int i = t0 * 8 + X.tid; i < t1 * 8; i += 512) {
        const int e = toke[i]; const int slot = base[e] + bbase[e] + tokp[i];
        rowidx[slot] = i >> 3; tokslot[(i >> 3) * 9 + (i & 7)] = slot;
    }
    const int sbase = base[NEXP];
    for (int tok = X.blk * 512 + X.tid; tok < ntok; tok += X.G * 512) { rowidx[sbase + tok] = tok; tokslot[tok * 9 + 8] = sbase + tok; }
    for (int e = X.blk; e < NEXP; e += X.G)
        for (int s = base[e] + tot[e] + X.tid; s < base[e + 1]; s += 512) rowidx[s] = 0;
    if (X.blk == 0) {
        int* TAB = (int*)(p.ws + WS_TAB);
        if (X.tid == 0) TAB[128] = ntl[0];
        for (int t = X.tid; t < ntl[0]; t += 512) {
            const int s = t * 256; int lo = 0, hi = NEXP;
#pragma unroll
            for (int it = 0; it < 7; ++it) { const int mid = (lo + hi + 1) >> 1; if (base[mid] <= s) lo = mid; else hi = mid - 1; }
            TAB[256 + t] = lo; }
    }
}
__device__ __forceinline__ int load_tiles(const Ctx& X, const Params& p) {
    const int* TAB = (const int*)(p.ws + WS_TAB);
    LAS unsigned char* te = X.lds + MISC_OFF + M_TILE;
    const int nt = TAB[128];
    for (int t = X.tid; t < nt; t += 512) te[t] = (unsigned char)TAB[256 + t];
    __syncthreads();
    return __builtin_amdgcn_readfirstlane(nt);
}

template <bool NEXTNORM>
__device__ __forceinline__ void phase_combine(const Ctx& X, const Params& p, int l, int ntok, bool final_out, float rs) {
    const unsigned char* Y = (const unsigned char*)(p.ws + WS_Y); bf16_t* XR = (bf16_t*)(p.ws + WS_XR);
    const int* tokslot = (const int*)(p.ws + WS_YROW); const float* tokw = (const float*)(p.ws + WS_TOKW);
    const float* gate = (const float*)(p.ws + WS_MOD) + (size_t)l * 9 * 6144 + 5 * 1024;
    const float* gain = p.in[I_NMG] + (l + 1) * 1024; const float* modn = (const float*)(p.ws + WS_MOD) + (size_t)(l + 1) * 9 * 6144;
    bf16_t* XN = (bf16_t*)(p.ws + WS_ACT);
    for (int tok = X.gw; tok < ntok; tok += X.NGW) {
        const int b = tok < NLAT ? (tok >> 11) : 8, c = 16 * X.lane;
        float s[16];
#pragma unroll
        for (int q = 0; q < 16; ++q) s[q] = 0.f;
#pragma unroll
        for (int j = 0; j < 9; ++j) {
            const int slot = __builtin_amdgcn_readfirstlane(tokslot[tok * 9 + j]);
            const float w = j < 8 ? __builtin_bit_cast(float, __builtin_amdgcn_readfirstlane(__builtin_bit_cast(int, tokw[tok * 8 + (j & 7)]))) : 1.f;
            const u32x4 y = *(const u32x4*)(Y + ((size_t)slot * 1024 + c));
#pragma unroll
            for (int q = 0; q < 4; ++q) {
                const f32x2 lo = __builtin_amdgcn_cvt_pk_f32_fp8((int)y[q], false), hi = __builtin_amdgcn_cvt_pk_f32_fp8((int)y[q], true);
                s[4 * q] += w * lo.x; s[4 * q + 1] += w * lo.y; s[4 * q + 2] += w * hi.x; s[4 * q + 3] += w * hi.y;
            }
        }
        const float* gp = gate + b * 6144 + c; bf16_t* xp = XR + (size_t)tok * DM + c;
        const float sc = rs * (1.f / 16.f);
        const u32x4 xa = *(const u32x4*)xp, xc = *(const u32x4*)(xp + 8);
        f32x4 o[4]; float ss = 0.f;
        o[0] = (f32x4){bflo(xa.x), bfhi(xa.x), bflo(xa.y), bfhi(xa.y)}; o[1] = (f32x4){bflo(xa.z), bfhi(xa.z), bflo(xa.w), bfhi(xa.w)};
        o[2] = (f32x4){bflo(xc.x), bfhi(xc.x), bflo(xc.y), bfhi(xc.y)}; o[3] = (f32x4){bflo(xc.z), bfhi(xc.z), bflo(xc.w), bfhi(xc.w)};
#pragma unroll
        for (int q = 0; q < 4; ++q) {
            const f32x4 g = *(const f32x4*)(gp + 4 * q) * sc;
            o[q] = o[q] + g * (f32x4){s[4 * q], s[4 * q + 1], s[4 * q + 2], s[4 * q + 3]};
            if (final_out) *(f32x4*)(p.out + (size_t)tok * DM + c + 4 * q) = o[q];
            ss += (o[q][0] * o[q][0] + o[q][1] * o[q][1]) + (o[q][2] * o[q][2] + o[q][3] * o[q][3]);
        }
        if (!final_out) { *(u32x4*)xp = pack8(o[0], o[1]); *(u32x4*)(xp + 8) = pack8(o[2], o[3]); }
        if (NEXTNORM) {
            const float rstd = rsqrtf(wave_sum_uniform(ss) * (1.f / 1024.f) + 1e-6f);
            u32x4 w0, w1;
#pragma unroll
            for (int q = 0; q < 4; ++q) {
                const f32x4 g4 = *(const f32x4*)(gain + c + 4 * q), sc4 = *(const f32x4*)(modn + b * 6144 + 1024 + c + 4 * q), sh4 = *(const f32x4*)(modn + b * 6144 + c + 4 * q);
                const f32x4 v = o[q] * rstd * (g4 * (sc4 + 1.f)) + sh4;
                if (q < 2) { w0[2 * q] = pk2(v[0], v[1]); w0[2 * q + 1] = pk2(v[2], v[3]); } else { w1[2 * (q - 2)] = pk2(v[0], v[1]); w1[2 * (q - 2) + 1] = pk2(v[2], v[3]); }
            }
            *(u32x4*)(XN + (size_t)tok * DM + c) = w0; *(u32x4*)(XN + (size_t)tok * DM + c + 8) = w1;
        }
    }
}

constexpr float AT_DEFER = 8.f;
constexpr int AT_KB = 8192, AT_VB = 8192, AT_K0 = 0, AT_V0 = 4 * AT_KB, AT_BIAS = 4 * AT_KB + 4 * AT_VB, AT_BPAD = 48, AT_BP = 48;
constexpr int AT_NINF = 3584, AT_CK = AT_BIAS + 3712,
     AT_CVP = 0, AT_CV = AT_CK + 256 * 128;
static_assert(AT_CV + 256 * 128 <= MISC_OFF + M_BAR && AT_V0 % 128 == 0 && AT_CV % 128 == 0 && AT_VB % 128 == 0, "attention LDS map");
#define ATT_TR(dst_, a_, off_) asm volatile("ds_read_b64_tr_b16 %0, %1 offset:%2" : "=&v"(dst_) : "v"(a_), "i"(off_) : "memory")
#define ATT_VFRAGS(LAT_, voff_, t0_, a0, a1, a2, a3, c0, c1, c2, c3) do { const unsigned va_ = (LAT_) ? vlat0 : vctx0, vc_ = (LAT_) ? vlat1 : vctx1; \
    ATT_TR(a0, va_, ((LAT_) ? (voff_) : (voff_) + (t0_) * 128) + 0); ATT_TR(a1, va_, ((LAT_) ? (voff_) : (voff_) + (t0_) * 128) + 1024); ATT_TR(a2, va_, ((LAT_) ? (voff_) : (voff_) + (t0_) * 128) + 2048); ATT_TR(a3, va_, ((LAT_) ? (voff_) : (voff_) + (t0_) * 128) + 3072); \
    ATT_TR(c0, vc_, ((LAT_) ? (voff_) : (voff_) + (t0_) * 128) + 0); ATT_TR(c1, vc_, ((LAT_) ? (voff_) : (voff_) + (t0_) * 128) + 1024); ATT_TR(c2, vc_, ((LAT_) ? (voff_) : (voff_) + (t0_) * 128) + 2048); ATT_TR(c3, vc_, ((LAT_) ? (voff_) : (voff_) + (t0_) * 128) + 3072); } while (0)
#define ATT_TRWAIT asm volatile("s_waitcnt lgkmcnt(0)" : "+v"(a0), "+v"(a1), "+v"(a2), "+v"(a3), "+v"(c0), "+v"(c1), "+v"(c2), "+v"(c3) :: "memory")
#define ATT_TILE(kb_, vb_, VP_, t0_, LAT_, brow4_, rpen_) do { \
    f32x16 sa; \
    _Pragma("unroll") for (int i = 0; i < 16; ++i) sa[i] = 0.f; \
    _Pragma("unroll") for (int s = 0; s < 4; ++s) { \
        const bf16x8 kf = *(const LAS bf16x8*)((kb_) + ((t0_) + l31) * 128 + (((2 * s + hh) ^ ((((t0_) + l31) >> 1) & 7)) << 4)); \
        sa = __builtin_amdgcn_mfma_f32_32x32x16_bf16(kf, qf[s], sa, 0, 0, 0); } \
    float tmax = -1e30f; \
    if (LAT_) { \
        const LAS float* bp = (const LAS float*)((const LAS unsigned char*)biasL + (brow4_)); \
        _Pragma("unroll") for (int i = 0; i < 16; ++i) { sa[i] = (sa[i] + bp[(i & 3) + 8 * (i >> 2)]) + pen[i]; tmax = fmaxf(tmax, sa[i]); } \
    } else { \
        _Pragma("unroll") for (int i = 0; i < 16; ++i) tmax = fmaxf(tmax, sa[i]); \
    } \
    { const auto sw_ = __builtin_amdgcn_permlane32_swap(__builtin_bit_cast(unsigned, tmax), __builtin_bit_cast(unsigned, tmax), false, false);        \
      tmax = fmaxf(__builtin_bit_cast(float, (unsigned)sw_[0]), __builtin_bit_cast(float, (unsigned)sw_[1])); } \
    if (__any(tmax > mrun + AT_DEFER)) {        \
        const float mnew = fmaxf(mrun, tmax), alpha = __builtin_amdgcn_exp2f(mrun - mnew); \
        lrun *= alpha; mrun = mnew; \
        _Pragma("unroll") for (int i = 0; i < 16; ++i) { o0[i] *= alpha; o1[i] *= alpha; } } \
    float psum = 0.f; \
    _Pragma("unroll") for (int i = 0; i < 16; ++i) { sa[i] = __builtin_amdgcn_exp2f(sa[i] - mrun); psum += sa[i]; } \
    lrun += psum; \
    bf16x8 pf0, pf1; \
    { u32x4 w0, w1; \
      _Pragma("unroll") for (int j = 0; j < 4; ++j) { w0[j] = pk2(sa[2 * j], sa[2 * j + 1]); w1[j] = pk2(sa[8 + 2 * j], sa[8 + 2 * j + 1]); } \
      pf0 = __builtin_bit_cast(bf16x8, w0); pf1 = __builtin_bit_cast(bf16x8, w1); } \
    s16x4 a0, a1, a2, a3, c0, c1, c2, c3; ATT_VFRAGS(LAT_, vb_, t0_, a0, a1, a2, a3, c0, c1, c2, c3); ATT_TRWAIT; \
    const bf16x8 va0 = __builtin_shufflevector(a0, a1, 0, 1, 2, 3, 4, 5, 6, 7), va1 = __builtin_shufflevector(a2, a3, 0, 1, 2, 3, 4, 5, 6, 7); \
    const bf16x8 vb0 = __builtin_shufflevector(c0, c1, 0, 1, 2, 3, 4, 5, 6, 7), vb1 = __builtin_shufflevector(c2, c3, 0, 1, 2, 3, 4, 5, 6, 7); \
    o0 = __builtin_amdgcn_mfma_f32_32x32x16_bf16(va0, pf0, o0, 0, 0, 0); o0 = __builtin_amdgcn_mfma_f32_32x32x16_bf16(va1, pf1, o0, 0, 0, 0); \
    o1 = __builtin_amdgcn_mfma_f32_32x32x16_bf16(vb0, pf0, o1, 0, 0, 0); o1 = __builtin_amdgcn_mfma_f32_32x32x16_bf16(vb1, pf1, o1, 0, 0, 0); \
    } while (0)
#define ATT_TILE2(kbA_, vbA_, t0A_, kbB_, vbB_, t0B_, VP_, LAT_, brow4A_, rpenA_, brow4B_, rpenB_) do { \
    f32x16 sa0, sa1; \
    _Pragma("unroll") for (int i = 0; i < 16; ++i) { sa0[i] = 0.f; sa1[i] = 0.f; } \
    _Pragma("unroll") for (int s = 0; s < 4; ++s) { \
        const bf16x8 kf0 = *(const LAS bf16x8*)((kbA_) + ((t0A_) + l31) * 128 + (((2 * s + hh) ^ ((((t0A_) + l31) >> 1) & 7)) << 4)); \
        const bf16x8 kf1 = *(const LAS bf16x8*)((kbB_) + ((t0B_) + l31) * 128 + (((2 * s + hh) ^ ((((t0B_) + l31) >> 1) & 7)) << 4)); \
        sa0 = __builtin_amdgcn_mfma_f32_32x32x16_bf16(kf0, qf[s], sa0, 0, 0, 0); \
        sa1 = __builtin_amdgcn_mfma_f32_32x32x16_bf16(kf1, qf[s], sa1, 0, 0, 0); } \
    float tmax = -1e30f; \
    if (LAT_) { \
        const LAS float* bpA = (const LAS float*)((const LAS unsigned char*)biasL + (brow4A_)); const LAS float* bpB = (const LAS float*)((const LAS unsigned char*)biasL + (brow4B_)); \
        _Pragma("unroll") for (int i = 0; i < 16; ++i) { \
            sa0[i] = (sa0[i] + bpA[(i & 3) + 8 * (i >> 2)]) + pen[i]; sa1[i] = (sa1[i] + bpB[(i & 3) + 8 * (i >> 2)]) + pen[i]; \
            tmax = fmaxf(tmax, fmaxf(sa0[i], sa1[i])); } \
    } else { \
        _Pragma("unroll") for (int i = 0; i < 16; ++i) tmax = fmaxf(tmax, fmaxf(sa0[i], sa1[i])); \
    } \
    { const auto sw_ = __builtin_amdgcn_permlane32_swap(__builtin_bit_cast(unsigned, tmax), __builtin_bit_cast(unsigned, tmax), false, false);        \
      tmax = fmaxf(__builtin_bit_cast(float, (unsigned)sw_[0]), __builtin_bit_cast(float, (unsigned)sw_[1])); } \
    if (__any(tmax > mrun + AT_DEFER)) {        \
        const float mnew = fmaxf(mrun, tmax), alpha = __builtin_amdgcn_exp2f(mrun - mnew); \
        lrun *= alpha; mrun = mnew; \
        _Pragma("unroll") for (int i = 0; i < 16; ++i) { o0[i] *= alpha; o1[i] *= alpha; } } \
    float psumA = 0.f, psumB = 0.f; \
    _Pragma("unroll") for (int i = 0; i < 16; ++i) { sa0[i] = __builtin_amdgcn_exp2f(sa0[i] - mrun); sa1[i] = __builtin_amdgcn_exp2f(sa1[i] - mrun); psumA += sa0[i]; psumB += sa1[i]; } \
    lrun += psumA + psumB; \
    bf16x8 pf0, pf1, pf2, pf3; \
    { u32x4 w0, w1, w2, w3; \
      _Pragma("unroll") for (int j = 0; j < 4; ++j) { w0[j] = pk2(sa0[2 * j], sa0[2 * j + 1]); w1[j] = pk2(sa0[8 + 2 * j], sa0[8 + 2 * j + 1]); \
                                                      w2[j] = pk2(sa1[2 * j], sa1[2 * j + 1]); w3[j] = pk2(sa1[8 + 2 * j], sa1[8 + 2 * j + 1]); } \
      pf0 = __builtin_bit_cast(bf16x8, w0); pf1 = __builtin_bit_cast(bf16x8, w1); pf2 = __builtin_bit_cast(bf16x8, w2); pf3 = __builtin_bit_cast(bf16x8, w3); } \
    { s16x4 a0, a1, a2, a3, c0, c1, c2, c3; ATT_VFRAGS(LAT_, vbA_, t0A_, a0, a1, a2, a3, c0, c1, c2, c3); ATT_TRWAIT; \
      const bf16x8 va0 = __builtin_shufflevector(a0, a1, 0, 1, 2, 3, 4, 5, 6, 7), va1 = __builtin_shufflevector(a2, a3, 0, 1, 2, 3, 4, 5, 6, 7); \
      const bf16x8 vb0 = __builtin_shufflevector(c0, c1, 0, 1, 2, 3, 4, 5, 6, 7), vb1 = __builtin_shufflevector(c2, c3, 0, 1, 2, 3, 4, 5, 6, 7); \
      o0 = __builtin_amdgcn_mfma_f32_32x32x16_bf16(va0, pf0, o0, 0, 0, 0); o1 = __builtin_amdgcn_mfma_f32_32x32x16_bf16(vb0, pf0, o1, 0, 0, 0); \
      o0 = __builtin_amdgcn_mfma_f32_32x32x16_bf16(va1, pf1, o0, 0, 0, 0); o1 = __builtin_amdgcn_mfma_f32_32x32x16_bf16(vb1, pf1, o1, 0, 0, 0); } \
    { s16x4 a0, a1, a2, a3, c0, c1, c2, c3; ATT_VFRAGS(LAT_, vbB_, t0B_, a0, a1, a2, a3, c0, c1, c2, c3); ATT_TRWAIT; \
      const bf16x8 va0 = __builtin_shufflevector(a0, a1, 0, 1, 2, 3, 4, 5, 6, 7), va1 = __builtin_shufflevector(a2, a3, 0, 1, 2, 3, 4, 5, 6, 7); \
      const bf16x8 vb0 = __builtin_shufflevector(c0, c1, 0, 1, 2, 3, 4, 5, 6, 7), vb1 = __builtin_shufflevector(c2, c3, 0, 1, 2, 3, 4, 5, 6, 7); \
      o0 = __builtin_amdgcn_mfma_f32_32x32x16_bf16(va0, pf2, o0, 0, 0, 0); o1 = __builtin_amdgcn_mfma_f32_32x32x16_bf16(vb0, pf2, o1, 0, 0, 0); \
      o0 = __builtin_amdgcn_mfma_f32_32x32x16_bf16(va1, pf3, o0, 0, 0, 0); o1 = __builtin_amdgcn_mfma_f32_32x32x16_bf16(vb1, pf3, o1, 0, 0, 0); } \
    } while (0)
__device__ __forceinline__ void phase_attn(const Ctx& X, const Params& p) {
    const bf16_t* Q = (const bf16_t*)(p.ws + WS_Q); const bf16_t* Kb = (const bf16_t*)(p.ws + WS_K); const bf16_t* VT = (const bf16_t*)(p.ws + WS_VT);
    bf16_t* O = (bf16_t*)(p.ws + WS_O);
    LAS float* biasL = (LAS float*)(X.lds + AT_BIAS);
    const int lane = X.lane, l31 = lane & 31, hh = lane >> 5, tid = X.tid;
    const float LOG2E = 1.4426950408889634f;
    const int skey = tid >> 3, sch = tid & 7;
    const unsigned ldsb = (unsigned)(unsigned long)X.lds;
    const unsigned vlane = (unsigned)((4 * hh + ((lane >> 2) & 3)) * 128 + ((32 * ((lane >> 4) & 1) + 8 * (lane & 3)) ^ (64 * ((lane >> 3) & 1))));
    const unsigned vctx0 = ldsb + AT_CV + vlane, vctx1 = ldsb + AT_CV + (vlane ^ 64u);
    for (int task = X.blk; task < 256; task += X.G) {
        const int b = task >> 5, h = (task >> 1) & 15, hf = task & 1;
        __syncthreads();
        const bf16_t* vcol = VT + (size_t)skey * DM + h * 64 + 8 * sch;
        const bf16_t* kcol = Kb + (size_t)skey * DM + h * 64 + 8 * sch;
        {
            u32x4 ck[4], cv[4];
#pragma unroll
            for (int q = 0; q < 4; ++q) { const size_t kt = (size_t)NLAT + b * 256 + 64 * q; ck[q] = *(const u32x4*)(kcol + kt * DM); cv[q] = *(const u32x4*)(vcol + kt * DM); }
            for (int i = tid; i < 15 * AT_BP + 2 * AT_BPAD + 64; i += 512) { const int j = i - AT_BPAD, dr_ = j / AT_BP, dc_ = j - dr_ * AT_BP; biasL[i] = (j >= 0 && dr_ < 15 && dc_ < 31) ? p.in[I_RPB][h * 465 + dr_ * 31 + dc_] * LOG2E : 0.f; }
            if (tid < 32) biasL[AT_NINF / 4 + tid] = -1e30f;
#pragma unroll
            for (int q = 0; q < 4; ++q) {
                const int key = 64 * q + skey;
                *(LAS u32x4*)(X.lds + AT_CK + key * 128 + ((sch ^ ((key >> 1) & 7)) << 4)) = ck[q];
                *(LAS u32x4*)(X.lds + AT_CV + key * 128 + ((16 * sch) ^ (64 * ((key >> 1) & 1)))) = cv[q];
            }
        }
        for (int gq = 0; gq < 4; ++gq) {
            const int R0 = 16 * hf + 4 * gq;
            const int rp = X.wave >> 2, cb = X.wave & 3, r = R0 + 2 * rp, c0 = 16 * cb;
            const int t0 = cb == 0 ? 0 : (cb == 1 ? 8 : (cb == 2 ? 24 : 32));
            const int rq = r + (l31 >> 4), qc = c0 + (l31 & 15);
            const int r0q = rq < 4 ? 0 : (rq > 28 ? 24 : rq - 4);
            const int r0lo = r < 4 ? 0 : (r > 28 ? 24 : r - 4), r0hi = (r + 1 < 4 ? 0 : (r + 1 > 28 ? 24 : r + 1 - 4)) + 7;
            const int rmin = R0 < 4 ? 0 : (R0 > 28 ? 24 : R0 - 4);
            const int rl = R0 + 3, rmax = (rl < 4 ? 0 : (rl > 28 ? 24 : rl - 4)) + 7;
            const int nl = rmax - rmin + 1, nsteps = (nl + 1) >> 1;
            const size_t qtok = (size_t)b * 2048 + rq * 64 + qc;
            bf16x8 qf[4];
#pragma unroll
            for (int s = 0; s < 4; ++s) qf[s] = *(const bf16x8*)(Q + qtok * DM + h * 64 + 16 * s + 8 * hh);
            const int cs = qc < 8 ? 0 : (qc > 56 ? 48 : qc - 8);
            float pen[16];
#pragma unroll
            for (int i = 0; i < 16; ++i) { const int kc = t0 + (i & 3) + 8 * (i >> 2) + 4 * hh; pen[i] = (kc >= cs && kc < cs + 16) ? 0.f : -1e30f; }
            const unsigned vlat0 = ldsb + AT_V0 + (vlane + (unsigned)t0 * 128u), vlat1 = ldsb + AT_V0 + ((vlane + (unsigned)t0 * 128u) ^ 64u);
            const int lb4 = 4 * ((7 - (l31 >> 4)) * AT_BP + t0 - qc + 15 + 4 * hh + AT_BPAD);
            f32x16 o0, o1;
#pragma unroll
            for (int i = 0; i < 16; ++i) { o0[i] = 0.f; o1[i] = 0.f; }
            float mrun = -1e30f, lrun = 0.f;
            u32x4 kA0, kA1, vA0, vA1, kB0, kB1, vB0, vB1;
#define ATT_ISSUE(st_, k0_, k1_, v0r_, v1r_) do { int s_ = (st_); s_ = s_ < nsteps ? s_ : nsteps - 1; \
                size_t kt0_, kt1_; \
                { const int ra_ = rmin + 2 * s_, rb_ = ra_ + 1 <= rmax ? ra_ + 1 : rmax; kt0_ = (size_t)b * 2048 + ra_ * 64; kt1_ = (size_t)b * 2048 + rb_ * 64; } \
                k0_ = *(const u32x4*)(kcol + kt0_ * DM); k1_ = *(const u32x4*)(kcol + kt1_ * DM); v0r_ = *(const u32x4*)(vcol + kt0_ * DM); v1r_ = *(const u32x4*)(vcol + kt1_ * DM); } while (0)
#define ATT_WRITE(nb_, k0_, k1_, v0r_, v1r_) do { \
                LAS unsigned char* kw_ = X.lds + AT_K0 + (nb_) * 2 * AT_KB + skey * 128 + ((sch ^ ((skey >> 1) & 7)) << 4); \
                *(LAS u32x4*)(kw_) = k0_; *(LAS u32x4*)(kw_ + AT_KB) = k1_; \
                LAS unsigned char* vw_ = X.lds + AT_V0 + (nb_) * 2 * AT_VB + skey * 128 + ((16 * sch) ^ (64 * ((skey >> 1) & 1)));        \
                *(LAS u32x4*)(vw_) = v0r_; *(LAS u32x4*)(vw_ + AT_VB) = v1r_; } while (0)
#define ATT_STEP(st_, cur_) do { const int st = (st_); \
                const LAS unsigned char* kb = X.lds + AT_K0 + (cur_) * 2 * AT_KB; \
                { const int ka = rmin + 2 * st, kc2 = ka + 1; \
                    const bool ina = ka >= r0lo && ka <= r0hi, inb = kc2 <= rmax && kc2 >= r0lo && kc2 <= r0hi; \
                    const float rpa = (ka >= r0q && ka < r0q + 8) ? 0.f : -1e30f, rpb = (kc2 >= r0q && kc2 < r0q + 8) ? 0.f : -1e30f; \
                    const int bra = (ka >= r0q && ka < r0q + 8) ? lb4 + 4 * AT_BP * (ka - r) : AT_NINF, brb = (kc2 >= r0q && kc2 < r0q + 8) ? lb4 + 4 * AT_BP * (kc2 - r) : AT_NINF;     \
                    if (ina && inb) { ATT_TILE2(kb, (cur_) * 2 * AT_VB, t0, kb + AT_KB, (cur_) * 2 * AT_VB + AT_VB, t0, 0, true, bra, rpa, brb, rpb); } \
                    else if (ina) { ATT_TILE(kb, (cur_) * 2 * AT_VB, 0, t0, true, bra, rpa); } \
                    else if (inb) { ATT_TILE(kb + AT_KB, (cur_) * 2 * AT_VB + AT_VB, 0, t0, true, brb, rpb); } } } while (0)
            ATT_ISSUE(0, kA0, kA1, vA0, vA1);
            ATT_ISSUE(1, kB0, kB1, vB0, vB1);
            if (gq == 0) __syncthreads();
            {
                const LAS unsigned char* ck_ = X.lds + AT_CK;
                ATT_TILE2(ck_, 0, 0, ck_, 0, 32, AT_CVP, false, 0, 0.f, 0, 0.f); ATT_TILE2(ck_, 0, 64, ck_, 0, 96, AT_CVP, false, 0, 0.f, 0, 0.f);
                ATT_TILE2(ck_, 0, 128, ck_, 0, 160, AT_CVP, false, 0, 0.f, 0, 0.f); ATT_TILE2(ck_, 0, 192, ck_, 0, 224, AT_CVP, false, 0, 0.f, 0, 0.f);
            }
            ATT_WRITE(0, kA0, kA1, vA0, vA1);
            __syncthreads();
            for (int sp = 0; sp < nsteps; sp += 2) {
                ATT_ISSUE(sp + 2, kA0, kA1, vA0, vA1);
                ATT_STEP(sp, 0);
                ATT_WRITE(1, kB0, kB1, vB0, vB1);
                __syncthreads();
                if (sp + 1 < nsteps) {
                    ATT_ISSUE(sp + 3, kB0, kB1, vB0, vB1);
                    ATT_STEP(sp + 1, 1);
                    ATT_WRITE(0, kA0, kA1, vA0, vA1);
                    __syncthreads();
                }
            }
#undef ATT_ISSUE
#undef ATT_WRITE
#undef ATT_STEP
            const float ltot = add_xor32(lrun), inv = 1.f / ltot;
            bf16_t* op = O + qtok * DM + h * 64;
#pragma unroll
            for (int g = 0; g < 4; ++g) {
                u32x2 w; w.x = pk2(o0[4 * g] * inv, o0[4 * g + 1] * inv); w.y = pk2(o0[4 * g + 2] * inv, o0[4 * g + 3] * inv);
                *(u32x2*)(op + 8 * g + 4 * hh) = w;
                u32x2 w2; w2.x = pk2(o1[4 * g] * inv, o1[4 * g + 1] * inv); w2.y = pk2(o1[4 * g + 2] * inv, o1[4 * g + 3] * inv);
                *(u32x2*)(op + 32 + 8 * g + 4 * hh) = w2;
            }
        }
    }
}
#undef ATT_TILE
#undef ATT_TILE2


constexpr int N_PHASES = 23;
constexpr int C0A = 3400, C0B = 5400, C0C = 6500, C0D = 7900;
constexpr int C1P = 920, C1Q = 5220, C1R = 6120, C2A = 2500;
#ifndef PROBE_LO
#define PROBE_LO 99
#define PROBE_HI (-1)
#endif
__host__ __device__ constexpr int nrep(int k) { return (k >= PROBE_LO && k <= PROBE_HI) ? 2 : 1; }
__global__ void __launch_bounds__(512, 2) fwd_kernel(Params p) {
    extern __shared__ __attribute__((aligned(16))) unsigned char lds_raw[];
    LAS unsigned char* lds = (LAS unsigned char*)lds_raw;
    const int wave0 = __builtin_amdgcn_readfirstlane((int)(threadIdx.x >> 6));
    for (int u = threadIdx.x; u < (LDS_BYTES - MISC_OFF) / 4; u += 512) ((LAS unsigned*)(lds + MISC_OFF))[u] = 0u;
    __syncthreads();
    XcdBarrier bar; bar.bar = (unsigned*)(p.ws + WS_CTL) + 4096; bar.x = 0; bar.st = (volatile LAS unsigned*)(lds + MISC_OFF + M_BAR);
    if (p.ph_hi - p.ph_lo > 1) bar = xcd_barrier_post((unsigned*)(p.ws + WS_CTL) + 4096, (volatile LAS unsigned*)(lds + MISC_OFF + M_BAR));
#define PH(k) (p.ph_lo <= (k) && (k) < p.ph_hi)
#define SEAM(k) do { if (PH(k) && PH((k) + 1)) xcd_barrier(bar, wave0); } while (0)
#define RUN(k, ...) do { if (PH(k)) { _Pragma("unroll") for (int rep_ = 0; rep_ < nrep(k); ++rep_) { const float rs_ = rep_ == 0 ? 1.f : 0.f; (void)rs_; { __VA_ARGS__ } if (rep_ + 1 < nrep(k)) xcd_barrier(bar, wave0); } } SEAM(k); } while (0)
#define RUNL(k, lok_, ...) do { if (PH(k)) { _Pragma("unroll") for (int rep_ = 0; rep_ < nrep(k); ++rep_) { const float rs_ = rep_ == 0 ? 1.f : 0.f; (void)rs_; { __VA_ARGS__ } if (rep_ + 1 < nrep(k)) xcd_barrier(bar, wave0); } } \
        if (PH(k) && PH((k) + 1)) { if (lok_) { __builtin_amdgcn_fence(__ATOMIC_RELEASE, "workgroup"); __syncthreads(); __builtin_amdgcn_fence(__ATOMIC_ACQUIRE, "workgroup"); } else xcd_barrier(bar, wave0); } } while (0)
    unsigned char* ws = p.ws;
    const float* MOD = (const float*)(ws + WS_MOD);

    RUN(0, const Ctx X = mkctx(lds, wave0); phase_p0a(X, p););
    RUN(1, const Ctx X = mkctx(lds, wave0); phase_norm<0>(X, p, 0, 0, NTOK); phase_p0b(X, p););
    RUN(2,
        g8::RectSched S{72, 8, (int)gridDim.x, (int)blockIdx.x, 0u, 2048u, (const char*)(ws + WS_WIN), 2048u};
        EpiWin E{(bf16_t*)(ws + WS_A2), (bf16_t*)(ws + WS_BCV)};
        g8::gemm_phase(lds, wave0, (const char*)(ws + WS_XA), 1024, 2048u, S, E);
        { const Ctx X = mkctx(lds, wave0); int nidle; const int rk = idle_rank(576, X.G, X.blk, nidle);
          if (rk >= 0) { conv_small(X, p, rk, nidle); conv_moe_items<0>(X, p, 0, (bf16_t*)(ws + WS_GU), (bf16_t*)(ws + WS_DN), 0, C0A, rk, nidle); } });
    RUN(3,
        g8::BatchSched S{32, 3, 1, (int)gridDim.x, (int)blockIdx.x, 1536u, (const char*)(ws + WS_WF), 1024u, 256};
        EpiS5F E{(float*)(ws + WS_F)};
        g8::gemm_phase(lds, wave0, (const char*)(ws + WS_A2), 512, 1024u, S, E);
        { const Ctx X = mkctx(lds, wave0); int nidle; const int rk = moe_idle_rank(96, 1, X.G, X.blk, nidle);
          if (rk >= 0) conv_moe_items<0>(X, p, 0, (bf16_t*)(ws + WS_GU), (bf16_t*)(ws + WS_DN), C0A, C0B, rk, nidle); });
    RUN(4, const Ctx X = mkctx(lds, wave0); phase_scan_conv(X, p););
    RUN(5,
        g8::BatchSched S{32, 3, 2, (int)gridDim.x, (int)blockIdx.x, 1536u, (const char*)(ws + WS_ME), 1536u, 512};
        EpiS5Y E{(bf16_t*)(ws + WS_G)};
        g8::gemm_phase(lds, wave0, (const char*)(ws + WS_A2), 768, 1536u, S, E);
        { const Ctx X = mkctx(lds, wave0); int nidle; const int rk = moe_idle_rank(96, 2, X.G, X.blk, nidle);
          if (rk >= 0) conv_moe_items<0>(X, p, 0, (bf16_t*)(ws + WS_GU), (bf16_t*)(ws + WS_DN), C0B, C0C, rk, nidle); });
    RUN(6,
        g8::RectSched S{72, 2, (int)gridDim.x, (int)blockIdx.x, 0u, 1024u, (const char*)(ws + WS_GLU), 1024u};
        EpiGlu E{(const bf16_t*)(ws + WS_G), p.in[I_GLUB], (bf16_t*)(ws + WS_Z)};
        g8::gemm_phase(lds, wave0, (const char*)(ws + WS_G), 512, 1024u, S, E);
        { const Ctx X = mkctx(lds, wave0); int nidle; const int rk = idle_rank(144, X.G, X.blk, nidle);
          if (rk >= 0) conv_moe_items<0>(X, p, 0, (bf16_t*)(ws + WS_GU), (bf16_t*)(ws + WS_DN), C0C, C0D, rk, nidle); });
    RUN(7,
        g8::RectSched S{72, 4, (int)gridDim.x, (int)blockIdx.x, 0u, 2048u, (const char*)(ws + WS_HOUT), 2048u};
        EpiResid E{MOD + 2 * 1024, (bf16_t*)(ws + WS_XR), rs_};
        g8::gemm_phase(lds, wave0, (const char*)(ws + WS_Z), 1024, 2048u, S, E);
        { const Ctx X = mkctx(lds, wave0); int nidle; const int rk = idle_rank(288, X.G, X.blk, nidle);
          if (rk >= 0) { conv_moe_items<0>(X, p, 0, (bf16_t*)(ws + WS_GU), (bf16_t*)(ws + WS_DN), C0D, 12480, rk, nidle);
                         conv_moe_items<1>(X, p, 1, (bf16_t*)(ws + WS_GU1), nullptr, 0, C1P, rk, nidle); } });
#define MOE_PHASES(P0, L, NTOKL, FINAL) \
      \
    RUNL(P0, (8 * ((NTOKL + 8 * (int)gridDim.x - 1) / (8 * (int)gridDim.x)) == (NTOKL + (int)gridDim.x - 1) / (int)gridDim.x), const Ctx X = mkctx(lds, wave0); phase_norm<1>(X, p, L, 1, NTOKL);); \
    RUN(P0 + 1, const Ctx X = mkctx(lds, wave0); phase_route(X, p, L, NTOKL);); \
    RUN(P0 + 2, const Ctx X = mkctx(lds, wave0); phase_slots(X, p, NTOKL);); \
    RUN(P0 + 3, \
        const Ctx X = mkctx(lds, wave0); const int ntiles = load_tiles(X, p); \
        g8::MoeSched<true> S{ntiles, 2, (int)gridDim.x, (int)blockIdx.x, 2048u, (const char*)(ws + (L == 0 ? WS_GU : WS_GU1)), 2048u, 512, 0, 128, lds + MISC_OFF + M_TILE, (const int*)(ws + WS_ROWIDX)}; \
        EpiGU E{(bf16_t*)(ws + WS_ACT)}; \
        g8::gemm_phase(lds, wave0, (const char*)(ws + WS_XA), 1024, 2048u, S, E); \
        { const Ctx X2 = mkctx(lds, wave0); int nidle; const int rk = moe_idle_rank(ntiles, 2, X2.G, X2.blk, nidle);        \
          if (rk >= 0) { if (L == 0) conv_moe_items<1>(X2, p, 1, (bf16_t*)(ws + WS_GU1), nullptr, C1P, C1Q, rk, nidle); \
                         else conv_moe_items<2>(X2, p, 1, nullptr, (bf16_t*)(ws + WS_DN), C2A, 4160, rk, nidle); } }); \
    RUN(P0 + 4, \
        const Ctx X = mkctx(lds, wave0); const int ntiles = load_tiles(X, p); \
        g8::MoeSched<false> S{ntiles, 4, (int)gridDim.x, (int)blockIdx.x, 512u, (const char*)(ws + WS_DN), 512u, 1024, 0, 256, lds + MISC_OFF + M_TILE, nullptr}; \
        EpiDN E{(unsigned char*)(ws + WS_Y)}; \
        g8::gemm_phase(lds, wave0, (const char*)(ws + WS_ACT), 256, 512u, S, E); \
        { const Ctx X2 = mkctx(lds, wave0); int nidle; const int rk = moe_idle_rank(ntiles, 4, X2.G, X2.blk, nidle); \
          if (rk >= 0 && L == 0) conv_moe_items<1>(X2, p, 1, (bf16_t*)(ws + WS_GU1), nullptr, C1Q, C1R, rk, nidle); }); \
    RUN(P0 + 5, const Ctx X = mkctx(lds, wave0); phase_combine<!FINAL>(X, p, L, NTOKL, FINAL, 1.f););

    MOE_PHASES(8, 0, NTOK, false)
    RUN(14,
        g8::QkvSched S{(int)gridDim.x, (int)blockIdx.x, 2048u, (const char*)(ws + WS_QKV), 2048u};
        EpiQKV E{(bf16_t*)(ws + WS_Q), (bf16_t*)(ws + WS_K), (bf16_t*)(ws + WS_VT), p.in[I_QG], p.in[I_KG]};
        g8::gemm_phase(lds, wave0, (const char*)(ws + WS_ACT), 1024, 2048u, S, E);
        { const Ctx X = mkctx(lds, wave0); int nidle; const int rk = idle_rank(832, X.G, X.blk, nidle);
          if (rk >= 0) { conv_moe_items<1>(X, p, 1, (bf16_t*)(ws + WS_GU1), nullptr, C1R, 8320, rk, nidle);
                         conv_moe_items<2>(X, p, 1, nullptr, (bf16_t*)(ws + WS_DN), 0, C2A, rk, nidle); } });
    RUN(15, const Ctx X = mkctx(lds, wave0); phase_attn(X, p););
    RUN(16,
        g8::RectSched S{64, 4, (int)gridDim.x, (int)blockIdx.x, 0u, 2048u, (const char*)(ws + WS_NOUT), 2048u};
        EpiResid E{MOD + 9 * 6144 + 2 * 1024, (bf16_t*)(ws + WS_XR), rs_};
        g8::gemm_phase(lds, wave0, (const char*)(ws + WS_O), 1024, 2048u, S, E););
    MOE_PHASES(17, 1, NLAT, true)
#undef PH
#undef SEAM
#undef RUN
}

extern "C" void kernel_launch(void* const* d_in, const int* in_sizes, int n_in, void* d_out, int out_size, void* d_ws, size_t ws_size, hipStream_t stream) {
    static int grid = 0;
    if (grid == 0) {
        int dev = 0, cus = 0, per_cu = 0;
        if (n_in != 34 || ws_size < WS_END) { fprintf(stderr, "kernel_launch: unexpected inputs (n_in %d, ws %zu, need %zu)\n", n_in, ws_size, (size_t)WS_END); grid = -1; return; }
        if (hipGetDevice(&dev) != hipSuccess || hipDeviceGetAttribute(&cus, hipDeviceAttributeMultiprocessorCount, dev) != hipSuccess) { grid = -1; return; }
        if (hipFuncSetAttribute((const void*)fwd_kernel, hipFuncAttributeMaxDynamicSharedMemorySize, LDS_BYTES) != hipSuccess) { fprintf(stderr, "kernel_launch: hipFuncSetAttribute failed\n"); grid = -1; return; }
        if (hipOccupancyMaxActiveBlocksPerMultiprocessor(&per_cu, (const void*)fwd_kernel, 512, LDS_BYTES) != hipSuccess || per_cu < 1) { fprintf(stderr, "kernel_launch: occupancy query says %d\n", per_cu); }
        (void)hipGetLastError();
        grid = cus;
    }
    if (grid < 0) return;
    (void)hipMemsetAsync((char*)d_ws + WS_CTL, 0, 64 * 1024, stream);
    Params p{};
    for (int i = 0; i < 34; ++i) p.in[i] = (const float*)d_in[i];
    p.out = (float*)d_out; p.ws = (unsigned char*)d_ws;
#if MK_ONE_LAUNCH
    p.ph_lo = 0; p.ph_hi = N_PHASES;
    hipLaunchKernelGGL(fwd_kernel, dim3(grid), dim3(512), LDS_BYTES, stream, p);
#else
    for (int k = 0; k < N_PHASES; ++k) { p.ph_lo = k; p.ph_hi = k + 1; hipLaunchKernelGGL(fwd_kernel, dim3(grid), dim3(512), LDS_BYTES, stream, p); }
#endif
}
```
